# Optimizing an MI355X kernel written in HIP

```python
import jax, jax.numpy as jnp
from jax import lax
import numpy as np

D_MODEL = 1024
BATCH = 2
SEQ = 16384
DEPTH = 2

GRID_W = 64
CTX_LEN = 256
N_MOD = 6
EPS = 1e-6
ROPE_THETA = 10000.0
BLOCK = 128
CONV_DIM = 512
MLA_HEADS = 8
MLA_Q_LORA = 256
MLA_KV_LORA = 128
MLA_NOPE = 64
MLA_ROPE = 32
MLA_V = 64
SWA_HEADS = 16
SWA_KV_HEADS = 4
SWA_HEAD_DIM = 64
WINDOW = 128
N_EXPERTS = 16
EC_CAPACITY = 2
D_FF_EXPERT = 1024
AB_SPLITS = [CONV_DIM, 2 * CONV_DIM, 3 * CONV_DIM, 3 * CONV_DIM + MLA_Q_LORA, 3 * CONV_DIM + MLA_Q_LORA + MLA_KV_LORA]
AB_IN = 3 * CONV_DIM + MLA_Q_LORA + MLA_KV_LORA + MLA_ROPE
AB_OUT = CONV_DIM + MLA_HEADS * MLA_V
SWA_QKV = (SWA_HEADS + 2 * SWA_KV_HEADS) * SWA_HEAD_DIM
N_EVEN = (DEPTH + 1) // 2
N_ODD = DEPTH // 2

kernel_name = "hybrid_dit_conv_mla_swa_ecmoe"


def rms_norm(x, g):
    xf = x.astype(jnp.float32)
    y = xf * lax.rsqrt(jnp.mean(xf * xf, axis=-1, keepdims=True) + EPS)
    return (y * g.astype(jnp.float32)).astype(x.dtype)


def modulate(z, shift, scale):
    return z * (1 + scale) + shift


def axial_rope_tables(row, col, dim):
    half = dim // 2
    freqs = ROPE_THETA ** (-jnp.arange(0, half, 2, dtype=jnp.float32) / half)
    ang = jnp.concatenate([row[:, None] * freqs, col[:, None] * freqs], axis=-1)
    return jnp.cos(ang), jnp.sin(ang)


def apply_axial_rope(x, cos, sin):
    b, n, h, d = x.shape
    q = d // 4
    xr = x.astype(jnp.float32).reshape(b, n, h, 2, 2, q)
    x1, x2 = xr[..., 0, :], xr[..., 1, :]
    c = cos.reshape(n, 1, 2, q)
    s = sin.reshape(n, 1, 2, q)
    out = jnp.stack([x1 * c - x2 * s, x1 * s + x2 * c], axis=-2)
    return out.reshape(b, n, h, d).astype(x.dtype)


def softmax_attend(q, k, v, scale):
    s = jnp.einsum('bqhd,bkhd->bhqk', q, k).astype(jnp.float32) * scale
    p = jax.nn.softmax(s, axis=-1).astype(v.dtype)
    return jnp.einsum('bhqk,bkhd->bqhd', p, v)


def blocked_dense_attend(q, k, v, scale):
    b, n, h, dk = q.shape
    nb = n // BLOCK
    qb = jnp.moveaxis(q.reshape(b, nb, BLOCK, h, dk), 1, 0)
    ob = lax.map(lambda qi: softmax_attend(qi, k, v, scale), qb)
    return jnp.moveaxis(ob, 0, 1).reshape(b, n, h * v.shape[-1])


def short_conv_mixer(gate_b, gate_c, u, conv_w, conv_b):
    z = gate_c * u
    zp = jnp.pad(z, ((0, 0), (1, 1), (0, 0)))
    y = zp[:, :-2] * conv_w[0] + zp[:, 1:-1] * conv_w[1] + zp[:, 2:] * conv_w[2] + conv_b
    return gate_b * y


def mla_qkv(q_lat, kv_lat, k_rope, q_norm_g, w_uq, kv_norm_g, w_ukv, rope):
    b, n, _ = q_lat.shape
    q = (rms_norm(q_lat, q_norm_g) @ w_uq).reshape(b, n, MLA_HEADS, MLA_NOPE + MLA_ROPE)
    kv = (rms_norm(kv_lat, kv_norm_g) @ w_ukv).reshape(b, n, MLA_HEADS, MLA_NOPE + MLA_V)
    q_nope, q_rot = q[..., :MLA_NOPE], q[..., MLA_NOPE:]
    k_nope, v = kv[..., :MLA_NOPE], kv[..., MLA_NOPE:]
    k_rot = k_rope[:, :, None, :]
    if rope is not None:
        q_rot = apply_axial_rope(q_rot, *rope)
        k_rot = apply_axial_rope(k_rot, *rope)
    q = jnp.concatenate([q_nope, q_rot], axis=-1)
    k = jnp.concatenate([k_nope, jnp.broadcast_to(k_rot, (b, n, MLA_HEADS, MLA_ROPE))], axis=-1)
    return q, k, v


def mixer_conv_mla(h, hc, w_in, conv_w, conv_b, q_norm_g, w_uq, kv_norm_g, w_ukv, w_out, rope, need_ctx):
    b, n, _ = h.shape
    scale = (MLA_NOPE + MLA_ROPE) ** -0.5
    gb, gc, u, ql, kvl, kr = jnp.split(h @ w_in, AB_SPLITS, axis=-1)
    gbc, gcc, uc, qlc, kvlc, krc = jnp.split(hc @ w_in, AB_SPLITS, axis=-1)
    q, k, v = mla_qkv(ql, kvl, kr, q_norm_g, w_uq, kv_norm_g, w_ukv, rope)
    qc, kc, vc = mla_qkv(qlc, kvlc, krc, q_norm_g, w_uq, kv_norm_g, w_ukv, None)
    att = blocked_dense_attend(q, jnp.concatenate([kc, k], axis=1), jnp.concatenate([vc, v], axis=1), scale)
    y = jnp.concatenate([short_conv_mixer(gb, gc, u, conv_w, conv_b), att], axis=-1) @ w_out
    if not need_ctx:
        return y, None
    att_c = softmax_attend(qc, kc, vc, scale).reshape(b, hc.shape[1], MLA_HEADS * MLA_V)
    yc = jnp.concatenate([short_conv_mixer(gbc, gcc, uc, conv_w, conv_b), att_c], axis=-1) @ w_out
    return y, yc


def mixer_window_gqa(h, hc, w_qkv, sink, w_out, rope, need_ctx):
    b, n, _ = h.shape
    hd, kvh = SWA_HEAD_DIM, SWA_KV_HEADS
    grp = SWA_HEADS // kvh
    scale = hd ** -0.5

    def qkv(z):
        L = z.shape[1]
        p = z @ w_qkv
        q = p[..., :SWA_HEADS * hd].reshape(b, L, SWA_HEADS, hd)
        k = p[..., SWA_HEADS * hd:(SWA_HEADS + kvh) * hd].reshape(b, L, kvh, hd)
        v = p[..., (SWA_HEADS + kvh) * hd:].reshape(b, L, kvh, hd)
        return q, k, v

    q, k, v = qkv(h)
    qc, kc, vc = qkv(hc)
    L_ctx = hc.shape[1]
    q = apply_axial_rope(q, *rope).reshape(b, n, kvh, grp, hd)
    k = apply_axial_rope(k, *rope)
    sink_l = sink.astype(jnp.float32).reshape(kvh, grp)
    kp = jnp.pad(k, ((0, 0), (BLOCK, BLOCK), (0, 0), (0, 0)))
    vp = jnp.pad(v, ((0, 0), (BLOCK, BLOCK), (0, 0), (0, 0)))
    r = jnp.arange(BLOCK, dtype=jnp.int32)
    s = jnp.arange(3 * BLOCK, dtype=jnp.int32)

    def block(args):
        qi, i = args
        start = i * BLOCK
        kb = lax.dynamic_slice_in_dim(kp, start, 3 * BLOCK, axis=1)
        vb = lax.dynamic_slice_in_dim(vp, start, 3 * BLOCK, axis=1)
        qpos = start + r
        kpos = start - BLOCK + s
        valid = (jnp.abs(qpos[:, None] - kpos[None, :]) <= WINDOW) & (kpos[None, :] >= 0) & (kpos[None, :] < n)
        s_loc = jnp.einsum('bqkgd,bskd->bkgqs', qi, kb).astype(jnp.float32) * scale
        s_loc = jnp.where(valid, s_loc, -1e30)
        s_ctx = jnp.einsum('bqkgd,bskd->bkgqs', qi, kc).astype(jnp.float32) * scale
        sink_col = jnp.broadcast_to(sink_l[None, :, :, None, None], (b, kvh, grp, BLOCK, 1))
        p = jax.nn.softmax(jnp.concatenate([s_ctx, s_loc, sink_col], axis=-1), axis=-1).astype(v.dtype)
        return (jnp.einsum('bkgqs,bskd->bqkgd', p[..., :L_ctx], vc)
                + jnp.einsum('bkgqs,bskd->bqkgd', p[..., L_ctx:L_ctx + 3 * BLOCK], vb))

    nb = n // BLOCK
    qb = jnp.moveaxis(q.reshape(b, nb, BLOCK, kvh, grp, hd), 1, 0)
    ob = lax.map(block, (qb, jnp.arange(nb, dtype=jnp.int32)))
    y = jnp.moveaxis(ob, 0, 1).reshape(b, n, SWA_HEADS * hd) @ w_out
    if not need_ctx:
        return y, None
    qc = qc.reshape(b, L_ctx, kvh, grp, hd)
    sc = jnp.einsum('bqkgd,bskd->bkgqs', qc, kc).astype(jnp.float32) * scale
    sink_c = jnp.broadcast_to(sink_l[None, :, :, None, None], (b, kvh, grp, L_ctx, 1))
    pc = jax.nn.softmax(jnp.concatenate([sc, sink_c], axis=-1), axis=-1)[..., :L_ctx].astype(vc.dtype)
    yc = jnp.einsum('bkgqs,bskd->bqkgd', pc, vc).reshape(b, L_ctx, SWA_HEADS * hd) @ w_out
    return y, yc


def ec_moe(h, router_w, w_gate, w_up, w_down):
    b, n, _ = h.shape
    cap = max(1, (EC_CAPACITY * n) // N_EXPERTS)
    aff = jax.nn.softmax(jnp.einsum('bnd,de->bne', h, router_w).astype(jnp.float32), axis=-1)
    g, idx = lax.top_k(jnp.swapaxes(aff, 1, 2), cap)
    bidx = jnp.arange(b)[:, None, None]
    xg = h[bidx, idx]
    hid = jax.nn.silu(jnp.einsum('becd,edf->becf', xg, w_gate)) * jnp.einsum('becd,edf->becf', xg, w_up)
    ye = jnp.einsum('becf,efd->becd', hid, w_down) * g[..., None].astype(h.dtype)
    return jnp.zeros_like(h).at[bidx, idx].add(ye)


def setup_inputs(seed: int = 0) -> dict:
    key = jax.random.key(seed)
    ks = jax.random.split(key, 32)
    nrm = jax.random.normal
    D, F, E = D_MODEL, D_FF_EXPERT, N_EXPERTS
    f32 = jnp.float32
    return {
        "x": nrm(ks[0], (BATCH, SEQ, D), f32),
        "c": nrm(ks[1], (BATCH, D), f32),
        "ctx": nrm(ks[2], (BATCH, CTX_LEN, D), f32),
        "c_ctx": nrm(ks[3], (D,), f32),
        "mod_w": nrm(ks[4], (DEPTH, D, N_MOD * D), f32) * (0.5 * D ** -0.5),
        "mod_b": nrm(ks[5], (DEPTH, N_MOD * D), f32) * 0.01,
        "norm1_g": 1.0 + 0.01 * nrm(ks[6], (DEPTH, D), f32),
        "norm2_g": 1.0 + 0.01 * nrm(ks[7], (DEPTH, D), f32),
        "ab_w_in": nrm(ks[8], (N_EVEN, D, AB_IN), f32) * D ** -0.5,
        "conv_w": nrm(ks[9], (N_EVEN, 3, CONV_DIM), f32) * 3 ** -0.5,
        "conv_b": nrm(ks[10], (N_EVEN, CONV_DIM), f32) * 0.01,
        "mla_q_norm_g": 1.0 + 0.01 * nrm(ks[11], (N_EVEN, MLA_Q_LORA), f32),
        "mla_w_uq": nrm(ks[12], (N_EVEN, MLA_Q_LORA, MLA_HEADS * (MLA_NOPE + MLA_ROPE)), f32) * MLA_Q_LORA ** -0.5,
        "mla_kv_norm_g": 1.0 + 0.01 * nrm(ks[13], (N_EVEN, MLA_KV_LORA), f32),
        "mla_w_ukv": nrm(ks[14], (N_EVEN, MLA_KV_LORA, MLA_HEADS * (MLA_NOPE + MLA_V)), f32) * MLA_KV_LORA ** -0.5,
        "ab_w_out": nrm(ks[15], (N_EVEN, AB_OUT, D), f32) * AB_OUT ** -0.5,
        "swa_w_qkv": nrm(ks[16], (N_ODD, D, SWA_QKV), f32) * D ** -0.5,
        "swa_sink": nrm(ks[17], (N_ODD, SWA_HEADS), f32) * 0.5,
        "swa_w_out": nrm(ks[18], (N_ODD, SWA_HEADS * SWA_HEAD_DIM, D), f32) * (SWA_HEADS * SWA_HEAD_DIM) ** -0.5,
        "router_w": nrm(ks[19], (DEPTH, D, E), f32) * D ** -0.5,
        "exp_w_gate": nrm(ks[20], (DEPTH, E, D, F), f32) * D ** -0.5,
        "exp_w_up": nrm(ks[21], (DEPTH, E, D, F), f32) * D ** -0.5,
        "exp_w_down": nrm(ks[22], (DEPTH, E, F, D), f32) * F ** -0.5,
        "final_g": 1.0 + 0.01 * nrm(ks[23], (D,), f32),
    }


def reference(x, c, ctx, c_ctx, mod_w, mod_b, norm1_g, norm2_g, ab_w_in, conv_w, conv_b,
              mla_q_norm_g, mla_w_uq, mla_kv_norm_g, mla_w_ukv, ab_w_out, swa_w_qkv, swa_sink,
              swa_w_out, router_w, exp_w_gate, exp_w_up, exp_w_down, final_g):
    n = x.shape[1]
    n_rows = n // GRID_W
    row = jnp.repeat(jnp.arange(n_rows, dtype=jnp.float32), GRID_W)
    col = jnp.tile(jnp.arange(GRID_W, dtype=jnp.float32), n_rows)
    rope_mla = axial_rope_tables(row, col, MLA_ROPE)
    rope_swa = axial_rope_tables(row, col, SWA_HEAD_DIM)

    xs, xc = x, ctx
    for layer in range(DEPTH):
        need_ctx = layer < DEPTH - 1
        mod = jax.nn.silu(c) @ mod_w[layer] + mod_b[layer]
        sh1, sc1, g1, sh2, sc2, g2 = jnp.split(mod[:, None, :], N_MOD, axis=-1)
        modc = jax.nn.silu(c_ctx) @ mod_w[layer] + mod_b[layer]
        csh1, csc1, cg1, csh2, csc2, cg2 = jnp.split(modc, N_MOD, axis=-1)

        h = modulate(rms_norm(xs, norm1_g[layer]), sh1, sc1)
        hc = modulate(rms_norm(xc, norm1_g[layer]), csh1, csc1)
        if layer % 2 == 0:
            e = layer // 2
            y, yc = mixer_conv_mla(h, hc, ab_w_in[e], conv_w[e], conv_b[e], mla_q_norm_g[e], mla_w_uq[e],
                                   mla_kv_norm_g[e], mla_w_ukv[e], ab_w_out[e], rope_mla, need_ctx)
        else:
            o = layer // 2
            y, yc = mixer_window_gqa(h, hc, swa_w_qkv[o], swa_sink[o], swa_w_out[o], rope_swa, need_ctx)
        xs = xs + g1 * y

        h2 = modulate(rms_norm(xs, norm2_g[layer]), sh2, sc2)
        xs = xs + g2 * ec_moe(h2, router_w[layer], exp_w_gate[layer], exp_w_up[layer], exp_w_down[layer])
        if need_ctx:
            xc = xc + cg1 * yc
            hc2 = modulate(rms_norm(xc, norm2_g[layer]), csh2, csc2)
            xc = xc + cg2 * ec_moe(hc2, router_w[layer], exp_w_gate[layer], exp_w_up[layer], exp_w_down[layer])
    return rms_norm(xs, final_g)
```

```cpp
#include <hip/hip_runtime.h>
#include <hip/hip_bf16.h>
#include <cstdio>
#include <cstdint>

typedef unsigned short bf16_t;

constexpr int NB = 2, SEQ = 16384, DM = 1024, CTX = 256;
constexpr int NLAT = NB * SEQ;
constexpr int NCTX = NB * CTX;
constexpr int NROW = NLAT + NCTX;
constexpr int NKEY = CTX + SEQ;
constexpr int AB_IN = 1952, PPITCH = 2048;
constexpr int NE = 16, CAP_L = 2048, CAP_C = 32, DFF = 1024;
constexpr int NMOD = 6 * DM;
constexpr float EPS = 1e-6f;
constexpr float LOG2E = 1.4426950408889634f;
constexpr float QF8_SCALE = 16.f;

constexpr size_t al256(size_t x) { return (x + 255) / 256 * 256; }
constexpr size_t CTL_BYTES = 65536;
constexpr size_t WS_CTL  = 0;
constexpr size_t WS_MODV = WS_CTL + CTL_BYTES;
constexpr size_t WS_ROPE = WS_MODV + al256(2 * 3 * NMOD * 4);
constexpr size_t WS_XC   = WS_ROPE + al256(256 * 48 * 4);
constexpr size_t WS_AFF  = WS_XC + al256((size_t)NCTX * DM * 4);
constexpr size_t WS_SIDX = WS_AFF + al256((size_t)(NB * NE * SEQ + NB * NE * CTX) * 4);
constexpr size_t WS_SG   = WS_SIDX + al256((size_t)(NB * NE * CAP_L + NB * NE * CAP_C) * 4);
constexpr size_t WS_SLOT = WS_SG + al256((size_t)(NB * NE * CAP_L + NB * NE * CAP_C) * 4);
constexpr size_t WS_HB   = WS_SLOT + al256((size_t)(NB * NE * SEQ + NB * NE * CTX) * 4);
constexpr size_t MOE_ROWS = (size_t)NB * NE * CAP_L + NB * NE * CAP_C;
constexpr size_t WS_PB   = WS_HB + al256((size_t)NROW * DM * 2);
constexpr size_t WS_QN   = WS_PB + al256(MOE_ROWS * DM * 2 + (1u << 20));
constexpr size_t WS_KVN  = WS_QN + al256((size_t)NROW * 256 * 2);
constexpr size_t WS_QKV  = WS_KVN + al256((size_t)NROW * 128 * 2);
constexpr size_t QKV_BYTES = MOE_ROWS * DM * 2;
constexpr size_t WS_W    = WS_QKV + al256(QKV_BYTES);
constexpr size_t WS_CAT  = WS_HB;
constexpr size_t OFF_WIN = 0;
constexpr size_t OFF_WUP = OFF_WIN + (size_t)2048 * 1024 * 2;
constexpr size_t OFF_WOUT = OFF_WUP + al256((size_t)1792 * 384 * 2);
constexpr size_t OFF_WQKV = OFF_WOUT + (size_t)1024 * 1024 * 2;
constexpr size_t OFF_WSO = OFF_WQKV + (size_t)1536 * 1024 * 2;
constexpr size_t OFF_WGU = OFF_WSO + (size_t)1024 * 1024 * 2;
constexpr size_t OFF_WD  = OFF_WGU + (size_t)16 * 2048 * 1024;
constexpr size_t OFF_WQKV8 = OFF_WD + (size_t)16 * 1024 * 1024;
constexpr size_t WS_XSB  = WS_W + OFF_WQKV8 + (size_t)1536 * 1024;
constexpr size_t WS_END  = WS_XSB + (size_t)NLAT * DM * 2;
constexpr size_t OFF_Q  = 0;
constexpr size_t OFF_QC = OFF_Q + (size_t)NB * 8 * SEQ * 96 * 2;
constexpr size_t OFF_K  = OFF_QC + (size_t)NB * 8 * CTX * 96 * 2;
constexpr size_t OFF_V  = OFF_K + (size_t)NB * 8 * NKEY * 96 * 2;
static_assert(OFF_V + (size_t)NB * 8 * NKEY * 64 * 2 <= QKV_BYTES, "qkv region");
constexpr size_t OFF_Q2 = 0;
constexpr size_t OFF_K2 = OFF_Q2 + (size_t)NB * 16 * SEQ * 64 * 2;
constexpr size_t OFF_V2 = OFF_K2 + (size_t)NB * 4 * NKEY * 64 * 2;
static_assert(OFF_V2 + (size_t)NB * 4 * NKEY * 64 * 2 <= QKV_BYTES, "qkv2 region");

__device__ __forceinline__ float bf2f(bf16_t v) { return __uint_as_float(((unsigned)v) << 16); }
__device__ __forceinline__ bf16_t f2bf(float f) { unsigned u = __float_as_uint(f); u += 0x7FFFu + ((u >> 16) & 1u); return (bf16_t)(u >> 16); }
__device__ __forceinline__ float silu_f(float x) { return x * __builtin_amdgcn_rcpf(1.f + __builtin_amdgcn_exp2f(x * -1.44269504088896f)); }

__device__ __forceinline__ float block_sum(float v, float* red) {
  for (int d = 32; d > 0; d >>= 1) v += __shfl_xor(v, d, 64);
  __syncthreads();
  if ((threadIdx.x & 63) == 0) red[threadIdx.x >> 6] = v;
  __syncthreads();
  float s = 0.f;
  for (int i = 0; i < (int)(blockDim.x >> 6); ++i) s += red[i];
  return s;
}

#define LAS __attribute__((address_space(3)))
typedef short bf16x8 __attribute__((ext_vector_type(8)));
typedef float f32x4 __attribute__((ext_vector_type(4)));
typedef unsigned u32x4 __attribute__((ext_vector_type(4)));
typedef unsigned u32x2 __attribute__((ext_vector_type(2)));

constexpr int NTHREADS = 512;
constexpr int RING_BYTES = 131072;
constexpr int LDS_MISC = RING_BYTES;
constexpr int LDS_BYTES = RING_BYTES + 1024;
__device__ __forceinline__ int my_tid() {
    extern __shared__ __attribute__((aligned(16))) unsigned char lds_raw[];
    const unsigned key = (unsigned)__builtin_amdgcn_s_getreg(0x2804) & 63u;
    const int w = __builtin_amdgcn_readfirstlane((int)((const LAS unsigned*)((LAS unsigned char*)lds_raw + LDS_MISC + 512))[key]);
    return w * 64 + (int)__builtin_amdgcn_mbcnt_hi(~0u, __builtin_amdgcn_mbcnt_lo(~0u, 0u));
}

struct Params { const float* in[24]; float* out; unsigned char* ws; int ph_lo, ph_hi; };

__device__ __forceinline__ unsigned pk4fp8(float a, float b, float c, float d) { unsigned r;
  asm("v_cvt_pk_fp8_f32 %0, %1, %2" : "=v"(r) : "v"(a), "v"(b)); asm("v_cvt_pk_fp8_f32 %0, %1, %2 op_sel:[0,0,1]" : "+v"(r) : "v"(c), "v"(d)); return r; }
__device__ __forceinline__ unsigned char f2fp8(float x) { return (unsigned char)((unsigned)__builtin_amdgcn_cvt_pk_fp8_f32(x, 0.f, 0, false) & 0xffu); }
__device__ __forceinline__ unsigned pk2bf(float lo, float hi) { return (unsigned)f2bf(lo) | ((unsigned)f2bf(hi) << 16); }
#if defined(PROBE_FP8ATT) || defined(PROBE_RND)
__device__ __forceinline__ float fp8rt(float x, float sc) { const unsigned r = (unsigned)__builtin_amdgcn_cvt_pk_fp8_f32(x * sc, 0.f, 0, false); return __builtin_amdgcn_cvt_f32_fp8((int)r, 0) * (1.f / sc); }
#endif

#define XB_TMO      128
#define XB_XCNT(j)  (256  + 64 * (j))
#define XB_XSUB(j)  (1280 + 64 * (j))
#define XB_XGEN(j)  (2304 + 64 * (j))
#define XB_TOP      3328
#define XB_TOPGEN   3392
#define XCD_BAR_WORDS 3456
#define XB_SPIN_CAP (1u << 18)
__device__ __forceinline__ unsigned xb_ld(unsigned* p)              { return __hip_atomic_load(p, __ATOMIC_RELAXED, __HIP_MEMORY_SCOPE_AGENT); }
__device__ __forceinline__ unsigned xb_add(unsigned* p, unsigned v) { return __hip_atomic_fetch_add(p, v, __ATOMIC_RELAXED, __HIP_MEMORY_SCOPE_AGENT); }
__device__ __forceinline__ unsigned xb_xcc_id() { return (unsigned)__builtin_amdgcn_s_getreg((3 << 11) | 20) & 0xFu; }
#define XB_SPIN(cond, bar) do { unsigned _sp = 0; while (cond) { __builtin_amdgcn_s_sleep(1); \
    if ((++_sp & 255u) == 0u) { if (xb_ld(&(bar)[XB_TMO])) break; if (_sp > XB_SPIN_CAP) { atomicAdd(&(bar)[XB_TMO], 1u); break; } } } } while (0)
struct XcdBarrier { unsigned* bar; unsigned x; volatile LAS unsigned* st; };
__device__ __forceinline__ XcdBarrier xcd_barrier_post(unsigned* bar, volatile LAS unsigned* st) {
    XcdBarrier b; b.bar = bar; b.x = xb_xcc_id(); b.st = st;
    if (my_tid() == 0) (void)xb_add(&bar[XB_XCNT(b.x)], 1u);
    return b;
}
__device__ __forceinline__ void xcd_barrier_complete(unsigned* bar, unsigned x, unsigned& nloc, unsigned& nx) {
    const unsigned G = gridDim.x * gridDim.y * gridDim.z;
    unsigned sum, cnt, mine, sp = 0u;
    for (;;) {
        sum = 0u; cnt = 0u; mine = 0u;
#pragma unroll
        for (unsigned j = 0; j < 16; ++j) { const unsigned c = xb_ld(&bar[XB_XCNT(j)]); sum += c; cnt += (c > 0u) ? 1u : 0u; mine = (j == x) ? c : mine; }
        if (sum == G) break;
        __builtin_amdgcn_s_sleep(1);
        if ((++sp & 255u) == 0u) { if (xb_ld(&bar[XB_TMO])) break; if (sp > XB_SPIN_CAP) { atomicAdd(&bar[XB_TMO], 1u); break; } }
    }
    nloc = mine > 0u ? mine : 1u; nx = cnt > 0u ? cnt : 1u;
}
__device__ __forceinline__ void xcd_barrier(const XcdBarrier& b) {
    asm volatile("s_waitcnt vmcnt(0)" ::: "memory");
    __syncthreads();
    if (my_tid() == 0) {
        unsigned* bar = b.bar;
        __builtin_amdgcn_s_waitcnt(0);
        unsigned nloc = b.st[0], nx = b.st[1];
        if (nloc == 0u) { xcd_barrier_complete(bar, b.x, nloc, nx); b.st[0] = nloc; b.st[1] = nx; }
        const unsigned old = xb_add(&bar[XB_XSUB(b.x)], 1u);
        const unsigned gen = old / nloc;
        if (old + 1u == (gen + 1u) * nloc) {
            __builtin_amdgcn_fence(__ATOMIC_RELEASE, "agent");
            asm volatile("s_waitcnt vmcnt(0)" ::: "memory");
            const unsigned og = xb_add(&bar[XB_TOP], 1u);
            const unsigned tg = og / nx;
            if (og + 1u == (tg + 1u) * nx) xb_add(&bar[XB_TOPGEN], 1u);
            else XB_SPIN(xb_ld(&bar[XB_TOPGEN]) == tg, bar);
            __builtin_amdgcn_fence(__ATOMIC_ACQUIRE, "agent");
            xb_add(&bar[XB_XGEN(b.x)], 1u);
            asm volatile("s_waitcnt vmcnt(0)" ::: "memory");
        } else {
            XB_SPIN(xb_ld(&bar[XB_XGEN(b.x)]) == gen, bar);
            __builtin_amdgcn_fence(__ATOMIC_ACQUIRE, "agent");
            asm volatile("s_waitcnt vmcnt(0)" ::: "memory");
        }
    }
    __syncthreads();
}

namespace pg8 {
constexpr int BM = 256, BK = 64, HALF = 128, HTB = HALF * BK * 2, STAGE_BYTES = 8 * HTB, NXCD = 8, WGM = 8;
__host__ __device__ __forceinline__ int lds_byte(int r, int c) { const int st = (r >> 4) * 2 + (c >> 5), rr = r & 15, cc = c & 31, ob = rr * 64 + cc * 2; return st * 1024 + (ob ^ (((ob >> 9) & 1) << 5)); }
__host__ __device__ __forceinline__ void stage_rc(int b, int& R, int& C) { const int st = b / 1024, sb = b % 1024, swz = sb ^ (((sb >> 9) & 1) << 5); R = (st >> 1) * 16 + swz / 64; C = (st & 1) * 32 + (swz % 64) / 2; }
__host__ __device__ __forceinline__ int perm32(int rho) { const int n = rho >> 4, i = rho & 15; return 8 * (i >> 2) + 4 * n + (i & 3); }
struct Unit { int pm, pn, grp; };

template <int EB_, int ASC_ = 0x7F7F7F7F>
struct SchedPlainT {
    static constexpr int EB = EB_, NBJ = 2, WSCALE = EB_ == 1 ? 0x7A7A7A7A : 0x7F7F7F7F, ASCALE = ASC_;
    int nM, nN, nwg, G, c; const char* Bt; int K;
    __device__ __forceinline__ void init(int M, int N, int K_, const bf16_t* Bt_, int G_, int c_) { nM = M / BM; nN = N / BM; nwg = nM * nN; G = G_; c = c_; Bt = (const char*)Bt_; K = K_; }
    __device__ __forceinline__ bool next(int i, Unit& u) const {
        const long L = (long)i * G + c; if (L >= nwg) return false;
        int wgid = (int)L; { const int q = nwg / NXCD, r = nwg % NXCD, xcd = wgid % NXCD, off = wgid / NXCD; wgid = (xcd < r ? xcd * (q + 1) : r * (q + 1) + (xcd - r) * q) + off; }
        const int nig = WGM * nN, gid = wgid / nig, fm = gid * WGM, gsz = (nM - fm) < WGM ? (nM - fm) : WGM;
        u.pm = fm + ((wgid % nig) % gsz); u.pn = (wgid % nig) / gsz; u.grp = 0; return true;
    }
    __device__ __forceinline__ int a_row(const Unit& u, int r) const { return u.pm * BM + r; }
    __device__ __forceinline__ const char* b_ptr(const Unit& u) const { return Bt + (size_t)u.pn * BM * K * EB; }
};
using SchedPlain = SchedPlainT<2>;

#define PG8_SA(b, h) (((b) * 2 + (h)) * HTB)
#define PG8_SB(b, h) ((4 + (b) * 2 + (h)) * HTB)
#ifdef PROBE_FAKEK
#define PG8_FK_B(x) (stage_on ? (x) : Abase)
#define PG8_FK_V(x) (stage_on ? (x) : 0u)
#else
#define PG8_FK_B(x) (x)
#define PG8_FK_V(x) (x)
#endif
#define PG8_STAGE(bufoff, gbase, voff) do { const char* gb_ = PG8_FK_B((const char*)(gbase)); asm volatile("" : "+s"(gb_)); _Pragma("unroll") for (int _i = 0; _i < 2; ++_i) { unsigned vo_ = PG8_FK_V((voff)[_i]); asm volatile("" : "+v"(vo_)); \
        __builtin_amdgcn_global_load_lds((const unsigned*)(gb_ + vo_), (LAS unsigned*)(lds + (bufoff) + ldsw + _i * 8192), 16, 0, 0); } } while (0)
#define PG8_LDA(dst, b, h) do { _Pragma("unroll") for (int m = 0; m < 4; ++m) { \
        if constexpr (EB == 1) dst##8[m] = cat32(*(const LAS bf16x8*)(lds + PG8_SA(b, h) + aoff + m * 2048), *(const LAS bf16x8*)(lds + PG8_SA(b, h) + aoff + m * 2048 + 1024)); \
        else { _Pragma("unroll") for (int k = 0; k < 2; ++k) dst[m][k] = *(const LAS bf16x8*)(lds + PG8_SA(b, h) + aoff + m * 2048 + k * 1024); } } } while (0)
#define PG8_LDB(dst, b, h) do { _Pragma("unroll") for (int n = 0; n < 2; ++n) { \
        if constexpr (EB == 1) dst##8[n] = cat32(*(const LAS bf16x8*)(lds + PG8_SB(b, h) + boff + n * 2048), *(const LAS bf16x8*)(lds + PG8_SB(b, h) + boff + n * 2048 + 1024)); \
        else { _Pragma("unroll") for (int k = 0; k < 2; ++k) dst[n][k] = *(const LAS bf16x8*)(lds + PG8_SB(b, h) + boff + n * 2048 + k * 1024); } } } while (0)
typedef float f32x16 __attribute__((ext_vector_type(16)));
__device__ __forceinline__ f32x4 get4(const f32x16& v, int k) { return (f32x4){v[4 * k], v[4 * k + 1], v[4 * k + 2], v[4 * k + 3]}; }
__device__ __forceinline__ void set4(f32x16& v, int k, f32x4 x) { v[4 * k] = x[0]; v[4 * k + 1] = x[1]; v[4 * k + 2] = x[2]; v[4 * k + 3] = x[3]; }
typedef int v8i32 __attribute__((ext_vector_type(8)));
typedef int v4i32 __attribute__((ext_vector_type(4)));
__device__ __forceinline__ v8i32 cat32(bf16x8 lo, bf16x8 hi) { const v4i32 a = __builtin_bit_cast(v4i32, lo), b = __builtin_bit_cast(v4i32, hi); return __builtin_shufflevector(a, b, 0, 1, 2, 3, 4, 5, 6, 7); }
#define PG8_MMA(ai, bj, At, Bt) do { __builtin_amdgcn_s_setprio(1); _Pragma("unroll") for (int m = 0; m < 4; ++m) _Pragma("unroll") for (int n = 0; n < 2; ++n) { \
        if constexpr (EB == 1) { if constexpr (ACC16) set4(accT[ai][bj][m >> 1], (m & 1) * 2 + n, __builtin_amdgcn_mfma_scale_f32_16x16x128_f8f6f4(Bt##8[n], At##8[m], get4(accT[ai][bj][m >> 1], (m & 1) * 2 + n), 0, 0, 0, Sched::WSCALE, 0, Sched::ASCALE)); \
            else acc[ai][bj][m][n] = __builtin_amdgcn_mfma_scale_f32_16x16x128_f8f6f4(Bt##8[n], At##8[m], acc[ai][bj][m][n], 0, 0, 0, Sched::WSCALE, 0, Sched::ASCALE); } \
        else { _Pragma("unroll") for (int k = 0; k < 2; ++k) acc[ai][bj][m][n] = __builtin_amdgcn_mfma_f32_16x16x32_bf16(Bt[n][k], At[m][k], acc[ai][bj][m][n], 0, 0, 0); } } \
        __builtin_amdgcn_s_setprio(0); } while (0)
#define PG8_WAIT_V(n) asm volatile("s_waitcnt vmcnt(" #n ")" ::: "memory")
#define PG8_WAIT_K do { if constexpr (NBJ == 2) asm volatile("s_waitcnt vmcnt(8)" ::: "memory"); else asm volatile("s_waitcnt vmcnt(6)" ::: "memory"); } while (0)
#define PG8_WAIT_L(n) asm volatile("s_waitcnt lgkmcnt(" #n ")" ::: "memory")
#define PG8_BAR __builtin_amdgcn_s_barrier()
#define PG8_SCHED __builtin_amdgcn_sched_barrier(0)

template <class Epi, class Sched, bool ALIGN_EPI>
__device__ __forceinline__ void gemm_phase(LAS unsigned char* lds, const char* Abase, const int K, const Sched& S, const Epi& E) {
    const int tid = my_tid(), wid = __builtin_amdgcn_readfirstlane(tid >> 6), lane = tid & 63, wr = wid >> 2, wc = wid & 3, fr = lane & 15, fq = lane >> 4;
    constexpr int EB = Sched::EB, NBJ = Sched::NBJ; constexpr bool ACC16 = (EB == 1 && NBJ == 2);
    const int nt = K * EB / 128;
    unsigned voffB[2];
#pragma unroll
    for (int i = 0; i < 2; ++i) { int R, C; stage_rc(tid * 16 + i * 8192, R, C); const int Rb = Epi::PERM ? ((R & ~31) + perm32(R & 31)) : R; voffB[i] = (unsigned)(Rb * K * EB + C * 2); }
#define PG8_AOFF(dst, unit) do { int l_ = (int)__builtin_amdgcn_mbcnt_hi(~0u, __builtin_amdgcn_mbcnt_lo(~0u, 0u)); asm volatile("" : "+v"(l_)); const int tid_ = wid * 64 + l_; _Pragma("unroll") for (int h = 0; h < 2; ++h) _Pragma("unroll") for (int i = 0; i < 2; ++i) { int R_, C_; stage_rc(tid_ * 16 + i * 8192, R_, C_); \
        dst[h][i] = (unsigned)S.a_row(unit, h * HALF + R_) * (unsigned)(K * EB) + (unsigned)(C_ * 2); } } while (0)
    const size_t kstep = 128;
    const size_t hstep = (size_t)HALF * K * EB;
    const unsigned ldsw = (unsigned)wid * 1024u;
    const int aoff = lds_byte(wr * 64 + fr, fq * 8), boff = lds_byte(wc * 32 + fr, fq * 8);
    Unit cur, nxt; int ui = 0;
#ifdef PROBE_FAKEK
    bool stage_on = true;
#endif
    if (!S.next(0, cur)) return;
#ifdef PROBE_FAKEK
#define PG8_UIX(i) (((PROBE_FAKEK >> (EB == 1 ? 0 : 1)) & 1) ? (i) >> 1 : (i))
#else
#define PG8_UIX(i) (i)
#endif
    f32x4 acc[2][NBJ][4][2];
#pragma unroll
    for (int a = 0; a < 2; ++a)
#pragma unroll
        for (int b = 0; b < NBJ; ++b)
#pragma unroll
            for (int m = 0; m < 4; ++m)
#pragma unroll
                for (int n = 0; n < 2; ++n) acc[a][b][m][n] = (f32x4){0.f, 0.f, 0.f, 0.f};
    f32x16 accT[2][NBJ][2];
#pragma unroll
    for (int a = 0; a < 2; ++a)
#pragma unroll
        for (int b = 0; b < NBJ; ++b)
#pragma unroll
            for (int m = 0; m < 2; ++m)
#pragma unroll
                for (int j = 0; j < 16; ++j) accT[a][b][m][j] = 0.f;
    bf16x8 At[4][2], B0[2][2], B1[2][2];
    v8i32 At8[4], B08[2], B18[2];
    unsigned offc[2][2], offn[2][2];
    PG8_AOFF(offc, cur);
    const char* cB = S.b_ptr(cur);
    PG8_STAGE(PG8_SB(0, 0), cB, voffB); if constexpr (NBJ == 2) PG8_STAGE(PG8_SB(0, 1), cB + hstep, voffB); PG8_STAGE(PG8_SA(0, 0), Abase, offc[0]); PG8_STAGE(PG8_SA(0, 1), Abase, offc[1]);
    if (wr == 1) PG8_BAR;
    PG8_WAIT_V(2); PG8_BAR;
    PG8_STAGE(PG8_SB(1, 0), cB + kstep, voffB); PG8_STAGE(PG8_SA(1, 0), Abase + kstep, offc[0]); if constexpr (NBJ == 2) PG8_STAGE(PG8_SB(1, 1), cB + hstep + kstep, voffB);
    if constexpr (NBJ == 2) PG8_WAIT_V(6); else PG8_WAIT_V(4);
    PG8_BAR;
    for (;;) {
        const bool has_next = S.next(PG8_UIX(ui + 1), nxt);
        const char* nB = cB;
        if (has_next) {
            nB = S.b_ptr(nxt);
            PG8_AOFF(offn, nxt);
        } else {
#pragma unroll
            for (int h = 0; h < 2; ++h)
#pragma unroll
                for (int i = 0; i < 2; ++i) offn[h][i] = offc[h][i];
        }
#pragma unroll 1
        for (int t = 0; t < nt; t += 2) {
            const bool last = (t == nt - 2);
#ifdef PROBE_FAKEK
            stage_on = !((PROBE_FAKEK >> (EB == 1 ? 0 : 1)) & 1) || !(ui & 1) || last;
#endif
            const char* kp1 = Abase + (size_t)(t + 1) * kstep;
            const char* kp2 = last ? Abase : Abase + (size_t)(t + 2) * kstep; const char* b2 = last ? nB : cB + (size_t)(t + 2) * kstep;
            const char* kp3 = kp2 + kstep; const char* b3 = b2 + kstep;
            unsigned o2[2][2];
#pragma unroll
            for (int h = 0; h < 2; ++h)
#pragma unroll
                for (int i = 0; i < 2; ++i) o2[h][i] = last ? offn[h][i] : offc[h][i];
            PG8_LDB(B0, 0, 0); if constexpr (NBJ == 2) PG8_LDB(B1, 0, 1); PG8_SCHED; PG8_LDA(At, 0, 0); PG8_STAGE(PG8_SA(1, 1), kp1, offc[1]);
            PG8_WAIT_K; PG8_WAIT_L(0); PG8_BAR; PG8_MMA(0, 0, At, B0); if constexpr (NBJ == 2) PG8_MMA(0, 1, At, B1); PG8_BAR; PG8_SCHED;
            PG8_LDA(At, 0, 1); PG8_STAGE(PG8_SB(0, 0), b2, voffB); if constexpr (NBJ == 2) PG8_STAGE(PG8_SB(0, 1), b2 + hstep, voffB); PG8_STAGE(PG8_SA(0, 0), kp2, o2[0]);
            PG8_WAIT_K; PG8_WAIT_L(0); PG8_BAR; PG8_MMA(1, 0, At, B0); if constexpr (NBJ == 2) PG8_MMA(1, 1, At, B1); PG8_BAR; PG8_SCHED;
            PG8_LDB(B0, 1, 0); if constexpr (NBJ == 2) PG8_LDB(B1, 1, 1); PG8_SCHED; PG8_LDA(At, 1, 0); PG8_STAGE(PG8_SA(0, 1), kp2, o2[1]);
            PG8_WAIT_K; PG8_WAIT_L(0); PG8_BAR; PG8_MMA(0, 0, At, B0); if constexpr (NBJ == 2) PG8_MMA(0, 1, At, B1); PG8_BAR; PG8_SCHED;
            PG8_LDA(At, 1, 1); PG8_STAGE(PG8_SB(1, 0), b3, voffB); if constexpr (NBJ == 2) PG8_STAGE(PG8_SB(1, 1), b3 + hstep, voffB); PG8_STAGE(PG8_SA(1, 0), kp3, o2[0]);
            PG8_WAIT_K; PG8_WAIT_L(0); PG8_BAR; PG8_MMA(1, 0, At, B0); if constexpr (NBJ == 2) PG8_MMA(1, 1, At, B1); PG8_BAR; PG8_SCHED;
        }
        if constexpr (ALIGN_EPI) { if (wr == 0) PG8_BAR; }
        if constexpr (ACC16) {
#pragma unroll
            for (int a = 0; a < 2; ++a)
#pragma unroll
                for (int b = 0; b < NBJ; ++b)
#pragma unroll
                    for (int m = 0; m < 4; ++m)
#pragma unroll
                        for (int n = 0; n < 2; ++n) acc[a][b][m][n] = get4(accT[a][b][m >> 1], (m & 1) * 2 + n);
        }
#ifdef PROBE_FAKEK
        if (!(((PROBE_FAKEK >> (EB == 1 ? 0 : 1)) & 1) && (ui & 1)))
#endif
        { int l2 = (int)__builtin_amdgcn_mbcnt_hi(~0u, __builtin_amdgcn_mbcnt_lo(~0u, 0u)); asm volatile("" : "+v"(l2)); E(acc, cur, wr, wc, l2 & 15, l2 >> 4); }
#ifdef PROBE_EPI2
        if constexpr (((PROBE_EPI2 >> (EB == 1 ? 0 : 1)) & 1) != 0) { int l2 = (int)__builtin_amdgcn_mbcnt_hi(~0u, __builtin_amdgcn_mbcnt_lo(~0u, 0u)); asm volatile("" : "+v"(l2)); E(acc, cur, wr, wc, l2 & 15, l2 >> 4); }
#endif
        if (!has_next) break;
#pragma unroll
        for (int a = 0; a < 2; ++a)
#pragma unroll
            for (int b = 0; b < NBJ; ++b)
#pragma unroll
                for (int m = 0; m < 4; ++m)
#pragma unroll
                    for (int n = 0; n < 2; ++n) acc[a][b][m][n] = (f32x4){0.f, 0.f, 0.f, 0.f};
#pragma unroll
        for (int a = 0; a < 2; ++a)
#pragma unroll
            for (int b = 0; b < NBJ; ++b)
#pragma unroll
                for (int m = 0; m < 2; ++m)
#pragma unroll
                    for (int j = 0; j < 16; ++j) accT[a][b][m][j] = 0.f;
        cur = nxt; cB = nB; ++ui;
#pragma unroll
        for (int h = 0; h < 2; ++h)
#pragma unroll
            for (int i = 0; i < 2; ++i) offc[h][i] = offn[h][i];
        if constexpr (ALIGN_EPI) { if (wr == 1) PG8_BAR; }
    }
    PG8_WAIT_V(0);
    if constexpr (!ALIGN_EPI) { if (wr == 0) PG8_BAR; }
    PG8_BAR;
}
#undef PG8_AOFF
#undef PG8_SA
#undef PG8_SB
#undef PG8_STAGE
#undef PG8_LDA
#undef PG8_LDB
#undef PG8_MMA
#undef PG8_WAIT_V
#undef PG8_WAIT_L
#undef PG8_WAIT_K
#undef PG8_BAR
#undef PG8_SCHED
}

struct EpiStore {
    static constexpr bool PERM = true;
    bf16_t* out; int ld;
    __device__ __forceinline__ void operator()(const f32x4 (&acc)[2][2][4][2], const pg8::Unit& u, int wr, int wc, int fr, int fq) const {
        const int row0 = u.pm * 256 + wr * 64 + fr, col0 = u.pn * 256 + wc * 32 + 8 * fq;
#pragma unroll
        for (int ai = 0; ai < 2; ++ai)
#pragma unroll
            for (int m = 0; m < 4; ++m) { bf16_t* rowp = out + (size_t)(row0 + ai * 128 + m * 16) * ld + col0;
#pragma unroll
                for (int bj = 0; bj < 2; ++bj) { const f32x4 v0 = acc[ai][bj][m][0], v1 = acc[ai][bj][m][1];
                    u32x4 w; w.x = pk2bf(v0[0], v0[1]); w.y = pk2bf(v0[2], v0[3]); w.z = pk2bf(v1[0], v1[1]); w.w = pk2bf(v1[2], v1[3]);
                    *(u32x4*)(rowp + bj * 128) = w; } }
    }
};
template <bool XIN_F32>
struct EpiResidB {
    static constexpr bool PERM = true;
    const float* xin_f; bf16_t* xs; const float* modl; int g_off;
    __device__ __forceinline__ void operator()(const f32x4 (&acc)[2][2][4][2], const pg8::Unit& u, int wr, int wc, int fr, int fq) const {
        const int row0 = u.pm * 256 + wr * 64 + fr;
        const float* gp = modl + ((u.pm * 256) / SEQ) * NMOD + g_off;
#pragma unroll
        for (int bj = 0; bj < 2; ++bj) {
            const int c = u.pn * 256 + bj * 128 + wc * 32 + 8 * fq;
            const f32x4 g0 = *(const f32x4*)(gp + c), g1 = *(const f32x4*)(gp + c + 4);
#pragma unroll
            for (int ai = 0; ai < 2; ++ai)
#pragma unroll
                for (int m = 0; m < 4; ++m) {
                    const size_t o = (size_t)(row0 + ai * 128 + m * 16) * DM + c;
                    f32x4 x0, x1;
                    if (XIN_F32) { x0 = *(const f32x4*)(xin_f + o); x1 = *(const f32x4*)(xin_f + o + 4); }
                    else { const u32x4 w = *(const u32x4*)(xs + o);
                        x0 = (f32x4){bf2f((bf16_t)(w.x & 0xffff)), bf2f((bf16_t)(w.x >> 16)), bf2f((bf16_t)(w.y & 0xffff)), bf2f((bf16_t)(w.y >> 16))};
                        x1 = (f32x4){bf2f((bf16_t)(w.z & 0xffff)), bf2f((bf16_t)(w.z >> 16)), bf2f((bf16_t)(w.w & 0xffff)), bf2f((bf16_t)(w.w >> 16))}; }
                    const f32x4 y0 = x0 + g0 * acc[ai][bj][m][0], y1 = x1 + g1 * acc[ai][bj][m][1];
                    u32x4 w; w.x = pk2bf(y0[0], y0[1]); w.y = pk2bf(y0[2], y0[3]); w.z = pk2bf(y1[0], y1[1]); w.w = pk2bf(y1[2], y1[3]);
                    *(u32x4*)(xs + o) = w;
                }
        }
    }
};

#ifndef MOE_NBJ
#define MOE_NBJ 2
#endif
constexpr int MNB = MOE_NBJ, GU_NPN = 16 / MNB, DN_NPN = 8 / MNB;
struct SchedMoeGU {
    static constexpr int EB = 1, NBJ = MNB, WSCALE = 0x7F7F7F7F, ASCALE = 0x7F7F7F7F;
    const int* sidx; const char* Wgu; int G, v, nunits;
    __device__ __forceinline__ void init(const int* sidx_, const bf16_t* Wgu_layer, int G_, int c_, bool has_ctx) { sidx = sidx_; Wgu = (const char*)Wgu_layer; G = G_; v = (G_ % 8 == 0) ? (c_ % 8) * (G_ / 8) + c_ / 8 : c_; nunits = 32 * 8 * GU_NPN + (has_ctx ? 32 * GU_NPN : 0); }
    __device__ __forceinline__ bool next(int i, pg8::Unit& u) const {
        const int U = i * G + v; if (U >= nunits) return false;
        if (U < 32 * 8 * GU_NPN) { u.grp = U / (8 * GU_NPN); u.pm = (U % (8 * GU_NPN)) / GU_NPN; u.pn = U % GU_NPN; } else { const int w = U - 32 * 8 * GU_NPN; u.grp = 32 + w / GU_NPN; u.pm = 0; u.pn = w % GU_NPN; }
        return true; }
    __device__ __forceinline__ int a_row(const pg8::Unit& u, int r) const {
        if (u.grp < 32) return (u.grp >> 4) * SEQ + sidx[u.grp * CAP_L + u.pm * 256 + r];
        const int gc = u.grp - 32; return r < CAP_C ? NLAT + (gc >> 4) * CTX + sidx[32 * CAP_L + gc * CAP_C + r] : 0; }
    __device__ __forceinline__ const char* b_ptr(const pg8::Unit& u) const { return Wgu + ((size_t)(u.grp & 15) * 2048 + (size_t)u.pn * (128 * MNB)) * DM; }
};
struct EpiHidMk {
    static constexpr bool PERM = true;
    bf16_t* hid;
    __device__ __forceinline__ void operator()(const f32x4 (&acc)[2][MNB][4][2], const pg8::Unit& u, int wr, int wc, int fr, int fq) const {
        const bool isctx = u.grp >= 32;
        const size_t rbase = isctx ? (size_t)32 * CAP_L + (size_t)(u.grp - 32) * CAP_C : (size_t)u.grp * CAP_L + u.pm * 256;
        const int r0 = wr * 64 + fr + fq * 16, c0 = (u.pn * (128 * MNB) + wc * 32) >> 1;
#pragma unroll
        for (int ai = 0; ai < 2; ++ai)
#pragma unroll
            for (int bj = 0; bj < MNB; ++bj) {
                unsigned w[4];
#pragma unroll
                for (int m = 0; m < 4; ++m) { const f32x4 v0 = acc[ai][bj][m][0] * (1.f / 32.f), v1 = acc[ai][bj][m][1] * (1.f / 32.f);
                    w[m] = pk4fp8(silu_f(v0[0]) * v0[1], silu_f(v0[2]) * v0[3], silu_f(v1[0]) * v1[1], silu_f(v1[2]) * v1[3]); }
                { auto t = __builtin_amdgcn_permlane32_swap(w[0], w[2], false, false); w[0] = t[0]; w[2] = t[1]; }
                { auto t = __builtin_amdgcn_permlane32_swap(w[1], w[3], false, false); w[1] = t[0]; w[3] = t[1]; }
                { auto t = __builtin_amdgcn_permlane16_swap(w[0], w[1], false, false); w[0] = t[0]; w[1] = t[1]; }
                { auto t = __builtin_amdgcn_permlane16_swap(w[2], w[3], false, false); w[2] = t[0]; w[3] = t[1]; }
                const int r = r0 + ai * 128; if (isctx && r >= CAP_C) continue;
                u32x4 o; o.x = w[0]; o.y = w[1]; o.z = w[2]; o.w = w[3];
                *(u32x4*)((unsigned char*)hid + (rbase + r) * DFF + c0 + bj * 64) = o; }
    }
};
struct SchedMoeDown {
    static constexpr int EB = 1, NBJ = MNB, WSCALE = 0x7F7F7F7F, ASCALE = 0x7F7F7F7F;
    const char* Wd; int G, v, nunits;
    __device__ __forceinline__ void init(const bf16_t* Wd_layer, int G_, int c_, bool has_ctx) { Wd = (const char*)Wd_layer; G = G_; v = (G_ % 8 == 0) ? (c_ % 8) * (G_ / 8) + c_ / 8 : c_; nunits = 32 * 8 * DN_NPN + (has_ctx ? 32 * DN_NPN : 0); }
    __device__ __forceinline__ bool next(int i, pg8::Unit& u) const {
        const int U = i * G + v; if (U >= nunits) return false;
        if (U < 32 * 8 * DN_NPN) { u.grp = U / (8 * DN_NPN); u.pm = (U % (8 * DN_NPN)) / DN_NPN; u.pn = U % DN_NPN; } else { const int w = U - 32 * 8 * DN_NPN; u.grp = 32 + w / DN_NPN; u.pm = 0; u.pn = w % DN_NPN; }
        return true; }
    __device__ __forceinline__ int a_row(const pg8::Unit& u, int r) const { return u.grp < 32 ? u.grp * CAP_L + u.pm * 256 + r : 32 * CAP_L + (u.grp - 32) * CAP_C + r; }
    __device__ __forceinline__ const char* b_ptr(const pg8::Unit& u) const { return Wd + ((size_t)(u.grp & 15) * 1024 + (size_t)u.pn * (128 * MNB)) * DFF; }
};
struct EpiYeMk {
    static constexpr bool PERM = true;
    bf16_t* ye; const float* sg;
    __device__ __forceinline__ void operator()(const f32x4 (&acc)[2][MNB][4][2], const pg8::Unit& u, int wr, int wc, int fr, int fq) const {
        const bool isctx = u.grp >= 32;
        const size_t rbase = isctx ? (size_t)32 * CAP_L + (size_t)(u.grp - 32) * CAP_C : (size_t)u.grp * CAP_L + u.pm * 256;
        const int r0 = wr * 64 + fr, c0 = u.pn * (128 * MNB) + wc * 32 + 8 * fq;
#pragma unroll
        for (int ai = 0; ai < 2; ++ai)
#pragma unroll
            for (int m = 0; m < 4; ++m) { const int r = r0 + ai * 128 + m * 16; if (isctx && r >= CAP_C) continue;
                const float g = sg[rbase + r] * (1.f / 32.f);
#pragma unroll
              for (int bj = 0; bj < MNB; ++bj) {
                const f32x4 v0 = acc[ai][bj][m][0] * g, v1 = acc[ai][bj][m][1] * g;
                u32x4 w; w.x = pk2bf(v0[0], v0[1]); w.y = pk2bf(v0[2], v0[3]); w.z = pk2bf(v1[0], v1[1]); w.w = pk2bf(v1[2], v1[3]);
                *(u32x4*)(ye + (rbase + r) * DM + c0 + bj * 128) = w; } }
    }
};

struct Frame {
    LAS unsigned char* lds; int tid, lane, wave, G, bid;
};
__device__ __forceinline__ Params lds_params(const Frame& F) {
    Params P;
    const LAS unsigned* t = (const LAS unsigned*)(F.lds + LDS_MISC + 64);
#pragma unroll
    for (int i = 0; i < 26; ++i) {
        const unsigned lo = (unsigned)__builtin_amdgcn_readfirstlane((int)t[2 * i]), hi = (unsigned)__builtin_amdgcn_readfirstlane((int)t[2 * i + 1]);
        const unsigned long long v = ((unsigned long long)hi << 32) | lo;
        if (i < 24) P.in[i] = (const float*)(const __attribute__((address_space(1))) float*)v; else if (i == 24) P.out = (float*)(__attribute__((address_space(1))) float*)v; else P.ws = (unsigned char*)(__attribute__((address_space(1))) unsigned char*)v;
    }
    P.ph_lo = 0; P.ph_hi = 0;
    return P;
}
enum { MAP_PLAIN = 0, MAP_GU = 1, MAP_QPERM = 2, MAP_SWAPERM = 3 };
struct CvtJob { const float* s0; const float* s1; bf16_t* dst; int ld_src, Ksrc, koff, nvalid, mode, ld_dst, ntr, ntk; float scale; int scale_rows; int fp8; };
__device__ __forceinline__ void cvt_load(const CvtJob& J, int tile, float (&v)[16]) {
    const int tr = tile % J.ntr, tk = tile / J.ntr, r0 = tr * 64, k0 = tk * 128, tid = my_tid();
    if (J.fp8 == 1) {
      const int g4 = tid & 15, kq = tid >> 4; const bool gu = J.mode == MAP_GU;
      const float* s4 = (gu && (g4 & 1)) ? J.s1 : J.s0; const int colb = gu ? (r0 >> 1) + (g4 >> 1) * 4 : r0 + g4 * 4;
#pragma unroll
      for (int j = 0; j < 4; ++j) { const f32x4 t4 = *(const f32x4*)(s4 + (size_t)(k0 + kq + 32 * j) * J.ld_src + colb); v[4 * j] = t4[0]; v[4 * j + 1] = t4[1]; v[4 * j + 2] = t4[2]; v[4 * j + 3] = t4[3]; }
      return; }
    const int rr = tid & 63, r = r0 + rr;
    const float* s = J.s0; int col = r;
    if (J.mode == MAP_GU) { s = (r & 1) ? J.s1 : J.s0; col = r >> 1; }
    else if (J.mode == MAP_QPERM) { const int h = r / 96, dd = r % 96; if (dd >= 64) { const int q = dd - 64, p = q >> 1; col = h * 96 + 64 + (p >> 3) * 16 + (q & 1) * 8 + (p & 7); } }
    else if (J.mode == MAP_SWAPERM) { if (r < 1280) { const int hh = r >> 6, dd = r & 63, p = dd >> 1; col = hh * 64 + (p >> 4) * 32 + (dd & 1) * 16 + (p & 15); } }
#pragma unroll
    for (int j = 0; j < 16; ++j) {
        const int kk = (tid >> 6) + 8 * j, ks = k0 + kk - J.koff;
        v[j] = (r < J.nvalid && ks >= 0 && ks < J.Ksrc) ? s[(size_t)ks * J.ld_src + col] : 0.f;
    }
}
__device__ __forceinline__ void cvt_store(const CvtJob& J, int tile, const float (&v)[16], LAS float* scr) {
    const int tr = tile % J.ntr, tk = tile / J.ntr, r0 = tr * 64, k0 = tk * 128, tid = my_tid();
    const int rr = tid & 63, r = r0 + rr;
    const float sc = ((r < J.scale_rows) ? J.scale : 1.f) * (J.fp8 == 2 ? 32.f : 1.f);
    if (J.fp8 == 1) { const int g4 = tid & 15, kq = tid >> 4; const bool gu = J.mode == MAP_GU;
#pragma unroll
      for (int j = 0; j < 4; ++j)
#pragma unroll
        for (int i = 0; i < 4; ++i) scr[(kq + 32 * j) * 65 + (gu ? 2 * ((g4 >> 1) * 4 + i) + (g4 & 1) : g4 * 4 + i)] = v[4 * j + i] * J.scale; }
    else {
#pragma unroll
    for (int j = 0; j < 16; ++j) scr[((tid >> 6) + 8 * j) * 65 + rr] = v[j] * sc; }
    __syncthreads();
    if (J.fp8) { const int r2 = tid >> 3, kc = (tid & 7) * 16; const LAS float* sp = scr + kc * 65 + r2;
      u32x4 w; w.x = pk4fp8(sp[0], sp[65], sp[2 * 65], sp[3 * 65]); w.y = pk4fp8(sp[4 * 65], sp[5 * 65], sp[6 * 65], sp[7 * 65]);
      w.z = pk4fp8(sp[8 * 65], sp[9 * 65], sp[10 * 65], sp[11 * 65]); w.w = pk4fp8(sp[12 * 65], sp[13 * 65], sp[14 * 65], sp[15 * 65]);
      *(u32x4*)((unsigned char*)J.dst + (size_t)(r0 + r2) * J.ld_dst + k0 + kc) = w; }
    else { const int r2 = tid >> 3, kc = (tid & 7) * 8; const LAS float* sp = scr + kc * 65 + r2; const LAS float* sq = sp + 64 * 65;
      u32x4 w0, w1;
      w0.x = pk2bf(sp[0], sp[65]); w0.y = pk2bf(sp[2 * 65], sp[3 * 65]); w0.z = pk2bf(sp[4 * 65], sp[5 * 65]); w0.w = pk2bf(sp[6 * 65], sp[7 * 65]);
      w1.x = pk2bf(sq[0], sq[65]); w1.y = pk2bf(sq[2 * 65], sq[3 * 65]); w1.z = pk2bf(sq[4 * 65], sq[5 * 65]); w1.w = pk2bf(sq[6 * 65], sq[7 * 65]);
      bf16_t* d = J.dst + (size_t)(r0 + r2) * J.ld_dst + k0 + kc;
      *(u32x4*)d = w0; *(u32x4*)(d + 64) = w1; }
}
constexpr int CVT_DENSE = 256 + 128 + 192 + 48 + 64 + 128 + 192, CVT_MOE = 16 * 384;
__device__ __forceinline__ void cvt_job(const Params& P, int g, CvtJob& J, int& tile) {
    unsigned char* W = P.ws + WS_W;
    if (g < 256) { J = CvtJob{P.in[8], nullptr, (bf16_t*)(W + OFF_WIN), AB_IN, DM, 0, AB_IN, MAP_PLAIN, DM, 32, 8, 1.f, 0, 0}; tile = g; return; } g -= 256;
    if (g < 128) { J = CvtJob{P.in[15], nullptr, (bf16_t*)(W + OFF_WOUT), DM, DM, 0, DM, MAP_PLAIN, DM, 16, 8, 1.f, 0, 0}; tile = g; return; } g -= 128;
    if (g < 192) { J = CvtJob{P.in[16], nullptr, (bf16_t*)(W + OFF_WQKV), 1536, DM, 0, 1536, MAP_SWAPERM, DM, 24, 8, 0.125f * LOG2E, 1024, 0}; tile = g; return; } g -= 192;
    if (g < 48) { J = CvtJob{P.in[12], nullptr, (bf16_t*)(W + OFF_WUP), 768, 256, 0, 768, MAP_QPERM, 512, 12, 4, 0.10206207261596575f * LOG2E * QF8_SCALE, 768, 2}; tile = g; return; } g -= 48;
    if (g < 64) { J = CvtJob{P.in[14], nullptr, (bf16_t*)((unsigned char*)(W + OFF_WUP) + (size_t)768 * 512), 1024, 128, 256, 1024, MAP_PLAIN, 512, 16, 4, 1.f, 0, 2}; tile = g; return; } g -= 64;
    if (g < 128) { J = CvtJob{P.in[18], nullptr, (bf16_t*)(W + OFF_WSO), DM, DM, 0, DM, MAP_PLAIN, DM, 16, 8, 1.f, 0, 2}; tile = g; return; } g -= 128;
    J = CvtJob{P.in[16], nullptr, (bf16_t*)(W + OFF_WQKV8), 1536, DM, 0, 1536, MAP_SWAPERM, DM, 24, 8, 0.125f * LOG2E * QF8_SCALE, 1024, 2}; tile = g;
}
__device__ __forceinline__ void cvt_job_moe(const Params& P, int layer, int g, CvtJob& J, int& tile) {
    unsigned char* W = P.ws + WS_W;
    const int e = g / 384, r = g % 384, le = layer * 16 + e;
    if (r < 256) { J = CvtJob{P.in[20] + (size_t)le * DM * DFF, P.in[21] + (size_t)le * DM * DFF, (bf16_t*)(W + OFF_WGU + (size_t)e * 2048 * DM), DFF, DM, 0, 2048, MAP_GU, DM, 32, 8, 32.f, 1 << 30, 1}; tile = r; }
    else { J = CvtJob{P.in[22] + (size_t)le * DFF * DM, nullptr, (bf16_t*)(W + OFF_WD + (size_t)e * 1024 * DFF), DM, DFF, 0, DM, MAP_PLAIN, DFF, 16, 8, 32.f, 1 << 30, 1}; tile = r - 256; }
}
template <bool MOE>
__device__ __forceinline__ void cvt_run(const Params& P, LAS float* scr, int layer, int first, int step, int total) {
    int g = first, par = 0; CvtJob Jc{}; int tc = 0; float vc[16];
    bool have = g < total;
    if (have) { if (MOE) cvt_job_moe(P, layer, g, Jc, tc); else cvt_job(P, g, Jc, tc); cvt_load(Jc, tc, vc); }
    while (have) {
        const int gn = g + step; const bool hn = gn < total; CvtJob Jn{}; int tn = 0; float vn[16];
        if (hn) { if (MOE) cvt_job_moe(P, layer, gn, Jn, tn); else cvt_job(P, gn, Jn, tn); cvt_load(Jn, tn, vn); }
        cvt_store(Jc, tc, vc, scr + par * (128 * 65)); par ^= 1;
        Jc = Jn; tc = tn; g = gn; have = hn;
#pragma unroll
        for (int j = 0; j < 16; ++j) vc[j] = vn[j];
    }
}

__device__ __forceinline__ void phase_prologue(Frame& F) {
  const Params P = lds_params(F);
    LAS float* scr = (LAS float*)F.lds;
    cvt_run<false>(P, scr, 0, F.bid, F.G, CVT_DENSE);
    {
        LAS float* sv = (LAS float*)(F.lds + 32768);
        LAS float* red = (LAS float*)(F.lds + 32768 + 12288);
        const float* c = P.in[1]; const float* c_ctx = P.in[3]; const float* mod_w = P.in[4]; const float* mod_b = P.in[5];
        float* modv = (float*)(P.ws + WS_MODV);
        __syncthreads();
        for (int i = F.tid; i < DM; i += NTHREADS) { sv[i] = silu_f(c[i]); sv[DM + i] = silu_f(c[DM + i]); sv[2 * DM + i] = silu_f(c_ctx[i]); }
        __syncthreads();
        for (int ch = F.bid; ch < 256; ch += F.G) {
            const int jg = ch * 48, l = jg / NMOD, j0 = jg % NMOD, rg = F.tid >> 4, ct = F.tid & 15;
            const float* w = mod_w + (size_t)l * DM * NMOD + j0 + 3 * ct;
            float a[3][3];
#pragma unroll
            for (int x = 0; x < 3; ++x)
#pragma unroll
                for (int y = 0; y < 3; ++y) a[x][y] = 0.f;
            for (int d = rg; d < DM; d += 32) { const float w0 = w[(size_t)d * NMOD], w1 = w[(size_t)d * NMOD + 1], w2 = w[(size_t)d * NMOD + 2];
#pragma unroll
                for (int x = 0; x < 3; ++x) { const float s = sv[x * DM + d]; a[x][0] += s * w0; a[x][1] += s * w1; a[x][2] += s * w2; } }
#pragma unroll
            for (int x = 0; x < 3; ++x)
#pragma unroll
                for (int y = 0; y < 3; ++y) red[rg * 144 + x * 48 + 3 * ct + y] = a[x][y];
            __syncthreads();
            if (F.tid < 144) { float s = 0.f; for (int r = 0; r < 32; ++r) s += red[r * 144 + F.tid]; const int x = F.tid / 48, jj = j0 + F.tid % 48; modv[(l * 3 + x) * NMOD + jj] = s + mod_b[l * NMOD + jj]; }
            __syncthreads();
        }
    }
    {
        float* tab = (float*)(P.ws + WS_ROPE);
        for (int i = F.bid * 64 + F.tid; i < 256 * 16 && F.tid < 64; i += F.G * 64) {
            if (i < 256 * 8) { const int p = i / 8, f = i % 8; const double fr = pow(10000.0, -(double)(2 * f) / 16.0); const double a = (double)p * fr; tab[i] = (float)cos(a); tab[2048 + i] = (float)sin(a); }
            { const int p = i / 16, f = i % 16; const double fr = pow(10000.0, -(double)(2 * f) / 32.0); const double a = (double)p * fr; tab[4096 + i] = (float)cos(a); tab[8192 + i] = (float)sin(a); }
        }
    }
}


namespace att {
using f32x16 = __attribute__((ext_vector_type(16))) float;
using s16x4  = __attribute__((ext_vector_type(4))) short;
__device__ __forceinline__ int crow(int r, int hi) { return (r & 3) + 8 * (r >> 2) + 4 * hi; }
__device__ __forceinline__ unsigned cvtpk(float lo, float hi) { unsigned r;
#ifdef PROBE_FP8ATT
  if (PROBE_FP8ATT & 4) { lo = fp8rt(lo, 1.f); hi = fp8rt(hi, 1.f); }
#endif
  asm volatile("v_cvt_pk_bf16_f32 %0, %1, %2" : "=v"(r) : "v"(lo), "v"(hi)); return r; }
__device__ __forceinline__ int v_rd_base(int lane) { return ((lane & 3) << 3) | (((lane >> 2) & 3) << 6) | (((lane >> 4) & 1) << 5) | (((lane >> 5) & 1) << 8); }
constexpr int v_rd_off(int d0, int ks, int half) { return d0 * 512 + ks * 2048 + half * 1024; }
template <int OFF> __device__ __forceinline__ s16x4 tr_read(int vb) {
  s16x4 r; asm volatile("ds_read_b64_tr_b16 %0, %1 offset:%2" : "=&v"(r) : "v"(vb), "i"(OFF) : "memory"); return r;
}
}


namespace att2 {
using att::f32x16; using att::s16x4; using att::crow; using att::cvtpk; using att::v_rd_base; using att::v_rd_off; using att::tr_read;
constexpr int VT = 8192, NSLOT = 4, LDS_WS = NSLOT * (12288 + VT);
#ifndef A2_PIPE
#define A2_PIPE 2
#endif
constexpr float THR = 8.f, P8_BIAS = 4.f;
#define A2_SBAR() __builtin_amdgcn_sched_barrier(0)
template <bool FAST, int ABL = 0, bool PACK = true>
__device__ __forceinline__ void softmax_blk(f32x16& p0, f32x16& p1, float& m_reg, float& l_reg, float& alpha, bf16x8& pa0, bf16x8& pa1, bf16x8& pa2, bf16x8& pa3) {
  if (FAST) {
    float ps = 0.f;
#pragma unroll
    for (int r = 0; r < 16; ++r) { if (ABL != 1) { p0[r] = __builtin_amdgcn_exp2f(p0[r]); p1[r] = __builtin_amdgcn_exp2f(p1[r]); } }
    if (ABL != 1) {
#pragma unroll
    for (int r = 0; r < 16; ++r) ps += p0[r] + p1[r];
    { auto rr = __builtin_amdgcn_permlane32_swap(__float_as_uint(ps), __float_as_uint(ps), false, false);
      ps = __uint_as_float(rr[0]) + __uint_as_float(rr[1]); }
    } else ps = 1.f;
    l_reg += ps; alpha = 1.f;
  } else {
  float pmax = fmaxf(p0[0], p1[0]);
#pragma unroll
  for (int r = 1; r < 16; ++r) pmax = fmaxf(fmaxf(pmax, p0[r]), p1[r]);
  { auto rr = __builtin_amdgcn_permlane32_swap(__float_as_uint(pmax), __float_as_uint(pmax), false, false);
    pmax = fmaxf(__uint_as_float(rr[0]), __uint_as_float(rr[1])); }
  float mn;
  if (__builtin_expect(__all(pmax - m_reg <= THR), 1)) { mn = m_reg; alpha = 1.f; }
  else { mn = fmaxf(m_reg, pmax); alpha = __builtin_amdgcn_exp2f(m_reg - mn); m_reg = mn; }
  float ps = 0.f;
#pragma unroll
  for (int r = 0; r < 16; ++r) { p0[r] = __builtin_amdgcn_exp2f(p0[r] - mn); p1[r] = __builtin_amdgcn_exp2f(p1[r] - mn); }
#pragma unroll
  for (int r = 0; r < 16; ++r) ps += p0[r] + p1[r];
  { auto rr = __builtin_amdgcn_permlane32_swap(__float_as_uint(ps), __float_as_uint(ps), false, false);
    ps = __uint_as_float(rr[0]) + __uint_as_float(rr[1]); }
  l_reg = l_reg * alpha + ps;
  }
#define A2_PK4(P, BASE, OUT) do { unsigned a0 = cvtpk(P[BASE + 0], P[BASE + 1]), a1 = cvtpk(P[BASE + 2], P[BASE + 3]);   \
    unsigned b0 = cvtpk(P[BASE + 4], P[BASE + 5]), b1 = cvtpk(P[BASE + 6], P[BASE + 7]);                              \
    auto r0 = __builtin_amdgcn_permlane32_swap(a0, b0, false, false); auto r1 = __builtin_amdgcn_permlane32_swap(a1, b1, false, false); \
    u32x4 w = {r0[0], r1[0], r0[1], r1[1]}; OUT = *reinterpret_cast<bf16x8*>(&w); } while (0)
  if constexpr (PACK) { A2_PK4(p0, 0, pa0); A2_PK4(p0, 8, pa1); A2_PK4(p1, 0, pa2); A2_PK4(p1, 8, pa3); }
#undef A2_PK4
}

template <bool FAST, int ABL = 0, int DK = 96, bool SWA = false, bool F8 = false>
__device__ __forceinline__ bool attn_unit(const bf16_t* __restrict__ Qb_, const int rows_valid, const char* __restrict__ Kimg, const char* __restrict__ Vimg,
                                          bf16_t* __restrict__ Ob_, const int NT, LAS unsigned char* lds, const int lt0 = 0, const int q0 = 0, const float* sinkp = nullptr) {
  constexpr int ND = DK / 16, KT = F8 ? DK * 64 : DK * 128, VTX = F8 ? 4096 : VT, SLOT = KT + VTX;
  constexpr int QB = F8 ? 1 : 2;
  const bf16_t* Qb = Qb_; bf16_t* Ob = Ob_;
  const int tid = my_tid(), wid = __builtin_amdgcn_readfirstlane(tid >> 6), lane = tid & 63, r32 = lane & 31, hi = lane >> 5;
  LAS float* ws = (LAS float*)(lds + LDS_WS) + wid * 128;
  float mA = -1e30f, mB = -1e30f, lA = 0.f, lB = 0.f; f32x16 oA[2] = {}, oB[2] = {};
  bf16x8 qA[ND], qB[ND]; pg8::v8i32 qA8[2], qB8[2];
  const int wrow0 = SWA ? (wid >> 2) * 64 : wid * 64;
  if (SWA) { Qb = (const bf16_t*)((const char*)Qb + (size_t)(wid & 3) * SEQ * DK * QB); Ob = (bf16_t*)((unsigned char*)Ob + (wid & 3) * 64); }
  { int ra = wrow0 + r32, rb = ra + 32; if (ra >= rows_valid) ra = 0; if (rb >= rows_valid) rb = 0;
    if constexpr (F8) { const char* pa_ = (const char*)Qb + (size_t)ra * DK; const char* pb_ = (const char*)Qb + (size_t)rb * DK;
      const pg8::v8i32 z8 = {0, 0, 0, 0, 0, 0, 0, 0};
      qA8[0] = *reinterpret_cast<const pg8::v8i32*>(pa_ + hi * 32); qB8[0] = *reinterpret_cast<const pg8::v8i32*>(pb_ + hi * 32);
      if constexpr (DK == 96) { const pg8::v8i32 ta = *reinterpret_cast<const pg8::v8i32*>(pa_ + 64), tb = *reinterpret_cast<const pg8::v8i32*>(pb_ + 64);
        qA8[1] = hi ? z8 : ta; qB8[1] = hi ? z8 : tb; } else { qA8[1] = z8; qB8[1] = z8; }
      asm volatile("" : "+v"(qA8[0]), "+v"(qA8[1]), "+v"(qB8[0]), "+v"(qB8[1]));
    } else {
    const bf16_t* pa_ = Qb + (size_t)ra * DK + hi * 8; const bf16_t* pb_ = Qb + (size_t)rb * DK + hi * 8;
#pragma unroll
    for (int d0 = 0; d0 < ND; ++d0) { qA[d0] = *reinterpret_cast<const bf16x8*>(pa_ + d0 * 16); qB[d0] = *reinterpret_cast<const bf16x8*>(pb_ + d0 * 16); } } }
  const bool two = F8 ? false : (DK == 96) && wid < 4;
  const bool hasK = F8 ? wid < 6 : true, hasV = F8 ? (wid < 2 || wid >= 6) : true;
  const int vpiece = F8 ? (wid >= 6 ? wid - 6 : wid + 2) : wid;
  const char* ksrc = Kimg + wid * 1024 + lane * 16; const char* vsrc = Vimg + vpiece * 1024 + lane * 16;
  constexpr int NKP = KT / 1024;
  const char* f8a = (wid < NKP) ? Kimg + wid * 1024 : Vimg + (wid - NKP) * 1024; const int f8as = (wid < NKP) ? KT : VTX, f8ad = (wid < NKP) ? wid * 1024 : KT + (wid - NKP) * 1024;
  const char* f8b = (wid < 2) ? Vimg + (wid + 2) * 1024 : f8a; const int f8bs = (wid < 2) ? VTX : f8as, f8bd = (wid < 2) ? KT + (wid + 2) * 1024 : LDS_WS + 8192 + wid * 1024; const bool f8breal = wid < 2;
#define A2_DMA8(t, s) do { const int it8_ = (SWA && (t) >= 4) ? lt0 + (t) : (t); const char* ga_ = f8a + (size_t)it8_ * f8as; const char* gb_ = f8b + (size_t)it8_ * f8bs; unsigned vo_ = (unsigned)lane * 16u; asm volatile("" : "+s"(ga_)); asm volatile("" : "+s"(gb_)); asm volatile("" : "+v"(vo_)); \
    __builtin_amdgcn_global_load_lds((const unsigned*)(ga_ + vo_), (LAS unsigned*)(lds + (s) * SLOT + f8ad), 16, 0, 0); \
    if constexpr (DK == 96) __builtin_amdgcn_global_load_lds((const unsigned*)(gb_ + vo_), (LAS unsigned*)(lds + (f8breal ? (s) * SLOT : 0) + f8bd), 16, 0, 0); } while (0)
#define A2_DMA(t, s) do { if constexpr (F8) { A2_DMA8(t, s); break; } const int it_ = (SWA && (t) >= 4) ? lt0 + (t) : (t); \
    if (hasK) __builtin_amdgcn_global_load_lds((const unsigned*)(ksrc + (size_t)it_ * KT), (LAS unsigned*)(lds + (s) * SLOT + wid * 1024), 16, 0, 0); \
    if (two) __builtin_amdgcn_global_load_lds((const unsigned*)(ksrc + (size_t)it_ * KT + 8192), (LAS unsigned*)(lds + (s) * SLOT + 8192 + wid * 1024), 16, 0, 0); \
    if (hasV) __builtin_amdgcn_global_load_lds((const unsigned*)(vsrc + (size_t)it_ * VTX), (LAS unsigned*)(lds + (s) * SLOT + KT + vpiece * 1024), 16, 0, 0); } while (0)
  LAS unsigned* flag = (LAS unsigned*)(lds + LDS_WS + 4096);
  if (FAST && tid == 0) *flag = 0u;
  asm volatile("s_waitcnt vmcnt(0)" ::: "memory");
  A2_DMA(0, 0); A2_DMA(1, 1);
  if constexpr (A2_PIPE == 2 && F8 && FAST && ABL == 0 && DK == 96) { A2_DMA(2, 2); }
  const int vb0 = (int)(uintptr_t)(lds + KT) + v_rd_base(lane);
  const int kb0 = hi * 1024 + r32 * 16;
  const int qpA = q0 + wrow0 + r32;
#define A2_PK(L, H) (bf16x8){L[0], L[1], L[2], L[3], H[0], H[1], H[2], H[3]}
#define A2_PV(D0, VB) do { \
      const s16x4 l0 = tr_read<v_rd_off(D0, 0, 0)>(VB), h0 = tr_read<v_rd_off(D0, 0, 1)>(VB), l1 = tr_read<v_rd_off(D0, 1, 0)>(VB), h1 = tr_read<v_rd_off(D0, 1, 1)>(VB); \
      const s16x4 l2 = tr_read<v_rd_off(D0, 2, 0)>(VB), h2 = tr_read<v_rd_off(D0, 2, 1)>(VB), l3 = tr_read<v_rd_off(D0, 3, 0)>(VB), h3 = tr_read<v_rd_off(D0, 3, 1)>(VB); \
      asm volatile("s_waitcnt lgkmcnt(0)" ::: "memory"); A2_SBAR(); \
      const bf16x8 v0_ = A2_PK(l0, h0), v1_ = A2_PK(l1, h1), v2_ = A2_PK(l2, h2), v3_ = A2_PK(l3, h3); \
      if (ABL == 3) { asm volatile("" :: "v"(v0_), "v"(v1_), "v"(v2_), "v"(v3_), "v"(a0), "v"(a1), "v"(a2), "v"(a3), "v"(b0), "v"(b1), "v"(b2), "v"(b3)); } else { \
      oA[D0] = __builtin_amdgcn_mfma_f32_32x32x16_bf16(a0, v0_, oA[D0], 0, 0, 0); oB[D0] = __builtin_amdgcn_mfma_f32_32x32x16_bf16(b0, v0_, oB[D0], 0, 0, 0); \
      oA[D0] = __builtin_amdgcn_mfma_f32_32x32x16_bf16(a1, v1_, oA[D0], 0, 0, 0); oB[D0] = __builtin_amdgcn_mfma_f32_32x32x16_bf16(b1, v1_, oB[D0], 0, 0, 0); \
      oA[D0] = __builtin_amdgcn_mfma_f32_32x32x16_bf16(a2, v2_, oA[D0], 0, 0, 0); oB[D0] = __builtin_amdgcn_mfma_f32_32x32x16_bf16(b2, v2_, oB[D0], 0, 0, 0); \
      oA[D0] = __builtin_amdgcn_mfma_f32_32x32x16_bf16(a3, v3_, oA[D0], 0, 0, 0); oB[D0] = __builtin_amdgcn_mfma_f32_32x32x16_bf16(b3, v3_, oB[D0], 0, 0, 0); } } while (0)
#define A2_PV2(VB) do { \
      const s16x4 l0 = tr_read<v_rd_off(0, 0, 0)>(VB), h0 = tr_read<v_rd_off(0, 0, 1)>(VB), l1 = tr_read<v_rd_off(0, 1, 0)>(VB), h1 = tr_read<v_rd_off(0, 1, 1)>(VB); \
      const s16x4 l2 = tr_read<v_rd_off(0, 2, 0)>(VB), h2 = tr_read<v_rd_off(0, 2, 1)>(VB), l3 = tr_read<v_rd_off(0, 3, 0)>(VB), h3 = tr_read<v_rd_off(0, 3, 1)>(VB); \
      const s16x4 m0 = tr_read<v_rd_off(1, 0, 0)>(VB), n0 = tr_read<v_rd_off(1, 0, 1)>(VB), m1 = tr_read<v_rd_off(1, 1, 0)>(VB), n1 = tr_read<v_rd_off(1, 1, 1)>(VB); \
      const s16x4 m2 = tr_read<v_rd_off(1, 2, 0)>(VB), n2 = tr_read<v_rd_off(1, 2, 1)>(VB), m3 = tr_read<v_rd_off(1, 3, 0)>(VB), n3 = tr_read<v_rd_off(1, 3, 1)>(VB); \
      asm volatile("s_waitcnt lgkmcnt(0)" ::: "memory"); A2_SBAR(); \
      const bf16x8 v0_ = A2_PK(l0, h0), v1_ = A2_PK(l1, h1), v2_ = A2_PK(l2, h2), v3_ = A2_PK(l3, h3); \
      const bf16x8 w0_ = A2_PK(m0, n0), w1_ = A2_PK(m1, n1), w2_ = A2_PK(m2, n2), w3_ = A2_PK(m3, n3); \
      oA[0] = __builtin_amdgcn_mfma_f32_32x32x16_bf16(a0, v0_, oA[0], 0, 0, 0); oB[0] = __builtin_amdgcn_mfma_f32_32x32x16_bf16(b0, v0_, oB[0], 0, 0, 0); \
      oA[1] = __builtin_amdgcn_mfma_f32_32x32x16_bf16(a0, w0_, oA[1], 0, 0, 0); oB[1] = __builtin_amdgcn_mfma_f32_32x32x16_bf16(b0, w0_, oB[1], 0, 0, 0); \
      oA[0] = __builtin_amdgcn_mfma_f32_32x32x16_bf16(a1, v1_, oA[0], 0, 0, 0); oB[0] = __builtin_amdgcn_mfma_f32_32x32x16_bf16(b1, v1_, oB[0], 0, 0, 0); \
      oA[1] = __builtin_amdgcn_mfma_f32_32x32x16_bf16(a1, w1_, oA[1], 0, 0, 0); oB[1] = __builtin_amdgcn_mfma_f32_32x32x16_bf16(b1, w1_, oB[1], 0, 0, 0); \
      oA[0] = __builtin_amdgcn_mfma_f32_32x32x16_bf16(a2, v2_, oA[0], 0, 0, 0); oB[0] = __builtin_amdgcn_mfma_f32_32x32x16_bf16(b2, v2_, oB[0], 0, 0, 0); \
      oA[1] = __builtin_amdgcn_mfma_f32_32x32x16_bf16(a2, w2_, oA[1], 0, 0, 0); oB[1] = __builtin_amdgcn_mfma_f32_32x32x16_bf16(b2, w2_, oB[1], 0, 0, 0); \
      oA[0] = __builtin_amdgcn_mfma_f32_32x32x16_bf16(a3, v3_, oA[0], 0, 0, 0); oB[0] = __builtin_amdgcn_mfma_f32_32x32x16_bf16(b3, v3_, oB[0], 0, 0, 0); \
      oA[1] = __builtin_amdgcn_mfma_f32_32x32x16_bf16(a3, w3_, oA[1], 0, 0, 0); oB[1] = __builtin_amdgcn_mfma_f32_32x32x16_bf16(b3, w3_, oB[1], 0, 0, 0); } while (0)
#define A2_WAITV(more) do { if (ABL == 5) break; if constexpr (F8) { if (more) { if constexpr (DK == 96) asm volatile("s_waitcnt vmcnt(2)" ::: "memory"); else asm volatile("s_waitcnt vmcnt(1)" ::: "memory"); } else asm volatile("s_waitcnt vmcnt(0)" ::: "memory"); break; } if (more) { if (two) asm volatile("s_waitcnt vmcnt(3)" ::: "memory"); else if (hasK && hasV) asm volatile("s_waitcnt vmcnt(2)" ::: "memory"); else asm volatile("s_waitcnt vmcnt(1)" ::: "memory"); } \
    else asm volatile("s_waitcnt vmcnt(0)" ::: "memory"); } while (0)
#define A2_MF8(KF, QF, ACC) __builtin_amdgcn_mfma_scale_f32_32x32x64_f8f6f4(KF, QF, ACC, 0, 0, 0, 0x7B7B7B7B, 0, 0x7F7F7F7F)
#define A2_MF8P(PF, VF, ACC) __builtin_amdgcn_mfma_scale_f32_32x32x64_f8f6f4(PF, VF, ACC, 0, 0, 0, 0x7F7F7F7F, 0, 0x7F7F7F7F)
#define A2_TILE(S, t) do { \
    A2_WAITV((t) + 1 < NT); \
    if (ABL != 5) __builtin_amdgcn_s_barrier(); \
    A2_SBAR(); \
    if ((t) + 2 < NT) { A2_DMA((t) + 2, ((S) + 2) % 4); } \
    const LAS unsigned char* Ks = lds + (S) * SLOT + kb0; \
    f32x16 pA0 = {}, pA1 = {}, pB0 = {}, pB1 = {}; \
    if constexpr (F8 && FAST) { _Pragma("unroll") for (int r = 0; r < 16; ++r) { pA0[r] = -P8_BIAS; pA1[r] = -P8_BIAS; pB0[r] = -P8_BIAS; pB1[r] = -P8_BIAS; } }     \
    if constexpr (F8 && DK == 64) { const LAS unsigned char* K0 = lds + (S) * SLOT + hi * 2048 + r32 * 16; \
      const pg8::v8i32 k00 = pg8::cat32(*(const LAS bf16x8*)(K0), *(const LAS bf16x8*)(K0 + 1024)), k01 = pg8::cat32(*(const LAS bf16x8*)(K0 + 512), *(const LAS bf16x8*)(K0 + 1536)); \
      pA0 = A2_MF8(k00, qA8[0], pA0); pA1 = A2_MF8(k01, qA8[0], pA1); pB0 = A2_MF8(k00, qB8[0], pB0); pB1 = A2_MF8(k01, qB8[0], pB1); \
      asm volatile("" : "+v"(pA0), "+v"(pA1), "+v"(pB0), "+v"(pB1)); A2_SBAR(); } else \
    if constexpr (F8) { const LAS unsigned char* K0 = lds + (S) * SLOT + hi * 2048 + r32 * 16; const LAS unsigned char* K1 = lds + (S) * SLOT + 4096 + r32 * 16; \
      const pg8::v8i32 k00 = pg8::cat32(*(const LAS bf16x8*)(K0), *(const LAS bf16x8*)(K0 + 1024)), k01 = pg8::cat32(*(const LAS bf16x8*)(K0 + 512), *(const LAS bf16x8*)(K0 + 1536)); \
      const pg8::v8i32 k10 = pg8::cat32(*(const LAS bf16x8*)(K1), *(const LAS bf16x8*)(K1 + 1024)), k11 = pg8::cat32(*(const LAS bf16x8*)(K1 + 512), *(const LAS bf16x8*)(K1 + 1536)); \
      if (ABL == 2) { asm volatile("" :: "v"(k00), "v"(k01), "v"(k10), "v"(k11)); pA0[0] += 0.01f; pB1[1] += 0.02f; } else { \
      pA0 = A2_MF8(k00, qA8[0], pA0); pA1 = A2_MF8(k01, qA8[0], pA1); pB0 = A2_MF8(k00, qB8[0], pB0); pB1 = A2_MF8(k01, qB8[0], pB1); \
      pA0 = A2_MF8(k10, qA8[1], pA0); pA1 = A2_MF8(k11, qA8[1], pA1); pB0 = A2_MF8(k10, qB8[1], pB0); pB1 = A2_MF8(k11, qB8[1], pB1); } \
      asm volatile("" : "+v"(pA0), "+v"(pA1), "+v"(pB0), "+v"(pB1)); A2_SBAR(); } else { \
    bf16x8 kf[2][2]; if (ABL == 4) { kf[0][0] = qA[0]; kf[0][1] = qB[0]; } else { kf[0][0] = *(const LAS bf16x8*)(Ks); kf[0][1] = *(const LAS bf16x8*)(Ks + 512); } \
    _Pragma("unroll") for (int d0 = 0; d0 < ND; ++d0) {              \
      if (d0 + 1 < ND) { if (ABL == 4) { kf[(d0 + 1) & 1][0] = qA[d0 + 1]; kf[(d0 + 1) & 1][1] = qB[d0 + 1]; } else { kf[(d0 + 1) & 1][0] = *(const LAS bf16x8*)(Ks + (d0 + 1) * 2048); kf[(d0 + 1) & 1][1] = *(const LAS bf16x8*)(Ks + (d0 + 1) * 2048 + 512); } } \
      const bf16x8 k0 = kf[d0 & 1][0], k1 = kf[d0 & 1][1]; \
      if (ABL == 2) { asm volatile("" :: "v"(k0), "v"(k1)); pA0[d0] += 0.01f; pB1[d0] += 0.02f; } else { \
      pA0 = __builtin_amdgcn_mfma_f32_32x32x16_bf16(k0, qA[d0], pA0, 0, 0, 0); pA1 = __builtin_amdgcn_mfma_f32_32x32x16_bf16(k1, qA[d0], pA1, 0, 0, 0); \
      pB0 = __builtin_amdgcn_mfma_f32_32x32x16_bf16(k0, qB[d0], pB0, 0, 0, 0); pB1 = __builtin_amdgcn_mfma_f32_32x32x16_bf16(k1, qB[d0], pB1, 0, 0, 0); } \
      A2_SBAR(); } } \
    if (SWA && (t) >= 4) { const int kb_ = 64 * (lt0 + (t) - 4) - qpA;          \
      _Pragma("unroll") for (int r = 0; r < 16; ++r) { const int dA = kb_ + crow(r, hi), dB = dA - 32; \
        if (dA > 128 || dA < -128) pA0[r] = -INFINITY; if (dA + 32 > 128 || dA + 32 < -128) pA1[r] = -INFINITY; \
        if (dB > 128 || dB < -128) pB0[r] = -INFINITY; if (dB + 32 > 128 || dB + 32 < -128) pB1[r] = -INFINITY; } } \
    float alA, alB; bf16x8 a0, a1, a2, a3, b0, b1, b2, b3; \
    pg8::v8i32 pa8, pb8; \
    softmax_blk<FAST, ABL, !F8>(pA0, pA1, mA, lA, alA, a0, a1, a2, a3); \
    if constexpr (F8) { _Pragma("unroll") for (int j = 0; j < 4; ++j) { pa8[j] = (int)pk4fp8(pA0[4 * j], pA0[4 * j + 1], pA0[4 * j + 2], pA0[4 * j + 3]); pa8[4 + j] = (int)pk4fp8(pA1[4 * j], pA1[4 * j + 1], pA1[4 * j + 2], pA1[4 * j + 3]); } asm volatile("" : "+v"(pa8)); } \
    A2_SBAR(); \
    A2_MID((t) + 2 < NT); \
    A2_SBAR(); \
    softmax_blk<FAST, ABL, !F8>(pB0, pB1, mB, lB, alB, b0, b1, b2, b3); \
    if (!FAST && __any(alA < 1.f || alB < 1.f)) {                            \
      if (hi == 0) { ws[64 + r32] = alA; ws[96 + r32] = alB; } \
      asm volatile("s_waitcnt lgkmcnt(0)" ::: "memory"); \
      _Pragma("unroll") for (int d = 0; d < 2; ++d) _Pragma("unroll") for (int r = 0; r < 16; ++r) { oA[d][r] *= ws[64 + crow(r, hi)]; oB[d][r] *= ws[96 + crow(r, hi)]; } } \
    if constexpr (F8) { const LAS unsigned char* Vs = lds + (S) * SLOT + KT + hi * 512 + r32 * 16; \
      const pg8::v8i32 v0_ = pg8::cat32(*(const LAS bf16x8*)(Vs), *(const LAS bf16x8*)(Vs + 1024)), v1_ = pg8::cat32(*(const LAS bf16x8*)(Vs + 2048), *(const LAS bf16x8*)(Vs + 3072)); \
      _Pragma("unroll") for (int j = 0; j < 4; ++j) { pb8[j] = (int)pk4fp8(pB0[4 * j], pB0[4 * j + 1], pB0[4 * j + 2], pB0[4 * j + 3]); pb8[4 + j] = (int)pk4fp8(pB1[4 * j], pB1[4 * j + 1], pB1[4 * j + 2], pB1[4 * j + 3]); } asm volatile("" : "+v"(pb8)); \
      asm volatile("s_waitcnt lgkmcnt(0)" ::: "memory"); A2_SBAR(); \
      if (ABL == 3) { asm volatile("" :: "v"(v0_), "v"(v1_), "v"(pa8), "v"(pb8)); } else { \
      oA[0] = A2_MF8P(pa8, v0_, oA[0]); oB[0] = A2_MF8P(pb8, v0_, oB[0]); oA[1] = A2_MF8P(pa8, v1_, oA[1]); oB[1] = A2_MF8P(pb8, v1_, oB[1]); } \
      asm volatile("" : "+v"(oA[0]), "+v"(oA[1]), "+v"(oB[0]), "+v"(oB[1])); \
    } else { A2_PV(0, vb0 + (S) * SLOT); A2_PV(1, vb0 + (S) * SLOT); } \
    asm volatile("s_waitcnt lgkmcnt(0)" ::: "memory"); \
  } while (0)
#ifdef A2_NOSTAGGER
#define A2_MID(more) do { } while (0)
#else
#define A2_MID(more) do { A2_WAITV(more); if (ABL != 5) __builtin_amdgcn_s_barrier(); } while (0)
#endif
  if constexpr (A2_PIPE && F8 && FAST && ABL == 0 && DK == 96) {
#define P8_LD(p) (*(const LAS bf16x8*)(p))
#define P8_ADD(a_, b_) ({ float o_ = (a_) + (b_); asm("" : "+v"(o_)); o_; })
    const LAS unsigned char* kp0 = lds + hi * 2048 + r32 * 16; const LAS unsigned char* kp1 = lds + 4096 + r32 * 16; const LAS unsigned char* vp0 = lds + KT + hi * 512 + r32 * 16;
    asm volatile("" : "+v"(kp0), "+v"(kp1), "+v"(vp0));
#define P8_KA(S) const LAS unsigned char* K0_ = kp0 + (S) * SLOT; const pg8::v8i32 k00 = pg8::cat32(P8_LD(K0_), P8_LD(K0_ + 1024)), k01 = pg8::cat32(P8_LD(K0_ + 512), P8_LD(K0_ + 1536));
#define P8_KB(S) const LAS unsigned char* K1_ = kp1 + (S) * SLOT; const pg8::v8i32 k10 = pg8::cat32(P8_LD(K1_), P8_LD(K1_ + 1024)), k11 = pg8::cat32(P8_LD(K1_ + 512), P8_LD(K1_ + 1536));
#define P8_VF(S) const LAS unsigned char* Vs_ = vp0 + (S) * SLOT; \
      const pg8::v8i32 v0_ = pg8::cat32(P8_LD(Vs_), P8_LD(Vs_ + 1024)), v1_ = pg8::cat32(P8_LD(Vs_ + 2048), P8_LD(Vs_ + 3072));
#define P8_BIAS16(name)
#define P8_SMG(g, p0, p1, lreg, p8) do { _Pragma("unroll") for (int r_ = 4 * (g); r_ < 4 * (g) + 4; ++r_) { p0[r_] = __builtin_amdgcn_exp2f(p0[r_]); p1[r_] = __builtin_amdgcn_exp2f(p1[r_]); } \
      { float s0_ = P8_ADD(p0[4 * (g)], p1[4 * (g)]), s1_ = P8_ADD(p0[4 * (g) + 1], p1[4 * (g) + 1]), s2_ = P8_ADD(p0[4 * (g) + 2], p1[4 * (g) + 2]), s3_ = P8_ADD(p0[4 * (g) + 3], p1[4 * (g) + 3]); \
        s0_ = P8_ADD(s0_, s1_); s2_ = P8_ADD(s2_, s3_); s0_ = P8_ADD(s0_, s2_); lreg = P8_ADD(lreg, s0_); } asm volatile("" : "+v"(lreg)); \
      p8[g] = (int)pk4fp8(p0[4 * (g)], p0[4 * (g) + 1], p0[4 * (g) + 2], p0[4 * (g) + 3]); p8[4 + (g)] = (int)pk4fp8(p1[4 * (g)], p1[4 * (g) + 1], p1[4 * (g) + 2], p1[4 * (g) + 3]); } while (0)
#define P8_EXP(g, p0, p1) do { _Pragma("unroll") for (int r_ = 4 * (g); r_ < 4 * (g) + 4; ++r_) { p0[r_] = __builtin_amdgcn_exp2f(p0[r_]); p1[r_] = __builtin_amdgcn_exp2f(p1[r_]); } } while (0)
#define P8_FIN(g, p0, p1, lreg, p8) do { \
        \
      lreg = (((((((lreg + p0[4 * (g)]) + p1[4 * (g)]) + p0[4 * (g) + 1]) + p1[4 * (g) + 1]) + p0[4 * (g) + 2]) + p1[4 * (g) + 2]) + p0[4 * (g) + 3]) + p1[4 * (g) + 3]; asm volatile("" : "+v"(lreg)); \
      p8[g] = (int)pk4fp8(p0[4 * (g)], p0[4 * (g) + 1], p0[4 * (g) + 2], p0[4 * (g) + 3]); p8[4 + (g)] = (int)pk4fp8(p1[4 * (g)], p1[4 * (g) + 1], p1[4 * (g) + 2], p1[4 * (g) + 3]); } while (0)
    f32x16 pA0, pA1, pB0, pB1; pg8::v8i32 pa8 = {0, 0, 0, 0, 0, 0, 0, 0}, pb8 = {0, 0, 0, 0, 0, 0, 0, 0};
    f32x16 b16;
#pragma unroll
    for (int r_ = 0; r_ < 16; ++r_) b16[r_] = -P8_BIAS;
    asm volatile("" : "+v"(b16));
    if constexpr (A2_PIPE == 2) asm volatile("s_waitcnt vmcnt(4)" ::: "memory"); else A2_WAITV(1 < NT);
    __builtin_amdgcn_s_barrier();
    { P8_KA(0); P8_KB(0); P8_BIAS16(b16); pA0 = A2_MF8(k00, qA8[0], b16); pA1 = A2_MF8(k01, qA8[0], b16); pA0 = A2_MF8(k10, qA8[1], pA0); pA1 = A2_MF8(k11, qA8[1], pA1); }
    asm volatile("" : "+v"(pA0), "+v"(pA1)); A2_SBAR();
#define P8_TILE(S, t, FIRST) do { \
        \
      __builtin_amdgcn_s_barrier(); A2_SBAR(); \
      if ((t) + 2 < NT) { A2_DMA((t) + 2, ((S) + 2) % 4); } \
      { P8_KA(S); \
        if (!(FIRST)) { P8_VF(((S) + 3) % 4); A2_SBAR(); oB[0] = A2_MF8P(pb8, v0_, oB[0]); A2_SBAR(); P8_SMG(0, pA0, pA1, lA, pa8); A2_SBAR(); oB[1] = A2_MF8P(pb8, v1_, oB[1]); A2_SBAR(); } else { A2_SBAR(); P8_SMG(0, pA0, pA1, lA, pa8); A2_SBAR(); } \
        pB0 = A2_MF8(k00, qB8[0], b16); A2_SBAR(); P8_KB(S); P8_SMG(1, pA0, pA1, lA, pa8); A2_SBAR(); pB1 = A2_MF8(k01, qB8[0], b16); A2_SBAR(); P8_SMG(2, pA0, pA1, lA, pa8); A2_SBAR(); \
        pB0 = A2_MF8(k10, qB8[1], pB0); A2_SBAR(); P8_SMG(3, pA0, pA1, lA, pa8); A2_SBAR(); pB1 = A2_MF8(k11, qB8[1], pB1); } \
      asm volatile("" : "+v"(pB0), "+v"(pB1), "+v"(pa8), "+v"(oB[0]), "+v"(oB[1])); A2_SBAR(); \
        \
      A2_WAITV((t) + 2 < NT); __builtin_amdgcn_s_barrier(); A2_SBAR(); \
      { P8_VF(S); P8_KA(((S) + 1) % 4); A2_SBAR(); \
        oA[0] = A2_MF8P(pa8, v0_, oA[0]); A2_SBAR(); P8_SMG(0, pB0, pB1, lB, pb8); A2_SBAR(); oA[1] = A2_MF8P(pa8, v1_, oA[1]); A2_SBAR(); \
        pA0 = A2_MF8(k00, qA8[0], b16); A2_SBAR(); P8_KB(((S) + 1) % 4); P8_SMG(1, pB0, pB1, lB, pb8); A2_SBAR(); pA1 = A2_MF8(k01, qA8[0], b16); A2_SBAR(); P8_SMG(2, pB0, pB1, lB, pb8); A2_SBAR(); \
        pA0 = A2_MF8(k10, qA8[1], pA0); A2_SBAR(); P8_SMG(3, pB0, pB1, lB, pb8); A2_SBAR(); pA1 = A2_MF8(k11, qA8[1], pA1); } \
      asm volatile("" : "+v"(pA0), "+v"(pA1), "+v"(pb8), "+v"(oA[0]), "+v"(oA[1])); A2_SBAR(); \
    } while (0)
#define P8_TILE5(S, t, FIRST) do { \
      A2_WAITV((t) + 2 < NT); __builtin_amdgcn_s_barrier(); A2_SBAR(); \
      if ((t) + 3 < NT) { A2_DMA((t) + 3, ((S) + 3) % 5); } \
        \
      { P8_KA(S); \
        if (!(FIRST)) { P8_VF(((S) + 4) % 5); A2_SBAR(); oB[0] = A2_MF8P(pb8, v0_, oB[0]); A2_SBAR(); P8_EXP(0, pA0, pA1); A2_SBAR(); oB[1] = A2_MF8P(pb8, v1_, oB[1]); A2_SBAR(); } else { A2_SBAR(); P8_EXP(0, pA0, pA1); A2_SBAR(); } \
        P8_EXP(1, pA0, pA1); A2_SBAR(); P8_FIN(0, pA0, pA1, lA, pa8); A2_SBAR(); \
        pB0 = A2_MF8(k00, qB8[0], b16); A2_SBAR(); P8_KB(S); P8_EXP(2, pA0, pA1); A2_SBAR(); P8_FIN(1, pA0, pA1, lA, pa8); A2_SBAR(); \
        pB1 = A2_MF8(k01, qB8[0], b16); A2_SBAR(); P8_EXP(3, pA0, pA1); A2_SBAR(); P8_FIN(2, pA0, pA1, lA, pa8); A2_SBAR(); \
        pB0 = A2_MF8(k10, qB8[1], pB0); A2_SBAR(); P8_FIN(3, pA0, pA1, lA, pa8); A2_SBAR(); pB1 = A2_MF8(k11, qB8[1], pB1); } \
      asm volatile("" : "+v"(pB0), "+v"(pB1), "+v"(pa8), "+v"(oB[0]), "+v"(oB[1])); A2_SBAR(); \
      { P8_VF(S); P8_KA(((S) + 1) % 5); A2_SBAR(); \
        oA[0] = A2_MF8P(pa8, v0_, oA[0]); A2_SBAR(); P8_EXP(0, pB0, pB1); A2_SBAR(); oA[1] = A2_MF8P(pa8, v1_, oA[1]); A2_SBAR(); \
        P8_EXP(1, pB0, pB1); A2_SBAR(); P8_FIN(0, pB0, pB1, lB, pb8); A2_SBAR(); \
        pA0 = A2_MF8(k00, qA8[0], b16); A2_SBAR(); P8_KB(((S) + 1) % 5); P8_EXP(2, pB0, pB1); A2_SBAR(); P8_FIN(1, pB0, pB1, lB, pb8); A2_SBAR(); \
        pA1 = A2_MF8(k01, qA8[0], b16); A2_SBAR(); P8_EXP(3, pB0, pB1); A2_SBAR(); P8_FIN(2, pB0, pB1, lB, pb8); A2_SBAR(); \
        pA0 = A2_MF8(k10, qA8[1], pA0); A2_SBAR(); P8_FIN(3, pB0, pB1, lB, pb8); A2_SBAR(); pA1 = A2_MF8(k11, qA8[1], pA1); } \
      asm volatile("" : "+v"(pA0), "+v"(pA1), "+v"(pb8), "+v"(oA[0]), "+v"(oA[1])); A2_SBAR(); \
    } while (0)
    if constexpr (A2_PIPE == 2) {
#ifdef A2_PEEL
      P8_TILE5(0, 0, true); P8_TILE5(1, 1, false); P8_TILE5(2, 2, false); P8_TILE5(3, 3, false); P8_TILE5(4, 4, false);
      for (int t = 5; t + 4 < NT; t += 5) { P8_TILE5(0, t, false); P8_TILE5(1, t + 1, false); P8_TILE5(2, t + 2, false); P8_TILE5(3, t + 3, false); P8_TILE5(4, t + 4, false); }
#else
      for (int t = 0; t + 4 < NT; t += 5) { P8_TILE5(0, t, t == 0); P8_TILE5(1, t + 1, false); P8_TILE5(2, t + 2, false); P8_TILE5(3, t + 3, false); P8_TILE5(4, t + 4, false); }
#endif
      { P8_VF(4); oB[0] = A2_MF8P(pb8, v0_, oB[0]); oB[1] = A2_MF8P(pb8, v1_, oB[1]); }
    } else {
    P8_TILE(0, 0, true); P8_TILE(1, 1, false); P8_TILE(2, 2, false); P8_TILE(3, 3, false);
    for (int t = 4; t + 3 < NT; t += 4) { P8_TILE(0, t, false); P8_TILE(1, t + 1, false); P8_TILE(2, t + 2, false); P8_TILE(3, t + 3, false); }
    { P8_VF(3); oB[0] = A2_MF8P(pb8, v0_, oB[0]); oB[1] = A2_MF8P(pb8, v1_, oB[1]); }
    }
    { auto rr = __builtin_amdgcn_permlane32_swap(__float_as_uint(lA), __float_as_uint(lA), false, false); lA = __uint_as_float(rr[0]) + __uint_as_float(rr[1]); }
    { auto rr = __builtin_amdgcn_permlane32_swap(__float_as_uint(lB), __float_as_uint(lB), false, false); lB = __uint_as_float(rr[0]) + __uint_as_float(rr[1]); }
#undef P8_TILE
#undef P8_TILE5
#undef P8_SMG
#undef P8_EXP
#undef P8_FIN
#undef P8_VF
#undef P8_KA
#undef P8_KB
#undef P8_BIAS16
#undef P8_LD
#undef P8_ADD
  } else {
#ifndef A2_NOSTAGGER
  if (wid >= 4 && ABL != 5) { A2_WAITV(true); __builtin_amdgcn_s_barrier(); }
#endif
#ifdef A2_PRIO
  if (wid >= 4) __builtin_amdgcn_s_setprio(1);
#endif
  int t = 0;
  for (; t + 3 < NT; t += 4) { A2_TILE(0, t); A2_TILE(1, t + 1); A2_TILE(2, t + 2); A2_TILE(3, t + 3); }
  if (t < NT) { A2_TILE(0, t); if (t + 1 < NT) { A2_TILE(1, t + 1); if (t + 2 < NT) { A2_TILE(2, t + 2); } } }
#ifndef A2_NOSTAGGER
  if (wid < 4 && ABL != 5) __builtin_amdgcn_s_barrier();
#endif
#ifdef A2_PRIO
  __builtin_amdgcn_s_setprio(0);
#endif
  }
#undef A2_MID
#undef A2_WAITV
#undef A2_TILE
#undef A2_MF8
#undef A2_MF8P
#undef A2_PV
#undef A2_PV2
#undef A2_PK
  if (SWA) { const float sk = sinkp[wid & 3] * LOG2E - ((F8 && FAST) ? P8_BIAS : 0.f); lA += __builtin_amdgcn_exp2f(FAST ? sk : sk - mA); lB += __builtin_amdgcn_exp2f(FAST ? sk : sk - mB); }
#ifdef A2_FORCE_FALLBACK
  if (FAST) { if (lane == 0) *flag = 1u; }
#else
  if (FAST) { bool bad = !(lA >= 1e-30f && lA <= 1e30f) || !(lB >= 1e-30f && lB <= 1e30f);
    if constexpr (F8) { float z = 0.f;
#pragma unroll
      for (int r = 0; r < 16; ++r) z += (oA[0][r] + oA[1][r] + oB[0][r] + oB[1][r]) * 0.f;
      bad = bad || !(z == 0.f); }
    if (__any(bad) && lane == 0) *flag = 1u; }
#endif
  if (hi == 0) { ws[r32] = lA; ws[32 + r32] = lB; }
  asm volatile("s_waitcnt lgkmcnt(0)" ::: "memory");
  int hi_e = hi, r32_e = r32; asm volatile("" : "+v"(hi_e), "+v"(r32_e));
#pragma unroll
  for (int blk = 0; blk < 2; ++blk) {
    const int rbase = wrow0 + blk * 32;
    if (rbase < rows_valid) {
#pragma unroll
      for (int r = 0; r < 16; ++r) { const int orow = crow(r, hi_e); const float il = __builtin_amdgcn_rcpf(ws[blk * 32 + orow]);
        if constexpr (SWA) { unsigned char* op = (unsigned char*)Ob + (size_t)(rbase + orow) * DM + r32_e;
          const float il16 = il * 16.f; op[0] = f2fp8((blk ? oB[0][r] : oA[0][r]) * il16); op[32] = f2fp8((blk ? oB[1][r] : oA[1][r]) * il16); }
        else { bf16_t* op = Ob + (size_t)(rbase + orow) * DM + r32_e;
        op[0] = f2bf((blk ? oB[0][r] : oA[0][r]) * il); op[32] = f2bf((blk ? oB[1][r] : oA[1][r]) * il); } }
    }
  }
  asm volatile("s_waitcnt vmcnt(0) lgkmcnt(0)" ::: "memory");
  __builtin_amdgcn_s_barrier();
  bool ok = true;
  if (FAST) { ok = (*flag == 0u); asm volatile("s_waitcnt lgkmcnt(0)" ::: "memory"); __builtin_amdgcn_s_barrier(); }
  return ok;
#undef A2_DMA
#undef A2_DMA8
}
#undef A2_SBAR
}

#ifdef PROBE_RND
__device__ __forceinline__ void phase_rnd(Frame& F, size_t off, size_t nbytes) {
  const Params P = lds_params(F);
  u32x4* base = (u32x4*)(P.ws + off); const size_t n = nbytes / 16;
  for (size_t i = (size_t)F.bid * NTHREADS + F.tid; i < n; i += (size_t)F.G * NTHREADS) {
    u32x4 w = base[i]; unsigned* wp = (unsigned*)&w;
#pragma unroll
    for (int j = 0; j < 4; ++j) { const float a = fp8rt(bf2f((bf16_t)(wp[j] & 0xffff)), 16.f), b = fp8rt(bf2f((bf16_t)(wp[j] >> 16)), 16.f); wp[j] = pk2bf(a, b); }
    base[i] = w; }
}
#endif
#ifdef PROBE_UB
__device__ __forceinline__ void phase_ubench(Frame& F) {
  const Params P = lds_params(F);
  pg8::v8i32 a, b; for (int j = 0; j < 8; ++j) { a[j] = 0x38383838 + F.lane; b[j] = 0x30303030 + j; }
  att::f32x16 c0 = {}, c1 = {}; float e[16];
#pragma unroll
  for (int j = 0; j < 16; ++j) e[j] = -0.001f * (float)(F.lane + j);
#pragma unroll 1
  for (int i = 0; i < 2048; ++i) {
    if (PROBE_UB & 1) c0 = __builtin_amdgcn_mfma_scale_f32_32x32x64_f8f6f4(a, b, c0, 0, 0, 0, 0x7F7F7F7F, 0, 0x7F7F7F7F);
    __builtin_amdgcn_sched_barrier(0);
    if (PROBE_UB & 2) {
#pragma unroll
      for (int j = 0; j < 8; ++j) e[j] = (PROBE_UB & 4) ? e[j] + 1.0009765625f : __builtin_amdgcn_exp2f(e[j]); }
    __builtin_amdgcn_sched_barrier(0);
    if (PROBE_UB & 1) c1 = __builtin_amdgcn_mfma_scale_f32_32x32x64_f8f6f4(a, b, c1, 0, 0, 0, 0x7F7F7F7F, 0, 0x7F7F7F7F);
    __builtin_amdgcn_sched_barrier(0);
    if (PROBE_UB & 2) {
#pragma unroll
      for (int j = 8; j < 16; ++j) e[j] = (PROBE_UB & 4) ? e[j] + 1.0009765625f : __builtin_amdgcn_exp2f(e[j]); }
    __builtin_amdgcn_sched_barrier(0);
    asm volatile("" : "+v"(c0), "+v"(c1));
  }
  float r = 0.f;
#pragma unroll
  for (int j = 0; j < 16; ++j) r += e[j] + c0[j] + c1[j];
  ((float*)(P.ws + WS_PB))[(size_t)F.bid * NTHREADS + F.tid] = r;
}
#endif
__device__ __forceinline__ void phase_attn_mla(Frame& F) {
  const Params P = lds_params(F);
  const bf16_t* Q = (const bf16_t*)(P.ws + WS_QKV + OFF_Q); const bf16_t* QC = (const bf16_t*)(P.ws + WS_QKV + OFF_QC);
  const char* Kimg = (const char*)(P.ws + WS_QKV + OFF_K); const char* Vimg = (const char*)(P.ws + WS_QKV + OFF_V);
  bf16_t* CAT = (bf16_t*)(P.ws + WS_CAT);
  const int v = (F.G % 8 == 0) ? (F.bid % 8) * (F.G / 8) + F.bid / 8 : F.bid;
  for (int U = v; U < 512 + 16; U += F.G) {
    if (U < 512) { const int bh = U >> 5, qb = U & 31, b = bh >> 3, h = bh & 7;
      const bf16_t* Qu = (const bf16_t*)((const char*)Q + ((size_t)bh * SEQ + qb * 512) * 96);
      if (!att2::attn_unit<true, 0, 96, false, true>(Qu, 512, Kimg + (size_t)bh * NKEY * 96, Vimg + (size_t)bh * NKEY * 64,
                                 CAT + ((size_t)b * SEQ + qb * 512) * DM + 512 + h * 64, NKEY / 64, F.lds))
        att2::attn_unit<false, 0, 96, false, true>(Qu, 512, Kimg + (size_t)bh * NKEY * 96, Vimg + (size_t)bh * NKEY * 64,
                               CAT + ((size_t)b * SEQ + qb * 512) * DM + 512 + h * 64, NKEY / 64, F.lds);
    } else { const int bh = U - 512, b = bh >> 3, h = bh & 7;
      att2::attn_unit<false, 0, 96, false, true>((const bf16_t*)((const char*)QC + (size_t)bh * CTX * 96), 256, Kimg + (size_t)bh * NKEY * 96, Vimg + (size_t)bh * NKEY * 64,
                             CAT + ((size_t)NLAT + b * CTX) * DM + 512 + h * 64, CTX / 64, F.lds);
    }
  }
}
#ifdef PROBE_ATT_ABL
__device__ __forceinline__ void phase_attn_probe(Frame& F) {
  const Params P = lds_params(F);
  const bf16_t* Q = (const bf16_t*)(P.ws + WS_QKV + OFF_Q);
  const char* Kimg = (const char*)(P.ws + WS_QKV + OFF_K); const char* Vimg = (const char*)(P.ws + WS_QKV + OFF_V);
  bf16_t* SCR = (bf16_t*)(P.ws + WS_PB);
  const int v = (F.G % 8 == 0) ? (F.bid % 8) * (F.G / 8) + F.bid / 8 : F.bid;
  for (int U = v; U < 512; U += F.G) { const int bh = U >> 5, qb = U & 31, b = bh >> 3, h = bh & 7;
    att2::attn_unit<true, PROBE_ATT_ABL, 96, false, true>((const bf16_t*)((const char*)Q + ((size_t)bh * SEQ + qb * 512) * 96), 512, Kimg + (size_t)bh * NKEY * 96, Vimg + (size_t)bh * NKEY * 64,
                                         SCR + ((size_t)b * SEQ + qb * 512) * DM + 512 + h * 64, NKEY / 64, F.lds); }
}
#endif
__device__ __forceinline__ void phase_attn_swa(Frame& F) {
  const Params P = lds_params(F);
  const bf16_t* Q2 = (const bf16_t*)(P.ws + WS_QKV + OFF_Q2); const char* K2 = (const char*)(P.ws + WS_QKV + OFF_K2); const char* V2 = (const char*)(P.ws + WS_QKV + OFF_V2);
  bf16_t* CAT = (bf16_t*)(P.ws + WS_CAT); const float* sink = P.in[17];
  const int v = (F.G % 8 == 0) ? (F.bid % 8) * (F.G / 8) + F.bid / 8 : F.bid;
  for (int U = v; U < NB * 4 * 128; U += F.G) {
    const int bk = U >> 7, qb = U & 127, b = bk >> 2, kvh = bk & 3, q0 = qb * 128;
    int lo = q0 - 128, hi2 = q0 + 256; if (lo < 0) lo = 0; if (hi2 > SEQ) hi2 = SEQ;
    const int lt0 = lo >> 6, NT = 4 + ((hi2 - lo) >> 6);
    const bf16_t* Qb = (const bf16_t*)((const char*)Q2 + ((size_t)(b * 16 + kvh * 4) * SEQ + q0) * 64); const char* Kb = K2 + (size_t)bk * NKEY * 64; const char* Vb = V2 + (size_t)bk * NKEY * 64;
    bf16_t* Ob = (bf16_t*)((unsigned char*)CAT + ((size_t)b * SEQ + q0) * DM + kvh * 256);
    if (!att2::attn_unit<true, 0, 64, true, true>(Qb, 128, Kb, Vb, Ob, NT, F.lds, lt0, q0, sink + kvh * 4))
      att2::attn_unit<false, 0, 64, true, true>(Qb, 128, Kb, Vb, Ob, NT, F.lds, lt0, q0, sink + kvh * 4);
  }
}
__device__ __forceinline__ float wave_sum(float v) {
#pragma unroll
  for (int o = 1; o < 64; o <<= 1) v += __shfl_xor(v, o);
  return v;
}
__device__ __forceinline__ void row_load(const float* row, int lane, f32x4 (&x)[4]) {
#pragma unroll
  for (int j = 0; j < 4; ++j) x[j] = *(const f32x4*)(row + 4 * lane + 256 * j);
}
__device__ __forceinline__ float row_ssq(const f32x4 (&x)[4]) {
  float s = 0.f;
#pragma unroll
  for (int j = 0; j < 4; ++j) s += (x[j][0] * x[j][0] + x[j][1] * x[j][1]) + (x[j][2] * x[j][2] + x[j][3] * x[j][3]);
  return wave_sum(s);
}
__device__ __forceinline__ void xs_load(const bf16_t* xsb, const float* xcx, int r, int lane, f32x4 (&x)[4]) {
  if (r < NLAT) { const bf16_t* p = xsb + (size_t)r * DM + 4 * lane;
#pragma unroll
    for (int j = 0; j < 4; ++j) { const u32x2 w = *(const u32x2*)(p + 256 * j);
      x[j] = (f32x4){bf2f((bf16_t)(w.x & 0xffff)), bf2f((bf16_t)(w.x >> 16)), bf2f((bf16_t)(w.y & 0xffff)), bf2f((bf16_t)(w.y >> 16))}; } }
  else row_load(xcx + (size_t)(r - NLAT) * DM, lane, x);
}
__device__ __forceinline__ void row_norm_mod_fp8(f32x4 (&x)[4], float inv, const float* g, const float* sh, const float* sc, unsigned char* orow, int lane) {
#pragma unroll
  for (int j = 0; j < 4; ++j) {
    const int c = 4 * lane + 256 * j;
    const f32x4 gg = *(const f32x4*)(g + c), s1 = *(const f32x4*)(sh + c), s2 = *(const f32x4*)(sc + c);
    x[j] = x[j] * inv * gg * (s2 + 1.f) + s1;
    *(unsigned*)(orow + c) = pk4fp8(x[j][0], x[j][1], x[j][2], x[j][3]);
  }
}
__device__ __forceinline__ void row_norm_mod(f32x4 (&x)[4], float inv, const float* g, const float* sh, const float* sc, bf16_t* orow, int lane) {
#pragma unroll
  for (int j = 0; j < 4; ++j) {
    const int c = 4 * lane + 256 * j;
    const f32x4 gg = *(const f32x4*)(g + c), s1 = *(const f32x4*)(sh + c), s2 = *(const f32x4*)(sc + c);
    x[j] = x[j] * inv * gg * (s2 + 1.f) + s1;
    u32x2 w; w.x = pk2bf(x[j][0], x[j][1]); w.y = pk2bf(x[j][2], x[j][3]);
    *(u32x2*)(orow + c) = w;
  }
}

__device__ __forceinline__ void phase_norm1_l0(Frame& F) {
  const Params P = lds_params(F);
  const float* x = P.in[0]; const float* ctx = P.in[2]; const float* g = P.in[6]; const float* modv = (const float*)(P.ws + WS_MODV);
  bf16_t* HB = (bf16_t*)(P.ws + WS_HB);
  for (int row = F.bid * 8 + F.wave; row < NROW; row += F.G * 8) {
    const float* src; int v;
    if (row < NLAT) { src = x + (size_t)row * DM; v = row / SEQ; } else { src = ctx + (size_t)(row - NLAT) * DM; v = 2; }
    f32x4 xv[4]; row_load(src, F.lane, xv);
    const float inv = rsqrtf(row_ssq(xv) * (1.f / DM) + EPS);
    row_norm_mod(xv, inv, g, modv + v * NMOD, modv + v * NMOD + DM, HB + (size_t)row * DM, F.lane);
  }
}

__device__ __forceinline__ void phase_norm2(Frame& F, int layer) {
  const Params P = lds_params(F);
  const float* g = P.in[7] + layer * DM; const float* modl = (const float*)(P.ws + WS_MODV) + (size_t)layer * 3 * NMOD;
  const float* rw = P.in[19] + (size_t)layer * DM * NE;
  const bf16_t* xsb = (const bf16_t*)(P.ws + WS_XSB); const float* xcx = (const float*)(P.ws + WS_XC);
  bf16_t* HB = (bf16_t*)(P.ws + WS_HB); float* aff = (float*)(P.ws + WS_AFF);
  const int nrows = layer == 0 ? NROW : NLAT, lane = F.lane;
  __syncthreads();
  for (int f = F.tid; f < DM * 4; f += NTHREADS) { const int c = f >> 2, q = f & 3, j = c >> 8, ln = (c & 255) >> 2, i = c & 3;
    *(LAS f32x4*)(F.lds + ((4 * j + i) * 4 + q) * 1024 + 16 * ln) = *(const f32x4*)(rw + 4 * f); }
  __syncthreads();
  const unsigned wl = (unsigned)(uintptr_t)(F.lds + 16 * lane);
  const int stride = F.G * 8;
  int row = F.bid * 8 + F.wave;
  f32x4 xv[4], xn[4], xm[4];
  if (row < nrows) xs_load(xsb, xcx, row, lane, xv);
  if (row + stride < nrows) xs_load(xsb, xcx, row + stride, lane, xn);
  int cv = -1; f32x4 ga[4], sb[4];
  while (row < nrows) {
    const int nrow = row + stride, mrow = nrow + stride;
    if (mrow < nrows) xs_load(xsb, xcx, mrow, lane, xm);
    const int v = row < NLAT ? row / SEQ : 2;
    if (v != cv) { cv = v; const float* shp = modl + v * NMOD + 3 * DM; const float* scp = shp + DM;
#pragma unroll
      for (int j = 0; j < 4; ++j) { const int c = 4 * lane + 256 * j; ga[j] = *(const f32x4*)(g + c) * (*(const f32x4*)(scp + c) + 1.f); sb[j] = *(const f32x4*)(shp + c); } }
    const float inv = rsqrtf(row_ssq(xv) * (1.f / DM) + EPS);
    { unsigned char* orow = (unsigned char*)HB + (size_t)row * DM;
#pragma unroll
      for (int j = 0; j < 4; ++j) { xv[j] = xv[j] * inv * ga[j] + sb[j]; *(unsigned*)(orow + 4 * lane + 256 * j) = pk4fp8(xv[j][0], xv[j][1], xv[j][2], xv[j][3]); } }
    typedef float f32x2 __attribute__((ext_vector_type(2)));
    f32x2 pp[8];
#pragma unroll
    for (int e = 0; e < 8; ++e) pp[e] = (f32x2){0.f, 0.f};
#pragma unroll
    for (int j = 0; j < 4; ++j) {
      unsigned wb = wl + j * 16384; asm volatile("" : "+v"(wb));
#pragma unroll
      for (int i = 0; i < 4; ++i)
#pragma unroll
        for (int q = 0; q < 4; ++q) {
          const f32x4 w = *(const LAS f32x4*)(wb + (i * 4 + q) * 1024); const f32x2 hv = (f32x2){xv[j][i], xv[j][i]};
          pp[2 * q] = __builtin_elementwise_fma(hv, (f32x2){w[0], w[1]}, pp[2 * q]); pp[2 * q + 1] = __builtin_elementwise_fma(hv, (f32x2){w[2], w[3]}, pp[2 * q + 1]);
        }
      __builtin_amdgcn_sched_barrier(0);
    }
    float p[16];
#pragma unroll
    for (int e = 0; e < 8; ++e) { p[2 * e] = pp[e][0]; p[2 * e + 1] = pp[e][1]; }
    float q8[8];
#pragma unroll
    for (int e = 0; e < 8; ++e) { auto rr = __builtin_amdgcn_permlane32_swap(__float_as_uint(p[e]), __float_as_uint(p[e + 8]), false, false); q8[e] = __uint_as_float(rr[0]) + __uint_as_float(rr[1]); }
    float q4[4];
#pragma unroll
    for (int e = 0; e < 4; ++e) { const bool up = (lane & 16) != 0; const float snd = up ? q8[e] : q8[e + 4], keep = up ? q8[e + 4] : q8[e]; q4[e] = keep + __shfl_xor(snd, 16); }
    float q2[2];
#pragma unroll
    for (int e = 0; e < 2; ++e) { const bool up = (lane & 8) != 0; const float snd = up ? q4[e] : q4[e + 2], keep = up ? q4[e + 2] : q4[e]; q2[e] = keep + __shfl_xor(snd, 8); }
    float lg; { const bool up = (lane & 4) != 0; const float snd = up ? q2[0] : q2[1], keep = up ? q2[1] : q2[0]; lg = keep + __shfl_xor(snd, 4); }
    lg += __shfl_xor(lg, 2); lg += __shfl_xor(lg, 1);
    float mx = lg;
    mx = fmaxf(mx, __shfl_xor(mx, 4)); mx = fmaxf(mx, __shfl_xor(mx, 8)); mx = fmaxf(mx, __shfl_xor(mx, 16)); mx = fmaxf(mx, __shfl_xor(mx, 32));
    const float ex = expf(lg - mx);
    float sum = ex;
    sum += __shfl_xor(sum, 4); sum += __shfl_xor(sum, 8); sum += __shfl_xor(sum, 16); sum += __shfl_xor(sum, 32);
    if ((lane & 3) == 0) {
      const float a = ex / sum; const int e = 8 * (lane >> 5) + 4 * ((lane >> 4) & 1) + 2 * ((lane >> 3) & 1) + ((lane >> 2) & 1);
      if (row < NLAT) { const int b = row / SEQ, t = row % SEQ; aff[((size_t)(b * NE + e)) * SEQ + t] = a; }
      else { const int jj = row - NLAT, b = jj / CTX, t = jj % CTX; aff[(size_t)NB * NE * SEQ + ((size_t)(b * NE + e)) * CTX + t] = a; }
    }
#pragma unroll
    for (int j = 0; j < 4; ++j) { xv[j] = xn[j]; xn[j] = xm[j]; }
    row = nrow;
  }
  __syncthreads();
}

__device__ __forceinline__ void phase_preup(Frame& F) {
  const Params P = lds_params(F);
  const bf16_t* Pm = (const bf16_t*)(P.ws + WS_PB); bf16_t* QKN = (bf16_t*)(P.ws + WS_QN); bf16_t* CAT = (bf16_t*)(P.ws + WS_CAT);
  bf16_t* Kk = (bf16_t*)(P.ws + WS_QKV + OFF_K); const float* tab = (const float*)(P.ws + WS_ROPE);
  const float* cw = P.in[9]; const float* cb = P.in[10]; const float* qg = P.in[11]; const float* kg = P.in[13];
  const int lane = F.lane;
  for (int row = F.bid * 8 + F.wave; row < NROW; row += F.G * 8) {
    const bf16_t* pr = Pm + (size_t)row * PPITCH;
    const bool lat = row < NLAT; int b, pos, t = 0, lo, hi;
    if (lat) { b = row / SEQ; t = row % SEQ; pos = CTX + t; lo = b * SEQ; hi = lo + SEQ; } else { const int j = row - NLAT; b = j / CTX; pos = j % CTX; lo = NLAT + b * CTX; hi = lo + CTX; }
    { const u32x2 qw = *(const u32x2*)(pr + 1536 + 4 * lane); const unsigned kw = *(const unsigned*)(pr + 1792 + 2 * lane);
      const float q0 = bf2f((bf16_t)(qw.x & 0xffff)), q1 = bf2f((bf16_t)(qw.x >> 16)), q2 = bf2f((bf16_t)(qw.y & 0xffff)), q3 = bf2f((bf16_t)(qw.y >> 16));
      const float k0 = bf2f((bf16_t)(kw & 0xffff)), k1 = bf2f((bf16_t)(kw >> 16));
      const float sq = wave_sum((q0 * q0 + q1 * q1) + (q2 * q2 + q3 * q3)), sk = wave_sum(k0 * k0 + k1 * k1);
      const float iq = rsqrtf(sq * (1.f / 256.f) + EPS), ik = rsqrtf(sk * (1.f / 128.f) + EPS);
      const f32x4 gq = *(const f32x4*)(qg + 4 * lane); const float gk0 = kg[2 * lane], gk1 = kg[2 * lane + 1];
      unsigned char* qrow = (unsigned char*)QKN + (size_t)row * 512;
      *(unsigned*)(qrow + 4 * lane) = pk4fp8(q0 * iq * gq[0], q1 * iq * gq[1], q2 * iq * gq[2], q3 * iq * gq[3]);
      *(unsigned short*)(qrow + 256 + 2 * lane) = (unsigned short)__builtin_amdgcn_cvt_pk_fp8_f32(k0 * ik * gk0, k1 * ik * gk1, 0, false);
      if (lane < 32) *(unsigned*)(qrow + 384 + 4 * lane) = 0u; }
    { const int p = lane & 15, a = p >> 3, ii = p & 7, hq = lane >> 4;
      const float x1 = bf2f(pr[1920 + a * 16 + ii]), x2 = bf2f(pr[1920 + a * 16 + 8 + ii]);
      float cs = 1.f, sn = 0.f;
      if (lat) { const int pp = a == 0 ? (t >> 6) : (t & 63); cs = tab[pp * 8 + ii]; sn = tab[2048 + pp * 8 + ii]; }
      const unsigned short w = (unsigned short)__builtin_amdgcn_cvt_pk_fp8_f32(x1 * cs - x2 * sn, x1 * sn + x2 * cs, 0, false);
#pragma unroll
      for (int hh = 0; hh < 2; ++hh) { const int h = 2 * hq + hh;
        *(unsigned short*)((char*)Kk + (size_t)(b * 8 + h) * NKEY * 96 + (size_t)(pos >> 6) * 6144 + (4 + (p >> 3)) * 1024 + (pos & 63) * 16 + (p & 7) * 2) = w; } }
    { const int c = 8 * lane;
      const u32x4 gbv = *(const u32x4*)(pr + c), gc1 = *(const u32x4*)(pr + 512 + c), u1 = *(const u32x4*)(pr + 1024 + c);
      u32x4 gc0 = {0u, 0u, 0u, 0u}, u0 = gc0, gc2 = gc0, u2 = gc0;
      if (row - 1 >= lo) { gc0 = *(const u32x4*)(pr - PPITCH + 512 + c); u0 = *(const u32x4*)(pr - PPITCH + 1024 + c); }
      if (row + 1 < hi) { gc2 = *(const u32x4*)(pr + PPITCH + 512 + c); u2 = *(const u32x4*)(pr + PPITCH + 1024 + c); }
      float y[8];
#pragma unroll
      for (int i = 0; i < 8; ++i) {
        const int sh = (i & 1) * 16; const int wi = i >> 1;
        const float z0 = bf2f((bf16_t)((gc0[wi] >> sh) & 0xffff)) * bf2f((bf16_t)((u0[wi] >> sh) & 0xffff));
        const float z1 = bf2f((bf16_t)((gc1[wi] >> sh) & 0xffff)) * bf2f((bf16_t)((u1[wi] >> sh) & 0xffff));
        const float z2 = bf2f((bf16_t)((gc2[wi] >> sh) & 0xffff)) * bf2f((bf16_t)((u2[wi] >> sh) & 0xffff));
        const float yy = z0 * cw[c + i] + z1 * cw[512 + c + i] + z2 * cw[1024 + c + i] + cb[c + i];
        y[i] = bf2f((bf16_t)((gbv[wi] >> sh) & 0xffff)) * yy;
      }
      u32x4 w; w.x = pk2bf(y[0], y[1]); w.y = pk2bf(y[2], y[3]); w.z = pk2bf(y[4], y[5]); w.w = pk2bf(y[6], y[7]);
      *(u32x4*)(CAT + (size_t)row * DM + c) = w; }
  }
}

template <bool PROBE = false>
__device__ __forceinline__ void phase_combine(Frame& F, int layer) {
  const Params P = lds_params(F);
  const float* modv = (const float*)(P.ws + WS_MODV); const float* modl = modv + (size_t)layer * 3 * NMOD;
  const bf16_t* YE = (const bf16_t*)(P.ws + WS_QKV); const int* slot = (const int*)(P.ws + WS_SLOT);
  bf16_t* xsb = (bf16_t*)(P.ws + WS_XSB); float* xcx = (float*)(P.ws + WS_XC); bf16_t* HB = (bf16_t*)(P.ws + WS_HB);
  const int nrows = layer == 0 ? NROW : NLAT, lane = F.lane, stride = F.G * 8;
#define CB_SLOT(r) (((r) < NLAT) ? slot[((size_t)(((r) / SEQ) * NE + (lane & 15))) * SEQ + (r) % SEQ] \
                                 : slot[(size_t)NB * NE * SEQ + ((size_t)((((r) - NLAT) / CTX) * NE + (lane & 15))) * CTX + ((r) - NLAT) % CTX])
  int row = F.bid * 8 + F.wave;
  f32x4 xv[4], xn[4]; int sl = -1, sln = -1;
  int cv = -1; f32x4 g2v[4], ga[4], sb[4];
  if (row < nrows) { sl = CB_SLOT(row); xs_load(xsb, xcx, row, lane, xv); }
  while (row < nrows) {
    const int nrow = row + stride;
    if (nrow < nrows) { sln = CB_SLOT(nrow); xs_load(xsb, xcx, nrow, lane, xn); }
    int v; size_t ybase; int cap;
    if (row < NLAT) { const int b = row / SEQ; v = b; cap = CAP_L; ybase = (size_t)(b * NE) * CAP_L; }
    else { const int b = (row - NLAT) / CTX; v = 2; cap = CAP_C; ybase = (size_t)32 * CAP_L + (size_t)(b * NE) * CAP_C; }
    f32x4 acc[4];
#pragma unroll
    for (int j = 0; j < 4; ++j) acc[j] = (f32x4){0.f, 0.f, 0.f, 0.f};
    unsigned emask = (unsigned)(__ballot(sl >= 0) & 0xFFFFull);
    while (emask) {
      int ee[4]; u32x2 w[4][4];
#pragma unroll
      for (int k = 0; k < 4; ++k) { ee[k] = emask ? __builtin_ctz(emask) : -1; if (emask) emask &= emask - 1; }
#pragma unroll
      for (int k = 0; k < 4; ++k) if (ee[k] >= 0) { const int s_ = __shfl(sl, ee[k]); const bf16_t* yr = YE + (ybase + (size_t)ee[k] * cap + s_) * DM;
#pragma unroll
        for (int j = 0; j < 4; ++j) w[k][j] = *(const u32x2*)(yr + 4 * lane + 256 * j); }
#pragma unroll
      for (int k = 0; k < 4; ++k) if (ee[k] >= 0) {
#pragma unroll
        for (int j = 0; j < 4; ++j) { acc[j][0] += bf2f((bf16_t)(w[k][j].x & 0xffff)); acc[j][1] += bf2f((bf16_t)(w[k][j].x >> 16)); acc[j][2] += bf2f((bf16_t)(w[k][j].y & 0xffff)); acc[j][3] += bf2f((bf16_t)(w[k][j].y >> 16)); } }
    }
    if (v != cv) { cv = v;
      const float* m1 = modv + 3 * NMOD + v * NMOD;
#pragma unroll
      for (int j = 0; j < 4; ++j) { const int c = 4 * lane + 256 * j; g2v[j] = *(const f32x4*)(modl + v * NMOD + 5 * DM + c);
        if (layer == 0) { ga[j] = *(const f32x4*)(P.in[6] + DM + c) * (*(const f32x4*)(m1 + DM + c) + 1.f); sb[j] = *(const f32x4*)(m1 + c); }
        else ga[j] = *(const f32x4*)(P.in[23] + c); } }
#pragma unroll
    for (int j = 0; j < 4; ++j) xv[j] = xv[j] + g2v[j] * acc[j];
    const float inv = rsqrtf(row_ssq(xv) * (1.f / DM) + EPS);
    if (layer == 0) {
      if (PROBE) { }
      else if (row < NLAT) {
#pragma unroll
        for (int j = 0; j < 4; ++j) { u32x2 w; w.x = pk2bf(xv[j][0], xv[j][1]); w.y = pk2bf(xv[j][2], xv[j][3]); *(u32x2*)(xsb + (size_t)row * DM + 4 * lane + 256 * j) = w; } }
      else {
#pragma unroll
        for (int j = 0; j < 4; ++j) *(f32x4*)(xcx + (size_t)(row - NLAT) * DM + 4 * lane + 256 * j) = xv[j]; }
#pragma unroll
      for (int j = 0; j < 4; ++j) xv[j] = xv[j] * inv * ga[j] + sb[j];
      if (PROBE) { }
      else if (row < NLAT) { unsigned char* orow = (unsigned char*)HB + (size_t)row * DM;
#pragma unroll
        for (int j = 0; j < 4; ++j) *(unsigned*)(orow + 4 * lane + 256 * j) = pk4fp8(xv[j][0], xv[j][1], xv[j][2], xv[j][3]); }
      else { bf16_t* orow = HB + (size_t)row * DM;
#pragma unroll
        for (int j = 0; j < 4; ++j) { u32x2 w; w.x = pk2bf(xv[j][0], xv[j][1]); w.y = pk2bf(xv[j][2], xv[j][3]); *(u32x2*)(orow + 4 * lane + 256 * j) = w; } }
    } else {
      float* op = (PROBE ? (float*)(P.ws + WS_PB) : P.out) + (size_t)row * DM;
#pragma unroll
      for (int j = 0; j < 4; ++j) *(f32x4*)(op + 4 * lane + 256 * j) = xv[j] * inv * ga[j];
    }
#pragma unroll
    for (int j = 0; j < 4; ++j) xv[j] = xn[j];
    sl = sln; row = nrow;
  }
#undef CB_SLOT
}

__device__ __forceinline__ unsigned block_sum_u(unsigned v, LAS unsigned* red, int par, int wave, int lane) {
#pragma unroll
  for (int o = 1; o < 64; o <<= 1) v += __shfl_xor(v, o);
  if (lane == 0) red[par * 8 + wave] = v;
  __syncthreads();
  unsigned s = 0;
#pragma unroll
  for (int i = 0; i < 8; ++i) s += red[par * 8 + i];
  return s;
}
__device__ __forceinline__ void phase_topk(Frame& F, int layer) {
  const Params P = lds_params(F);
  const float* aff = (const float*)(P.ws + WS_AFF); int* sidx = (int*)(P.ws + WS_SIDX); float* sg = (float*)(P.ws + WS_SG); int* slot = (int*)(P.ws + WS_SLOT);
  LAS unsigned* red = (LAS unsigned*)F.lds;
  const int nprob = layer == 0 ? 64 : 32, tid = F.tid, lane = F.lane, wave = F.wave;
  for (int pb = F.bid; pb < nprob; pb += F.G) {
    const bool isctx = pb >= 32; const int ge = isctx ? pb - 32 : pb, n = isctx ? CTX : SEQ, cap = isctx ? CAP_C : CAP_L;
    const size_t aoff = isctx ? (size_t)NB * NE * SEQ + (size_t)ge * CTX : (size_t)ge * SEQ;
    const size_t soff = isctx ? (size_t)NB * NE * CAP_L + (size_t)ge * CAP_C : (size_t)ge * CAP_L;
    unsigned key[32];
#pragma unroll
    for (int j = 0; j < 8; ++j) {
      u32x4 w = {0u, 0u, 0u, 0u};
      if (32 * tid + 4 * j < n) w = *(const u32x4*)(aff + aoff + 32 * tid + 4 * j);
      key[4 * j] = w.x; key[4 * j + 1] = w.y; key[4 * j + 2] = w.z; key[4 * j + 3] = w.w;
    }
    __syncthreads();
    unsigned T = 0u; int par = 0;
    for (int bit = 30; bit >= 0; --bit) {
      const unsigned cand = T | (1u << bit);
      unsigned c = 0;
#pragma unroll
      for (int i = 0; i < 32; ++i) c += (key[i] >= cand) ? 1u : 0u;
      const unsigned tot = block_sum_u(c, red, par, wave, lane); par = (par + 1) & 3;
      if (tot >= (unsigned)cap) T = cand;
    }
    unsigned cg = 0, ce = 0;
#pragma unroll
    for (int i = 0; i < 32; ++i) { cg += (key[i] > T) ? 1u : 0u; ce += (key[i] == T) ? 1u : 0u; }
    const unsigned ngt = block_sum_u(cg, red, par, wave, lane); par = (par + 1) & 3;
    const unsigned need_eq = (unsigned)cap - ngt;
    unsigned pk = cg | (ce << 16), inc = pk;
#pragma unroll
    for (int o = 1; o < 64; o <<= 1) { const unsigned up = __shfl_up(inc, o); if (lane >= o) inc += up; }
    LAS unsigned* wtot = red + 32;
    __syncthreads();
    if (lane == 63) wtot[wave] = inc;
    __syncthreads();
    unsigned base = 0;
#pragma unroll
    for (int i = 0; i < 8; ++i) base += (i < wave) ? wtot[i] : 0u;
    unsigned excl = base + inc - pk;
    unsigned g_before = excl & 0xffffu, e_before = excl >> 16;
    int sl[32];
#pragma unroll
    for (int i = 0; i < 32; ++i) {
      const bool gt = key[i] > T, eq = key[i] == T;
      const bool take = gt || (eq && e_before < need_eq);
      const unsigned s = g_before + (e_before < need_eq ? e_before : need_eq);
      sl[i] = take ? (int)s : -1;
      if (take) { sidx[soff + s] = 32 * tid + i; sg[soff + s] = __uint_as_float(key[i]); }
      g_before += gt ? 1u : 0u; e_before += eq ? 1u : 0u;
    }
    if (32 * tid < n) {
#pragma unroll
      for (int j = 0; j < 8; ++j) { int4 w; w.x = sl[4 * j]; w.y = sl[4 * j + 1]; w.z = sl[4 * j + 2]; w.w = sl[4 * j + 3]; *(int4*)(slot + aoff + 32 * tid + 4 * j) = w; }
    }
    __syncthreads();
  }
  __syncthreads();
  if (F.G > 32) { if (F.bid >= 32) { cvt_run<true>(P, (LAS float*)(F.lds + 1024), layer, F.bid - 32, F.G - 32, CVT_MOE);
#ifdef PROBE_CVT2
      __syncthreads(); cvt_run<true>(P, (LAS float*)(F.lds + 1024), layer, F.bid - 32, F.G - 32, CVT_MOE);
#endif
  } }
  else cvt_run<true>(P, (LAS float*)(F.lds + 1024), layer, F.bid, F.G, CVT_MOE);
}

__device__ __forceinline__ void rope4(f32x4& v0, f32x4& v1, const f32x4 cs, const f32x4 sn) {
  f32x4 w0, w1;
  w0[0] = v0[0] * cs[0] - v0[1] * sn[0]; w0[1] = v0[0] * sn[0] + v0[1] * cs[0]; w0[2] = v0[2] * cs[1] - v0[3] * sn[1]; w0[3] = v0[2] * sn[1] + v0[3] * cs[1];
  w1[0] = v1[0] * cs[2] - v1[1] * sn[2]; w1[1] = v1[0] * sn[2] + v1[1] * cs[2]; w1[2] = v1[2] * cs[3] - v1[3] * sn[3]; w1[3] = v1[2] * sn[3] + v1[3] * cs[3];
  v0 = w0; v1 = w1;
}
__device__ __forceinline__ int v_img(int k, int c) { const int kk = (k & ~0xC) | ((k & 4) << 1) | ((k & 8) >> 1); return ((kk >> 3) * 2 + (c >> 5)) * 512 + ((kk & 7) * 32 + (c & 31)) * 2; }
template <int KIND, bool ROT>
__device__ __forceinline__ void up_store(const f32x4 (&acc)[2][2][4][2], const int bj, char* base, const int pos0, const int dd, const float* tabp, const int tl, const int a) {
#pragma unroll
  for (int ai = 0; ai < 2; ++ai)
#pragma unroll
    for (int m = 0; m < 4; ++m) {
      const int ro = ai * 128 + m * 16;
      f32x4 v0 = acc[ai][bj][m][0], v1 = acc[ai][bj][m][1];
      if (ROT) { const int t = tl + ro; const int pp = a == 0 ? (t >> 6) : (t & 63); rope4(v0, v1, *(const f32x4*)(tabp + pp * 8), *(const f32x4*)(tabp + 2048 + pp * 8)); }
      const int pos = pos0 + ro;
      if (KIND == 2) {
        const unsigned w0 = pk4fp8(v0[0], v0[1], v0[2], v0[3]), w1 = pk4fp8(v1[0], v1[1], v1[2], v1[3]);
        const int qi = pos & 3; const unsigned sel = (unsigned)qi | ((unsigned)(4 + qi) << 8);
        unsigned o[2];
#pragma unroll
        for (int e = 0; e < 2; ++e) { const unsigned w = e ? w1 : w0;
          const unsigned t0 = (unsigned)__builtin_amdgcn_update_dpp(0, (int)w, 0x00, 0xF, 0xF, false), t1 = (unsigned)__builtin_amdgcn_update_dpp(0, (int)w, 0x55, 0xF, 0xF, false);
          const unsigned t2 = (unsigned)__builtin_amdgcn_update_dpp(0, (int)w, 0xAA, 0xF, 0xF, false), t3 = (unsigned)__builtin_amdgcn_update_dpp(0, (int)w, 0xFF, 0xF, 0xF, false);
          const unsigned x01 = __builtin_amdgcn_perm(t1, t0, sel), x23 = __builtin_amdgcn_perm(t3, t2, sel);
          o[e] = (x01 & 0xffffu) | (x23 << 16); }
        const int kk = pos & 63, a_ = kk >> 5, hi_ = (kk >> 2) & 1, j_ = (kk & 31) >> 3;
        char* tb = base + (size_t)(pos >> 6) * 4096 + (a_ * 2 + hi_) * 512 + j_ * 4;
#pragma unroll
        for (int e = 0; e < 2; ++e) { const int d = dd + 4 * e + qi; *(unsigned*)(tb + (d >> 5) * 2048 + (d & 31) * 16) = o[e]; } }
      else { u32x2 w; w.x = pk4fp8(v0[0], v0[1], v0[2], v0[3]); w.y = pk4fp8(v1[0], v1[1], v1[2], v1[3]);
        char* dst = KIND == 0 ? base + (size_t)pos * 96 + dd : base + (size_t)(pos >> 6) * 6144 + (dd >> 4) * 1024 + (pos & 63) * 16 + (dd & 15);
        *(u32x2*)dst = w; }
    }
}
struct EpiUp {
  static constexpr bool PERM = true;
  bf16_t* Q; bf16_t* QC; bf16_t* K; bf16_t* V; const float* tab;
  __device__ __forceinline__ void operator()(const f32x4 (&acc)[2][2][4][2], const pg8::Unit& u, int wr, int wc, int fr, int fq) const {
    const int trow0 = u.pm * 256; const bool isctx = trow0 >= NLAT;
    const int b = isctx ? (trow0 - NLAT) / CTX : trow0 / SEQ;
    const int tl = (isctx ? 0 : trow0 % SEQ) + wr * 64 + fr;
#pragma unroll
    for (int bj = 0; bj < 2; ++bj) {
      const int cg = u.pn * 256 + bj * 128 + wc * 32;
      if (cg < 768) { const int h = cg / 96, ddg = cg % 96;
        char* base = isctx ? (char*)QC + (size_t)(b * 8 + h) * CTX * 96 : (char*)Q + (size_t)(b * 8 + h) * SEQ * 96;
        if (ddg >= 64 && !isctx) up_store<0, true>(acc, bj, base, tl, ddg + 8 * fq, tab + ((4 * fq) & 7), tl, (4 * fq) >> 3);
        else up_store<0, false>(acc, bj, base, tl, ddg + 8 * fq, tab, tl, 0); }
      else { const int j = cg - 768, h = j >> 7, ddg = j & 127; const int pos0 = (isctx ? 0 : CTX) + tl;
        if (ddg < 64) up_store<1, false>(acc, bj, (char*)K + (size_t)(b * 8 + h) * NKEY * 96, pos0, ddg + 8 * fq, tab, tl, 0);
        else up_store<2, false>(acc, bj, (char*)V + (size_t)(b * 8 + h) * NKEY * 64, pos0, (ddg - 64) + 8 * fq, tab, tl, 0); }
    }
  }
};
struct EpiQkv2 {
  static constexpr bool PERM = true;
  bf16_t* Q2; bf16_t* K2; bf16_t* V2; const float* tab;
  __device__ __forceinline__ void operator()(const f32x4 (&acc)[2][2][4][2], const pg8::Unit& u, int wr, int wc, int fr, int fq) const {
    const int trow0 = u.pm * 256; const bool isctx = trow0 >= NLAT;
    const int b = isctx ? (trow0 - NLAT) / CTX : trow0 / SEQ;
    const int tl = (isctx ? 0 : trow0 % SEQ) + wr * 64 + fr;
#pragma unroll
    for (int bj = 0; bj < 2; ++bj) {
      const int cg = u.pn * 256 + bj * 128 + wc * 32;
      if (isctx && cg < 1024) continue;
      const int hh = cg >> 6, dd = (cg & 63) + 8 * fq; const int pos = (isctx ? 0 : CTX) + tl;
      const bool rot = (cg < 1280) && !isctx;
      const int kind = cg < 1024 ? 0 : (cg < 1280 ? 1 : 2);
      char* dst0;
      if (kind == 0) dst0 = (char*)Q2 + ((size_t)(b * 16 + hh) * SEQ + tl) * 64 + dd;
      else if (kind == 1) dst0 = (char*)K2 + (size_t)(b * 4 + hh - 16) * NKEY * 64;
      else dst0 = (char*)V2 + (size_t)(b * 4 + hh - 20) * NKEY * 64;
      const int p0 = dd >> 1, a = p0 >> 4, i0 = p0 & 15;
#pragma unroll
      for (int ai = 0; ai < 2; ++ai)
#pragma unroll
        for (int m = 0; m < 4; ++m) {
          const int ro = ai * 128 + m * 16;
          f32x4 v0 = acc[ai][bj][m][0], v1 = acc[ai][bj][m][1];
          if (rot) { const int t = tl + ro; const int pp = a == 0 ? (t >> 6) : (t & 63);
            rope4(v0, v1, *(const f32x4*)(tab + 4096 + pp * 16 + i0), *(const f32x4*)(tab + 8192 + pp * 16 + i0)); }
          const int ps = pos + ro;
          const unsigned w0 = pk4fp8(v0[0], v0[1], v0[2], v0[3]), w1 = pk4fp8(v1[0], v1[1], v1[2], v1[3]);
          if (kind < 2) { u32x2 w; w.x = w0; w.y = w1;
            char* dst = kind == 0 ? dst0 + (size_t)ro * 64 : dst0 + (size_t)(ps >> 6) * 4096 + (dd >> 4) * 1024 + (ps & 63) * 16 + (dd & 15);
            *(u32x2*)dst = w; }
          else {
            const int qi = ps & 3; const unsigned sel = (unsigned)qi | ((unsigned)(4 + qi) << 8);
            const int kk = ps & 63, a_ = kk >> 5, hi_ = (kk >> 2) & 1, j_ = (kk & 31) >> 3;
            char* tb = dst0 + (size_t)(ps >> 6) * 4096 + (a_ * 2 + hi_) * 512 + j_ * 4;
#pragma unroll
            for (int e = 0; e < 2; ++e) { const unsigned w = e ? w1 : w0;
              const unsigned t0 = (unsigned)__builtin_amdgcn_update_dpp(0, (int)w, 0x00, 0xF, 0xF, false), t1 = (unsigned)__builtin_amdgcn_update_dpp(0, (int)w, 0x55, 0xF, 0xF, false);
              const unsigned t2 = (unsigned)__builtin_amdgcn_update_dpp(0, (int)w, 0xAA, 0xF, 0xF, false), t3 = (unsigned)__builtin_amdgcn_update_dpp(0, (int)w, 0xFF, 0xF, 0xF, false);
              const unsigned x01 = __builtin_amdgcn_perm(t1, t0, sel), x23 = __builtin_amdgcn_perm(t3, t2, sel);
              const int d = dd + 4 * e + qi; *(unsigned*)(tb + (d >> 5) * 2048 + (d & 31) * 16) = (x01 & 0xffffu) | (x23 << 16); } }
        }
    }
  }
};

enum { PH_PRO = 0, PH_L0_NORM1, PH_L0_WIN, PH_L0_PREUP, PH_L0_UP, PH_L0_ATTN, PH_L0_WOUT, PH_L0_NORM2, PH_L0_TOPK, PH_L0_GU, PH_L0_DOWN, PH_L0_COMB,
       PH_L1_QKV, PH_L1_ATTN, PH_L1_WOUT, PH_L1_NORM2, PH_L1_TOPK, PH_L1_GU, PH_L1_DOWN, PH_L1_COMB, PH_COUNT };

template <class Epi>
__device__ __forceinline__ void sg_tile(const bf16_t* __restrict__ X, const bf16_t* __restrict__ Wt, const int K, const int row0, const int col0, const int lane, const Epi& E) {
    using att::f32x16;
    const int r32 = lane & 31, hi = lane >> 5;
    const bf16_t* xp = X + (size_t)(row0 + r32) * K + hi * 8;
    const bf16_t* w0 = Wt + (size_t)(col0 + r32) * K + hi * 8;
    f32x16 a0 = {}, a1 = {};
#pragma unroll 16
    for (int s = 0; s < K; s += 32) {
        const bf16x8 x0 = *reinterpret_cast<const bf16x8*>(xp + s), wa = *reinterpret_cast<const bf16x8*>(w0 + s);
        const bf16x8 x1 = *reinterpret_cast<const bf16x8*>(xp + s + 16), wb = *reinterpret_cast<const bf16x8*>(w0 + s + 16);
        a0 = __builtin_amdgcn_mfma_f32_32x32x16_bf16(wa, x0, a0, 0, 0, 0); a1 = __builtin_amdgcn_mfma_f32_32x32x16_bf16(wb, x1, a1, 0, 0, 0);
    }
#pragma unroll
    for (int g = 0; g < 4; ++g)
        E(row0 + r32, col0 + 8 * g + 4 * hi, (f32x4){a0[4 * g] + a1[4 * g], a0[4 * g + 1] + a1[4 * g + 1], a0[4 * g + 2] + a1[4 * g + 2], a0[4 * g + 3] + a1[4 * g + 3]});
}
template <class Epi>
__device__ __forceinline__ void sg_ctx(Frame& F, const bf16_t* X, const bf16_t* Wt, int K, int col_lo, int col_hi, const Epi& E) {
    const int ncb = (col_hi - col_lo) / 32, nu = (NCTX / 32) * ncb;
    for (int u = F.bid + F.wave * F.G; u < nu; u += 8 * F.G) sg_tile(X, Wt, K, NLAT + 32 * (u / ncb), col_lo + 32 * (u % ncb), F.lane, E);
}
struct SgStore { bf16_t* out; int ld; __device__ __forceinline__ void operator()(int row, int col, f32x4 v) const { u32x2 w; w.x = pk2bf(v[0], v[1]); w.y = pk2bf(v[2], v[3]); *(u32x2*)(out + (size_t)row * ld + col) = w; } };
struct SgResidCtx { const float* xin; float* xo; const float* gate;
    __device__ __forceinline__ void operator()(int row, int col, f32x4 v) const { const size_t o = (size_t)(row - NLAT) * DM + col; *(f32x4*)(xo + o) = *(const f32x4*)(xin + o) + *(const f32x4*)(gate + col) * v; } };
struct SgKv2Ctx { char* K2; char* V2;
    __device__ __forceinline__ void operator()(int row, int col, f32x4 v) const {
        const int j = row - NLAT, b = j / CTX, pos = j % CTX, hh = (col - 1024) >> 6, dd = col & 63;
        if (hh < 4) *(unsigned*)(K2 + (size_t)(b * 4 + hh) * NKEY * 64 + (size_t)(pos >> 6) * 4096 + (dd >> 4) * 1024 + (pos & 63) * 16 + (dd & 15)) = pk4fp8(v[0], v[1], v[2], v[3]);
        else { const int kk = pos & 63, a_ = kk >> 5, hi_ = (kk >> 2) & 1, tt = (kk & 3) + 4 * ((kk & 31) >> 3);
          char* tb = V2 + (size_t)(b * 4 + hh - 4) * NKEY * 64 + (size_t)(pos >> 6) * 4096 + (a_ * 2 + hi_) * 512 + tt;
#pragma unroll
          for (int e = 0; e < 4; ++e) { const int d = dd + e; *(unsigned char*)(tb + (d >> 5) * 2048 + (d & 31) * 16) = f2fp8(v[e]); } } } };

__device__ __forceinline__ void sg_tile64(const bf16_t* __restrict__ xr0, const bf16_t* __restrict__ xr1, const bf16_t* __restrict__ Wt, const int K, const int col0, const int lane,
                                          att::f32x16 (&acc)[2][2]) {
    const int r32 = lane & 31, hi = lane >> 5;
    const bf16_t* x0 = xr0 + hi * 8; const bf16_t* x1 = xr1 + hi * 8;
    const bf16_t* w0 = Wt + (size_t)(col0 + r32) * K + hi * 8; const bf16_t* w1 = w0 + (size_t)32 * K;
#pragma unroll
    for (int a = 0; a < 2; ++a)
#pragma unroll
        for (int b = 0; b < 2; ++b) acc[a][b] = att::f32x16{};
#pragma unroll 8
    for (int s = 0; s < K; s += 16) {
        const bf16x8 xa = *reinterpret_cast<const bf16x8*>(x0 + s), xb = *reinterpret_cast<const bf16x8*>(x1 + s);
        const bf16x8 wa = *reinterpret_cast<const bf16x8*>(w0 + s), wb = *reinterpret_cast<const bf16x8*>(w1 + s);
        acc[0][0] = __builtin_amdgcn_mfma_f32_32x32x16_bf16(wa, xa, acc[0][0], 0, 0, 0); acc[0][1] = __builtin_amdgcn_mfma_f32_32x32x16_bf16(wa, xb, acc[0][1], 0, 0, 0);
        acc[1][0] = __builtin_amdgcn_mfma_f32_32x32x16_bf16(wb, xa, acc[1][0], 0, 0, 0); acc[1][1] = __builtin_amdgcn_mfma_f32_32x32x16_bf16(wb, xb, acc[1][1], 0, 0, 0);
    }
}
__device__ __forceinline__ void sg_moe_gu_ctx(Frame& F, const Params& P) {
    const bf16_t* HB = (const bf16_t*)(P.ws + WS_HB); const int* sidx = (const int*)(P.ws + WS_SIDX) + 32 * CAP_L;
    bf16_t* HID = (bf16_t*)(P.ws + WS_PB) + (size_t)32 * CAP_L * DFF;
    const int lane = F.lane, r32 = lane & 31, hi = lane >> 5;
    for (int u = F.bid + F.wave * F.G; u < 16 * 32; u += 8 * F.G) {
        const int e = u >> 5, cb = u & 31;
        const int t0 = sidx[(0 * 16 + e) * CAP_C + r32], t1 = sidx[(1 * 16 + e) * CAP_C + r32];
        att::f32x16 acc[2][2];
        sg_tile64(HB + ((size_t)NLAT + 0 * CTX + t0) * DM, HB + ((size_t)NLAT + 1 * CTX + t1) * DM, (const bf16_t*)(P.ws + WS_W + OFF_WGU) + (size_t)e * 2048 * DM, DM, cb * 64, lane, acc);
#pragma unroll
        for (int rb = 0; rb < 2; ++rb) { bf16_t* hrow = HID + ((size_t)(rb * 16 + e) * CAP_C + r32) * DFF;
#pragma unroll
            for (int c2 = 0; c2 < 2; ++c2)
#pragma unroll
                for (int g = 0; g < 4; ++g) { const int col = cb * 64 + c2 * 32 + 8 * g + 4 * hi;
                    const att::f32x16& a = acc[c2][rb];
                    *(unsigned*)(hrow + (col >> 1)) = pk2bf(silu_f(a[4 * g]) * a[4 * g + 1], silu_f(a[4 * g + 2]) * a[4 * g + 3]); } }
    }
}
__device__ __forceinline__ void sg_moe_down_ctx(Frame& F, const Params& P) {
    const bf16_t* HID = (const bf16_t*)(P.ws + WS_PB) + (size_t)32 * CAP_L * DFF; bf16_t* YE = (bf16_t*)(P.ws + WS_QKV) + (size_t)32 * CAP_L * DM;
    const float* sg = (const float*)(P.ws + WS_SG) + 32 * CAP_L;
    const int lane = F.lane, r32 = lane & 31, hi = lane >> 5;
    for (int u = F.bid + F.wave * F.G; u < 16 * 16; u += 8 * F.G) {
        const int e = u >> 4, cb = u & 15;
        att::f32x16 acc[2][2];
        sg_tile64(HID + ((size_t)(0 * 16 + e) * CAP_C + r32) * DFF, HID + ((size_t)(1 * 16 + e) * CAP_C + r32) * DFF, (const bf16_t*)(P.ws + WS_W + OFF_WD) + (size_t)e * 1024 * DFF, DFF, cb * 64, lane, acc);
#pragma unroll
        for (int rb = 0; rb < 2; ++rb) { const size_t r = (size_t)(rb * 16 + e) * CAP_C + r32; const float gv = sg[r]; bf16_t* yrow = YE + r * DM;
#pragma unroll
            for (int c2 = 0; c2 < 2; ++c2)
#pragma unroll
                for (int g = 0; g < 4; ++g) { const int col = cb * 64 + c2 * 32 + 8 * g + 4 * hi; const att::f32x16& a = acc[c2][rb];
                    u32x2 w; w.x = pk2bf(a[4 * g] * gv, a[4 * g + 1] * gv); w.y = pk2bf(a[4 * g + 2] * gv, a[4 * g + 3] * gv); *(u32x2*)(yrow + col) = w; } }
    }
}

__device__ __forceinline__ void phase_gemm_win(Frame& F) {
    const Params P = lds_params(F);
    pg8::SchedPlain S; S.init(NLAT, 2048, DM, (const bf16_t*)(P.ws + WS_W + OFF_WIN), F.G, F.bid);
    EpiStore E{(bf16_t*)(P.ws + WS_PB), PPITCH};
    pg8::gemm_phase<EpiStore, pg8::SchedPlain, true>(F.lds, (const char*)(P.ws + WS_HB), DM, S, E);
    sg_ctx(F, (const bf16_t*)(P.ws + WS_HB), (const bf16_t*)(P.ws + WS_W + OFF_WIN), DM, 0, 1984, SgStore{(bf16_t*)(P.ws + WS_PB), PPITCH});
}
__device__ __forceinline__ void phase_gemm_up(Frame& F) {
    const Params P = lds_params(F);
    pg8::SchedPlainT<1> S; S.init(NROW, 1792, 512, (const bf16_t*)(P.ws + WS_W + OFF_WUP), F.G, F.bid);
    EpiUp E{(bf16_t*)(P.ws + WS_QKV + OFF_Q), (bf16_t*)(P.ws + WS_QKV + OFF_QC), (bf16_t*)(P.ws + WS_QKV + OFF_K), (bf16_t*)(P.ws + WS_QKV + OFF_V), (const float*)(P.ws + WS_ROPE)};
    pg8::gemm_phase<EpiUp, pg8::SchedPlainT<1>, true>(F.lds, (const char*)(P.ws + WS_QN), 512, S, E);
}
__device__ __forceinline__ void phase_gemm_wout(Frame& F, int layer) {
    const Params P = lds_params(F);
    float* modv = (float*)(P.ws + WS_MODV); float* xc = (float*)(P.ws + WS_XC);
    if (layer == 0) {
        pg8::SchedPlain S; S.init(NLAT, DM, DM, (const bf16_t*)(P.ws + WS_W + OFF_WOUT), F.G, F.bid);
        EpiResidB<true> E{P.in[0], (bf16_t*)(P.ws + WS_XSB), modv, 2 * DM};
        pg8::gemm_phase<EpiResidB<true>, pg8::SchedPlain, true>(F.lds, (const char*)(P.ws + WS_CAT), DM, S, E);
        sg_ctx(F, (const bf16_t*)(P.ws + WS_CAT), (const bf16_t*)(P.ws + WS_W + OFF_WOUT), DM, 0, DM, SgResidCtx{P.in[2], xc, modv + 2 * NMOD + 2 * DM});
    } else {
        pg8::SchedPlainT<1, 0x7B7B7B7B> S; S.init(NLAT, DM, DM, (const bf16_t*)(P.ws + WS_W + OFF_WSO), F.G, F.bid);
        EpiResidB<false> E{nullptr, (bf16_t*)(P.ws + WS_XSB), modv + 3 * NMOD, 2 * DM};
        pg8::gemm_phase<EpiResidB<false>, pg8::SchedPlainT<1, 0x7B7B7B7B>, true>(F.lds, (const char*)(P.ws + WS_CAT), DM, S, E);
    }
}
__device__ __forceinline__ void phase_gemm_gu(Frame& F, int layer) {
    const Params P = lds_params(F);
    SchedMoeGU S; S.init((const int*)(P.ws + WS_SIDX), (const bf16_t*)(P.ws + WS_W + OFF_WGU), F.G, F.bid, layer == 0);
    EpiHidMk E{(bf16_t*)(P.ws + WS_PB)};
    pg8::gemm_phase<EpiHidMk, SchedMoeGU, true>(F.lds, (const char*)(P.ws + WS_HB), DM, S, E);
}
__device__ __forceinline__ void phase_gemm_down(Frame& F, int layer) {
    const Params P = lds_params(F);
    SchedMoeDown S; S.init((const bf16_t*)(P.ws + WS_W + OFF_WD), F.G, F.bid, layer == 0);
    EpiYeMk E{(bf16_t*)(P.ws + WS_QKV), (const float*)(P.ws + WS_SG)};
    pg8::gemm_phase<EpiYeMk, SchedMoeDown, true>(F.lds, (const char*)(P.ws + WS_PB), DFF, S, E);
}
__device__ __forceinline__ void phase_gemm_qkv2(Frame& F) {
    const Params P = lds_params(F);
    pg8::SchedPlainT<1> S; S.init(NLAT, 1536, DM, (const bf16_t*)(P.ws + WS_W + OFF_WQKV8), F.G, F.bid);
    EpiQkv2 E{(bf16_t*)(P.ws + WS_QKV + OFF_Q2), (bf16_t*)(P.ws + WS_QKV + OFF_K2), (bf16_t*)(P.ws + WS_QKV + OFF_V2), (const float*)(P.ws + WS_ROPE)};
    pg8::gemm_phase<EpiQkv2, pg8::SchedPlainT<1>, true>(F.lds, (const char*)(P.ws + WS_HB), DM, S, E);
    sg_ctx(F, (const bf16_t*)(P.ws + WS_HB), (const bf16_t*)(P.ws + WS_W + OFF_WQKV), DM, 1024, 1536, SgKv2Ctx{(char*)(P.ws + WS_QKV + OFF_K2), (char*)(P.ws + WS_QKV + OFF_V2)});
}

__global__ void __launch_bounds__(NTHREADS, 2) mk_fwd(Params KP) {
    extern __shared__ __attribute__((aligned(16))) unsigned char lds_raw[];
    Frame F;
    F.lds = (LAS unsigned char*)lds_raw; F.tid = threadIdx.x; F.lane = F.tid & 63; F.wave = __builtin_amdgcn_readfirstlane(F.tid >> 6); F.G = gridDim.x; F.bid = blockIdx.x;
    volatile LAS unsigned* MISC = (volatile LAS unsigned*)(F.lds + LDS_MISC);
    if (F.tid < 16) MISC[F.tid] = 0u;
    if (F.tid < 26) { const unsigned long long v = F.tid < 24 ? (unsigned long long)KP.in[F.tid] : (F.tid == 24 ? (unsigned long long)KP.out : (unsigned long long)KP.ws);
        ((LAS unsigned long long*)(F.lds + LDS_MISC + 64))[F.tid] = v; }
    if ((threadIdx.x & 63) == 0) ((LAS unsigned*)(F.lds + LDS_MISC + 512))[(unsigned)__builtin_amdgcn_s_getreg(0x2804) & 63u] = threadIdx.x >> 6;
    __syncthreads();
    const int lo = KP.ph_lo, hi = KP.ph_hi;
    const bool multi = (hi - lo) > 1;
    XcdBarrier bar; bar.bar = (unsigned*)(KP.ws + WS_CTL); bar.x = 0; bar.st = nullptr;
    if (multi) bar = xcd_barrier_post((unsigned*)(KP.ws + WS_CTL), MISC);
#ifndef PHMASK
#define PHMASK 0xFFFFFu
#endif
#define IN(k) ((((PHMASK) >> (k)) & 1u) && lo <= (k) && (k) < hi)
#define SEAM(k) do { if (IN(k) && IN((k) + 1)) xcd_barrier(bar); } while (0)
#ifndef PROBE_DUP
#define PROBE_DUP 0u
#endif
#define RUN(k, call) do { if (IN(k)) { Frame F; { int t_ = my_tid(); asm volatile("" : "+v"(t_)); F.lds = (LAS unsigned char*)lds_raw; F.tid = t_; F.lane = t_ & 63; \
        F.wave = __builtin_amdgcn_readfirstlane(t_ >> 6); F.G = gridDim.x; F.bid = blockIdx.x; } \
        call; if (((PROBE_DUP) >> (k)) & 1u) { xcd_barrier(bar); call; } } SEAM(k); } while (0)
#ifdef PROBE_UB
    RUN(PH_PRO, phase_ubench(F));
#endif
    RUN(PH_PRO, phase_prologue(F));
    RUN(PH_L0_NORM1, phase_norm1_l0(F));
#ifdef PROBE_RND
    if (PROBE_RND & 1) { RUN(PH_L0_WIN, phase_rnd(F, WS_HB, (size_t)NROW * DM * 2)); if (IN(PH_L0_WIN)) xcd_barrier(bar); }
#endif
    RUN(PH_L0_WIN, phase_gemm_win(F));
    RUN(PH_L0_PREUP, phase_preup(F));
#ifdef PROBE_RND
    if (PROBE_RND & 16) { RUN(PH_L0_UP, phase_rnd(F, WS_QN, (size_t)NROW * 384 * 2)); if (IN(PH_L0_UP)) xcd_barrier(bar); }
#endif
    RUN(PH_L0_UP, phase_gemm_up(F));
    RUN(PH_L0_ATTN, phase_attn_mla(F));
#ifdef PROBE_ATT_ABL
    RUN(PH_L0_ATTN, phase_attn_probe(F)); if (IN(PH_L0_ATTN)) xcd_barrier(bar);
#endif
#ifdef PROBE_RND
    if (PROBE_RND & 2) { RUN(PH_L0_WOUT, phase_rnd(F, WS_CAT, (size_t)NROW * DM * 2)); if (IN(PH_L0_WOUT)) xcd_barrier(bar); }
#endif
    RUN(PH_L0_WOUT, phase_gemm_wout(F, 0));
    RUN(PH_L0_NORM2, phase_norm2(F, 0));
    RUN(PH_L0_TOPK, phase_topk(F, 0));
    RUN(PH_L0_GU, phase_gemm_gu(F, 0));
    RUN(PH_L0_DOWN, phase_gemm_down(F, 0));
    RUN(PH_L0_COMB, phase_combine(F, 0));
#ifdef PROBE_COMB
    if (IN(PH_L0_COMB)) { Frame F; F.lds = (LAS unsigned char*)lds_raw; F.tid = my_tid(); F.lane = F.tid & 63; F.wave = __builtin_amdgcn_readfirstlane(F.tid >> 6); F.G = gridDim.x; F.bid = blockIdx.x; phase_combine<true>(F, PROBE_COMB); xcd_barrier(bar); }
#endif
#ifdef PROBE_RND
    if (PROBE_RND & 4) { RUN(PH_L1_QKV, phase_rnd(F, WS_HB, (size_t)NROW * DM * 2)); if (IN(PH_L1_QKV)) xcd_barrier(bar); }
#endif
    RUN(PH_L1_QKV, phase_gemm_qkv2(F));
#ifdef PROBE_RND
    if (PROBE_RND & 32) { RUN(PH_L1_ATTN, phase_rnd(F, WS_QKV + OFF_Q2, OFF_V2 + (size_t)NB * 4 * NKEY * 64 * 2 - OFF_Q2)); if (IN(PH_L1_ATTN)) xcd_barrier(bar); }
#endif
    RUN(PH_L1_ATTN, phase_attn_swa(F));
#ifdef PROBE_RND
    if (PROBE_RND & 8) { RUN(PH_L1_WOUT, phase_rnd(F, WS_CAT, (size_t)NLAT * DM * 2)); if (IN(PH_L1_WOUT)) xcd_barrier(bar); }
#endif
    RUN(PH_L1_WOUT, phase_gemm_wout(F, 1));
    RUN(PH_L1_NORM2, phase_norm2(F, 1));
    RUN(PH_L1_TOPK, phase_topk(F, 1));
    RUN(PH_L1_GU, phase_gemm_gu(F, 1));
    RUN(PH_L1_DOWN, phase_gemm_down(F, 1));
    RUN(PH_L1_COMB, phase_combine(F, 1));
#undef IN
#undef SEAM
#undef RUN
}

static void launch_phase(hipStream_t s, int grid, const Params& base, int lo, int hi) {
  Params p = base; p.ph_lo = lo; p.ph_hi = hi;
  hipLaunchKernelGGL(mk_fwd, dim3(grid), dim3(NTHREADS), LDS_BYTES, s, p);
}

extern "C" void kernel_launch(void* const* d_in, const int* in_sizes, int n_in, void* d_out, int out_size, void* d_ws, size_t ws_size, hipStream_t stream) {
  static int grid = 0;
  if (grid == 0) {
    if (n_in != 24 || ws_size < WS_END || out_size != NLAT * DM) { fprintf(stderr, "kernel_launch: bad sizes n_in %d ws %zu (need %zu) out %d\n", n_in, ws_size, (size_t)WS_END, out_size); grid = -1; return; }
    int dev = 0, cus = 0;
    if (hipGetDevice(&dev) != hipSuccess || hipDeviceGetAttribute(&cus, hipDeviceAttributeMultiprocessorCount, dev) != hipSuccess) { grid = -1; return; }
    if (hipFuncSetAttribute((const void*)mk_fwd, hipFuncAttributeMaxDynamicSharedMemorySize, LDS_BYTES) != hipSuccess) { fprintf(stderr, "kernel_launch: hipFuncSetAttribute failed\n"); grid = -1; return; }
    int per_cu = 0;
    if (hipOccupancyMaxActiveBlocksPerMultiprocessor(&per_cu, (const void*)mk_fwd, NTHREADS, LDS_BYTES) != hipSuccess || per_cu < 1) { fprintf(stderr, "kernel_launch: occupancy query says %d\n", per_cu); grid = -1; return; }
    grid = cus;
  }
  if (grid < 0) return;
  Params P{};
  for (int i = 0; i < 24; ++i) P.in[i] = (const float*)d_in[i];
  P.out = (float*)d_out; P.ws = (unsigned char*)d_ws; P.ph_lo = 0; P.ph_hi = 0;
  if (hipMemsetAsync((char*)d_ws + WS_CTL, 0, CTL_BYTES, stream) != hipSuccess) return;
#ifdef MK_PER_PHASE
  for (int ph = 0; ph < PH_COUNT; ++ph) launch_phase(stream, grid, P, ph, ph + 1);
#else
  launch_phase(stream, grid, P, 0, PH_COUNT);
#endif
}
```

```cpp
#include <hip/hip_runtime.h>
#include <hip/hip_bf16.h>
#include <cstdio>
#include <cstdint>

typedef unsigned short bf16_t;

constexpr int NB = 2, SEQ = 16384, DM = 1024, CTX = 256;
constexpr int NLAT = NB * SEQ;
constexpr int NCTX = NB * CTX;
constexpr int NROW = NLAT + NCTX;
constexpr int NKEY = CTX + SEQ;
constexpr int AB_IN = 1952, PPITCH = 2048;
constexpr int NE = 16, CAP_L = 2048, CAP_C = 32, DFF = 1024;
constexpr int NMOD = 6 * DM;
constexpr float EPS = 1e-6f;
constexpr float LOG2E = 1.4426950408889634f;
constexpr float QF8_SCALE = 16.f;

constexpr size_t al256(size_t x) { return (x + 255) / 256 * 256; }
constexpr size_t CTL_BYTES = 65536;
constexpr size_t WS_CTL  = 0;
constexpr size_t WS_MODV = WS_CTL + CTL_BYTES;
constexpr size_t WS_ROPE = WS_MODV + al256(2 * 3 * NMOD * 4);
constexpr size_t WS_XC   = WS_ROPE + al256(256 * 48 * 4);
constexpr size_t WS_AFF  = WS_XC + al256((size_t)NCTX * DM * 4);
constexpr size_t WS_SIDX = WS_AFF + al256((size_t)(NB * NE * SEQ + NB * NE * CTX) * 4);
constexpr size_t WS_SG   = WS_SIDX + al256((size_t)(NB * NE * CAP_L + NB * NE * CAP_C) * 4);
constexpr size_t WS_SLOT = WS_SG + al256((size_t)(NB * NE * CAP_L + NB * NE * CAP_C) * 4);
constexpr size_t WS_HB   = WS_SLOT + al256((size_t)(NB * NE * SEQ + NB * NE * CTX) * 4);
constexpr size_t MOE_ROWS = (size_t)NB * NE * CAP_L + NB * NE * CAP_C;
constexpr size_t WS_PB   = WS_HB + al256((size_t)NROW * DM * 2);
constexpr size_t WS_QN   = WS_PB + al256(MOE_ROWS * DM * 2 + (1u << 20));
constexpr size_t WS_KVN  = WS_QN + al256((size_t)NROW * 256 * 2);
constexpr size_t WS_QKV  = WS_KVN + al256((size_t)NROW * 128 * 2);
constexpr size_t QKV_BYTES = MOE_ROWS * DM * 2;
constexpr size_t WS_W    = WS_QKV + al256(QKV_BYTES);
constexpr size_t WS_CAT  = WS_HB;
constexpr size_t OFF_WIN = 0;
constexpr size_t OFF_WUP = OFF_WIN + (size_t)2048 * 1024 * 2;
constexpr size_t OFF_WOUT = OFF_WUP + al256((size_t)1792 * 384 * 2);
constexpr size_t OFF_WQKV = OFF_WOUT + (size_t)1024 * 1024 * 2;
constexpr size_t OFF_WSO = OFF_WQKV + (size_t)1536 * 1024 * 2;
constexpr size_t OFF_WGU = OFF_WSO + (size_t)1024 * 1024 * 2;
constexpr size_t OFF_WD  = OFF_WGU + (size_t)16 * 2048 * 1024;
constexpr size_t OFF_WQKV8 = OFF_WD + (size_t)16 * 1024 * 1024;
constexpr size_t WS_XSB  = WS_W + OFF_WQKV8 + (size_t)1536 * 1024;
constexpr size_t WS_END  = WS_XSB + (size_t)NLAT * DM * 2;
constexpr size_t OFF_Q  = 0;
constexpr size_t OFF_QC = OFF_Q + (size_t)NB * 8 * SEQ * 96 * 2;
constexpr size_t OFF_K  = OFF_QC + (size_t)NB * 8 * CTX * 96 * 2;
constexpr size_t OFF_V  = OFF_K + (size_t)NB * 8 * NKEY * 96 * 2;
static_assert(OFF_V + (size_t)NB * 8 * NKEY * 64 * 2 <= QKV_BYTES, "qkv region");
constexpr size_t OFF_Q2 = 0;
constexpr size_t OFF_K2 = OFF_Q2 + (size_t)NB * 16 * SEQ * 64 * 2;
constexpr size_t OFF_V2 = OFF_K2 + (size_t)NB * 4 * NKEY * 64 * 2;
static_assert(OFF_V2 + (size_t)NB * 4 * NKEY * 64 * 2 <= QKV_BYTES, "qkv2 region");

__device__ __forceinline__ float bf2f(bf16_t v) { return __uint_as_float(((unsigned)v) << 16); }
__device__ __forceinline__ bf16_t f2bf(float f) { unsigned u = __float_as_uint(f); u += 0x7FFFu + ((u >> 16) & 1u); return (bf16_t)(u >> 16); }
__device__ __forceinline__ float silu_f(float x) { return x * __builtin_amdgcn_rcpf(1.f + __builtin_amdgcn_exp2f(x * -1.44269504088896f)); }

__device__ __forceinline__ float block_sum(float v, float* red) {
  for (int d = 32; d > 0; d >>= 1) v += __shfl_xor(v, d, 64);
  __syncthreads();
  if ((threadIdx.x & 63) == 0) red[threadIdx.x >> 6] = v;
  __syncthreads();
  float s = 0.f;
  for (int i = 0; i < (int)(blockDim.x >> 6); ++i) s += red[i];
  return s;
}

#define LAS __attribute__((address_space(3)))
typedef short bf16x8 __attribute__((ext_vector_type(8)));
typedef float f32x4 __attribute__((ext_vector_type(4)));
typedef unsigned u32x4 __attribute__((ext_vector_type(4)));
typedef unsigned u32x2 __attribute__((ext_vector_type(2)));

constexpr int NTHREADS = 512;
constexpr int RING_BYTES = 131072;
constexpr int LDS_MISC = RING_BYTES;
constexpr int LDS_BYTES = RING_BYTES + 1024;
__device__ __forceinline__ int my_tid() {
    extern __shared__ __attribute__((aligned(16))) unsigned char lds_raw[];
    const unsigned key = (unsigned)__builtin_amdgcn_s_getreg(0x2804) & 63u;
    const int w = __builtin_amdgcn_readfirstlane((int)((const LAS unsigned*)((LAS unsigned char*)lds_raw + LDS_MISC + 512))[key]);
    return w * 64 + (int)__builtin_amdgcn_mbcnt_hi(~0u, __builtin_amdgcn_mbcnt_lo(~0u, 0u));
}

struct Params { const float* in[24]; float* out; unsigned char* ws; int ph_lo, ph_hi; };

__device__ __forceinline__ unsigned pk4fp8(float a, float b, float c, float d) { unsigned r;
  asm("v_cvt_pk_fp8_f32 %0, %1, %2" : "=v"(r) : "v"(a), "v"(b)); asm("v_cvt_pk_fp8_f32 %0, %1, %2 op_sel:[0,0,1]" : "+v"(r) : "v"(c), "v"(d)); return r; }
__device__ __forceinline__ unsigned char f2fp8(float x) { return (unsigned char)((unsigned)__builtin_amdgcn_cvt_pk_fp8_f32(x, 0.f, 0, false) & 0xffu); }
__device__ __forceinline__ unsigned pk2bf(float lo, float hi) { return (unsigned)f2bf(lo) | ((unsigned)f2bf(hi) << 16); }
#if defined(PROBE_FP8ATT) || defined(PROBE_RND)
__device__ __forceinline__ float fp8rt(float x, float sc) { const unsigned r = (unsigned)__builtin_amdgcn_cvt_pk_fp8_f32(x * sc, 0.f, 0, false); return __builtin_amdgcn_cvt_f32_fp8((int)r, 0) * (1.f / sc); }
#endif

#define XB_TMO      128
#define XB_XCNT(j)  (256  + 64 * (j))
#define XB_XSUB(j)  (1280 + 64 * (j))
#define XB_XGEN(j)  (2304 + 64 * (j))
#define XB_TOP      3328
#define XB_TOPGEN   3392
#define XCD_BAR_WORDS 3456
#define XB_SPIN_CAP (1u << 18)
__device__ __forceinline__ unsigned xb_ld(unsigned* p)              { return __hip_atomic_load(p, __ATOMIC_RELAXED, __HIP_MEMORY_SCOPE_AGENT); }
__device__ __forceinline__ unsigned xb_add(unsigned* p, unsigned v) { return __hip_atomic_fetch_add(p, v, __ATOMIC_RELAXED, __HIP_MEMORY_SCOPE_AGENT); }
__device__ __forceinline__ unsigned xb_xcc_id() { return (unsigned)__builtin_amdgcn_s_getreg((3 << 11) | 20) & 0xFu; }
#define XB_SPIN(cond, bar) do { unsigned _sp = 0; while (cond) { __builtin_amdgcn_s_sleep(1); \
    if ((++_sp & 255u) == 0u) { if (xb_ld(&(bar)[XB_TMO])) break; if (_sp > XB_SPIN_CAP) { atomicAdd(&(bar)[XB_TMO], 1u); break; } } } } while (0)
struct XcdBarrier { unsigned* bar; unsigned x; volatile LAS unsigned* st; };
__device__ __forceinline__ XcdBarrier xcd_barrier_post(unsigned* bar, volatile LAS unsigned* st) {
    XcdBarrier b; b.bar = bar; b.x = xb_xcc_id(); b.st = st;
    if (my_tid() == 0) (void)xb_add(&bar[XB_XCNT(b.x)], 1u);
    return b;
}
__device__ __forceinline__ void xcd_barrier_complete(unsigned* bar, unsigned x, unsigned& nloc, unsigned& nx) {
    const unsigned G = gridDim.x * gridDim.y * gridDim.z;
    unsigned sum, cnt, mine, sp = 0u;
    for (;;) {
        sum = 0u; cnt = 0u; mine = 0u;
#pragma unroll
        for (unsigned j = 0; j < 16; ++j) { const unsigned c = xb_ld(&bar[XB_XCNT(j)]); sum += c; cnt += (c > 0u) ? 1u : 0u; mine = (j == x) ? c : mine; }
        if (sum == G) break;
        __builtin_amdgcn_s_sleep(1);
        if ((++sp & 255u) == 0u) { if (xb_ld(&bar[XB_TMO])) break; if (sp > XB_SPIN_CAP) { atomicAdd(&bar[XB_TMO], 1u); break; } }
    }
    nloc = mine > 0u ? mine : 1u; nx = cnt > 0u ? cnt : 1u;
}
__device__ __forceinline__ void xcd_barrier(const XcdBarrier& b) {
    asm volatile("s_waitcnt vmcnt(0)" ::: "memory");
    __syncthreads();
    if (my_tid() == 0) {
        unsigned* bar = b.bar;
        __builtin_amdgcn_s_waitcnt(0);
        unsigned nloc = b.st[0], nx = b.st[1];
        if (nloc == 0u) { xcd_barrier_complete(bar, b.x, nloc, nx); b.st[0] = nloc; b.st[1] = nx; }
        const unsigned old = xb_add(&bar[XB_XSUB(b.x)], 1u);
        const unsigned gen = old / nloc;
        if (old + 1u == (gen + 1u) * nloc) {
            __builtin_amdgcn_fence(__ATOMIC_RELEASE, "agent");
            asm volatile("s_waitcnt vmcnt(0)" ::: "memory");
            const unsigned og = xb_add(&bar[XB_TOP], 1u);
            const unsigned tg = og / nx;
            if (og + 1u == (tg + 1u) * nx) xb_add(&bar[XB_TOPGEN], 1u);
            else XB_SPIN(xb_ld(&bar[XB_TOPGEN]) == tg, bar);
            __builtin_amdgcn_fence(__ATOMIC_ACQUIRE, "agent");
            xb_add(&bar[XB_XGEN(b.x)], 1u);
            asm volatile("s_waitcnt vmcnt(0)" ::: "memory");
        } else {
            XB_SPIN(xb_ld(&bar[XB_XGEN(b.x)]) == gen, bar);
            __builtin_amdgcn_fence(__ATOMIC_ACQUIRE, "agent");
            asm volatile("s_waitcnt vmcnt(0)" ::: "memory");
        }
    }
    __syncthreads();
}

namespace pg8 {
constexpr int BM = 256, BK = 64, HALF = 128, HTB = HALF * BK * 2, STAGE_BYTES = 8 * HTB, NXCD = 8, WGM = 8;
__host__ __device__ __forceinline__ int lds_byte(int r, int c) { const int st = (r >> 4) * 2 + (c >> 5), rr = r & 15, cc = c & 31, ob = rr * 64 + cc * 2; return st * 1024 + (ob ^ (((ob >> 9) & 1) << 5)); }
__host__ __device__ __forceinline__ void stage_rc(int b, int& R, int& C) { const int st = b / 1024, sb = b % 1024, swz = sb ^ (((sb >> 9) & 1) << 5); R = (st >> 1) * 16 + swz / 64; C = (st & 1) * 32 + (swz % 64) / 2; }
__host__ __device__ __forceinline__ int perm32(int rho) { const int n = rho >> 4, i = rho & 15; return 8 * (i >> 2) + 4 * n + (i & 3); }
struct Unit { int pm, pn, grp; };

template <int EB_, int ASC_ = 0x7F7F7F7F>
struct SchedPlainT {
    static constexpr int EB = EB_, NBJ = 2, WSCALE = EB_ == 1 ? 0x7A7A7A7A : 0x7F7F7F7F, ASCALE = ASC_;
    int nM, nN, nwg, G, c; const char* Bt; int K;
    __device__ __forceinline__ void init(int M, int N, int K_, const bf16_t* Bt_, int G_, int c_) { nM = M / BM; nN = N / BM; nwg = nM * nN; G = G_; c = c_; Bt = (const char*)Bt_; K = K_; }
    __device__ __forceinline__ bool next(int i, Unit& u) const {
        const long L = (long)i * G + c; if (L >= nwg) return false;
        int wgid = (int)L; { const int q = nwg / NXCD, r = nwg % NXCD, xcd = wgid % NXCD, off = wgid / NXCD; wgid = (xcd < r ? xcd * (q + 1) : r * (q + 1) + (xcd - r) * q) + off; }
        const int nig = WGM * nN, gid = wgid / nig, fm = gid * WGM, gsz = (nM - fm) < WGM ? (nM - fm) : WGM;
        u.pm = fm + ((wgid % nig) % gsz); u.pn = (wgid % nig) / gsz; u.grp = 0; return true;
    }
    __device__ __forceinline__ int a_row(const Unit& u, int r) const { return u.pm * BM + r; }
    __device__ __forceinline__ const char* b_ptr(const Unit& u) const { return Bt + (size_t)u.pn * BM * K * EB; }
};
using SchedPlain = SchedPlainT<2>;

#define PG8_SA(b, h) (((b) * 2 + (h)) * HTB)
#define PG8_SB(b, h) ((4 + (b) * 2 + (h)) * HTB)
#ifdef PROBE_FAKEK
#define PG8_FK_B(x) (stage_on ? (x) : Abase)
#define PG8_FK_V(x) (stage_on ? (x) : 0u)
#else
#define PG8_FK_B(x) (x)
#define PG8_FK_V(x) (x)
#endif
#define PG8_STAGE(bufoff, gbase, voff) do { const char* gb_ = PG8_FK_B((const char*)(gbase)); asm volatile("" : "+s"(gb_)); _Pragma("unroll") for (int _i = 0; _i < 2; ++_i) { unsigned vo_ = PG8_FK_V((voff)[_i]); asm volatile("" : "+v"(vo_)); \
        __builtin_amdgcn_global_load_lds((const unsigned*)(gb_ + vo_), (LAS unsigned*)(lds + (bufoff) + ldsw + _i * 8192), 16, 0, 0); } } while (0)
#define PG8_LDA(dst, b, h) do { _Pragma("unroll") for (int m = 0; m < 4; ++m) { \
        if constexpr (EB == 1) dst##8[m] = cat32(*(const LAS bf16x8*)(lds + PG8_SA(b, h) + aoff + m * 2048), *(const LAS bf16x8*)(lds + PG8_SA(b, h) + aoff + m * 2048 + 1024)); \
        else { _Pragma("unroll") for (int k = 0; k < 2; ++k) dst[m][k] = *(const LAS bf16x8*)(lds + PG8_SA(b, h) + aoff + m * 2048 + k * 1024); } } } while (0)
#define PG8_LDB(dst, b, h) do { _Pragma("unroll") for (int n = 0; n < 2; ++n) { \
        if constexpr (EB == 1) dst##8[n] = cat32(*(const LAS bf16x8*)(lds + PG8_SB(b, h) + boff + n * 2048), *(const LAS bf16x8*)(lds + PG8_SB(b, h) + boff + n * 2048 + 1024)); \
        else { _Pragma("unroll") for (int k = 0; k < 2; ++k) dst[n][k] = *(const LAS bf16x8*)(lds + PG8_SB(b, h) + boff + n * 2048 + k * 1024); } } } while (0)
typedef float f32x16 __attribute__((ext_vector_type(16)));
__device__ __forceinline__ f32x4 get4(const f32x16& v, int k) { return (f32x4){v[4 * k], v[4 * k + 1], v[4 * k + 2], v[4 * k + 3]}; }
__device__ __forceinline__ void set4(f32x16& v, int k, f32x4 x) { v[4 * k] = x[0]; v[4 * k + 1] = x[1]; v[4 * k + 2] = x[2]; v[4 * k + 3] = x[3]; }
typedef int v8i32 __attribute__((ext_vector_type(8)));
typedef int v4i32 __attribute__((ext_vector_type(4)));
__device__ __forceinline__ v8i32 cat32(bf16x8 lo, bf16x8 hi) { const v4i32 a = __builtin_bit_cast(v4i32, lo), b = __builtin_bit_cast(v4i32, hi); return __builtin_shufflevector(a, b, 0, 1, 2, 3, 4, 5, 6, 7); }
#define PG8_MMA(ai, bj, At, Bt) do { __builtin_amdgcn_s_setprio(1); _Pragma("unroll") for (int m = 0; m < 4; ++m) _Pragma("unroll") for (int n = 0; n < 2; ++n) { \
        if constexpr (EB == 1) { if constexpr (ACC16) set4(accT[ai][bj][m >> 1], (m & 1) * 2 + n, __builtin_amdgcn_mfma_scale_f32_16x16x128_f8f6f4(Bt##8[n], At##8[m], get4(accT[ai][bj][m >> 1], (m & 1) * 2 + n), 0, 0, 0, Sched::WSCALE, 0, Sched::ASCALE)); \
            else acc[ai][bj][m][n] = __builtin_amdgcn_mfma_scale_f32_16x16x128_f8f6f4(Bt##8[n], At##8[m], acc[ai][bj][m][n], 0, 0, 0, Sched::WSCALE, 0, Sched::ASCALE); } \
        else { _Pragma("unroll") for (int k = 0; k < 2; ++k) acc[ai][bj][m][n] = __builtin_amdgcn_mfma_f32_16x16x32_bf16(Bt[n][k], At[m][k], acc[ai][bj][m][n], 0, 0, 0); } } \
        __builtin_amdgcn_s_setprio(0); } while (0)
#define PG8_WAIT_V(n) asm volatile("s_waitcnt vmcnt(" #n ")" ::: "memory")
#define PG8_WAIT_K do { if constexpr (NBJ == 2) asm volatile("s_waitcnt vmcnt(8)" ::: "memory"); else asm volatile("s_waitcnt vmcnt(6)" ::: "memory"); } while (0)
#define PG8_WAIT_L(n) asm volatile("s_waitcnt lgkmcnt(" #n ")" ::: "memory")
#define PG8_BAR __builtin_amdgcn_s_barrier()
#define PG8_SCHED __builtin_amdgcn_sched_barrier(0)

template <class Epi, class Sched, bool ALIGN_EPI>
__device__ __forceinline__ void gemm_phase(LAS unsigned char* lds, const char* Abase, const int K, const Sched& S, const Epi& E) {
    const int tid = my_tid(), wid = __builtin_amdgcn_readfirstlane(tid >> 6), lane = tid & 63, wr = wid >> 2, wc = wid & 3, fr = lane & 15, fq = lane >> 4;
    constexpr int EB = Sched::EB, NBJ = Sched::NBJ; constexpr bool ACC16 = (EB == 1 && NBJ == 2);
    const int nt = K * EB / 128;
    unsigned voffB[2];
#pragma unroll
    for (int i = 0; i < 2; ++i) { int R, C; stage_rc(tid * 16 + i * 8192, R, C); const int Rb = Epi::PERM ? ((R & ~31) + perm32(R & 31)) : R; voffB[i] = (unsigned)(Rb * K * EB + C * 2); }
#define PG8_AOFF(dst, unit) do { int l_ = (int)__builtin_amdgcn_mbcnt_hi(~0u, __builtin_amdgcn_mbcnt_lo(~0u, 0u)); asm volatile("" : "+v"(l_)); const int tid_ = wid * 64 + l_; _Pragma("unroll") for (int h = 0; h < 2; ++h) _Pragma("unroll") for (int i = 0; i < 2; ++i) { int R_, C_; stage_rc(tid_ * 16 + i * 8192, R_, C_); \
        dst[h][i] = (unsigned)S.a_row(unit, h * HALF + R_) * (unsigned)(K * EB) + (unsigned)(C_ * 2); } } while (0)
    const size_t kstep = 128;
    const size_t hstep = (size_t)HALF * K * EB;
    const unsigned ldsw = (unsigned)wid * 1024u;
    const int aoff = lds_byte(wr * 64 + fr, fq * 8), boff = lds_byte(wc * 32 + fr, fq * 8);
    Unit cur, nxt; int ui = 0;
#ifdef PROBE_FAKEK
    bool stage_on = true;
#endif
    if (!S.next(0, cur)) return;
#ifdef PROBE_FAKEK
#define PG8_UIX(i) (((PROBE_FAKEK >> (EB == 1 ? 0 : 1)) & 1) ? (i) >> 1 : (i))
#else
#define PG8_UIX(i) (i)
#endif
    f32x4 acc[2][NBJ][4][2];
#pragma unroll
    for (int a = 0; a < 2; ++a)
#pragma unroll
        for (int b = 0; b < NBJ; ++b)
#pragma unroll
            for (int m = 0; m < 4; ++m)
#pragma unroll
                for (int n = 0; n < 2; ++n) acc[a][b][m][n] = (f32x4){0.f, 0.f, 0.f, 0.f};
    f32x16 accT[2][NBJ][2];
#pragma unroll
    for (int a = 0; a < 2; ++a)
#pragma unroll
        for (int b = 0; b < NBJ; ++b)
#pragma unroll
            for (int m = 0; m < 2; ++m)
#pragma unroll
                for (int j = 0; j < 16; ++j) accT[a][b][m][j] = 0.f;
    bf16x8 At[4][2], B0[2][2], B1[2][2];
    v8i32 At8[4], B08[2], B18[2];
    unsigned offc[2][2], offn[2][2];
    PG8_AOFF(offc, cur);
    const char* cB = S.b_ptr(cur);
    PG8_STAGE(PG8_SB(0, 0), cB, voffB); if constexpr (NBJ == 2) PG8_STAGE(PG8_SB(0, 1), cB + hstep, voffB); PG8_STAGE(PG8_SA(0, 0), Abase, offc[0]); PG8_STAGE(PG8_SA(0, 1), Abase, offc[1]);
    if (wr == 1) PG8_BAR;
    PG8_WAIT_V(2); PG8_BAR;
    PG8_STAGE(PG8_SB(1, 0), cB + kstep, voffB); PG8_STAGE(PG8_SA(1, 0), Abase + kstep, offc[0]); if constexpr (NBJ == 2) PG8_STAGE(PG8_SB(1, 1), cB + hstep + kstep, voffB);
    if constexpr (NBJ == 2) PG8_WAIT_V(6); else PG8_WAIT_V(4);
    PG8_BAR;
    for (;;) {
        const bool has_next = S.next(PG8_UIX(ui + 1), nxt);
        const char* nB = cB;
        if (has_next) {
            nB = S.b_ptr(nxt);
            PG8_AOFF(offn, nxt);
        } else {
#pragma unroll
            for (int h = 0; h < 2; ++h)
#pragma unroll
                for (int i = 0; i < 2; ++i) offn[h][i] = offc[h][i];
        }
#pragma unroll 1
        for (int t = 0; t < nt; t += 2) {
            const bool last = (t == nt - 2);
#ifdef PROBE_FAKEK
            stage_on = !((PROBE_FAKEK >> (EB == 1 ? 0 : 1)) & 1) || !(ui & 1) || last;
#endif
            const char* kp1 = Abase + (size_t)(t + 1) * kstep;
            const char* kp2 = last ? Abase : Abase + (size_t)(t + 2) * kstep; const char* b2 = last ? nB : cB + (size_t)(t + 2) * kstep;
            const char* kp3 = kp2 + kstep; const char* b3 = b2 + kstep;
            unsigned o2[2][2];
#pragma unroll
            for (int h = 0; h < 2; ++h)
#pragma unroll
                for (int i = 0; i < 2; ++i) o2[h][i] = last ? offn[h][i] : offc[h][i];
            PG8_LDB(B0, 0, 0); if constexpr (NBJ == 2) PG8_LDB(B1, 0, 1); PG8_SCHED; PG8_LDA(At, 0, 0); PG8_STAGE(PG8_SA(1, 1), kp1, offc[1]);
            PG8_WAIT_K; PG8_WAIT_L(0); PG8_BAR; PG8_MMA(0, 0, At, B0); if constexpr (NBJ == 2) PG8_MMA(0, 1, At, B1); PG8_BAR; PG8_SCHED;
            PG8_LDA(At, 0, 1); PG8_STAGE(PG8_SB(0, 0), b2, voffB); if constexpr (NBJ == 2) PG8_STAGE(PG8_SB(0, 1), b2 + hstep, voffB); PG8_STAGE(PG8_SA(0, 0), kp2, o2[0]);
            PG8_WAIT_K; PG8_WAIT_L(0); PG8_BAR; PG8_MMA(1, 0, At, B0); if constexpr (NBJ == 2) PG8_MMA(1, 1, At, B1); PG8_BAR; PG8_SCHED;
            PG8_LDB(B0, 1, 0); if constexpr (NBJ == 2) PG8_LDB(B1, 1, 1); PG8_SCHED; PG8_LDA(At, 1, 0); PG8_STAGE(PG8_SA(0, 1), kp2, o2[1]);
            PG8_WAIT_K; PG8_WAIT_L(0); PG8_BAR; PG8_MMA(0, 0, At, B0); if constexpr (NBJ == 2) PG8_MMA(0, 1, At, B1); PG8_BAR; PG8_SCHED;
            PG8_LDA(At, 1, 1); PG8_STAGE(PG8_SB(1, 0), b3, voffB); if constexpr (NBJ == 2) PG8_STAGE(PG8_SB(1, 1), b3 + hstep, voffB); PG8_STAGE(PG8_SA(1, 0), kp3, o2[0]);
            PG8_WAIT_K; PG8_WAIT_L(0); PG8_BAR; PG8_MMA(1, 0, At, B0); if constexpr (NBJ == 2) PG8_MMA(1, 1, At, B1); PG8_BAR; PG8_SCHED;
        }
        if constexpr (ALIGN_EPI) { if (wr == 0) PG8_BAR; }
        if constexpr (ACC16) {
#pragma unroll
            for (int a = 0; a < 2; ++a)
#pragma unroll
                for (int b = 0; b < NBJ; ++b)
#pragma unroll
                    for (int m = 0; m < 4; ++m)
#pragma unroll
                        for (int n = 0; n < 2; ++n) acc[a][b][m][n] = get4(accT[a][b][m >> 1], (m & 1) * 2 + n);
        }
#ifdef PROBE_FAKEK
        if (!(((PROBE_FAKEK >> (EB == 1 ? 0 : 1)) & 1) && (ui & 1)))
#endif
        { int l2 = (int)__builtin_amdgcn_mbcnt_hi(~0u, __builtin_amdgcn_mbcnt_lo(~0u, 0u)); asm volatile("" : "+v"(l2)); E(acc, cur, wr, wc, l2 & 15, l2 >> 4); }
#ifdef PROBE_EPI2
        if constexpr (((PROBE_EPI2 >> (EB == 1 ? 0 : 1)) & 1) != 0) { int l2 = (int)__builtin_amdgcn_mbcnt_hi(~0u, __builtin_amdgcn_mbcnt_lo(~0u, 0u)); asm volatile("" : "+v"(l2)); E(acc, cur, wr, wc, l2 & 15, l2 >> 4); }
#endif
        if (!has_next) break;
#pragma unroll
        for (int a = 0; a < 2; ++a)
#pragma unroll
            for (int b = 0; b < NBJ; ++b)
#pragma unroll
                for (int m = 0; m < 4; ++m)
#pragma unroll
                    for (int n = 0; n < 2; ++n) acc[a][b][m][n] = (f32x4){0.f, 0.f, 0.f, 0.f};
#pragma unroll
        for (int a = 0; a < 2; ++a)
#pragma unroll
            for (int b = 0; b < NBJ; ++b)
#pragma unroll
                for (int m = 0; m < 2; ++m)
#pragma unroll
                    for (int j = 0; j < 16; ++j) accT[a][b][m][j] = 0.f;
        cur = nxt; cB = nB; ++ui;
#pragma unroll
        for (int h = 0; h < 2; ++h)
#pragma unroll
            for (int i = 0; i < 2; ++i) offc[h][i] = offn[h][i];
        if constexpr (ALIGN_EPI) { if (wr == 1) PG8_BAR; }
    }
    PG8_WAIT_V(0);
    if constexpr (!ALIGN_EPI) { if (wr == 0) PG8_BAR; }
    PG8_BAR;
}
#undef PG8_AOFF
#undef PG8_SA
#undef PG8_SB
#undef PG8_STAGE
#undef PG8_LDA
#undef PG8_LDB
#undef PG8_MMA
#undef PG8_WAIT_V
#undef PG8_WAIT_L
#undef PG8_WAIT_K
#undef PG8_BAR
#undef PG8_SCHED
}

struct EpiStore {
    static constexpr bool PERM = true;
    bf16_t* out; int ld;
    __device__ __forceinline__ void operator()(const f32x4 (&acc)[2][2][4][2], const pg8::Unit& u, int wr, int wc, int fr, int fq) const {
        const int row0 = u.pm * 256 + wr * 64 + fr, col0 = u.pn * 256 + wc * 32 + 8 * fq;
#pragma unroll
        for (int ai = 0; ai < 2; ++ai)
#pragma unroll
            for (int m = 0; m < 4; ++m) { bf16_t* rowp = out + (size_t)(row0 + ai * 128 + m * 16) * ld + col0;
#pragma unroll
                for (int bj = 0; bj < 2; ++bj) { const f32x4 v0 = acc[ai][bj][m][0], v1 = acc[ai][bj][m][1];
                    u32x4 w; w.x = pk2bf(v0[0], v0[1]); w.y = pk2bf(v0[2], v0[3]); w.z = pk2bf(v1[0], v1[1]); w.w = pk2bf(v1[2], v1[3]);
                    *(u32x4*)(rowp + bj * 128) = w; } }
    }
};
template <bool XIN_F32>
struct EpiResidB {
    static constexpr bool PERM = true;
    const float* xin_f; bf16_t* xs; const float* modl; int g_off;
    __device__ __forceinline__ void operator()(const f32x4 (&acc)[2][2][4][2], const pg8::Unit& u, int wr, int wc, int fr, int fq) const {
        const int row0 = u.pm * 256 + wr * 64 + fr;
        const float* gp = modl + ((u.pm * 256) / SEQ) * NMOD + g_off;
#pragma unroll
        for (int bj = 0; bj < 2; ++bj) {
            const int c = u.pn * 256 + bj * 128 + wc * 32 + 8 * fq;
            const f32x4 g0 = *(const f32x4*)(gp + c), g1 = *(const f32x4*)(gp + c + 4);
#pragma unroll
            for (int ai = 0; ai < 2; ++ai)
#pragma unroll
                for (int m = 0; m < 4; ++m) {
                    const size_t o = (size_t)(row0 + ai * 128 + m * 16) * DM + c;
                    f32x4 x0, x1;
                    if (XIN_F32) { x0 = *(const f32x4*)(xin_f + o); x1 = *(const f32x4*)(xin_f + o + 4); }
                    else { const u32x4 w = *(const u32x4*)(xs + o);
                        x0 = (f32x4){bf2f((bf16_t)(w.x & 0xffff)), bf2f((bf16_t)(w.x >> 16)), bf2f((bf16_t)(w.y & 0xffff)), bf2f((bf16_t)(w.y >> 16))};
                        x1 = (f32x4){bf2f((bf16_t)(w.z & 0xffff)), bf2f((bf16_t)(w.z >> 16)), bf2f((bf16_t)(w.w & 0xffff)), bf2f((bf16_t)(w.w >> 16))}; }
                    const f32x4 y0 = x0 + g0 * acc[ai][bj][m][0], y1 = x1 + g1 * acc[ai][bj][m][1];
                    u32x4 w; w.x = pk2bf(y0[0], y0[1]); w.y = pk2bf(y0[2], y0[3]); w.z = pk2bf(y1[0], y1[1]); w.w = pk2bf(y1[2], y1[3]);
                    *(u32x4*)(xs + o) = w;
                }
        }
    }
};

#ifndef MOE_NBJ
#define MOE_NBJ 2
#endif
constexpr int MNB = MOE_NBJ, GU_NPN = 16 / MNB, DN_NPN = 8 / MNB;
struct SchedMoeGU {
    static constexpr int EB = 1, NBJ = MNB, WSCALE = 0x7F7F7F7F, ASCALE = 0x7F7F7F7F;
    const int* sidx; const char* Wgu; int G, v, nunits;
    __device__ __forceinline__ void init(const int* sidx_, const bf16_t* Wgu_layer, int G_, int c_, bool has_ctx) { sidx = sidx_; Wgu = (const char*)Wgu_layer; G = G_; v = (G_ % 8 == 0) ? (c_ % 8) * (G_ / 8) + c_ / 8 : c_; nunits = 32 * 8 * GU_NPN + (has_ctx ? 32 * GU_NPN : 0); }
    __device__ __forceinline__ bool next(int i, pg8::Unit& u) const {
        const int U = i * G + v; if (U >= nunits) return false;
        if (U < 32 * 8 * GU_NPN) { u.grp = U / (8 * GU_NPN); u.pm = (U % (8 * GU_NPN)) / GU_NPN; u.pn = U % GU_NPN; } else { const int w = U - 32 * 8 * GU_NPN; u.grp = 32 + w / GU_NPN; u.pm = 0; u.pn = w % GU_NPN; }
        return true; }
    __device__ __forceinline__ int a_row(const pg8::Unit& u, int r) const {
        if (u.grp < 32) return (u.grp >> 4) * SEQ + sidx[u.grp * CAP_L + u.pm * 256 + r];
        const int gc = u.grp - 32; return r < CAP_C ? NLAT + (gc >> 4) * CTX + sidx[32 * CAP_L + gc * CAP_C + r] : 0; }
    __device__ __forceinline__ const char* b_ptr(const pg8::Unit& u) const { return Wgu + ((size_t)(u.grp & 15) * 2048 + (size_t)u.pn * (128 * MNB)) * DM; }
};
struct EpiHidMk {
    static constexpr bool PERM = true;
    bf16_t* hid;
    __device__ __forceinline__ void operator()(const f32x4 (&acc)[2][MNB][4][2], const pg8::Unit& u, int wr, int wc, int fr, int fq) const {
        const bool isctx = u.grp >= 32;
        const size_t rbase = isctx ? (size_t)32 * CAP_L + (size_t)(u.grp - 32) * CAP_C : (size_t)u.grp * CAP_L + u.pm * 256;
        const int r0 = wr * 64 + fr + fq * 16, c0 = (u.pn * (128 * MNB) + wc * 32) >> 1;
#pragma unroll
        for (int ai = 0; ai < 2; ++ai)
#pragma unroll
            for (int bj = 0; bj < MNB; ++bj) {
                unsigned w[4];
#pragma unroll
                for (int m = 0; m < 4; ++m) { const f32x4 v0 = acc[ai][bj][m][0] * (1.f / 32.f), v1 = acc[ai][bj][m][1] * (1.f / 32.f);
                    w[m] = pk4fp8(silu_f(v0[0]) * v0[1], silu_f(v0[2]) * v0[3], silu_f(v1[0]) * v1[1], silu_f(v1[2]) * v1[3]); }
                { auto t = __builtin_amdgcn_permlane32_swap(w[0], w[2], false, false); w[0] = t[0]; w[2] = t[1]; }
                { auto t = __builtin_amdgcn_permlane32_swap(w[1], w[3], false, false); w[1] = t[0]; w[3] = t[1]; }
                { auto t = __builtin_amdgcn_permlane16_swap(w[0], w[1], false, false); w[0] = t[0]; w[1] = t[1]; }
                { auto t = __builtin_amdgcn_permlane16_swap(w[2], w[3], false, false); w[2] = t[0]; w[3] = t[1]; }
                const int r = r0 + ai * 128; if (isctx && r >= CAP_C) continue;
                u32x4 o; o.x = w[0]; o.y = w[1]; o.z = w[2]; o.w = w[3];
                *(u32x4*)((unsigned char*)hid + (rbase + r) * DFF + c0 + bj * 64) = o; }
    }
};
struct SchedMoeDown {
    static constexpr int EB = 1, NBJ = MNB, WSCALE = 0x7F7F7F7F, ASCALE = 0x7F7F7F7F;
    const char* Wd; int G, v, nunits;
    __device__ __forceinline__ void init(const bf16_t* Wd_layer, int G_, int c_, bool has_ctx) { Wd = (const char*)Wd_layer; G = G_; v = (G_ % 8 == 0) ? (c_ % 8) * (G_ / 8) + c_ / 8 : c_; nunits = 32 * 8 * DN_NPN + (has_ctx ? 32 * DN_NPN : 0); }
    __device__ __forceinline__ bool next(int i, pg8::Unit& u) const {
        const int U = i * G + v; if (U >= nunits) return false;
        if (U < 32 * 8 * DN_NPN) { u.grp = U / (8 * DN_NPN); u.pm = (U % (8 * DN_NPN)) / DN_NPN; u.pn = U % DN_NPN; } else { const int w = U - 32 * 8 * DN_NPN; u.grp = 32 + w / DN_NPN; u.pm = 0; u.pn = w % DN_NPN; }
        return true; }
    __device__ __forceinline__ int a_row(const pg8::Unit& u, int r) const { return u.grp < 32 ? u.grp * CAP_L + u.pm * 256 + r : 32 * CAP_L + (u.grp - 32) * CAP_C + r; }
    __device__ __forceinline__ const char* b_ptr(const pg8::Unit& u) const { return Wd + ((size_t)(u.grp & 15) * 1024 + (size_t)u.pn * (128 * MNB)) * DFF; }
};
struct EpiYeMk {
    static constexpr bool PERM = true;
    bf16_t* ye; const float* sg;
    __device__ __forceinline__ void operator()(const f32x4 (&acc)[2][MNB][4][2], const pg8::Unit& u, int wr, int wc, int fr, int fq) const {
        const bool isctx = u.grp >= 32;
        const size_t rbase = isctx ? (size_t)32 * CAP_L + (size_t)(u.grp - 32) * CAP_C : (size_t)u.grp * CAP_L + u.pm * 256;
        const int r0 = wr * 64 + fr, c0 = u.pn * (128 * MNB) + wc * 32 + 8 * fq;
#pragma unroll
        for (int ai = 0; ai < 2; ++ai)
#pragma unroll
            for (int m = 0; m < 4; ++m) { const int r = r0 + ai * 128 + m * 16; if (isctx && r >= CAP_C) continue;
                const float g = sg[rbase + r] * (1.f / 32.f);
#pragma unroll
              for (int bj = 0; bj < MNB; ++bj) {
                const f32x4 v0 = acc[ai][bj][m][0] * g, v1 = acc[ai][bj][m][1] * g;
                u32x4 w; w.x = pk2bf(v0[0], v0[1]); w.y = pk2bf(v0[2], v0[3]); w.z = pk2bf(v1[0], v1[1]); w.w = pk2bf(v1[2], v1[3]);
                *(u32x4*)(ye + (rbase + r) * DM + c0 + bj * 128) = w; } }
    }
};

struct Frame {
    LAS unsigned char* lds; int tid, lane, wave, G, bid;
};
__device__ __forceinline__ Params lds_params(const Frame& F) {
    Params P;
    const LAS unsigned* t = (const LAS unsigned*)(F.lds + LDS_MISC + 64);
#pragma unroll
    for (int i = 0; i < 26; ++i) {
        const unsigned lo = (unsigned)__builtin_amdgcn_readfirstlane((int)t[2 * i]), hi = (unsigned)__builtin_amdgcn_readfirstlane((int)t[2 * i + 1]);
        const unsigned long long v = ((unsigned long long)hi << 32) | lo;
        if (i < 24) P.in[i] = (const float*)(const __attribute__((address_space(1))) float*)v; else if (i == 24) P.out = (float*)(__attribute__((address_space(1))) float*)v; else P.ws = (unsigned char*)(__attribute__((address_space(1))) unsigned char*)v;
    }
    P.ph_lo = 0; P.ph_hi = 0;
    return P;
}
enum { MAP_PLAIN = 0, MAP_GU = 1, MAP_QPERM = 2, MAP_SWAPERM = 3 };
struct CvtJob { const float* s0; const float* s1; bf16_t* dst; int ld_src, Ksrc, koff, nvalid, mode, ld_dst, ntr, ntk; float scale; int scale_rows; int fp8; };
__device__ __forceinline__ void cvt_load(const CvtJob& J, int tile, float (&v)[16]) {
    const int tr = tile % J.ntr, tk = tile / J.ntr, r0 = tr * 64, k0 = tk * 128, tid = my_tid();
    if (J.fp8 == 1) {
      const int g4 = tid & 15, kq = tid >> 4; const bool gu = J.mode == MAP_GU;
      const float* s4 = (gu && (g4 & 1)) ? J.s1 : J.s0; const int colb = gu ? (r0 >> 1) + (g4 >> 1) * 4 : r0 + g4 * 4;
#pragma unroll
      for (int j = 0; j < 4; ++j) { const f32x4 t4 = *(const f32x4*)(s4 + (size_t)(k0 + kq + 32 * j) * J.ld_src + colb); v[4 * j] = t4[0]; v[4 * j + 1] = t4[1]; v[4 * j + 2] = t4[2]; v[4 * j + 3] = t4[3]; }
      return; }
    const int rr = tid & 63, r = r0 + rr;
    const float* s = J.s0; int col = r;
    if (J.mode == MAP_GU) { s = (r & 1) ? J.s1 : J.s0; col = r >> 1; }
    else if (J.mode == MAP_QPERM) { const int h = r / 96, dd = r % 96; if (dd >= 64) { const int q = dd - 64, p = q >> 1; col = h * 96 + 64 + (p >> 3) * 16 + (q & 1) * 8 + (p & 7); } }
    else if (J.mode == MAP_SWAPERM) { if (r < 1280) { const int hh = r >> 6, dd = r & 63, p = dd >> 1; col = hh * 64 + (p >> 4) * 32 + (dd & 1) * 16 + (p & 15); } }
#pragma unroll
    for (int j = 0; j < 16; ++j) {
        const int kk = (tid >> 6) + 8 * j, ks = k0 + kk - J.koff;
        v[j] = (r < J.nvalid && ks >= 0 && ks < J.Ksrc) ? s[(size_t)ks * J.ld_src + col] : 0.f;
    }
}
__device__ __forceinline__ void cvt_store(const CvtJob& J, int tile, const float (&v)[16], LAS float* scr) {
    const int tr = tile % J.ntr, tk = tile / J.ntr, r0 = tr * 64, k0 = tk * 128, tid = my_tid();
    const int rr = tid & 63, r = r0 + rr;
    const float sc = ((r < J.scale_rows) ? J.scale : 1.f) * (J.fp8 == 2 ? 32.f : 1.f);
    if (J.fp8 == 1) { const int g4 = tid & 15, kq = tid >> 4; const bool gu = J.mode == MAP_GU;
#pragma unroll
      for (int j = 0; j < 4; ++j)
#pragma unroll
        for (int i = 0; i < 4; ++i) scr[(kq + 32 * j) * 65 + (gu ? 2 * ((g4 >> 1) * 4 + i) + (g4 & 1) : g4 * 4 + i)] = v[4 * j + i] * J.scale; }
    else {
#pragma unroll
    for (int j = 0; j < 16; ++j) scr[((tid >> 6) + 8 * j) * 65 + rr] = v[j] * sc; }
    __syncthreads();
    if (J.fp8) { const int r2 = tid >> 3, kc = (tid & 7) * 16; const LAS float* sp = scr + kc * 65 + r2;
      u32x4 w; w.x = pk4fp8(sp[0], sp[65], sp[2 * 65], sp[3 * 65]); w.y = pk4fp8(sp[4 * 65], sp[5 * 65], sp[6 * 65], sp[7 * 65]);
      w.z = pk4fp8(sp[8 * 65], sp[9 * 65], sp[10 * 65], sp[11 * 65]); w.w = pk4fp8(sp[12 * 65], sp[13 * 65], sp[14 * 65], sp[15 * 65]);
      *(u32x4*)((unsigned char*)J.dst + (size_t)(r0 + r2) * J.ld_dst + k0 + kc) = w; }
    else { const int r2 = tid >> 3, kc = (tid & 7) * 8; const LAS float* sp = scr + kc * 65 + r2; const LAS float* sq = sp + 64 * 65;
      u32x4 w0, w1;
      w0.x = pk2bf(sp[0], sp[65]); w0.y = pk2bf(sp[2 * 65], sp[3 * 65]); w0.z = pk2bf(sp[4 * 65], sp[5 * 65]); w0.w = pk2bf(sp[6 * 65], sp[7 * 65]);
      w1.x = pk2bf(sq[0], sq[65]); w1.y = pk2bf(sq[2 * 65], sq[3 * 65]); w1.z = pk2bf(sq[4 * 65], sq[5 * 65]); w1.w = pk2bf(sq[6 * 65], sq[7 * 65]);
      bf16_t* d = J.dst + (size_t)(r0 + r2) * J.ld_dst + k0 + kc;
      *(u32x4*)d = w0; *(u32x4*)(d + 64) = w1; }
}
constexpr int CVT_DENSE = 256 + 128 + 192 + 48 + 64 + 128 + 192, CVT_MOE = 16 * 384;
__device__ __forceinline__ void cvt_job(const Params& P, int g, CvtJob& J, int& tile) {
    unsigned char* W = P.ws + WS_W;
    if (g < 256) { J = CvtJob{P.in[8], nullptr, (bf16_t*)(W + OFF_WIN), AB_IN, DM, 0, AB_IN, MAP_PLAIN, DM, 32, 8, 1.f, 0, 0}; tile = g; return; } g -= 256;
    if (g < 128) { J = CvtJob{P.in[15], nullptr, (bf16_t*)(W + OFF_WOUT), DM, DM, 0, DM, MAP_PLAIN, DM, 16, 8, 1.f, 0, 0}; tile = g; return; } g -= 128;
    if (g < 192) { J = CvtJob{P.in[16], nullptr, (bf16_t*)(W + OFF_WQKV), 1536, DM, 0, 1536, MAP_SWAPERM, DM, 24, 8, 0.125f * LOG2E, 1024, 0}; tile = g; return; } g -= 192;
    if (g < 48) { J = CvtJob{P.in[12], nullptr, (bf16_t*)(W + OFF_WUP), 768, 256, 0, 768, MAP_QPERM, 512, 12, 4, 0.10206207261596575f * LOG2E * QF8_SCALE, 768, 2}; tile = g; return; } g -= 48;
    if (g < 64) { J = CvtJob{P.in[14], nullptr, (bf16_t*)((unsigned char*)(W + OFF_WUP) + (size_t)768 * 512), 1024, 128, 256, 1024, MAP_PLAIN, 512, 16, 4, 1.f, 0, 2}; tile = g; return; } g -= 64;
    if (g < 128) { J = CvtJob{P.in[18], nullptr, (bf16_t*)(W + OFF_WSO), DM, DM, 0, DM, MAP_PLAIN, DM, 16, 8, 1.f, 0, 2}; tile = g; return; } g -= 128;
    J = CvtJob{P.in[16], nullptr, (bf16_t*)(W + OFF_WQKV8), 1536, DM, 0, 1536, MAP_SWAPERM, DM, 24, 8, 0.125f * LOG2E * QF8_SCALE, 1024, 2}; tile = g;
}
__device__ __forceinline__ void cvt_job_moe(const Params& P, int layer, int g, CvtJob& J, int& tile) {
    unsigned char* W = P.ws + WS_W;
    const int e = g / 384, r = g % 384, le = layer * 16 + e;
    if (r < 256) { J = CvtJob{P.in[20] + (size_t)le * DM * DFF, P.in[21] + (size_t)le * DM * DFF, (bf16_t*)(W + OFF_WGU + (size_t)e * 2048 * DM), DFF, DM, 0, 2048, MAP_GU, DM, 32, 8, 32.f, 1 << 30, 1}; tile = r; }
    else { J = CvtJob{P.in[22] + (size_t)le * DFF * DM, nullptr, (bf16_t*)(W + OFF_WD + (size_t)e * 1024 * DFF), DM, DFF, 0, DM, MAP_PLAIN, DFF, 16, 8, 32.f, 1 << 30, 1}; tile = r - 256; }
}
template <bool MOE>
__device__ __forceinline__ void cvt_run(const Params& P, LAS float* scr, int layer, int first, int step, int total) {
    int g = first, par = 0; CvtJob Jc{}; int tc = 0; float vc[16];
    bool have = g < total;
    if (have) { if (MOE) cvt_job_moe(P, layer, g, Jc, tc); else cvt_job(P, g, Jc, tc); cvt_load(Jc, tc, vc); }
    while (have) {
        const int gn = g + step; const bool hn = gn < total; CvtJob Jn{}; int tn = 0; float vn[16];
        if (hn) { if (MOE) cvt_job_moe(P, layer, gn, Jn, tn); else cvt_job(P, gn, Jn, tn); cvt_load(Jn, tn, vn); }
        cvt_store(Jc, tc, vc, scr + par * (128 * 65)); par ^= 1;
        Jc = Jn; tc = tn; g = gn; have = hn;
#pragma unroll
        for (int j = 0; j < 16; ++j) vc[j] = vn[j];
    }
}

__device__ __forceinline__ void phase_prologue(Frame& F) {
  const Params P = lds_params(F);
    LAS float* scr = (LAS float*)F.lds;
    cvt_run<false>(P, scr, 0, F.bid, F.G, CVT_DENSE);
    {
        LAS float* sv = (LAS float*)(F.lds + 32768);
        LAS float* red = (LAS float*)(F.lds + 32768 + 12288);
        const float* c = P.in[1]; const float* c_ctx = P.in[3]; const float* mod_w = P.in[4]; const float* mod_b = P.in[5];
        float* modv = (float*)(P.ws + WS_MODV);
        __syncthreads();
        for (int i = F.tid; i < DM; i += NTHREADS) { sv[i] = silu_f(c[i]); sv[DM + i] = silu_f(c[DM + i]); sv[2 * DM + i] = silu_f(c_ctx[i]); }
        __syncthreads();
        for (int ch = F.bid; ch < 256; ch += F.G) {
            const int jg = ch * 48, l = jg / NMOD, j0 = jg % NMOD, rg = F.tid >> 4, ct = F.tid & 15;
            const float* w = mod_w + (size_t)l * DM * NMOD + j0 + 3 * ct;
            float a[3][3];
#pragma unroll
            for (int x = 0; x < 3; ++x)
#pragma unroll
                for (int y = 0; y < 3; ++y) a[x][y] = 0.f;
            for (int d = rg; d < DM; d += 32) { const float w0 = w[(size_t)d * NMOD], w1 = w[(size_t)d * NMOD + 1], w2 = w[(size_t)d * NMOD + 2];
#pragma unroll
                for (int x = 0; x < 3; ++x) { const float s = sv[x * DM + d]; a[x][0] += s * w0; a[x][1] += s * w1; a[x][2] += s * w2; } }
#pragma unroll
            for (int x = 0; x < 3; ++x)
#pragma unroll
                for (int y = 0; y < 3; ++y) red[rg * 144 + x * 48 + 3 * ct + y] = a[x][y];
            __syncthreads();
            if (F.tid < 144) { float s = 0.f; for (int r = 0; r < 32; ++r) s += red[r * 144 + F.tid]; const int x = F.tid / 48, jj = j0 + F.tid % 48; modv[(l * 3 + x) * NMOD + jj] = s + mod_b[l * NMOD + jj]; }
            __syncthreads();
        }
    }
    {
        float* tab = (float*)(P.ws + WS_ROPE);
        for (int i = F.bid * 64 + F.tid; i < 256 * 16 && F.tid < 64; i += F.G * 64) {
            if (i < 256 * 8) { const int p = i / 8, f = i % 8; const double fr = pow(10000.0, -(double)(2 * f) / 16.0); const double a = (double)p * fr; tab[i] = (float)cos(a); tab[2048 + i] = (float)sin(a); }
            { const int p = i / 16, f = i % 16; const double fr = pow(10000.0, -(double)(2 * f) / 32.0); const double a = (double)p * fr; tab[4096 + i] = (float)cos(a); tab[8192 + i] = (float)sin(a); }
        }
    }
}


namespace att {
using f32x16 = __attribute__((ext_vector_type(16))) float;
using s16x4  = __attribute__((ext_vector_type(4))) short;
__device__ __forceinline__ int crow(int r, int hi) { return (r & 3) + 8 * (r >> 2) + 4 * hi; }
__device__ __forceinline__ unsigned cvtpk(float lo, float hi) { unsigned r;
#ifdef PROBE_FP8ATT
  if (PROBE_FP8ATT & 4) { lo = fp8rt(lo, 1.f); hi = fp8rt(hi, 1.f); }
#endif
  asm volatile("v_cvt_pk_bf16_f32 %0, %1, %2" : "=v"(r) : "v"(lo), "v"(hi)); return r; }
__device__ __forceinline__ int v_rd_base(int lane) { return ((lane & 3) << 3) | (((lane >> 2) & 3) << 6) | (((lane >> 4) & 1) << 5) | (((lane >> 5) & 1) << 8); }
constexpr int v_rd_off(int d0, int ks, int half) { return d0 * 512 + ks * 2048 + half * 1024; }
template <int OFF> __device__ __forceinline__ s16x4 tr_read(int vb) {
  s16x4 r; asm volatile("ds_read_b64_tr_b16 %0, %1 offset:%2" : "=&v"(r) : "v"(vb), "i"(OFF) : "memory"); return r;
}
}


namespace att2 {
using att::f32x16; using att::s16x4; using att::crow; using att::cvtpk; using att::v_rd_base; using att::v_rd_off; using att::tr_read;
constexpr int VT = 8192, NSLOT = 4, LDS_WS = NSLOT * (12288 + VT);
#ifndef A2_PIPE
#define A2_PIPE 2
#endif
constexpr float THR = 8.f, P8_BIAS = 4.f;
#define A2_SBAR() __builtin_amdgcn_sched_barrier(0)
template <bool FAST, int ABL = 0, bool PACK = true>
__device__ __forceinline__ void softmax_blk(f32x16& p0, f32x16& p1, float& m_reg, float& l_reg, float& alpha, bf16x8& pa0, bf16x8& pa1, bf16x8& pa2, bf16x8& pa3) {
  if (FAST) {
    float ps = 0.f;
#pragma unroll
    for (int r = 0; r < 16; ++r) { if (ABL != 1) { p0[r] = __builtin_amdgcn_exp2f(p0[r]); p1[r] = __builtin_amdgcn_exp2f(p1[r]); } }
    if (ABL != 1) {
#pragma unroll
    for (int r = 0; r < 16; ++r) ps += p0[r] + p1[r];
    { auto rr = __builtin_amdgcn_permlane32_swap(__float_as_uint(ps), __float_as_uint(ps), false, false);
      ps = __uint_as_float(rr[0]) + __uint_as_float(rr[1]); }
    } else ps = 1.f;
    l_reg += ps; alpha = 1.f;
  } else {
  float pmax = fmaxf(p0[0], p1[0]);
#pragma unroll
  for (int r = 1; r < 16; ++r) pmax = fmaxf(fmaxf(pmax, p0[r]), p1[r]);
  { auto rr = __builtin_amdgcn_permlane32_swap(__float_as_uint(pmax), __float_as_uint(pmax), false, false);
    pmax = fmaxf(__uint_as_float(rr[0]), __uint_as_float(rr[1])); }
  float mn;
  if (__builtin_expect(__all(pmax - m_reg <= THR), 1)) { mn = m_reg; alpha = 1.f; }
  else { mn = fmaxf(m_reg, pmax); alpha = __builtin_amdgcn_exp2f(m_reg - mn); m_reg = mn; }
  float ps = 0.f;
#pragma unroll
  for (int r = 0; r < 16; ++r) { p0[r] = __builtin_amdgcn_exp2f(p0[r] - mn); p1[r] = __builtin_amdgcn_exp2f(p1[r] - mn); }
#pragma unroll
  for (int r = 0; r < 16; ++r) ps += p0[r] + p1[r];
  { auto rr = __builtin_amdgcn_permlane32_swap(__float_as_uint(ps), __float_as_uint(ps), false, false);
    ps = __uint_as_float(rr[0]) + __uint_as_float(rr[1]); }
  l_reg = l_reg * alpha + ps;
  }
#define A2_PK4(P, BASE, OUT) do { unsigned a0 = cvtpk(P[BASE + 0], P[BASE + 1]), a1 = cvtpk(P[BASE + 2], P[BASE + 3]);   \
    unsigned b0 = cvtpk(P[BASE + 4], P[BASE + 5]), b1 = cvtpk(P[BASE + 6], P[BASE + 7]);                              \
    auto r0 = __builtin_amdgcn_permlane32_swap(a0, b0, false, false); auto r1 = __builtin_amdgcn_permlane32_swap(a1, b1, false, false); \
    u32x4 w = {r0[0], r1[0], r0[1], r1[1]}; OUT = *reinterpret_cast<bf16x8*>(&w); } while (0)
  if constexpr (PACK) { A2_PK4(p0, 0, pa0); A2_PK4(p0, 8, pa1); A2_PK4(p1, 0, pa2); A2_PK4(p1, 8, pa3); }
#undef A2_PK4
}

template <bool FAST, int ABL = 0, int DK = 96, bool SWA = false, bool F8 = false>
__device__ __forceinline__ bool attn_unit(const bf16_t* __restrict__ Qb_, const int rows_valid, const char* __restrict__ Kimg, const char* __restrict__ Vimg,
                                          bf16_t* __restrict__ Ob_, const int NT, LAS unsigned char* lds, const int lt0 = 0, const int q0 = 0, const float* sinkp = nullptr) {
  constexpr bool PIPED = (A2_PIPE != 0) && F8 && FAST && ABL == 0 && DK == 96;
  constexpr int ND = DK / 16, KT = F8 ? DK * 64 : DK * 128, VTX = F8 ? 4096 : VT, ONESB = PIPED ? 2048 : 0, VO = KT + ONESB, SLOT = KT + ONESB + VTX;
  constexpr int QB = F8 ? 1 : 2;
  const bf16_t* Qb = Qb_; bf16_t* Ob = Ob_;
  const int tid = my_tid(), wid = __builtin_amdgcn_readfirstlane(tid >> 6), lane = tid & 63, r32 = lane & 31, hi = lane >> 5;
  LAS float* ws = (LAS float*)(lds + LDS_WS) + wid * 128;
  float mA = -1e30f, mB = -1e30f, lA = 0.f, lB = 0.f; f32x16 oA[2] = {}, oB[2] = {};
  bf16x8 qA[ND], qB[ND]; pg8::v8i32 qA8[2], qB8[2];
  const int wrow0 = SWA ? (wid >> 2) * 64 : wid * 64;
  if (SWA) { Qb = (const bf16_t*)((const char*)Qb + (size_t)(wid & 3) * SEQ * DK * QB); Ob = (bf16_t*)((unsigned char*)Ob + (wid & 3) * 64); }
  { int ra = wrow0 + r32, rb = ra + 32; if (ra >= rows_valid) ra = 0; if (rb >= rows_valid) rb = 0;
    if constexpr (F8) { const char* pa_ = (const char*)Qb + (size_t)ra * DK; const char* pb_ = (const char*)Qb + (size_t)rb * DK;
      const pg8::v8i32 z8 = {0, 0, 0, 0, 0, 0, 0, 0};
      qA8[0] = *reinterpret_cast<const pg8::v8i32*>(pa_ + hi * 32); qB8[0] = *reinterpret_cast<const pg8::v8i32*>(pb_ + hi * 32);
      if constexpr (DK == 96) { const pg8::v8i32 ta = *reinterpret_cast<const pg8::v8i32*>(pa_ + 64), tb = *reinterpret_cast<const pg8::v8i32*>(pb_ + 64);
        pg8::v8i32 zb = z8; if constexpr (PIPED) zb[0] = 0xE8;
        qA8[1] = hi ? zb : ta; qB8[1] = hi ? zb : tb; } else { qA8[1] = z8; qB8[1] = z8; }
      asm volatile("" : "+v"(qA8[0]), "+v"(qA8[1]), "+v"(qB8[0]), "+v"(qB8[1]));
    } else {
    const bf16_t* pa_ = Qb + (size_t)ra * DK + hi * 8; const bf16_t* pb_ = Qb + (size_t)rb * DK + hi * 8;
#pragma unroll
    for (int d0 = 0; d0 < ND; ++d0) { qA[d0] = *reinterpret_cast<const bf16x8*>(pa_ + d0 * 16); qB[d0] = *reinterpret_cast<const bf16x8*>(pb_ + d0 * 16); } } }
  const bool two = F8 ? false : (DK == 96) && wid < 4;
  const bool hasK = F8 ? wid < 6 : true, hasV = F8 ? (wid < 2 || wid >= 6) : true;
  const int vpiece = F8 ? (wid >= 6 ? wid - 6 : wid + 2) : wid;
  const char* ksrc = Kimg + wid * 1024 + lane * 16; const char* vsrc = Vimg + vpiece * 1024 + lane * 16;
  constexpr int NKP = KT / 1024;
  const char* f8a = (wid < NKP) ? Kimg + wid * 1024 : Vimg + (wid - NKP) * 1024; const int f8as = (wid < NKP) ? KT : VTX, f8ad = (wid < NKP) ? wid * 1024 : VO + (wid - NKP) * 1024;
  const char* f8b = (wid < 2) ? Vimg + (wid + 2) * 1024 : f8a; const int f8bs = (wid < 2) ? VTX : f8as, f8bd = (wid < 2) ? VO + (wid + 2) * 1024 : LDS_WS + 8192 + wid * 1024; const bool f8breal = wid < 2;
#define A2_DMA8(t, s) do { const int it8_ = (SWA && (t) >= 4) ? lt0 + (t) : (t); const char* ga_ = f8a + (size_t)it8_ * f8as; const char* gb_ = f8b + (size_t)it8_ * f8bs; unsigned vo_ = (unsigned)lane * 16u; asm volatile("" : "+s"(ga_)); asm volatile("" : "+s"(gb_)); asm volatile("" : "+v"(vo_)); \
    __builtin_amdgcn_global_load_lds((const unsigned*)(ga_ + vo_), (LAS unsigned*)(lds + (s) * SLOT + f8ad), 16, 0, 0); \
    if constexpr (DK == 96) __builtin_amdgcn_global_load_lds((const unsigned*)(gb_ + vo_), (LAS unsigned*)(lds + (f8breal ? (s) * SLOT : 0) + f8bd), 16, 0, 0); } while (0)
#define A2_DMA(t, s) do { if constexpr (F8) { A2_DMA8(t, s); break; } const int it_ = (SWA && (t) >= 4) ? lt0 + (t) : (t); \
    if (hasK) __builtin_amdgcn_global_load_lds((const unsigned*)(ksrc + (size_t)it_ * KT), (LAS unsigned*)(lds + (s) * SLOT + wid * 1024), 16, 0, 0); \
    if (two) __builtin_amdgcn_global_load_lds((const unsigned*)(ksrc + (size_t)it_ * KT + 8192), (LAS unsigned*)(lds + (s) * SLOT + 8192 + wid * 1024), 16, 0, 0); \
    if (hasV) __builtin_amdgcn_global_load_lds((const unsigned*)(vsrc + (size_t)it_ * VTX), (LAS unsigned*)(lds + (s) * SLOT + KT + vpiece * 1024), 16, 0, 0); } while (0)
  LAS unsigned* flag = (LAS unsigned*)(lds + LDS_WS + 4096);
  if (FAST && tid == 0) *flag = 0u;
  asm volatile("s_waitcnt vmcnt(0)" ::: "memory");
  A2_DMA(0, 0); A2_DMA(1, 1);
  if constexpr (A2_PIPE == 2 && F8 && FAST && ABL == 0 && DK == 96) { A2_DMA(2, 2); }
  const int vb0 = (int)(uintptr_t)(lds + KT) + v_rd_base(lane);
  const int kb0 = hi * 1024 + r32 * 16;
  const int qpA = q0 + wrow0 + r32;
#define A2_PK(L, H) (bf16x8){L[0], L[1], L[2], L[3], H[0], H[1], H[2], H[3]}
#define A2_PV(D0, VB) do { \
      const s16x4 l0 = tr_read<v_rd_off(D0, 0, 0)>(VB), h0 = tr_read<v_rd_off(D0, 0, 1)>(VB), l1 = tr_read<v_rd_off(D0, 1, 0)>(VB), h1 = tr_read<v_rd_off(D0, 1, 1)>(VB); \
      const s16x4 l2 = tr_read<v_rd_off(D0, 2, 0)>(VB), h2 = tr_read<v_rd_off(D0, 2, 1)>(VB), l3 = tr_read<v_rd_off(D0, 3, 0)>(VB), h3 = tr_read<v_rd_off(D0, 3, 1)>(VB); \
      asm volatile("s_waitcnt lgkmcnt(0)" ::: "memory"); A2_SBAR(); \
      const bf16x8 v0_ = A2_PK(l0, h0), v1_ = A2_PK(l1, h1), v2_ = A2_PK(l2, h2), v3_ = A2_PK(l3, h3); \
      if (ABL == 3) { asm volatile("" :: "v"(v0_), "v"(v1_), "v"(v2_), "v"(v3_), "v"(a0), "v"(a1), "v"(a2), "v"(a3), "v"(b0), "v"(b1), "v"(b2), "v"(b3)); } else { \
      oA[D0] = __builtin_amdgcn_mfma_f32_32x32x16_bf16(a0, v0_, oA[D0], 0, 0, 0); oB[D0] = __builtin_amdgcn_mfma_f32_32x32x16_bf16(b0, v0_, oB[D0], 0, 0, 0); \
      oA[D0] = __builtin_amdgcn_mfma_f32_32x32x16_bf16(a1, v1_, oA[D0], 0, 0, 0); oB[D0] = __builtin_amdgcn_mfma_f32_32x32x16_bf16(b1, v1_, oB[D0], 0, 0, 0); \
      oA[D0] = __builtin_amdgcn_mfma_f32_32x32x16_bf16(a2, v2_, oA[D0], 0, 0, 0); oB[D0] = __builtin_amdgcn_mfma_f32_32x32x16_bf16(b2, v2_, oB[D0], 0, 0, 0); \
      oA[D0] = __builtin_amdgcn_mfma_f32_32x32x16_bf16(a3, v3_, oA[D0], 0, 0, 0); oB[D0] = __builtin_amdgcn_mfma_f32_32x32x16_bf16(b3, v3_, oB[D0], 0, 0, 0); } } while (0)
#define A2_PV2(VB) do { \
      const s16x4 l0 = tr_read<v_rd_off(0, 0, 0)>(VB), h0 = tr_read<v_rd_off(0, 0, 1)>(VB), l1 = tr_read<v_rd_off(0, 1, 0)>(VB), h1 = tr_read<v_rd_off(0, 1, 1)>(VB); \
      const s16x4 l2 = tr_read<v_rd_off(0, 2, 0)>(VB), h2 = tr_read<v_rd_off(0, 2, 1)>(VB), l3 = tr_read<v_rd_off(0, 3, 0)>(VB), h3 = tr_read<v_rd_off(0, 3, 1)>(VB); \
      const s16x4 m0 = tr_read<v_rd_off(1, 0, 0)>(VB), n0 = tr_read<v_rd_off(1, 0, 1)>(VB), m1 = tr_read<v_rd_off(1, 1, 0)>(VB), n1 = tr_read<v_rd_off(1, 1, 1)>(VB); \
      const s16x4 m2 = tr_read<v_rd_off(1, 2, 0)>(VB), n2 = tr_read<v_rd_off(1, 2, 1)>(VB), m3 = tr_read<v_rd_off(1, 3, 0)>(VB), n3 = tr_read<v_rd_off(1, 3, 1)>(VB); \
      asm volatile("s_waitcnt lgkmcnt(0)" ::: "memory"); A2_SBAR(); \
      const bf16x8 v0_ = A2_PK(l0, h0), v1_ = A2_PK(l1, h1), v2_ = A2_PK(l2, h2), v3_ = A2_PK(l3, h3); \
      const bf16x8 w0_ = A2_PK(m0, n0), w1_ = A2_PK(m1, n1), w2_ = A2_PK(m2, n2), w3_ = A2_PK(m3, n3); \
      oA[0] = __builtin_amdgcn_mfma_f32_32x32x16_bf16(a0, v0_, oA[0], 0, 0, 0); oB[0] = __builtin_amdgcn_mfma_f32_32x32x16_bf16(b0, v0_, oB[0], 0, 0, 0); \
      oA[1] = __builtin_amdgcn_mfma_f32_32x32x16_bf16(a0, w0_, oA[1], 0, 0, 0); oB[1] = __builtin_amdgcn_mfma_f32_32x32x16_bf16(b0, w0_, oB[1], 0, 0, 0); \
      oA[0] = __builtin_amdgcn_mfma_f32_32x32x16_bf16(a1, v1_, oA[0], 0, 0, 0); oB[0] = __builtin_amdgcn_mfma_f32_32x32x16_bf16(b1, v1_, oB[0], 0, 0, 0); \
      oA[1] = __builtin_amdgcn_mfma_f32_32x32x16_bf16(a1, w1_, oA[1], 0, 0, 0); oB[1] = __builtin_amdgcn_mfma_f32_32x32x16_bf16(b1, w1_, oB[1], 0, 0, 0); \
      oA[0] = __builtin_amdgcn_mfma_f32_32x32x16_bf16(a2, v2_, oA[0], 0, 0, 0); oB[0] = __builtin_amdgcn_mfma_f32_32x32x16_bf16(b2, v2_, oB[0], 0, 0, 0); \
      oA[1] = __builtin_amdgcn_mfma_f32_32x32x16_bf16(a2, w2_, oA[1], 0, 0, 0); oB[1] = __builtin_amdgcn_mfma_f32_32x32x16_bf16(b2, w2_, oB[1], 0, 0, 0); \
      oA[0] = __builtin_amdgcn_mfma_f32_32x32x16_bf16(a3, v3_, oA[0], 0, 0, 0); oB[0] = __builtin_amdgcn_mfma_f32_32x32x16_bf16(b3, v3_, oB[0], 0, 0, 0); \
      oA[1] = __builtin_amdgcn_mfma_f32_32x32x16_bf16(a3, w3_, oA[1], 0, 0, 0); oB[1] = __builtin_amdgcn_mfma_f32_32x32x16_bf16(b3, w3_, oB[1], 0, 0, 0); } while (0)
#define A2_WAITV(more) do { if (ABL == 5) break; if constexpr (F8) { if (more) { if constexpr (DK == 96) asm volatile("s_waitcnt vmcnt(2)" ::: "memory"); else asm volatile("s_waitcnt vmcnt(1)" ::: "memory"); } else asm volatile("s_waitcnt vmcnt(0)" ::: "memory"); break; } if (more) { if (two) asm volatile("s_waitcnt vmcnt(3)" ::: "memory"); else if (hasK && hasV) asm volatile("s_waitcnt vmcnt(2)" ::: "memory"); else asm volatile("s_waitcnt vmcnt(1)" ::: "memory"); } \
    else asm volatile("s_waitcnt vmcnt(0)" ::: "memory"); } while (0)
#define A2_MF8(KF, QF, ACC) __builtin_amdgcn_mfma_scale_f32_32x32x64_f8f6f4(KF, QF, ACC, 0, 0, 0, 0x7B7B7B7B, 0, 0x7F7F7F7F)
#define A2_MF8P(PF, VF, ACC) __builtin_amdgcn_mfma_scale_f32_32x32x64_f8f6f4(PF, VF, ACC, 0, 0, 0, 0x7F7F7F7F, 0, 0x7F7F7F7F)
#define A2_TILE(S, t) do { \
    A2_WAITV((t) + 1 < NT); \
    if (ABL != 5) __builtin_amdgcn_s_barrier(); \
    A2_SBAR(); \
    if ((t) + 2 < NT) { A2_DMA((t) + 2, ((S) + 2) % 4); } \
    const LAS unsigned char* Ks = lds + (S) * SLOT + kb0; \
    f32x16 pA0 = {}, pA1 = {}, pB0 = {}, pB1 = {}; \
    if constexpr (F8 && FAST) { _Pragma("unroll") for (int r = 0; r < 16; ++r) { pA0[r] = -P8_BIAS; pA1[r] = -P8_BIAS; pB0[r] = -P8_BIAS; pB1[r] = -P8_BIAS; } }     \
    if constexpr (F8 && DK == 64) { const LAS unsigned char* K0 = lds + (S) * SLOT + hi * 2048 + r32 * 16; \
      const pg8::v8i32 k00 = pg8::cat32(*(const LAS bf16x8*)(K0), *(const LAS bf16x8*)(K0 + 1024)), k01 = pg8::cat32(*(const LAS bf16x8*)(K0 + 512), *(const LAS bf16x8*)(K0 + 1536)); \
      pA0 = A2_MF8(k00, qA8[0], pA0); pA1 = A2_MF8(k01, qA8[0], pA1); pB0 = A2_MF8(k00, qB8[0], pB0); pB1 = A2_MF8(k01, qB8[0], pB1); \
      asm volatile("" : "+v"(pA0), "+v"(pA1), "+v"(pB0), "+v"(pB1)); A2_SBAR(); } else \
    if constexpr (F8) { const LAS unsigned char* K0 = lds + (S) * SLOT + hi * 2048 + r32 * 16; const LAS unsigned char* K1 = lds + (S) * SLOT + 4096 + r32 * 16; \
      const pg8::v8i32 k00 = pg8::cat32(*(const LAS bf16x8*)(K0), *(const LAS bf16x8*)(K0 + 1024)), k01 = pg8::cat32(*(const LAS bf16x8*)(K0 + 512), *(const LAS bf16x8*)(K0 + 1536)); \
      const pg8::v8i32 k10 = pg8::cat32(*(const LAS bf16x8*)(K1), *(const LAS bf16x8*)(K1 + 1024)), k11 = pg8::cat32(*(const LAS bf16x8*)(K1 + 512), *(const LAS bf16x8*)(K1 + 1536)); \
      if (ABL == 2) { asm volatile("" :: "v"(k00), "v"(k01), "v"(k10), "v"(k11)); pA0[0] += 0.01f; pB1[1] += 0.02f; } else { \
      pA0 = A2_MF8(k00, qA8[0], pA0); pA1 = A2_MF8(k01, qA8[0], pA1); pB0 = A2_MF8(k00, qB8[0], pB0); pB1 = A2_MF8(k01, qB8[0], pB1); \
      pA0 = A2_MF8(k10, qA8[1], pA0); pA1 = A2_MF8(k11, qA8[1], pA1); pB0 = A2_MF8(k10, qB8[1], pB0); pB1 = A2_MF8(k11, qB8[1], pB1); } \
      asm volatile("" : "+v"(pA0), "+v"(pA1), "+v"(pB0), "+v"(pB1)); A2_SBAR(); } else { \
    bf16x8 kf[2][2]; if (ABL == 4) { kf[0][0] = qA[0]; kf[0][1] = qB[0]; } else { kf[0][0] = *(const LAS bf16x8*)(Ks); kf[0][1] = *(const LAS bf16x8*)(Ks + 512); } \
    _Pragma("unroll") for (int d0 = 0; d0 < ND; ++d0) {              \
      if (d0 + 1 < ND) { if (ABL == 4) { kf[(d0 + 1) & 1][0] = qA[d0 + 1]; kf[(d0 + 1) & 1][1] = qB[d0 + 1]; } else { kf[(d0 + 1) & 1][0] = *(const LAS bf16x8*)(Ks + (d0 + 1) * 2048); kf[(d0 + 1) & 1][1] = *(const LAS bf16x8*)(Ks + (d0 + 1) * 2048 + 512); } } \
      const bf16x8 k0 = kf[d0 & 1][0], k1 = kf[d0 & 1][1]; \
      if (ABL == 2) { asm volatile("" :: "v"(k0), "v"(k1)); pA0[d0] += 0.01f; pB1[d0] += 0.02f; } else { \
      pA0 = __builtin_amdgcn_mfma_f32_32x32x16_bf16(k0, qA[d0], pA0, 0, 0, 0); pA1 = __builtin_amdgcn_mfma_f32_32x32x16_bf16(k1, qA[d0], pA1, 0, 0, 0); \
      pB0 = __builtin_amdgcn_mfma_f32_32x32x16_bf16(k0, qB[d0], pB0, 0, 0, 0); pB1 = __builtin_amdgcn_mfma_f32_32x32x16_bf16(k1, qB[d0], pB1, 0, 0, 0); } \
      A2_SBAR(); } } \
    if (SWA && (t) >= 4) { const int kb_ = 64 * (lt0 + (t) - 4) - qpA;          \
      _Pragma("unroll") for (int r = 0; r < 16; ++r) { const int dA = kb_ + crow(r, hi), dB = dA - 32; \
        if (dA > 128 || dA < -128) pA0[r] = -INFINITY; if (dA + 32 > 128 || dA + 32 < -128) pA1[r] = -INFINITY; \
        if (dB > 128 || dB < -128) pB0[r] = -INFINITY; if (dB + 32 > 128 || dB + 32 < -128) pB1[r] = -INFINITY; } } \
    float alA, alB; bf16x8 a0, a1, a2, a3, b0, b1, b2, b3; \
    pg8::v8i32 pa8, pb8; \
    softmax_blk<FAST, ABL, !F8>(pA0, pA1, mA, lA, alA, a0, a1, a2, a3); \
    if constexpr (F8) { _Pragma("unroll") for (int j = 0; j < 4; ++j) { pa8[j] = (int)pk4fp8(pA0[4 * j], pA0[4 * j + 1], pA0[4 * j + 2], pA0[4 * j + 3]); pa8[4 + j] = (int)pk4fp8(pA1[4 * j], pA1[4 * j + 1], pA1[4 * j + 2], pA1[4 * j + 3]); } asm volatile("" : "+v"(pa8)); } \
    A2_SBAR(); \
    A2_MID((t) + 2 < NT); \
    A2_SBAR(); \
    softmax_blk<FAST, ABL, !F8>(pB0, pB1, mB, lB, alB, b0, b1, b2, b3); \
    if (!FAST && __any(alA < 1.f || alB < 1.f)) {                            \
      if (hi == 0) { ws[64 + r32] = alA; ws[96 + r32] = alB; } \
      asm volatile("s_waitcnt lgkmcnt(0)" ::: "memory"); \
      _Pragma("unroll") for (int d = 0; d < 2; ++d) _Pragma("unroll") for (int r = 0; r < 16; ++r) { oA[d][r] *= ws[64 + crow(r, hi)]; oB[d][r] *= ws[96 + crow(r, hi)]; } } \
    if constexpr (F8) { const LAS unsigned char* Vs = lds + (S) * SLOT + VO + hi * 512 + r32 * 16; \
      const pg8::v8i32 v0_ = pg8::cat32(*(const LAS bf16x8*)(Vs), *(const LAS bf16x8*)(Vs + 1024)), v1_ = pg8::cat32(*(const LAS bf16x8*)(Vs + 2048), *(const LAS bf16x8*)(Vs + 3072)); \
      _Pragma("unroll") for (int j = 0; j < 4; ++j) { pb8[j] = (int)pk4fp8(pB0[4 * j], pB0[4 * j + 1], pB0[4 * j + 2], pB0[4 * j + 3]); pb8[4 + j] = (int)pk4fp8(pB1[4 * j], pB1[4 * j + 1], pB1[4 * j + 2], pB1[4 * j + 3]); } asm volatile("" : "+v"(pb8)); \
      asm volatile("s_waitcnt lgkmcnt(0)" ::: "memory"); A2_SBAR(); \
      if (ABL == 3) { asm volatile("" :: "v"(v0_), "v"(v1_), "v"(pa8), "v"(pb8)); } else { \
      oA[0] = A2_MF8P(pa8, v0_, oA[0]); oB[0] = A2_MF8P(pb8, v0_, oB[0]); oA[1] = A2_MF8P(pa8, v1_, oA[1]); oB[1] = A2_MF8P(pb8, v1_, oB[1]); } \
      asm volatile("" : "+v"(oA[0]), "+v"(oA[1]), "+v"(oB[0]), "+v"(oB[1])); \
    } else { A2_PV(0, vb0 + (S) * SLOT); A2_PV(1, vb0 + (S) * SLOT); } \
    asm volatile("s_waitcnt lgkmcnt(0)" ::: "memory"); \
  } while (0)
#ifdef A2_NOSTAGGER
#define A2_MID(more) do { } while (0)
#else
#define A2_MID(more) do { A2_WAITV(more); if (ABL != 5) __builtin_amdgcn_s_barrier(); } while (0)
#endif
  if constexpr (A2_PIPE && F8 && FAST && ABL == 0 && DK == 96) {
#define P8_LD(p) (*(const LAS bf16x8*)(p))
#define P8_ADD(a_, b_) ({ float o_ = (a_) + (b_); asm("" : "+v"(o_)); o_; })
    const LAS unsigned char* kp0 = lds + hi * 2048 + r32 * 16; const LAS unsigned char* kp1 = hi ? lds + KT : lds + 4096 + r32 * 16; const LAS unsigned char* vp0 = lds + VO + hi * 512 + r32 * 16;
    asm volatile("" : "+v"(kp0), "+v"(kp1), "+v"(vp0));
#define P8_KA(S) const LAS unsigned char* K0_ = kp0 + (S) * SLOT; const pg8::v8i32 k00 = pg8::cat32(P8_LD(K0_), P8_LD(K0_ + 1024)), k01 = pg8::cat32(P8_LD(K0_ + 512), P8_LD(K0_ + 1536));
#define P8_KB(S) const LAS unsigned char* K1_ = kp1 + (S) * SLOT; const pg8::v8i32 k10 = pg8::cat32(P8_LD(K1_), P8_LD(K1_ + 1024)), k11 = pg8::cat32(P8_LD(K1_ + 512), P8_LD(K1_ + 1536));
#define P8_VF(S) const LAS unsigned char* Vs_ = vp0 + (S) * SLOT; \
      const pg8::v8i32 v0_ = pg8::cat32(P8_LD(Vs_), P8_LD(Vs_ + 1024)), v1_ = pg8::cat32(P8_LD(Vs_ + 2048), P8_LD(Vs_ + 3072));
#define P8_BIAS16(name)
#define P8_SMG(g, p0, p1, lreg, p8) do { _Pragma("unroll") for (int r_ = 4 * (g); r_ < 4 * (g) + 4; ++r_) { p0[r_] = __builtin_amdgcn_exp2f(p0[r_]); p1[r_] = __builtin_amdgcn_exp2f(p1[r_]); } \
      { float s0_ = P8_ADD(p0[4 * (g)], p1[4 * (g)]), s1_ = P8_ADD(p0[4 * (g) + 1], p1[4 * (g) + 1]), s2_ = P8_ADD(p0[4 * (g) + 2], p1[4 * (g) + 2]), s3_ = P8_ADD(p0[4 * (g) + 3], p1[4 * (g) + 3]); \
        s0_ = P8_ADD(s0_, s1_); s2_ = P8_ADD(s2_, s3_); s0_ = P8_ADD(s0_, s2_); lreg = P8_ADD(lreg, s0_); } asm volatile("" : "+v"(lreg)); \
      p8[g] = (int)pk4fp8(p0[4 * (g)], p0[4 * (g) + 1], p0[4 * (g) + 2], p0[4 * (g) + 3]); p8[4 + (g)] = (int)pk4fp8(p1[4 * (g)], p1[4 * (g) + 1], p1[4 * (g) + 2], p1[4 * (g) + 3]); } while (0)
#define P8_EXP(g, p0, p1) do { _Pragma("unroll") for (int r_ = 4 * (g); r_ < 4 * (g) + 4; ++r_) { p0[r_] = __builtin_amdgcn_exp2f(p0[r_]); p1[r_] = __builtin_amdgcn_exp2f(p1[r_]); } } while (0)
#define P8_PK(g, p0, p1, p8) do { p8[g] = (int)pk4fp8(p0[4 * (g)], p0[4 * (g) + 1], p0[4 * (g) + 2], p0[4 * (g) + 3]); p8[4 + (g)] = (int)pk4fp8(p1[4 * (g)], p1[4 * (g) + 1], p1[4 * (g) + 2], p1[4 * (g) + 3]); } while (0)
#define P8_FIN(g, p0, p1, lreg, p8) do { \
        \
      lreg = (((((((lreg + p0[4 * (g)]) + p1[4 * (g)]) + p0[4 * (g) + 1]) + p1[4 * (g) + 1]) + p0[4 * (g) + 2]) + p1[4 * (g) + 2]) + p0[4 * (g) + 3]) + p1[4 * (g) + 3]; asm volatile("" : "+v"(lreg)); \
      p8[g] = (int)pk4fp8(p0[4 * (g)], p0[4 * (g) + 1], p0[4 * (g) + 2], p0[4 * (g) + 3]); p8[4 + (g)] = (int)pk4fp8(p1[4 * (g)], p1[4 * (g) + 1], p1[4 * (g) + 2], p1[4 * (g) + 3]); } while (0)
    f32x16 pA0, pA1, pB0, pB1; pg8::v8i32 pa8 = {0, 0, 0, 0, 0, 0, 0, 0}, pb8 = {0, 0, 0, 0, 0, 0, 0, 0};
    const f32x16 b16 = {};
    for (int i_ = tid; i_ < 5 * (ONESB / 16); i_ += NTHREADS) *(LAS u32x4*)(lds + (i_ / (ONESB / 16)) * SLOT + KT + (i_ % (ONESB / 16)) * 16) = (u32x4){0x38383838u, 0x38383838u, 0x38383838u, 0x38383838u};
    asm volatile("s_waitcnt lgkmcnt(0)" ::: "memory");
    pg8::v8i32 ones8; { int lo_ = lane; asm volatile("" : "+v"(lo_));
      const int j_ = lo_ & 15, kq_ = lo_ >> 4; const int w_ = ((j_ == 0 && !(kq_ & 1)) || (j_ == 1 && (kq_ & 1))) ? 0x38383838 : 0;
#pragma unroll
      for (int r_ = 0; r_ < 8; ++r_) ones8[r_] = w_; }
    asm volatile("" : "+v"(ones8));
    f32x4 lAcc = {0.f, 0.f, 0.f, 0.f}, lBcc = {0.f, 0.f, 0.f, 0.f};
#define P8_LSUM(P8V, ACC) ACC = __builtin_amdgcn_mfma_scale_f32_16x16x128_f8f6f4(P8V, ones8, ACC, 0, 0, 0, 0x7F7F7F7F, 0, 0x7F7F7F7F)
    if constexpr (A2_PIPE == 2) asm volatile("s_waitcnt vmcnt(4)" ::: "memory"); else A2_WAITV(1 < NT);
    __builtin_amdgcn_s_barrier();
    { P8_KA(0); P8_KB(0); P8_BIAS16(b16); pA0 = A2_MF8(k00, qA8[0], b16); pA1 = A2_MF8(k01, qA8[0], b16); pA0 = A2_MF8(k10, qA8[1], pA0); pA1 = A2_MF8(k11, qA8[1], pA1); }
    asm volatile("" : "+v"(pA0), "+v"(pA1)); A2_SBAR();
#define P8_TILE(S, t, FIRST) do { \
        \
      __builtin_amdgcn_s_barrier(); A2_SBAR(); \
      if ((t) + 2 < NT) { A2_DMA((t) + 2, ((S) + 2) % 4); } \
      { P8_KA(S); \
        if (!(FIRST)) { P8_VF(((S) + 3) % 4); A2_SBAR(); oB[0] = A2_MF8P(pb8, v0_, oB[0]); A2_SBAR(); P8_SMG(0, pA0, pA1, lA, pa8); A2_SBAR(); oB[1] = A2_MF8P(pb8, v1_, oB[1]); A2_SBAR(); } else { A2_SBAR(); P8_SMG(0, pA0, pA1, lA, pa8); A2_SBAR(); } \
        pB0 = A2_MF8(k00, qB8[0], b16); A2_SBAR(); P8_KB(S); P8_SMG(1, pA0, pA1, lA, pa8); A2_SBAR(); pB1 = A2_MF8(k01, qB8[0], b16); A2_SBAR(); P8_SMG(2, pA0, pA1, lA, pa8); A2_SBAR(); \
        pB0 = A2_MF8(k10, qB8[1], pB0); A2_SBAR(); P8_SMG(3, pA0, pA1, lA, pa8); A2_SBAR(); pB1 = A2_MF8(k11, qB8[1], pB1); } \
      asm volatile("" : "+v"(pB0), "+v"(pB1), "+v"(pa8), "+v"(oB[0]), "+v"(oB[1])); A2_SBAR(); \
        \
      A2_WAITV((t) + 2 < NT); __builtin_amdgcn_s_barrier(); A2_SBAR(); \
      { P8_VF(S); P8_KA(((S) + 1) % 4); A2_SBAR(); \
        oA[0] = A2_MF8P(pa8, v0_, oA[0]); A2_SBAR(); P8_SMG(0, pB0, pB1, lB, pb8); A2_SBAR(); oA[1] = A2_MF8P(pa8, v1_, oA[1]); A2_SBAR(); \
        pA0 = A2_MF8(k00, qA8[0], b16); A2_SBAR(); P8_KB(((S) + 1) % 4); P8_SMG(1, pB0, pB1, lB, pb8); A2_SBAR(); pA1 = A2_MF8(k01, qA8[0], b16); A2_SBAR(); P8_SMG(2, pB0, pB1, lB, pb8); A2_SBAR(); \
        pA0 = A2_MF8(k10, qA8[1], pA0); A2_SBAR(); P8_SMG(3, pB0, pB1, lB, pb8); A2_SBAR(); pA1 = A2_MF8(k11, qA8[1], pA1); } \
      asm volatile("" : "+v"(pA0), "+v"(pA1), "+v"(pb8), "+v"(oA[0]), "+v"(oA[1])); A2_SBAR(); \
    } while (0)
#define P8_TILE5(S, t, FIRST) do { \
      A2_WAITV((t) + 2 < NT); __builtin_amdgcn_s_barrier(); A2_SBAR(); \
      if ((t) + 3 < NT) { A2_DMA((t) + 3, ((S) + 3) % 5); } \
        \
      { P8_KA(S); \
        if (!(FIRST)) { P8_VF(((S) + 4) % 5); A2_SBAR(); oB[0] = A2_MF8P(pb8, v0_, oB[0]); A2_SBAR(); P8_EXP(0, pA0, pA1); A2_SBAR(); oB[1] = A2_MF8P(pb8, v1_, oB[1]); P8_LSUM(pb8, lBcc); A2_SBAR(); } else { A2_SBAR(); P8_EXP(0, pA0, pA1); A2_SBAR(); } \
        P8_EXP(1, pA0, pA1); A2_SBAR(); P8_PK(0, pA0, pA1, pa8); A2_SBAR(); \
        pB0 = A2_MF8(k00, qB8[0], b16); A2_SBAR(); P8_KB(S); P8_EXP(2, pA0, pA1); A2_SBAR(); P8_PK(1, pA0, pA1, pa8); A2_SBAR(); \
        pB1 = A2_MF8(k01, qB8[0], b16); A2_SBAR(); P8_EXP(3, pA0, pA1); A2_SBAR(); P8_PK(2, pA0, pA1, pa8); A2_SBAR(); \
        pB0 = A2_MF8(k10, qB8[1], pB0); A2_SBAR(); P8_PK(3, pA0, pA1, pa8); A2_SBAR(); pB1 = A2_MF8(k11, qB8[1], pB1); } \
      asm volatile("" : "+v"(pB0), "+v"(pB1), "+v"(pa8), "+v"(oB[0]), "+v"(oB[1]), "+v"(lBcc)); A2_SBAR(); \
      { P8_VF(S); P8_KA(((S) + 1) % 5); A2_SBAR(); \
        oA[0] = A2_MF8P(pa8, v0_, oA[0]); A2_SBAR(); P8_EXP(0, pB0, pB1); A2_SBAR(); oA[1] = A2_MF8P(pa8, v1_, oA[1]); P8_LSUM(pa8, lAcc); A2_SBAR(); \
        P8_EXP(1, pB0, pB1); A2_SBAR(); P8_PK(0, pB0, pB1, pb8); A2_SBAR(); \
        pA0 = A2_MF8(k00, qA8[0], b16); A2_SBAR(); P8_KB(((S) + 1) % 5); P8_EXP(2, pB0, pB1); A2_SBAR(); P8_PK(1, pB0, pB1, pb8); A2_SBAR(); \
        pA1 = A2_MF8(k01, qA8[0], b16); A2_SBAR(); P8_EXP(3, pB0, pB1); A2_SBAR(); P8_PK(2, pB0, pB1, pb8); A2_SBAR(); \
        pA0 = A2_MF8(k10, qA8[1], pA0); A2_SBAR(); P8_PK(3, pB0, pB1, pb8); A2_SBAR(); pA1 = A2_MF8(k11, qA8[1], pA1); } \
      asm volatile("" : "+v"(pA0), "+v"(pA1), "+v"(pb8), "+v"(oA[0]), "+v"(oA[1]), "+v"(lAcc)); A2_SBAR(); \
    } while (0)
    if constexpr (A2_PIPE == 2) {
#ifdef A2_PEEL
      P8_TILE5(0, 0, true); P8_TILE5(1, 1, false); P8_TILE5(2, 2, false); P8_TILE5(3, 3, false); P8_TILE5(4, 4, false);
      for (int t = 5; t + 4 < NT; t += 5) { P8_TILE5(0, t, false); P8_TILE5(1, t + 1, false); P8_TILE5(2, t + 2, false); P8_TILE5(3, t + 3, false); P8_TILE5(4, t + 4, false); }
#else
      for (int t = 0; t + 4 < NT; t += 5) { P8_TILE5(0, t, t == 0); P8_TILE5(1, t + 1, false); P8_TILE5(2, t + 2, false); P8_TILE5(3, t + 3, false); P8_TILE5(4, t + 4, false); }
#endif
      { P8_VF(4); oB[0] = A2_MF8P(pb8, v0_, oB[0]); oB[1] = A2_MF8P(pb8, v1_, oB[1]); P8_LSUM(pb8, lBcc); }
      { const int j_ = lane & 15, rg_ = lane >> 4;
        if (j_ < 2) {
#pragma unroll
          for (int r_ = 0; r_ < 4; ++r_) { ws[j_ * 16 + 4 * rg_ + r_] = lAcc[r_]; ws[32 + j_ * 16 + 4 * rg_ + r_] = lBcc[r_]; } }
        asm volatile("s_waitcnt lgkmcnt(0)" ::: "memory");
        lA = 0.5f * ws[r32]; lB = 0.5f * ws[32 + r32]; asm volatile("s_waitcnt lgkmcnt(0)" ::: "memory"); }
    } else {
    P8_TILE(0, 0, true); P8_TILE(1, 1, false); P8_TILE(2, 2, false); P8_TILE(3, 3, false);
    for (int t = 4; t + 3 < NT; t += 4) { P8_TILE(0, t, false); P8_TILE(1, t + 1, false); P8_TILE(2, t + 2, false); P8_TILE(3, t + 3, false); }
    { P8_VF(3); oB[0] = A2_MF8P(pb8, v0_, oB[0]); oB[1] = A2_MF8P(pb8, v1_, oB[1]); }
    }
    { auto rr = __builtin_amdgcn_permlane32_swap(__float_as_uint(lA), __float_as_uint(lA), false, false); lA = __uint_as_float(rr[0]) + __uint_as_float(rr[1]); }
    { auto rr = __builtin_amdgcn_permlane32_swap(__float_as_uint(lB), __float_as_uint(lB), false, false); lB = __uint_as_float(rr[0]) + __uint_as_float(rr[1]); }
#undef P8_TILE
#undef P8_TILE5
#undef P8_SMG
#undef P8_EXP
#undef P8_PK
#undef P8_LSUM
#undef P8_FIN
#undef P8_VF
#undef P8_KA
#undef P8_KB
#undef P8_BIAS16
#undef P8_LD
#undef P8_ADD
  } else {
#ifndef A2_NOSTAGGER
  if (wid >= 4 && ABL != 5) { A2_WAITV(true); __builtin_amdgcn_s_barrier(); }
#endif
#ifdef A2_PRIO
  if (wid >= 4) __builtin_amdgcn_s_setprio(1);
#endif
  int t = 0;
  for (; t + 3 < NT; t += 4) { A2_TILE(0, t); A2_TILE(1, t + 1); A2_TILE(2, t + 2); A2_TILE(3, t + 3); }
  if (t < NT) { A2_TILE(0, t); if (t + 1 < NT) { A2_TILE(1, t + 1); if (t + 2 < NT) { A2_TILE(2, t + 2); } } }
#ifndef A2_NOSTAGGER
  if (wid < 4 && ABL != 5) __builtin_amdgcn_s_barrier();
#endif
#ifdef A2_PRIO
  __builtin_amdgcn_s_setprio(0);
#endif
  }
#undef A2_MID
#undef A2_WAITV
#undef A2_TILE
#undef A2_MF8
#undef A2_MF8P
#undef A2_PV
#undef A2_PV2
#undef A2_PK
  if (SWA) { const float sk = sinkp[wid & 3] * LOG2E - ((F8 && FAST) ? P8_BIAS : 0.f); lA += __builtin_amdgcn_exp2f(FAST ? sk : sk - mA); lB += __builtin_amdgcn_exp2f(FAST ? sk : sk - mB); }
#ifdef A2_FORCE_FALLBACK
  if (FAST) { if (lane == 0) *flag = 1u; }
#else
  if (FAST) { bool bad = !(lA >= 1e-30f && lA <= 1e30f) || !(lB >= 1e-30f && lB <= 1e30f);
    if constexpr (F8) { float z = 0.f;
#pragma unroll
      for (int r = 0; r < 16; ++r) z += (oA[0][r] + oA[1][r] + oB[0][r] + oB[1][r]) * 0.f;
      bad = bad || !(z == 0.f); }
    if (__any(bad) && lane == 0) *flag = 1u; }
#endif
  if (hi == 0) { ws[r32] = lA; ws[32 + r32] = lB; }
  asm volatile("s_waitcnt lgkmcnt(0)" ::: "memory");
  int hi_e = hi, r32_e = r32; asm volatile("" : "+v"(hi_e), "+v"(r32_e));
#pragma unroll
  for (int blk = 0; blk < 2; ++blk) {
    const int rbase = wrow0 + blk * 32;
    if (rbase < rows_valid) {
#pragma unroll
      for (int r = 0; r < 16; ++r) { const int orow = crow(r, hi_e); const float il = __builtin_amdgcn_rcpf(ws[blk * 32 + orow]);
        if constexpr (SWA) { unsigned char* op = (unsigned char*)Ob + (size_t)(rbase + orow) * DM + r32_e;
          const float il16 = il * 16.f; op[0] = f2fp8((blk ? oB[0][r] : oA[0][r]) * il16); op[32] = f2fp8((blk ? oB[1][r] : oA[1][r]) * il16); }
        else { bf16_t* op = Ob + (size_t)(rbase + orow) * DM + r32_e;
        op[0] = f2bf((blk ? oB[0][r] : oA[0][r]) * il); op[32] = f2bf((blk ? oB[1][r] : oA[1][r]) * il); } }
    }
  }
  asm volatile("s_waitcnt vmcnt(0) lgkmcnt(0)" ::: "memory");
  __builtin_amdgcn_s_barrier();
  bool ok = true;
  if (FAST) { ok = (*flag == 0u); asm volatile("s_waitcnt lgkmcnt(0)" ::: "memory"); __builtin_amdgcn_s_barrier(); }
  return ok;
#undef A2_DMA
#undef A2_DMA8
}
#undef A2_SBAR
}

#ifdef PROBE_RND
__device__ __forceinline__ void phase_rnd(Frame& F, size_t off, size_t nbytes) {
  const Params P = lds_params(F);
  u32x4* base = (u32x4*)(P.ws + off); const size_t n = nbytes / 16;
  for (size_t i = (size_t)F.bid * NTHREADS + F.tid; i < n; i += (size_t)F.G * NTHREADS) {
    u32x4 w = base[i]; unsigned* wp = (unsigned*)&w;
#pragma unroll
    for (int j = 0; j < 4; ++j) { const float a = fp8rt(bf2f((bf16_t)(wp[j] & 0xffff)), 16.f), b = fp8rt(bf2f((bf16_t)(wp[j] >> 16)), 16.f); wp[j] = pk2bf(a, b); }
    base[i] = w; }
}
#endif
#ifdef PROBE_UB
__device__ __forceinline__ void phase_ubench(Frame& F) {
  const Params P = lds_params(F);
  pg8::v8i32 a, b; for (int j = 0; j < 8; ++j) { a[j] = 0x38383838 + F.lane; b[j] = 0x30303030 + j; }
  att::f32x16 c0 = {}, c1 = {}; float e[16];
#pragma unroll
  for (int j = 0; j < 16; ++j) e[j] = -0.001f * (float)(F.lane + j);
#pragma unroll 1
  for (int i = 0; i < 2048; ++i) {
    if (PROBE_UB & 1) c0 = __builtin_amdgcn_mfma_scale_f32_32x32x64_f8f6f4(a, b, c0, 0, 0, 0, 0x7F7F7F7F, 0, 0x7F7F7F7F);
    __builtin_amdgcn_sched_barrier(0);
    if (PROBE_UB & 2) {
#pragma unroll
      for (int j = 0; j < 8; ++j) e[j] = (PROBE_UB & 4) ? e[j] + 1.0009765625f : __builtin_amdgcn_exp2f(e[j]); }
    __builtin_amdgcn_sched_barrier(0);
    if (PROBE_UB & 1) c1 = __builtin_amdgcn_mfma_scale_f32_32x32x64_f8f6f4(a, b, c1, 0, 0, 0, 0x7F7F7F7F, 0, 0x7F7F7F7F);
    __builtin_amdgcn_sched_barrier(0);
    if (PROBE_UB & 2) {
#pragma unroll
      for (int j = 8; j < 16; ++j) e[j] = (PROBE_UB & 4) ? e[j] + 1.0009765625f : __builtin_amdgcn_exp2f(e[j]); }
    __builtin_amdgcn_sched_barrier(0);
    asm volatile("" : "+v"(c0), "+v"(c1));
  }
  float r = 0.f;
#pragma unroll
  for (int j = 0; j < 16; ++j) r += e[j] + c0[j] + c1[j];
  ((float*)(P.ws + WS_PB))[(size_t)F.bid * NTHREADS + F.tid] = r;
}
#endif
__device__ __forceinline__ void phase_attn_mla(Frame& F) {
  const Params P = lds_params(F);
  const bf16_t* Q = (const bf16_t*)(P.ws + WS_QKV + OFF_Q); const bf16_t* QC = (const bf16_t*)(P.ws + WS_QKV + OFF_QC);
  const char* Kimg = (const char*)(P.ws + WS_QKV + OFF_K); const char* Vimg = (const char*)(P.ws + WS_QKV + OFF_V);
  bf16_t* CAT = (bf16_t*)(P.ws + WS_CAT);
  const int v = (F.G % 8 == 0) ? (F.bid % 8) * (F.G / 8) + F.bid / 8 : F.bid;
  for (int U = v; U < 512 + 16; U += F.G) {
    if (U < 512) { const int bh = U >> 5, qb = U & 31, b = bh >> 3, h = bh & 7;
      const bf16_t* Qu = (const bf16_t*)((const char*)Q + ((size_t)bh * SEQ + qb * 512) * 96);
      if (!att2::attn_unit<true, 0, 96, false, true>(Qu, 512, Kimg + (size_t)bh * NKEY * 96, Vimg + (size_t)bh * NKEY * 64,
                                 CAT + ((size_t)b * SEQ + qb * 512) * DM + 512 + h * 64, NKEY / 64, F.lds))
        att2::attn_unit<false, 0, 96, false, true>(Qu, 512, Kimg + (size_t)bh * NKEY * 96, Vimg + (size_t)bh * NKEY * 64,
                               CAT + ((size_t)b * SEQ + qb * 512) * DM + 512 + h * 64, NKEY / 64, F.lds);
    } else { const int bh = U - 512, b = bh >> 3, h = bh & 7;
      att2::attn_unit<false, 0, 96, false, true>((const bf16_t*)((const char*)QC + (size_t)bh * CTX * 96), 256, Kimg + (size_t)bh * NKEY * 96, Vimg + (size_t)bh * NKEY * 64,
                             CAT + ((size_t)NLAT + b * CTX) * DM + 512 + h * 64, CTX / 64, F.lds);
    }
  }
}
#ifdef PROBE_ATT_ABL
__device__ __forceinline__ void phase_attn_probe(Frame& F) {
  const Params P = lds_params(F);
  const bf16_t* Q = (const bf16_t*)(P.ws + WS_QKV + OFF_Q);
  const char* Kimg = (const char*)(P.ws + WS_QKV + OFF_K); const char* Vimg = (const char*)(P.ws + WS_QKV + OFF_V);
  bf16_t* SCR = (bf16_t*)(P.ws + WS_PB);
  const int v = (F.G % 8 == 0) ? (F.bid % 8) * (F.G / 8) + F.bid / 8 : F.bid;
  for (int U = v; U < 512; U += F.G) { const int bh = U >> 5, qb = U & 31, b = bh >> 3, h = bh & 7;
    att2::attn_unit<true, PROBE_ATT_ABL, 96, false, true>((const bf16_t*)((const char*)Q + ((size_t)bh * SEQ + qb * 512) * 96), 512, Kimg + (size_t)bh * NKEY * 96, Vimg + (size_t)bh * NKEY * 64,
                                         SCR + ((size_t)b * SEQ + qb * 512) * DM + 512 + h * 64, NKEY / 64, F.lds); }
}
#endif
__device__ __forceinline__ void phase_attn_swa(Frame& F) {
  const Params P = lds_params(F);
  const bf16_t* Q2 = (const bf16_t*)(P.ws + WS_QKV + OFF_Q2); const char* K2 = (const char*)(P.ws + WS_QKV + OFF_K2); const char* V2 = (const char*)(P.ws + WS_QKV + OFF_V2);
  bf16_t* CAT = (bf16_t*)(P.ws + WS_CAT); const float* sink = P.in[17];
  const int v = (F.G % 8 == 0) ? (F.bid % 8) * (F.G / 8) + F.bid / 8 : F.bid;
  for (int U = v; U < NB * 4 * 128; U += F.G) {
    const int bk = U >> 7, qb = U & 127, b = bk >> 2, kvh = bk & 3, q0 = qb * 128;
    int lo = q0 - 128, hi2 = q0 + 256; if (lo < 0) lo = 0; if (hi2 > SEQ) hi2 = SEQ;
    const int lt0 = lo >> 6, NT = 4 + ((hi2 - lo) >> 6);
    const bf16_t* Qb = (const bf16_t*)((const char*)Q2 + ((size_t)(b * 16 + kvh * 4) * SEQ + q0) * 64); const char* Kb = K2 + (size_t)bk * NKEY * 64; const char* Vb = V2 + (size_t)bk * NKEY * 64;
    bf16_t* Ob = (bf16_t*)((unsigned char*)CAT + ((size_t)b * SEQ + q0) * DM + kvh * 256);
    if (!att2::attn_unit<true, 0, 64, true, true>(Qb, 128, Kb, Vb, Ob, NT, F.lds, lt0, q0, sink + kvh * 4))
      att2::attn_unit<false, 0, 64, true, true>(Qb, 128, Kb, Vb, Ob, NT, F.lds, lt0, q0, sink + kvh * 4);
  }
}
__device__ __forceinline__ float wave_sum(float v) {
#pragma unroll
  for (int o = 1; o < 64; o <<= 1) v += __shfl_xor(v, o);
  return v;
}
__device__ __forceinline__ void row_load(const float* row, int lane, f32x4 (&x)[4]) {
#pragma unroll
  for (int j = 0; j < 4; ++j) x[j] = *(const f32x4*)(row + 4 * lane + 256 * j);
}
__device__ __forceinline__ float row_ssq(const f32x4 (&x)[4]) {
  float s = 0.f;
#pragma unroll
  for (int j = 0; j < 4; ++j) s += (x[j][0] * x[j][0] + x[j][1] * x[j][1]) + (x[j][2] * x[j][2] + x[j][3] * x[j][3]);
  return wave_sum(s);
}
__device__ __forceinline__ void xs_load(const bf16_t* xsb, const float* xcx, int r, int lane, f32x4 (&x)[4]) {
  if (r < NLAT) { const bf16_t* p = xsb + (size_t)r * DM + 4 * lane;
#pragma unroll
    for (int j = 0; j < 4; ++j) { const u32x2 w = *(const u32x2*)(p + 256 * j);
      x[j] = (f32x4){bf2f((bf16_t)(w.x & 0xffff)), bf2f((bf16_t)(w.x >> 16)), bf2f((bf16_t)(w.y & 0xffff)), bf2f((bf16_t)(w.y >> 16))}; } }
  else row_load(xcx + (size_t)(r - NLAT) * DM, lane, x);
}
__device__ __forceinline__ void row_norm_mod_fp8(f32x4 (&x)[4], float inv, const float* g, const float* sh, const float* sc, unsigned char* orow, int lane) {
#pragma unroll
  for (int j = 0; j < 4; ++j) {
    const int c = 4 * lane + 256 * j;
    const f32x4 gg = *(const f32x4*)(g + c), s1 = *(const f32x4*)(sh + c), s2 = *(const f32x4*)(sc + c);
    x[j] = x[j] * inv * gg * (s2 + 1.f) + s1;
    *(unsigned*)(orow + c) = pk4fp8(x[j][0], x[j][1], x[j][2], x[j][3]);
  }
}
__device__ __forceinline__ void row_norm_mod(f32x4 (&x)[4], float inv, const float* g, const float* sh, const float* sc, bf16_t* orow, int lane) {
#pragma unroll
  for (int j = 0; j < 4; ++j) {
    const int c = 4 * lane + 256 * j;
    const f32x4 gg = *(const f32x4*)(g + c), s1 = *(const f32x4*)(sh + c), s2 = *(const f32x4*)(sc + c);
    x[j] = x[j] * inv * gg * (s2 + 1.f) + s1;
    u32x2 w; w.x = pk2bf(x[j][0], x[j][1]); w.y = pk2bf(x[j][2], x[j][3]);
    *(u32x2*)(orow + c) = w;
  }
}

__device__ __forceinline__ void phase_norm1_l0(Frame& F) {
  const Params P = lds_params(F);
  const float* x = P.in[0]; const float* ctx = P.in[2]; const float* g = P.in[6]; const float* modv = (const float*)(P.ws + WS_MODV);
  bf16_t* HB = (bf16_t*)(P.ws + WS_HB);
  for (int row = F.bid * 8 + F.wave; row < NROW; row += F.G * 8) {
    const float* src; int v;
    if (row < NLAT) { src = x + (size_t)row * DM; v = row / SEQ; } else { src = ctx + (size_t)(row - NLAT) * DM; v = 2; }
    f32x4 xv[4]; row_load(src, F.lane, xv);
    const float inv = rsqrtf(row_ssq(xv) * (1.f / DM) + EPS);
    row_norm_mod(xv, inv, g, modv + v * NMOD, modv + v * NMOD + DM, HB + (size_t)row * DM, F.lane);
  }
}

__device__ __forceinline__ void phase_norm2(Frame& F, int layer) {
  const Params P = lds_params(F);
  const float* g = P.in[7] + layer * DM; const float* modl = (const float*)(P.ws + WS_MODV) + (size_t)layer * 3 * NMOD;
  const float* rw = P.in[19] + (size_t)layer * DM * NE;
  const bf16_t* xsb = (const bf16_t*)(P.ws + WS_XSB); const float* xcx = (const float*)(P.ws + WS_XC);
  bf16_t* HB = (bf16_t*)(P.ws + WS_HB); float* aff = (float*)(P.ws + WS_AFF);
  const int nrows = layer == 0 ? NROW : NLAT, lane = F.lane;
  __syncthreads();
  for (int f = F.tid; f < DM * 4; f += NTHREADS) { const int c = f >> 2, q = f & 3, j = c >> 8, ln = (c & 255) >> 2, i = c & 3;
    *(LAS f32x4*)(F.lds + ((4 * j + i) * 4 + q) * 1024 + 16 * ln) = *(const f32x4*)(rw + 4 * f); }
  __syncthreads();
  const unsigned wl = (unsigned)(uintptr_t)(F.lds + 16 * lane);
  const int stride = F.G * 8;
  int row = F.bid * 8 + F.wave;
  f32x4 xv[4], xn[4], xm[4];
  if (row < nrows) xs_load(xsb, xcx, row, lane, xv);
  if (row + stride < nrows) xs_load(xsb, xcx, row + stride, lane, xn);
  int cv = -1; f32x4 ga[4], sb[4];
  while (row < nrows) {
    const int nrow = row + stride, mrow = nrow + stride;
    if (mrow < nrows) xs_load(xsb, xcx, mrow, lane, xm);
    const int v = row < NLAT ? row / SEQ : 2;
    if (v != cv) { cv = v; const float* shp = modl + v * NMOD + 3 * DM; const float* scp = shp + DM;
#pragma unroll
      for (int j = 0; j < 4; ++j) { const int c = 4 * lane + 256 * j; ga[j] = *(const f32x4*)(g + c) * (*(const f32x4*)(scp + c) + 1.f); sb[j] = *(const f32x4*)(shp + c); } }
    const float inv = rsqrtf(row_ssq(xv) * (1.f / DM) + EPS);
    { unsigned char* orow = (unsigned char*)HB + (size_t)row * DM;
#pragma unroll
      for (int j = 0; j < 4; ++j) { xv[j] = xv[j] * inv * ga[j] + sb[j]; *(unsigned*)(orow + 4 * lane + 256 * j) = pk4fp8(xv[j][0], xv[j][1], xv[j][2], xv[j][3]); } }
    typedef float f32x2 __attribute__((ext_vector_type(2)));
    f32x2 pp[8];
#pragma unroll
    for (int e = 0; e < 8; ++e) pp[e] = (f32x2){0.f, 0.f};
#pragma unroll
    for (int j = 0; j < 4; ++j) {
      unsigned wb = wl + j * 16384; asm volatile("" : "+v"(wb));
#pragma unroll
      for (int i = 0; i < 4; ++i)
#pragma unroll
        for (int q = 0; q < 4; ++q) {
          const f32x4 w = *(const LAS f32x4*)(wb + (i * 4 + q) * 1024); const f32x2 hv = (f32x2){xv[j][i], xv[j][i]};
          pp[2 * q] = __builtin_elementwise_fma(hv, (f32x2){w[0], w[1]}, pp[2 * q]); pp[2 * q + 1] = __builtin_elementwise_fma(hv, (f32x2){w[2], w[3]}, pp[2 * q + 1]);
        }
      __builtin_amdgcn_sched_barrier(0);
    }
    float p[16];
#pragma unroll
    for (int e = 0; e < 8; ++e) { p[2 * e] = pp[e][0]; p[2 * e + 1] = pp[e][1]; }
    float q8[8];
#pragma unroll
    for (int e = 0; e < 8; ++e) { auto rr = __builtin_amdgcn_permlane32_swap(__float_as_uint(p[e]), __float_as_uint(p[e + 8]), false, false); q8[e] = __uint_as_float(rr[0]) + __uint_as_float(rr[1]); }
    float q4[4];
#pragma unroll
    for (int e = 0; e < 4; ++e) { const bool up = (lane & 16) != 0; const float snd = up ? q8[e] : q8[e + 4], keep = up ? q8[e + 4] : q8[e]; q4[e] = keep + __shfl_xor(snd, 16); }
    float q2[2];
#pragma unroll
    for (int e = 0; e < 2; ++e) { const bool up = (lane & 8) != 0; const float snd = up ? q4[e] : q4[e + 2], keep = up ? q4[e + 2] : q4[e]; q2[e] = keep + __shfl_xor(snd, 8); }
    float lg; { const bool up = (lane & 4) != 0; const float snd = up ? q2[0] : q2[1], keep = up ? q2[1] : q2[0]; lg = keep + __shfl_xor(snd, 4); }
    lg += __shfl_xor(lg, 2); lg += __shfl_xor(lg, 1);
    float mx = lg;
    mx = fmaxf(mx, __shfl_xor(mx, 4)); mx = fmaxf(mx, __shfl_xor(mx, 8)); mx = fmaxf(mx, __shfl_xor(mx, 16)); mx = fmaxf(mx, __shfl_xor(mx, 32));
    const float ex = expf(lg - mx);
    float sum = ex;
    sum += __shfl_xor(sum, 4); sum += __shfl_xor(sum, 8); sum += __shfl_xor(sum, 16); sum += __shfl_xor(sum, 32);
    if ((lane & 3) == 0) {
      const float a = ex / sum; const int e = 8 * (lane >> 5) + 4 * ((lane >> 4) & 1) + 2 * ((lane >> 3) & 1) + ((lane >> 2) & 1);
      if (row < NLAT) { const int b = row / SEQ, t = row % SEQ; aff[((size_t)(b * NE + e)) * SEQ + t] = a; }
      else { const int jj = row - NLAT, b = jj / CTX, t = jj % CTX; aff[(size_t)NB * NE * SEQ + ((size_t)(b * NE + e)) * CTX + t] = a; }
    }
#pragma unroll
    for (int j = 0; j < 4; ++j) { xv[j] = xn[j]; xn[j] = xm[j]; }
    row = nrow;
  }
  __syncthreads();
}

__device__ __forceinline__ void phase_preup(Frame& F) {
  const Params P = lds_params(F);
  const bf16_t* Pm = (const bf16_t*)(P.ws + WS_PB); bf16_t* QKN = (bf16_t*)(P.ws + WS_QN); bf16_t* CAT = (bf16_t*)(P.ws + WS_CAT);
  bf16_t* Kk = (bf16_t*)(P.ws + WS_QKV + OFF_K); const float* tab = (const float*)(P.ws + WS_ROPE);
  const float* cw = P.in[9]; const float* cb = P.in[10]; const float* qg = P.in[11]; const float* kg = P.in[13];
  const int lane = F.lane;
  for (int row = F.bid * 8 + F.wave; row < NROW; row += F.G * 8) {
    const bf16_t* pr = Pm + (size_t)row * PPITCH;
    const bool lat = row < NLAT; int b, pos, t = 0, lo, hi;
    if (lat) { b = row / SEQ; t = row % SEQ; pos = CTX + t; lo = b * SEQ; hi = lo + SEQ; } else { const int j = row - NLAT; b = j / CTX; pos = j % CTX; lo = NLAT + b * CTX; hi = lo + CTX; }
    { const u32x2 qw = *(const u32x2*)(pr + 1536 + 4 * lane); const unsigned kw = *(const unsigned*)(pr + 1792 + 2 * lane);
      const float q0 = bf2f((bf16_t)(qw.x & 0xffff)), q1 = bf2f((bf16_t)(qw.x >> 16)), q2 = bf2f((bf16_t)(qw.y & 0xffff)), q3 = bf2f((bf16_t)(qw.y >> 16));
      const float k0 = bf2f((bf16_t)(kw & 0xffff)), k1 = bf2f((bf16_t)(kw >> 16));
      const float sq = wave_sum((q0 * q0 + q1 * q1) + (q2 * q2 + q3 * q3)), sk = wave_sum(k0 * k0 + k1 * k1);
      const float iq = rsqrtf(sq * (1.f / 256.f) + EPS), ik = rsqrtf(sk * (1.f / 128.f) + EPS);
      const f32x4 gq = *(const f32x4*)(qg + 4 * lane); const float gk0 = kg[2 * lane], gk1 = kg[2 * lane + 1];
      unsigned char* qrow = (unsigned char*)QKN + (size_t)row * 512;
      *(unsigned*)(qrow + 4 * lane) = pk4fp8(q0 * iq * gq[0], q1 * iq * gq[1], q2 * iq * gq[2], q3 * iq * gq[3]);
      *(unsigned short*)(qrow + 256 + 2 * lane) = (unsigned short)__builtin_amdgcn_cvt_pk_fp8_f32(k0 * ik * gk0, k1 * ik * gk1, 0, false);
      if (lane < 32) *(unsigned*)(qrow + 384 + 4 * lane) = 0u; }
    { const int p = lane & 15, a = p >> 3, ii = p & 7, hq = lane >> 4;
      const float x1 = bf2f(pr[1920 + a * 16 + ii]), x2 = bf2f(pr[1920 + a * 16 + 8 + ii]);
      float cs = 1.f, sn = 0.f;
      if (lat) { const int pp = a == 0 ? (t >> 6) : (t & 63); cs = tab[pp * 8 + ii]; sn = tab[2048 + pp * 8 + ii]; }
      const unsigned short w = (unsigned short)__builtin_amdgcn_cvt_pk_fp8_f32(x1 * cs - x2 * sn, x1 * sn + x2 * cs, 0, false);
#pragma unroll
      for (int hh = 0; hh < 2; ++hh) { const int h = 2 * hq + hh;
        *(unsigned short*)((char*)Kk + (size_t)(b * 8 + h) * NKEY * 96 + (size_t)(pos >> 6) * 6144 + (4 + (p >> 3)) * 1024 + (pos & 63) * 16 + (p & 7) * 2) = w; } }
    { const int c = 8 * lane;
      const u32x4 gbv = *(const u32x4*)(pr + c), gc1 = *(const u32x4*)(pr + 512 + c), u1 = *(const u32x4*)(pr + 1024 + c);
      u32x4 gc0 = {0u, 0u, 0u, 0u}, u0 = gc0, gc2 = gc0, u2 = gc0;
      if (row - 1 >= lo) { gc0 = *(const u32x4*)(pr - PPITCH + 512 + c); u0 = *(const u32x4*)(pr - PPITCH + 1024 + c); }
      if (row + 1 < hi) { gc2 = *(const u32x4*)(pr + PPITCH + 512 + c); u2 = *(const u32x4*)(pr + PPITCH + 1024 + c); }
      float y[8];
#pragma unroll
      for (int i = 0; i < 8; ++i) {
        const int sh = (i & 1) * 16; const int wi = i >> 1;
        const float z0 = bf2f((bf16_t)((gc0[wi] >> sh) & 0xffff)) * bf2f((bf16_t)((u0[wi] >> sh) & 0xffff));
        const float z1 = bf2f((bf16_t)((gc1[wi] >> sh) & 0xffff)) * bf2f((bf16_t)((u1[wi] >> sh) & 0xffff));
        const float z2 = bf2f((bf16_t)((gc2[wi] >> sh) & 0xffff)) * bf2f((bf16_t)((u2[wi] >> sh) & 0xffff));
        const float yy = z0 * cw[c + i] + z1 * cw[512 + c + i] + z2 * cw[1024 + c + i] + cb[c + i];
        y[i] = bf2f((bf16_t)((gbv[wi] >> sh) & 0xffff)) * yy;
      }
      u32x4 w; w.x = pk2bf(y[0], y[1]); w.y = pk2bf(y[2], y[3]); w.z = pk2bf(y[4], y[5]); w.w = pk2bf(y[6], y[7]);
      *(u32x4*)(CAT + (size_t)row * DM + c) = w; }
  }
}

template <bool PROBE = false>
__device__ __forceinline__ void phase_combine(Frame& F, int layer) {
  const Params P = lds_params(F);
  const float* modv = (const float*)(P.ws + WS_MODV); const float* modl = modv + (size_t)layer * 3 * NMOD;
  const bf16_t* YE = (const bf16_t*)(P.ws + WS_QKV); const int* slot = (const int*)(P.ws + WS_SLOT);
  bf16_t* xsb = (bf16_t*)(P.ws + WS_XSB); float* xcx = (float*)(P.ws + WS_XC); bf16_t* HB = (bf16_t*)(P.ws + WS_HB);
  const int nrows = layer == 0 ? NROW : NLAT, lane = F.lane, stride = F.G * 8;
#define CB_SLOT(r) (((r) < NLAT) ? slot[((size_t)(((r) / SEQ) * NE + (lane & 15))) * SEQ + (r) % SEQ] \
                                 : slot[(size_t)NB * NE * SEQ + ((size_t)((((r) - NLAT) / CTX) * NE + (lane & 15))) * CTX + ((r) - NLAT) % CTX])
  int row = F.bid * 8 + F.wave;
  f32x4 xv[4], xn[4]; int sl = -1, sln = -1;
  int cv = -1; f32x4 g2v[4], ga[4], sb[4];
  if (row < nrows) { sl = CB_SLOT(row); xs_load(xsb, xcx, row, lane, xv); }
  while (row < nrows) {
    const int nrow = row + stride;
    if (nrow < nrows) { sln = CB_SLOT(nrow); xs_load(xsb, xcx, nrow, lane, xn); }
    int v; size_t ybase; int cap;
    if (row < NLAT) { const int b = row / SEQ; v = b; cap = CAP_L; ybase = (size_t)(b * NE) * CAP_L; }
    else { const int b = (row - NLAT) / CTX; v = 2; cap = CAP_C; ybase = (size_t)32 * CAP_L + (size_t)(b * NE) * CAP_C; }
    f32x4 acc[4];
#pragma unroll
    for (int j = 0; j < 4; ++j) acc[j] = (f32x4){0.f, 0.f, 0.f, 0.f};
    unsigned emask = (unsigned)(__ballot(sl >= 0) & 0xFFFFull);
    while (emask) {
      int ee[4]; u32x2 w[4][4];
#pragma unroll
      for (int k = 0; k < 4; ++k) { ee[k] = emask ? __builtin_ctz(emask) : -1; if (emask) emask &= emask - 1; }
#pragma unroll
      for (int k = 0; k < 4; ++k) if (ee[k] >= 0) { const int s_ = __shfl(sl, ee[k]); const bf16_t* yr = YE + (ybase + (size_t)ee[k] * cap + s_) * DM;
#pragma unroll
        for (int j = 0; j < 4; ++j) w[k][j] = *(const u32x2*)(yr + 4 * lane + 256 * j); }
#pragma unroll
      for (int k = 0; k < 4; ++k) if (ee[k] >= 0) {
#pragma unroll
        for (int j = 0; j < 4; ++j) { acc[j][0] += bf2f((bf16_t)(w[k][j].x & 0xffff)); acc[j][1] += bf2f((bf16_t)(w[k][j].x >> 16)); acc[j][2] += bf2f((bf16_t)(w[k][j].y & 0xffff)); acc[j][3] += bf2f((bf16_t)(w[k][j].y >> 16)); } }
    }
    if (v != cv) { cv = v;
      const float* m1 = modv + 3 * NMOD + v * NMOD;
#pragma unroll
      for (int j = 0; j < 4; ++j) { const int c = 4 * lane + 256 * j; g2v[j] = *(const f32x4*)(modl + v * NMOD + 5 * DM + c);
        if (layer == 0) { ga[j] = *(const f32x4*)(P.in[6] + DM + c) * (*(const f32x4*)(m1 + DM + c) + 1.f); sb[j] = *(const f32x4*)(m1 + c); }
        else ga[j] = *(const f32x4*)(P.in[23] + c); } }
#pragma unroll
    for (int j = 0; j < 4; ++j) xv[j] = xv[j] + g2v[j] * acc[j];
    const float inv = rsqrtf(row_ssq(xv) * (1.f / DM) + EPS);
    if (layer == 0) {
      if (PROBE) { }
      else if (row < NLAT) {
#pragma unroll
        for (int j = 0; j < 4; ++j) { u32x2 w; w.x = pk2bf(xv[j][0], xv[j][1]); w.y = pk2bf(xv[j][2], xv[j][3]); *(u32x2*)(xsb + (size_t)row * DM + 4 * lane + 256 * j) = w; } }
      else {
#pragma unroll
        for (int j = 0; j < 4; ++j) *(f32x4*)(xcx + (size_t)(row - NLAT) * DM + 4 * lane + 256 * j) = xv[j]; }
#pragma unroll
      for (int j = 0; j < 4; ++j) xv[j] = xv[j] * inv * ga[j] + sb[j];
      if (PROBE) { }
      else if (row < NLAT) { unsigned char* orow = (unsigned char*)HB + (size_t)row * DM;
#pragma unroll
        for (int j = 0; j < 4; ++j) *(unsigned*)(orow + 4 * lane + 256 * j) = pk4fp8(xv[j][0], xv[j][1], xv[j][2], xv[j][3]); }
      else { bf16_t* orow = HB + (size_t)row * DM;
#pragma unroll
        for (int j = 0; j < 4; ++j) { u32x2 w; w.x = pk2bf(xv[j][0], xv[j][1]); w.y = pk2bf(xv[j][2], xv[j][3]); *(u32x2*)(orow + 4 * lane + 256 * j) = w; } }
    } else {
      float* op = (PROBE ? (float*)(P.ws + WS_PB) : P.out) + (size_t)row * DM;
#pragma unroll
      for (int j = 0; j < 4; ++j) *(f32x4*)(op + 4 * lane + 256 * j) = xv[j] * inv * ga[j];
    }
#pragma unroll
    for (int j = 0; j < 4; ++j) xv[j] = xn[j];
    sl = sln; row = nrow;
  }
#undef CB_SLOT
}

__device__ __forceinline__ unsigned block_sum_u(unsigned v, LAS unsigned* red, int par, int wave, int lane) {
#pragma unroll
  for (int o = 1; o < 64; o <<= 1) v += __shfl_xor(v, o);
  if (lane == 0) red[par * 8 + wave] = v;
  __syncthreads();
  unsigned s = 0;
#pragma unroll
  for (int i = 0; i < 8; ++i) s += red[par * 8 + i];
  return s;
}
__device__ __forceinline__ void phase_topk(Frame& F, int layer) {
  const Params P = lds_params(F);
  const float* aff = (const float*)(P.ws + WS_AFF); int* sidx = (int*)(P.ws + WS_SIDX); float* sg = (float*)(P.ws + WS_SG); int* slot = (int*)(P.ws + WS_SLOT);
  LAS unsigned* red = (LAS unsigned*)F.lds;
  const int nprob = layer == 0 ? 64 : 32, tid = F.tid, lane = F.lane, wave = F.wave;
  for (int pb = F.bid; pb < nprob; pb += F.G) {
    const bool isctx = pb >= 32; const int ge = isctx ? pb - 32 : pb, n = isctx ? CTX : SEQ, cap = isctx ? CAP_C : CAP_L;
    const size_t aoff = isctx ? (size_t)NB * NE * SEQ + (size_t)ge * CTX : (size_t)ge * SEQ;
    const size_t soff = isctx ? (size_t)NB * NE * CAP_L + (size_t)ge * CAP_C : (size_t)ge * CAP_L;
    unsigned key[32];
#pragma unroll
    for (int j = 0; j < 8; ++j) {
      u32x4 w = {0u, 0u, 0u, 0u};
      if (32 * tid + 4 * j < n) w = *(const u32x4*)(aff + aoff + 32 * tid + 4 * j);
      key[4 * j] = w.x; key[4 * j + 1] = w.y; key[4 * j + 2] = w.z; key[4 * j + 3] = w.w;
    }
    __syncthreads();
    unsigned T = 0u; int par = 0;
    for (int bit = 30; bit >= 0; --bit) {
      const unsigned cand = T | (1u << bit);
      unsigned c = 0;
#pragma unroll
      for (int i = 0; i < 32; ++i) c += (key[i] >= cand) ? 1u : 0u;
      const unsigned tot = block_sum_u(c, red, par, wave, lane); par = (par + 1) & 3;
      if (tot >= (unsigned)cap) T = cand;
    }
    unsigned cg = 0, ce = 0;
#pragma unroll
    for (int i = 0; i < 32; ++i) { cg += (key[i] > T) ? 1u : 0u; ce += (key[i] == T) ? 1u : 0u; }
    const unsigned ngt = block_sum_u(cg, red, par, wave, lane); par = (par + 1) & 3;
    const unsigned need_eq = (unsigned)cap - ngt;
    unsigned pk = cg | (ce << 16), inc = pk;
#pragma unroll
    for (int o = 1; o < 64; o <<= 1) { const unsigned up = __shfl_up(inc, o); if (lane >= o) inc += up; }
    LAS unsigned* wtot = red + 32;
    __syncthreads();
    if (lane == 63) wtot[wave] = inc;
    __syncthreads();
    unsigned base = 0;
#pragma unroll
    for (int i = 0; i < 8; ++i) base += (i < wave) ? wtot[i] : 0u;
    unsigned excl = base + inc - pk;
    unsigned g_before = excl & 0xffffu, e_before = excl >> 16;
    int sl[32];
#pragma unroll
    for (int i = 0; i < 32; ++i) {
      const bool gt = key[i] > T, eq = key[i] == T;
      const bool take = gt || (eq && e_before < need_eq);
      const unsigned s = g_before + (e_before < need_eq ? e_before : need_eq);
      sl[i] = take ? (int)s : -1;
      if (take) { sidx[soff + s] = 32 * tid + i; sg[soff + s] = __uint_as_float(key[i]); }
      g_before += gt ? 1u : 0u; e_before += eq ? 1u : 0u;
    }
    if (32 * tid < n) {
#pragma unroll
      for (int j = 0; j < 8; ++j) { int4 w; w.x = sl[4 * j]; w.y = sl[4 * j + 1]; w.z = sl[4 * j + 2]; w.w = sl[4 * j + 3]; *(int4*)(slot + aoff + 32 * tid + 4 * j) = w; }
    }
    __syncthreads();
  }
  __syncthreads();
  if (F.G > 32) { if (F.bid >= 32) { cvt_run<true>(P, (LAS float*)(F.lds + 1024), layer, F.bid - 32, F.G - 32, CVT_MOE);
#ifdef PROBE_CVT2
      __syncthreads(); cvt_run<true>(P, (LAS float*)(F.lds + 1024), layer, F.bid - 32, F.G - 32, CVT_MOE);
#endif
  } }
  else cvt_run<true>(P, (LAS float*)(F.lds + 1024), layer, F.bid, F.G, CVT_MOE);
}

__device__ __forceinline__ void rope4(f32x4& v0, f32x4& v1, const f32x4 cs, const f32x4 sn) {
  f32x4 w0, w1;
  w0[0] = v0[0] * cs[0] - v0[1] * sn[0]; w0[1] = v0[0] * sn[0] + v0[1] * cs[0]; w0[2] = v0[2] * cs[1] - v0[3] * sn[1]; w0[3] = v0[2] * sn[1] + v0[3] * cs[1];
  w1[0] = v1[0] * cs[2] - v1[1] * sn[2]; w1[1] = v1[0] * sn[2] + v1[1] * cs[2]; w1[2] = v1[2] * cs[3] - v1[3] * sn[3]; w1[3] = v1[2] * sn[3] + v1[3] * cs[3];
  v0 = w0; v1 = w1;
}
__device__ __forceinline__ int v_img(int k, int c) { const int kk = (k & ~0xC) | ((k & 4) << 1) | ((k & 8) >> 1); return ((kk >> 3) * 2 + (c >> 5)) * 512 + ((kk & 7) * 32 + (c & 31)) * 2; }
template <int KIND, bool ROT>
__device__ __forceinline__ void up_store(const f32x4 (&acc)[2][2][4][2], const int bj, char* base, const int pos0, const int dd, const float* tabp, const int tl, const int a) {
#pragma unroll
  for (int ai = 0; ai < 2; ++ai)
#pragma unroll
    for (int m = 0; m < 4; ++m) {
      const int ro = ai * 128 + m * 16;
      f32x4 v0 = acc[ai][bj][m][0], v1 = acc[ai][bj][m][1];
      if (ROT) { const int t = tl + ro; const int pp = a == 0 ? (t >> 6) : (t & 63); rope4(v0, v1, *(const f32x4*)(tabp + pp * 8), *(const f32x4*)(tabp + 2048 + pp * 8)); }
      const int pos = pos0 + ro;
      if (KIND == 2) {
        const unsigned w0 = pk4fp8(v0[0], v0[1], v0[2], v0[3]), w1 = pk4fp8(v1[0], v1[1], v1[2], v1[3]);
        const int qi = pos & 3; const unsigned sel = (unsigned)qi | ((unsigned)(4 + qi) << 8);
        unsigned o[2];
#pragma unroll
        for (int e = 0; e < 2; ++e) { const unsigned w = e ? w1 : w0;
          const unsigned t0 = (unsigned)__builtin_amdgcn_update_dpp(0, (int)w, 0x00, 0xF, 0xF, false), t1 = (unsigned)__builtin_amdgcn_update_dpp(0, (int)w, 0x55, 0xF, 0xF, false);
          const unsigned t2 = (unsigned)__builtin_amdgcn_update_dpp(0, (int)w, 0xAA, 0xF, 0xF, false), t3 = (unsigned)__builtin_amdgcn_update_dpp(0, (int)w, 0xFF, 0xF, 0xF, false);
          const unsigned x01 = __builtin_amdgcn_perm(t1, t0, sel), x23 = __builtin_amdgcn_perm(t3, t2, sel);
          o[e] = (x01 & 0xffffu) | (x23 << 16); }
        const int kk = pos & 63, a_ = kk >> 5, hi_ = (kk >> 2) & 1, j_ = (kk & 31) >> 3;
        char* tb = base + (size_t)(pos >> 6) * 4096 + (a_ * 2 + hi_) * 512 + j_ * 4;
#pragma unroll
        for (int e = 0; e < 2; ++e) { const int d = dd + 4 * e + qi; *(unsigned*)(tb + (d >> 5) * 2048 + (d & 31) * 16) = o[e]; } }
      else { u32x2 w; w.x = pk4fp8(v0[0], v0[1], v0[2], v0[3]); w.y = pk4fp8(v1[0], v1[1], v1[2], v1[3]);
        char* dst = KIND == 0 ? base + (size_t)pos * 96 + dd : base + (size_t)(pos >> 6) * 6144 + (dd >> 4) * 1024 + (pos & 63) * 16 + (dd & 15);
        *(u32x2*)dst = w; }
    }
}
struct EpiUp {
  static constexpr bool PERM = true;
  bf16_t* Q; bf16_t* QC; bf16_t* K; bf16_t* V; const float* tab;
  __device__ __forceinline__ void operator()(const f32x4 (&acc)[2][2][4][2], const pg8::Unit& u, int wr, int wc, int fr, int fq) const {
    const int trow0 = u.pm * 256; const bool isctx = trow0 >= NLAT;
    const int b = isctx ? (trow0 - NLAT) / CTX : trow0 / SEQ;
    const int tl = (isctx ? 0 : trow0 % SEQ) + wr * 64 + fr;
#pragma unroll
    for (int bj = 0; bj < 2; ++bj) {
      const int cg = u.pn * 256 + bj * 128 + wc * 32;
      if (cg < 768) { const int h = cg / 96, ddg = cg % 96;
        char* base = isctx ? (char*)QC + (size_t)(b * 8 + h) * CTX * 96 : (char*)Q + (size_t)(b * 8 + h) * SEQ * 96;
        if (ddg >= 64 && !isctx) up_store<0, true>(acc, bj, base, tl, ddg + 8 * fq, tab + ((4 * fq) & 7), tl, (4 * fq) >> 3);
        else up_store<0, false>(acc, bj, base, tl, ddg + 8 * fq, tab, tl, 0); }
      else { const int j = cg - 768, h = j >> 7, ddg = j & 127; const int pos0 = (isctx ? 0 : CTX) + tl;
        if (ddg < 64) up_store<1, false>(acc, bj, (char*)K + (size_t)(b * 8 + h) * NKEY * 96, pos0, ddg + 8 * fq, tab, tl, 0);
        else up_store<2, false>(acc, bj, (char*)V + (size_t)(b * 8 + h) * NKEY * 64, pos0, (ddg - 64) + 8 * fq, tab, tl, 0); }
    }
  }
};
struct EpiQkv2 {
  static constexpr bool PERM = true;
  bf16_t* Q2; bf16_t* K2; bf16_t* V2; const float* tab;
  __device__ __forceinline__ void operator()(const f32x4 (&acc)[2][2][4][2], const pg8::Unit& u, int wr, int wc, int fr, int fq) const {
    const int trow0 = u.pm * 256; const bool isctx = trow0 >= NLAT;
    const int b = isctx ? (trow0 - NLAT) / CTX : trow0 / SEQ;
    const int tl = (isctx ? 0 : trow0 % SEQ) + wr * 64 + fr;
#pragma unroll
    for (int bj = 0; bj < 2; ++bj) {
      const int cg = u.pn * 256 + bj * 128 + wc * 32;
      if (isctx && cg < 1024) continue;
      const int hh = cg >> 6, dd = (cg & 63) + 8 * fq; const int pos = (isctx ? 0 : CTX) + tl;
      const bool rot = (cg < 1280) && !isctx;
      const int kind = cg < 1024 ? 0 : (cg < 1280 ? 1 : 2);
      char* dst0;
      if (kind == 0) dst0 = (char*)Q2 + ((size_t)(b * 16 + hh) * SEQ + tl) * 64 + dd;
      else if (kind == 1) dst0 = (char*)K2 + (size_t)(b * 4 + hh - 16) * NKEY * 64;
      else dst0 = (char*)V2 + (size_t)(b * 4 + hh - 20) * NKEY * 64;
      const int p0 = dd >> 1, a = p0 >> 4, i0 = p0 & 15;
#pragma unroll
      for (int ai = 0; ai < 2; ++ai)
#pragma unroll
        for (int m = 0; m < 4; ++m) {
          const int ro = ai * 128 + m * 16;
          f32x4 v0 = acc[ai][bj][m][0], v1 = acc[ai][bj][m][1];
          if (rot) { const int t = tl + ro; const int pp = a == 0 ? (t >> 6) : (t & 63);
            rope4(v0, v1, *(const f32x4*)(tab + 4096 + pp * 16 + i0), *(const f32x4*)(tab + 8192 + pp * 16 + i0)); }
          const int ps = pos + ro;
          const unsigned w0 = pk4fp8(v0[0], v0[1], v0[2], v0[3]), w1 = pk4fp8(v1[0], v1[1], v1[2], v1[3]);
          if (kind < 2) { u32x2 w; w.x = w0; w.y = w1;
            char* dst = kind == 0 ? dst0 + (size_t)ro * 64 : dst0 + (size_t)(ps >> 6) * 4096 + (dd >> 4) * 1024 + (ps & 63) * 16 + (dd & 15);
            *(u32x2*)dst = w; }
          else {
            const int qi = ps & 3; const unsigned sel = (unsigned)qi | ((unsigned)(4 + qi) << 8);
            const int kk = ps & 63, a_ = kk >> 5, hi_ = (kk >> 2) & 1, j_ = (kk & 31) >> 3;
            char* tb = dst0 + (size_t)(ps >> 6) * 4096 + (a_ * 2 + hi_) * 512 + j_ * 4;
#pragma unroll
            for (int e = 0; e < 2; ++e) { const unsigned w = e ? w1 : w0;
              const unsigned t0 = (unsigned)__builtin_amdgcn_update_dpp(0, (int)w, 0x00, 0xF, 0xF, false), t1 = (unsigned)__builtin_amdgcn_update_dpp(0, (int)w, 0x55, 0xF, 0xF, false);
              const unsigned t2 = (unsigned)__builtin_amdgcn_update_dpp(0, (int)w, 0xAA, 0xF, 0xF, false), t3 = (unsigned)__builtin_amdgcn_update_dpp(0, (int)w, 0xFF, 0xF, 0xF, false);
              const unsigned x01 = __builtin_amdgcn_perm(t1, t0, sel), x23 = __builtin_amdgcn_perm(t3, t2, sel);
              const int d = dd + 4 * e + qi; *(unsigned*)(tb + (d >> 5) * 2048 + (d & 31) * 16) = (x01 & 0xffffu) | (x23 << 16); } }
        }
    }
  }
};

enum { PH_PRO = 0, PH_L0_NORM1, PH_L0_WIN, PH_L0_PREUP, PH_L0_UP, PH_L0_ATTN, PH_L0_WOUT, PH_L0_NORM2, PH_L0_TOPK, PH_L0_GU, PH_L0_DOWN, PH_L0_COMB,
       PH_L1_QKV, PH_L1_ATTN, PH_L1_WOUT, PH_L1_NORM2, PH_L1_TOPK, PH_L1_GU, PH_L1_DOWN, PH_L1_COMB, PH_COUNT };

template <class Epi>
__device__ __forceinline__ void sg_tile(const bf16_t* __restrict__ X, const bf16_t* __restrict__ Wt, const int K, const int row0, const int col0, const int lane, const Epi& E) {
    using att::f32x16;
    const int r32 = lane & 31, hi = lane >> 5;
    const bf16_t* xp = X + (size_t)(row0 + r32) * K + hi * 8;
    const bf16_t* w0 = Wt + (size_t)(col0 + r32) * K + hi * 8;
    f32x16 a0 = {}, a1 = {};
#pragma unroll 16
    for (int s = 0; s < K; s += 32) {
        const bf16x8 x0 = *reinterpret_cast<const bf16x8*>(xp + s), wa = *reinterpret_cast<const bf16x8*>(w0 + s);
        const bf16x8 x1 = *reinterpret_cast<const bf16x8*>(xp + s + 16), wb = *reinterpret_cast<const bf16x8*>(w0 + s + 16);
        a0 = __builtin_amdgcn_mfma_f32_32x32x16_bf16(wa, x0, a0, 0, 0, 0); a1 = __builtin_amdgcn_mfma_f32_32x32x16_bf16(wb, x1, a1, 0, 0, 0);
    }
#pragma unroll
    for (int g = 0; g < 4; ++g)
        E(row0 + r32, col0 + 8 * g + 4 * hi, (f32x4){a0[4 * g] + a1[4 * g], a0[4 * g + 1] + a1[4 * g + 1], a0[4 * g + 2] + a1[4 * g + 2], a0[4 * g + 3] + a1[4 * g + 3]});
}
template <class Epi>
__device__ __forceinline__ void sg_ctx(Frame& F, const bf16_t* X, const bf16_t* Wt, int K, int col_lo, int col_hi, const Epi& E) {
    const int ncb = (col_hi - col_lo) / 32, nu = (NCTX / 32) * ncb;
    for (int u = F.bid + F.wave * F.G; u < nu; u += 8 * F.G) sg_tile(X, Wt, K, NLAT + 32 * (u / ncb), col_lo + 32 * (u % ncb), F.lane, E);
}
struct SgStore { bf16_t* out; int ld; __device__ __forceinline__ void operator()(int row, int col, f32x4 v) const { u32x2 w; w.x = pk2bf(v[0], v[1]); w.y = pk2bf(v[2], v[3]); *(u32x2*)(out + (size_t)row * ld + col) = w; } };
struct SgResidCtx { const float* xin; float* xo; const float* gate;
    __device__ __forceinline__ void operator()(int row, int col, f32x4 v) const { const size_t o = (size_t)(row - NLAT) * DM + col; *(f32x4*)(xo + o) = *(const f32x4*)(xin + o) + *(const f32x4*)(gate + col) * v; } };
struct SgKv2Ctx { char* K2; char* V2;
    __device__ __forceinline__ void operator()(int row, int col, f32x4 v) const {
        const int j = row - NLAT, b = j / CTX, pos = j % CTX, hh = (col - 1024) >> 6, dd = col & 63;
        if (hh < 4) *(unsigned*)(K2 + (size_t)(b * 4 + hh) * NKEY * 64 + (size_t)(pos >> 6) * 4096 + (dd >> 4) * 1024 + (pos & 63) * 16 + (dd & 15)) = pk4fp8(v[0], v[1], v[2], v[3]);
        else { const int kk = pos & 63, a_ = kk >> 5, hi_ = (kk >> 2) & 1, tt = (kk & 3) + 4 * ((kk & 31) >> 3);
          char* tb = V2 + (size_t)(b * 4 + hh - 4) * NKEY * 64 + (size_t)(pos >> 6) * 4096 + (a_ * 2 + hi_) * 512 + tt;
#pragma unroll
          for (int e = 0; e < 4; ++e) { const int d = dd + e; *(unsigned char*)(tb + (d >> 5) * 2048 + (d & 31) * 16) = f2fp8(v[e]); } } } };

__device__ __forceinline__ void sg_tile64(const bf16_t* __restrict__ xr0, const bf16_t* __restrict__ xr1, const bf16_t* __restrict__ Wt, const int K, const int col0, const int lane,
                                          att::f32x16 (&acc)[2][2]) {
    const int r32 = lane & 31, hi = lane >> 5;
    const bf16_t* x0 = xr0 + hi * 8; const bf16_t* x1 = xr1 + hi * 8;
    const bf16_t* w0 = Wt + (size_t)(col0 + r32) * K + hi * 8; const bf16_t* w1 = w0 + (size_t)32 * K;
#pragma unroll
    for (int a = 0; a < 2; ++a)
#pragma unroll
        for (int b = 0; b < 2; ++b) acc[a][b] = att::f32x16{};
#pragma unroll 8
    for (int s = 0; s < K; s += 16) {
        const bf16x8 xa = *reinterpret_cast<const bf16x8*>(x0 + s), xb = *reinterpret_cast<const bf16x8*>(x1 + s);
        const bf16x8 wa = *reinterpret_cast<const bf16x8*>(w0 + s), wb = *reinterpret_cast<const bf16x8*>(w1 + s);
        acc[0][0] = __builtin_amdgcn_mfma_f32_32x32x16_bf16(wa, xa, acc[0][0], 0, 0, 0); acc[0][1] = __builtin_amdgcn_mfma_f32_32x32x16_bf16(wa, xb, acc[0][1], 0, 0, 0);
        acc[1][0] = __builtin_amdgcn_mfma_f32_32x32x16_bf16(wb, xa, acc[1][0], 0, 0, 0); acc[1][1] = __builtin_amdgcn_mfma_f32_32x32x16_bf16(wb, xb, acc[1][1], 0, 0, 0);
    }
}
__device__ __forceinline__ void sg_moe_gu_ctx(Frame& F, const Params& P) {
    const bf16_t* HB = (const bf16_t*)(P.ws + WS_HB); const int* sidx = (const int*)(P.ws + WS_SIDX) + 32 * CAP_L;
    bf16_t* HID = (bf16_t*)(P.ws + WS_PB) + (size_t)32 * CAP_L * DFF;
    const int lane = F.lane, r32 = lane & 31, hi = lane >> 5;
    for (int u = F.bid + F.wave * F.G; u < 16 * 32; u += 8 * F.G) {
        const int e = u >> 5, cb = u & 31;
        const int t0 = sidx[(0 * 16 + e) * CAP_C + r32], t1 = sidx[(1 * 16 + e) * CAP_C + r32];
        att::f32x16 acc[2][2];
        sg_tile64(HB + ((size_t)NLAT + 0 * CTX + t0) * DM, HB + ((size_t)NLAT + 1 * CTX + t1) * DM, (const bf16_t*)(P.ws + WS_W + OFF_WGU) + (size_t)e * 2048 * DM, DM, cb * 64, lane, acc);
#pragma unroll
        for (int rb = 0; rb < 2; ++rb) { bf16_t* hrow = HID + ((size_t)(rb * 16 + e) * CAP_C + r32) * DFF;
#pragma unroll
            for (int c2 = 0; c2 < 2; ++c2)
#pragma unroll
                for (int g = 0; g < 4; ++g) { const int col = cb * 64 + c2 * 32 + 8 * g + 4 * hi;
                    const att::f32x16& a = acc[c2][rb];
                    *(unsigned*)(hrow + (col >> 1)) = pk2bf(silu_f(a[4 * g]) * a[4 * g + 1], silu_f(a[4 * g + 2]) * a[4 * g + 3]); } }
    }
}
__device__ __forceinline__ void sg_moe_down_ctx(Frame& F, const Params& P) {
    const bf16_t* HID = (const bf16_t*)(P.ws + WS_PB) + (size_t)32 * CAP_L * DFF; bf16_t* YE = (bf16_t*)(P.ws + WS_QKV) + (size_t)32 * CAP_L * DM;
    const float* sg = (const float*)(P.ws + WS_SG) + 32 * CAP_L;
    const int lane = F.lane, r32 = lane & 31, hi = lane >> 5;
    for (int u = F.bid + F.wave * F.G; u < 16 * 16; u += 8 * F.G) {
        const int e = u >> 4, cb = u & 15;
        att::f32x16 acc[2][2];
        sg_tile64(HID + ((size_t)(0 * 16 + e) * CAP_C + r32) * DFF, HID + ((size_t)(1 * 16 + e) * CAP_C + r32) * DFF, (const bf16_t*)(P.ws + WS_W + OFF_WD) + (size_t)e * 1024 * DFF, DFF, cb * 64, lane, acc);
#pragma unroll
        for (int rb = 0; rb < 2; ++rb) { const size_t r = (size_t)(rb * 16 + e) * CAP_C + r32; const float gv = sg[r]; bf16_t* yrow = YE + r * DM;
#pragma unroll
            for (int c2 = 0; c2 < 2; ++c2)
#pragma unroll
                for (int g = 0; g < 4; ++g) { const int col = cb * 64 + c2 * 32 + 8 * g + 4 * hi; const att::f32x16& a = acc[c2][rb];
                    u32x2 w; w.x = pk2bf(a[4 * g] * gv, a[4 * g + 1] * gv); w.y = pk2bf(a[4 * g + 2] * gv, a[4 * g + 3] * gv); *(u32x2*)(yrow + col) = w; } }
    }
}

__device__ __forceinline__ void phase_gemm_win(Frame& F) {
    const Params P = lds_params(F);
    pg8::SchedPlain S; S.init(NLAT, 2048, DM, (const bf16_t*)(P.ws + WS_W + OFF_WIN), F.G, F.bid);
    EpiStore E{(bf16_t*)(P.ws + WS_PB), PPITCH};
    pg8::gemm_phase<EpiStore, pg8::SchedPlain, true>(F.lds, (const char*)(P.ws + WS_HB), DM, S, E);
    sg_ctx(F, (const bf16_t*)(P.ws + WS_HB), (const bf16_t*)(P.ws + WS_W + OFF_WIN), DM, 0, 1984, SgStore{(bf16_t*)(P.ws + WS_PB), PPITCH});
}
__device__ __forceinline__ void phase_gemm_up(Frame& F) {
    const Params P = lds_params(F);
    pg8::SchedPlainT<1> S; S.init(NROW, 1792, 512, (const bf16_t*)(P.ws + WS_W + OFF_WUP), F.G, F.bid);
    EpiUp E{(bf16_t*)(P.ws + WS_QKV + OFF_Q), (bf16_t*)(P.ws + WS_QKV + OFF_QC), (bf16_t*)(P.ws + WS_QKV + OFF_K), (bf16_t*)(P.ws + WS_QKV + OFF_V), (const float*)(P.ws + WS_ROPE)};
    pg8::gemm_phase<EpiUp, pg8::SchedPlainT<1>, true>(F.lds, (const char*)(P.ws + WS_QN), 512, S, E);
}
__device__ __forceinline__ void phase_gemm_wout(Frame& F, int layer) {
    const Params P = lds_params(F);
    float* modv = (float*)(P.ws + WS_MODV); float* xc = (float*)(P.ws + WS_XC);
    if (layer == 0) {
        pg8::SchedPlain S; S.init(NLAT, DM, DM, (const bf16_t*)(P.ws + WS_W + OFF_WOUT), F.G, F.bid);
        EpiResidB<true> E{P.in[0], (bf16_t*)(P.ws + WS_XSB), modv, 2 * DM};
        pg8::gemm_phase<EpiResidB<true>, pg8::SchedPlain, true>(F.lds, (const char*)(P.ws + WS_CAT), DM, S, E);
        sg_ctx(F, (const bf16_t*)(P.ws + WS_CAT), (const bf16_t*)(P.ws + WS_W + OFF_WOUT), DM, 0, DM, SgResidCtx{P.in[2], xc, modv + 2 * NMOD + 2 * DM});
    } else {
        pg8::SchedPlainT<1, 0x7B7B7B7B> S; S.init(NLAT, DM, DM, (const bf16_t*)(P.ws + WS_W + OFF_WSO), F.G, F.bid);
        EpiResidB<false> E{nullptr, (bf16_t*)(P.ws + WS_XSB), modv + 3 * NMOD, 2 * DM};
        pg8::gemm_phase<EpiResidB<false>, pg8::SchedPlainT<1, 0x7B7B7B7B>, true>(F.lds, (const char*)(P.ws + WS_CAT), DM, S, E);
    }
}
__device__ __forceinline__ void phase_gemm_gu(Frame& F, int layer) {
    const Params P = lds_params(F);
    SchedMoeGU S; S.init((const int*)(P.ws + WS_SIDX), (const bf16_t*)(P.ws + WS_W + OFF_WGU), F.G, F.bid, layer == 0);
    EpiHidMk E{(bf16_t*)(P.ws + WS_PB)};
    pg8::gemm_phase<EpiHidMk, SchedMoeGU, true>(F.lds, (const char*)(P.ws + WS_HB), DM, S, E);
}
__device__ __forceinline__ void phase_gemm_down(Frame& F, int layer) {
    const Params P = lds_params(F);
    SchedMoeDown S; S.init((const bf16_t*)(P.ws + WS_W + OFF_WD), F.G, F.bid, layer == 0);
    EpiYeMk E{(bf16_t*)(P.ws + WS_QKV), (const float*)(P.ws + WS_SG)};
    pg8::gemm_phase<EpiYeMk, SchedMoeDown, true>(F.lds, (const char*)(P.ws + WS_PB), DFF, S, E);
}
__device__ __forceinline__ void phase_gemm_qkv2(Frame& F) {
    const Params P = lds_params(F);
    pg8::SchedPlainT<1> S; S.init(NLAT, 1536, DM, (const bf16_t*)(P.ws + WS_W + OFF_WQKV8), F.G, F.bid);
    EpiQkv2 E{(bf16_t*)(P.ws + WS_QKV + OFF_Q2), (bf16_t*)(P.ws + WS_QKV + OFF_K2), (bf16_t*)(P.ws + WS_QKV + OFF_V2), (const float*)(P.ws + WS_ROPE)};
    pg8::gemm_phase<EpiQkv2, pg8::SchedPlainT<1>, true>(F.lds, (const char*)(P.ws + WS_HB), DM, S, E);
    sg_ctx(F, (const bf16_t*)(P.ws + WS_HB), (const bf16_t*)(P.ws + WS_W + OFF_WQKV), DM, 1024, 1536, SgKv2Ctx{(char*)(P.ws + WS_QKV + OFF_K2), (char*)(P.ws + WS_QKV + OFF_V2)});
}

__global__ void __launch_bounds__(NTHREADS, 2) mk_fwd(Params KP) {
    extern __shared__ __attribute__((aligned(16))) unsigned char lds_raw[];
    Frame F;
    F.lds = (LAS unsigned char*)lds_raw; F.tid = threadIdx.x; F.lane = F.tid & 63; F.wave = __builtin_amdgcn_readfirstlane(F.tid >> 6); F.G = gridDim.x; F.bid = blockIdx.x;
    volatile LAS unsigned* MISC = (volatile LAS unsigned*)(F.lds + LDS_MISC);
    if (F.tid < 16) MISC[F.tid] = 0u;
    if (F.tid < 26) { const unsigned long long v = F.tid < 24 ? (unsigned long long)KP.in[F.tid] : (F.tid == 24 ? (unsigned long long)KP.out : (unsigned long long)KP.ws);
        ((LAS unsigned long long*)(F.lds + LDS_MISC + 64))[F.tid] = v; }
    if ((threadIdx.x & 63) == 0) ((LAS unsigned*)(F.lds + LDS_MISC + 512))[(unsigned)__builtin_amdgcn_s_getreg(0x2804) & 63u] = threadIdx.x >> 6;
    __syncthreads();
    const int lo = KP.ph_lo, hi = KP.ph_hi;
    const bool multi = (hi - lo) > 1;
    XcdBarrier bar; bar.bar = (unsigned*)(KP.ws + WS_CTL); bar.x = 0; bar.st = nullptr;
    if (multi) bar = xcd_barrier_post((unsigned*)(KP.ws + WS_CTL), MISC);
#ifndef PHMASK
#define PHMASK 0xFFFFFu
#endif
#define IN(k) ((((PHMASK) >> (k)) & 1u) && lo <= (k) && (k) < hi)
#define SEAM(k) do { if (IN(k) && IN((k) + 1)) xcd_barrier(bar); } while (0)
#ifndef PROBE_DUP
#define PROBE_DUP 0u
#endif
#define RUN(k, call) do { if (IN(k)) { Frame F; { int t_ = my_tid(); asm volatile("" : "+v"(t_)); F.lds = (LAS unsigned char*)lds_raw; F.tid = t_; F.lane = t_ & 63; \
        F.wave = __builtin_amdgcn_readfirstlane(t_ >> 6); F.G = gridDim.x; F.bid = blockIdx.x; } \
        call; if (((PROBE_DUP) >> (k)) & 1u) { xcd_barrier(bar); call; } } SEAM(k); } while (0)
#ifdef PROBE_UB
    RUN(PH_PRO, phase_ubench(F));
#endif
    RUN(PH_PRO, phase_prologue(F));
    RUN(PH_L0_NORM1, phase_norm1_l0(F));
#ifdef PROBE_RND
    if (PROBE_RND & 1) { RUN(PH_L0_WIN, phase_rnd(F, WS_HB, (size_t)NROW * DM * 2)); if (IN(PH_L0_WIN)) xcd_barrier(bar); }
#endif
    RUN(PH_L0_WIN, phase_gemm_win(F));
    RUN(PH_L0_PREUP, phase_preup(F));
#ifdef PROBE_RND
    if (PROBE_RND & 16) { RUN(PH_L0_UP, phase_rnd(F, WS_QN, (size_t)NROW * 384 * 2)); if (IN(PH_L0_UP)) xcd_barrier(bar); }
#endif
    RUN(PH_L0_UP, phase_gemm_up(F));
    RUN(PH_L0_ATTN, phase_attn_mla(F));
#ifdef PROBE_ATT_ABL
    RUN(PH_L0_ATTN, phase_attn_probe(F)); if (IN(PH_L0_ATTN)) xcd_barrier(bar);
#endif
#ifdef PROBE_RND
    if (PROBE_RND & 2) { RUN(PH_L0_WOUT, phase_rnd(F, WS_CAT, (size_t)NROW * DM * 2)); if (IN(PH_L0_WOUT)) xcd_barrier(bar); }
#endif
    RUN(PH_L0_WOUT, phase_gemm_wout(F, 0));
    RUN(PH_L0_NORM2, phase_norm2(F, 0));
    RUN(PH_L0_TOPK, phase_topk(F, 0));
    RUN(PH_L0_GU, phase_gemm_gu(F, 0));
    RUN(PH_L0_DOWN, phase_gemm_down(F, 0));
    RUN(PH_L0_COMB, phase_combine(F, 0));
#ifdef PROBE_COMB
    if (IN(PH_L0_COMB)) { Frame F; F.lds = (LAS unsigned char*)lds_raw; F.tid = my_tid(); F.lane = F.tid & 63; F.wave = __builtin_amdgcn_readfirstlane(F.tid >> 6); F.G = gridDim.x; F.bid = blockIdx.x; phase_combine<true>(F, PROBE_COMB); xcd_barrier(bar); }
#endif
#ifdef PROBE_RND
    if (PROBE_RND & 4) { RUN(PH_L1_QKV, phase_rnd(F, WS_HB, (size_t)NROW * DM * 2)); if (IN(PH_L1_QKV)) xcd_barrier(bar); }
#endif
    RUN(PH_L1_QKV, phase_gemm_qkv2(F));
#ifdef PROBE_RND
    if (PROBE_RND & 32) { RUN(PH_L1_ATTN, phase_rnd(F, WS_QKV + OFF_Q2, OFF_V2 + (size_t)NB * 4 * NKEY * 64 * 2 - OFF_Q2)); if (IN(PH_L1_ATTN)) xcd_barrier(bar); }
#endif
    RUN(PH_L1_ATTN, phase_attn_swa(F));
#ifdef PROBE_RND
    if (PROBE_RND & 8) { RUN(PH_L1_WOUT, phase_rnd(F, WS_CAT, (size_t)NLAT * DM * 2)); if (IN(PH_L1_WOUT)) xcd_barrier(bar); }
#endif
    RUN(PH_L1_WOUT, phase_gemm_wout(F, 1));
    RUN(PH_L1_NORM2, phase_norm2(F, 1));
    RUN(PH_L1_TOPK, phase_topk(F, 1));
    RUN(PH_L1_GU, phase_gemm_gu(F, 1));
    RUN(PH_L1_DOWN, phase_gemm_down(F, 1));
    RUN(PH_L1_COMB, phase_combine(F, 1));
#undef IN
#undef SEAM
#undef RUN
}

static void launch_phase(hipStream_t s, int grid, const Params& base, int lo, int hi) {
  Params p = base; p.ph_lo = lo; p.ph_hi = hi;
  hipLaunchKernelGGL(mk_fwd, dim3(grid), dim3(NTHREADS), LDS_BYTES, s, p);
}

extern "C" void kernel_launch(void* const* d_in, const int* in_sizes, int n_in, void* d_out, int out_size, void* d_ws, size_t ws_size, hipStream_t stream) {
  static int grid = 0;
  if (grid == 0) {
    if (n_in != 24 || ws_size < WS_END || out_size != NLAT * DM) { fprintf(stderr, "kernel_launch: bad sizes n_in %d ws %zu (need %zu) out %d\n", n_in, ws_size, (size_t)WS_END, out_size); grid = -1; return; }
    int dev = 0, cus = 0;
    if (hipGetDevice(&dev) != hipSuccess || hipDeviceGetAttribute(&cus, hipDeviceAttributeMultiprocessorCount, dev) != hipSuccess) { grid = -1; return; }
    if (hipFuncSetAttribute((const void*)mk_fwd, hipFuncAttributeMaxDynamicSharedMemorySize, LDS_BYTES) != hipSuccess) { fprintf(stderr, "kernel_launch: hipFuncSetAttribute failed\n"); grid = -1; return; }
    int per_cu = 0;
    if (hipOccupancyMaxActiveBlocksPerMultiprocessor(&per_cu, (const void*)mk_fwd, NTHREADS, LDS_BYTES) != hipSuccess || per_cu < 1) { fprintf(stderr, "kernel_launch: occupancy query says %d\n", per_cu); grid = -1; return; }
    grid = cus;
  }
  if (grid < 0) return;
  Params P{};
  for (int i = 0; i < 24; ++i) P.in[i] = (const float*)d_in[i];
  P.out = (float*)d_out; P.ws = (unsigned char*)d_ws; P.ph_lo = 0; P.ph_hi = 0;
  if (hipMemsetAsync((char*)d_ws + WS_CTL, 0, CTL_BYTES, stream) != hipSuccess) return;
#ifdef MK_PER_PHASE
  for (int ph = 0; ph < PH_COUNT; ++ph) launch_phase(stream, grid, P, ph, ph + 1);
#else
  launch_phase(stream, grid, P, 0, PH_COUNT);
#endif
}
```

```cpp
#include <hip/hip_runtime.h>
#include <hip/hip_bf16.h>
#include <cstdio>
#include <cstdint>

typedef unsigned short bf16_t;

constexpr int NB = 2, SEQ = 16384, DM = 1024, CTX = 256;
constexpr int NLAT = NB * SEQ;
constexpr int NCTX = NB * CTX;
constexpr int NROW = NLAT + NCTX;
constexpr int NKEY = CTX + SEQ;
constexpr int AB_IN = 1952, PPITCH = 2048;
constexpr int NE = 16, CAP_L = 2048, CAP_C = 32, DFF = 1024;
constexpr int NMOD = 6 * DM;
constexpr float EPS = 1e-6f;
constexpr float LOG2E = 1.4426950408889634f;
constexpr float QF8_SCALE = 16.f;

constexpr size_t al256(size_t x) { return (x + 255) / 256 * 256; }
constexpr size_t CTL_BYTES = 65536;
constexpr size_t WS_CTL  = 0;
constexpr size_t WS_MODV = WS_CTL + CTL_BYTES;
constexpr size_t WS_ROPE = WS_MODV + al256(2 * 3 * NMOD * 4);
constexpr size_t WS_XC   = WS_ROPE + al256(256 * 48 * 4);
constexpr size_t WS_AFF  = WS_XC + al256((size_t)NCTX * DM * 4);
constexpr size_t WS_SIDX = WS_AFF + al256((size_t)(NB * NE * SEQ + NB * NE * CTX) * 4);
constexpr size_t WS_SG   = WS_SIDX + al256((size_t)(NB * NE * CAP_L + NB * NE * CAP_C) * 4);
constexpr size_t WS_SLOT = WS_SG + al256((size_t)(NB * NE * CAP_L + NB * NE * CAP_C) * 4);
constexpr size_t WS_HB   = WS_SLOT + al256((size_t)(NB * NE * SEQ + NB * NE * CTX) * 4);
constexpr size_t MOE_ROWS = (size_t)NB * NE * CAP_L + NB * NE * CAP_C;
constexpr size_t WS_PB   = WS_HB + al256((size_t)NROW * DM * 2);
constexpr size_t WS_QN   = WS_PB + al256(MOE_ROWS * DM * 2 + (1u << 20));
constexpr size_t WS_KVN  = WS_QN + al256((size_t)NROW * 256 * 2);
constexpr size_t WS_QKV  = WS_KVN + al256((size_t)NROW * 128 * 2);
constexpr size_t QKV_BYTES = MOE_ROWS * DM * 2;
constexpr size_t WS_W    = WS_QKV + al256(QKV_BYTES);
constexpr size_t WS_CAT  = WS_HB;
constexpr size_t OFF_WIN = 0;
constexpr size_t OFF_WUP = OFF_WIN + (size_t)2048 * 1024 * 2;
constexpr size_t OFF_WOUT = OFF_WUP + al256((size_t)1792 * 384 * 2);
constexpr size_t OFF_WQKV = OFF_WOUT + (size_t)1024 * 1024 * 2;
constexpr size_t OFF_WSO = OFF_WQKV + (size_t)1536 * 1024 * 2;
constexpr size_t OFF_WGU = OFF_WSO + (size_t)1024 * 1024 * 2;
constexpr size_t OFF_WD  = OFF_WGU + (size_t)16 * 2048 * 1024;
constexpr size_t OFF_WQKV8 = OFF_WD + (size_t)16 * 1024 * 1024;
constexpr size_t WS_XSB  = WS_W + OFF_WQKV8 + (size_t)1536 * 1024;
constexpr size_t WS_END  = WS_XSB + (size_t)NLAT * DM * 2;
constexpr size_t OFF_Q  = 0;
constexpr size_t OFF_QC = OFF_Q + (size_t)NB * 8 * SEQ * 96 * 2;
constexpr size_t OFF_K  = OFF_QC + (size_t)NB * 8 * CTX * 96 * 2;
constexpr size_t OFF_V  = OFF_K + (size_t)NB * 8 * NKEY * 96 * 2;
static_assert(OFF_V + (size_t)NB * 8 * NKEY * 64 * 2 <= QKV_BYTES, "qkv region");
constexpr size_t OFF_Q2 = 0;
constexpr size_t OFF_K2 = OFF_Q2 + (size_t)NB * 16 * SEQ * 64 * 2;
constexpr size_t OFF_V2 = OFF_K2 + (size_t)NB * 4 * NKEY * 64 * 2;
static_assert(OFF_V2 + (size_t)NB * 4 * NKEY * 64 * 2 <= QKV_BYTES, "qkv2 region");

__device__ __forceinline__ float bf2f(bf16_t v) { return __uint_as_float(((unsigned)v) << 16); }
__device__ __forceinline__ bf16_t f2bf(float f) { unsigned u = __float_as_uint(f); u += 0x7FFFu + ((u >> 16) & 1u); return (bf16_t)(u >> 16); }
__device__ __forceinline__ float silu_f(float x) { return x * __builtin_amdgcn_rcpf(1.f + __builtin_amdgcn_exp2f(x * -1.44269504088896f)); }

__device__ __forceinline__ float block_sum(float v, float* red) {
  for (int d = 32; d > 0; d >>= 1) v += __shfl_xor(v, d, 64);
  __syncthreads();
  if ((threadIdx.x & 63) == 0) red[threadIdx.x >> 6] = v;
  __syncthreads();
  float s = 0.f;
  for (int i = 0; i < (int)(blockDim.x >> 6); ++i) s += red[i];
  return s;
}

#define LAS __attribute__((address_space(3)))
typedef short bf16x8 __attribute__((ext_vector_type(8)));
typedef float f32x4 __attribute__((ext_vector_type(4)));
typedef unsigned u32x4 __attribute__((ext_vector_type(4)));
typedef unsigned u32x2 __attribute__((ext_vector_type(2)));

constexpr int NTHREADS = 512;
constexpr int RING_BYTES = 131072;
constexpr int LDS_MISC = RING_BYTES;
constexpr int LDS_BYTES = RING_BYTES + 1024;
__device__ __forceinline__ int my_tid() {
    extern __shared__ __attribute__((aligned(16))) unsigned char lds_raw[];
    const unsigned key = (unsigned)__builtin_amdgcn_s_getreg(0x2804) & 63u;
    const int w = __builtin_amdgcn_readfirstlane((int)((const LAS unsigned*)((LAS unsigned char*)lds_raw + LDS_MISC + 512))[key]);
    return w * 64 + (int)__builtin_amdgcn_mbcnt_hi(~0u, __builtin_amdgcn_mbcnt_lo(~0u, 0u));
}

struct Params { const float* in[24]; float* out; unsigned char* ws; int ph_lo, ph_hi; };

__device__ __forceinline__ unsigned pk4fp8(float a, float b, float c, float d) { unsigned r;
  asm("v_cvt_pk_fp8_f32 %0, %1, %2" : "=v"(r) : "v"(a), "v"(b)); asm("v_cvt_pk_fp8_f32 %0, %1, %2 op_sel:[0,0,1]" : "+v"(r) : "v"(c), "v"(d)); return r; }
__device__ __forceinline__ unsigned char f2fp8(float x) { return (unsigned char)((unsigned)__builtin_amdgcn_cvt_pk_fp8_f32(x, 0.f, 0, false) & 0xffu); }
__device__ __forceinline__ unsigned pk2bf(float lo, float hi) { return (unsigned)f2bf(lo) | ((unsigned)f2bf(hi) << 16); }
#if defined(PROBE_FP8ATT) || defined(PROBE_RND)
__device__ __forceinline__ float fp8rt(float x, float sc) { const unsigned r = (unsigned)__builtin_amdgcn_cvt_pk_fp8_f32(x * sc, 0.f, 0, false); return __builtin_amdgcn_cvt_f32_fp8((int)r, 0) * (1.f / sc); }
#endif

#define XB_TMO      128
#define XB_XCNT(j)  (256  + 64 * (j))
#define XB_XSUB(j)  (1280 + 64 * (j))
#define XB_XGEN(j)  (2304 + 64 * (j))
#define XB_TOP      3328
#define XB_TOPGEN   3392
#define XCD_BAR_WORDS 3456
#define XB_SPIN_CAP (1u << 18)
__device__ __forceinline__ unsigned xb_ld(unsigned* p)              { return __hip_atomic_load(p, __ATOMIC_RELAXED, __HIP_MEMORY_SCOPE_AGENT); }
__device__ __forceinline__ unsigned xb_add(unsigned* p, unsigned v) { return __hip_atomic_fetch_add(p, v, __ATOMIC_RELAXED, __HIP_MEMORY_SCOPE_AGENT); }
__device__ __forceinline__ unsigned xb_xcc_id() { return (unsigned)__builtin_amdgcn_s_getreg((3 << 11) | 20) & 0xFu; }
#define XB_SPIN(cond, bar) do { unsigned _sp = 0; while (cond) { __builtin_amdgcn_s_sleep(1); \
    if ((++_sp & 255u) == 0u) { if (xb_ld(&(bar)[XB_TMO])) break; if (_sp > XB_SPIN_CAP) { atomicAdd(&(bar)[XB_TMO], 1u); break; } } } } while (0)
struct XcdBarrier { unsigned* bar; unsigned x; volatile LAS unsigned* st; };
__device__ __forceinline__ XcdBarrier xcd_barrier_post(unsigned* bar, volatile LAS unsigned* st) {
    XcdBarrier b; b.bar = bar; b.x = xb_xcc_id(); b.st = st;
    if (my_tid() == 0) (void)xb_add(&bar[XB_XCNT(b.x)], 1u);
    return b;
}
__device__ __forceinline__ void xcd_barrier_complete(unsigned* bar, unsigned x, unsigned& nloc, unsigned& nx) {
    const unsigned G = gridDim.x * gridDim.y * gridDim.z;
    unsigned sum, cnt, mine, sp = 0u;
    for (;;) {
        sum = 0u; cnt = 0u; mine = 0u;
#pragma unroll
        for (unsigned j = 0; j < 16; ++j) { const unsigned c = xb_ld(&bar[XB_XCNT(j)]); sum += c; cnt += (c > 0u) ? 1u : 0u; mine = (j == x) ? c : mine; }
        if (sum == G) break;
        __builtin_amdgcn_s_sleep(1);
        if ((++sp & 255u) == 0u) { if (xb_ld(&bar[XB_TMO])) break; if (sp > XB_SPIN_CAP) { atomicAdd(&bar[XB_TMO], 1u); break; } }
    }
    nloc = mine > 0u ? mine : 1u; nx = cnt > 0u ? cnt : 1u;
}
__device__ __forceinline__ void xcd_barrier(const XcdBarrier& b) {
    asm volatile("s_waitcnt vmcnt(0)" ::: "memory");
    __syncthreads();
    if (my_tid() == 0) {
        unsigned* bar = b.bar;
        __builtin_amdgcn_s_waitcnt(0);
        unsigned nloc = b.st[0], nx = b.st[1];
        if (nloc == 0u) { xcd_barrier_complete(bar, b.x, nloc, nx); b.st[0] = nloc; b.st[1] = nx; }
        const unsigned old = xb_add(&bar[XB_XSUB(b.x)], 1u);
        const unsigned gen = old / nloc;
        if (old + 1u == (gen + 1u) * nloc) {
            __builtin_amdgcn_fence(__ATOMIC_RELEASE, "agent");
            asm volatile("s_waitcnt vmcnt(0)" ::: "memory");
            const unsigned og = xb_add(&bar[XB_TOP], 1u);
            const unsigned tg = og / nx;
            if (og + 1u == (tg + 1u) * nx) xb_add(&bar[XB_TOPGEN], 1u);
            else XB_SPIN(xb_ld(&bar[XB_TOPGEN]) == tg, bar);
            __builtin_amdgcn_fence(__ATOMIC_ACQUIRE, "agent");
            xb_add(&bar[XB_XGEN(b.x)], 1u);
            asm volatile("s_waitcnt vmcnt(0)" ::: "memory");
        } else {
            XB_SPIN(xb_ld(&bar[XB_XGEN(b.x)]) == gen, bar);
            __builtin_amdgcn_fence(__ATOMIC_ACQUIRE, "agent");
            asm volatile("s_waitcnt vmcnt(0)" ::: "memory");
        }
    }
    __syncthreads();
}

namespace pg8 {
constexpr int BM = 256, BK = 64, HALF = 128, HTB = HALF * BK * 2, STAGE_BYTES = 8 * HTB, NXCD = 8, WGM = 8;
__host__ __device__ __forceinline__ int lds_byte(int r, int c) { const int st = (r >> 4) * 2 + (c >> 5), rr = r & 15, cc = c & 31, ob = rr * 64 + cc * 2; return st * 1024 + (ob ^ (((ob >> 9) & 1) << 5)); }
__host__ __device__ __forceinline__ void stage_rc(int b, int& R, int& C) { const int st = b / 1024, sb = b % 1024, swz = sb ^ (((sb >> 9) & 1) << 5); R = (st >> 1) * 16 + swz / 64; C = (st & 1) * 32 + (swz % 64) / 2; }
__host__ __device__ __forceinline__ int perm32(int rho) { const int n = rho >> 4, i = rho & 15; return 8 * (i >> 2) + 4 * n + (i & 3); }
struct Unit { int pm, pn, grp; };

template <int EB_, int ASC_ = 0x7F7F7F7F>
struct SchedPlainT {
    static constexpr int EB = EB_, NBJ = 2, WSCALE = EB_ == 1 ? 0x7A7A7A7A : 0x7F7F7F7F, ASCALE = ASC_;
    int nM, nN, nwg, G, c; const char* Bt; int K;
    __device__ __forceinline__ void init(int M, int N, int K_, const bf16_t* Bt_, int G_, int c_) { nM = M / BM; nN = N / BM; nwg = nM * nN; G = G_; c = c_; Bt = (const char*)Bt_; K = K_; }
    __device__ __forceinline__ bool next(int i, Unit& u) const {
        const long L = (long)i * G + c; if (L >= nwg) return false;
        int wgid = (int)L; { const int q = nwg / NXCD, r = nwg % NXCD, xcd = wgid % NXCD, off = wgid / NXCD; wgid = (xcd < r ? xcd * (q + 1) : r * (q + 1) + (xcd - r) * q) + off; }
        const int nig = WGM * nN, gid = wgid / nig, fm = gid * WGM, gsz = (nM - fm) < WGM ? (nM - fm) : WGM;
        u.pm = fm + ((wgid % nig) % gsz); u.pn = (wgid % nig) / gsz; u.grp = 0; return true;
    }
    __device__ __forceinline__ int a_row(const Unit& u, int r) const { return u.pm * BM + r; }
    __device__ __forceinline__ const char* b_ptr(const Unit& u) const { return Bt + (size_t)u.pn * BM * K * EB; }
};
using SchedPlain = SchedPlainT<2>;

#define PG8_SA(b, h) (((b) * 2 + (h)) * HTB)
#define PG8_SB(b, h) ((4 + (b) * 2 + (h)) * HTB)
#ifdef PROBE_FAKEK
#define PG8_FK_B(x) (stage_on ? (x) : Abase)
#define PG8_FK_V(x) (stage_on ? (x) : 0u)
#else
#define PG8_FK_B(x) (x)
#define PG8_FK_V(x) (x)
#endif
#define PG8_STAGE(bufoff, gbase, voff) do { const char* gb_ = PG8_FK_B((const char*)(gbase)); asm volatile("" : "+s"(gb_)); _Pragma("unroll") for (int _i = 0; _i < 2; ++_i) { unsigned vo_ = PG8_FK_V((voff)[_i]); asm volatile("" : "+v"(vo_)); \
        __builtin_amdgcn_global_load_lds((const unsigned*)(gb_ + vo_), (LAS unsigned*)(lds + (bufoff) + ldsw + _i * 8192), 16, 0, 0); } } while (0)
#define PG8_LDA(dst, b, h) do { _Pragma("unroll") for (int m = 0; m < 4; ++m) { \
        if constexpr (EB == 1) dst##8[m] = cat32(*(const LAS bf16x8*)(lds + PG8_SA(b, h) + aoff + m * 2048), *(const LAS bf16x8*)(lds + PG8_SA(b, h) + aoff + m * 2048 + 1024)); \
        else { _Pragma("unroll") for (int k = 0; k < 2; ++k) dst[m][k] = *(const LAS bf16x8*)(lds + PG8_SA(b, h) + aoff + m * 2048 + k * 1024); } } } while (0)
#define PG8_LDB(dst, b, h) do { _Pragma("unroll") for (int n = 0; n < 2; ++n) { \
        if constexpr (EB == 1) dst##8[n] = cat32(*(const LAS bf16x8*)(lds + PG8_SB(b, h) + boff + n * 2048), *(const LAS bf16x8*)(lds + PG8_SB(b, h) + boff + n * 2048 + 1024)); \
        else { _Pragma("unroll") for (int k = 0; k < 2; ++k) dst[n][k] = *(const LAS bf16x8*)(lds + PG8_SB(b, h) + boff + n * 2048 + k * 1024); } } } while (0)
typedef float f32x16 __attribute__((ext_vector_type(16)));
__device__ __forceinline__ f32x4 get4(const f32x16& v, int k) { return (f32x4){v[4 * k], v[4 * k + 1], v[4 * k + 2], v[4 * k + 3]}; }
__device__ __forceinline__ void set4(f32x16& v, int k, f32x4 x) { v[4 * k] = x[0]; v[4 * k + 1] = x[1]; v[4 * k + 2] = x[2]; v[4 * k + 3] = x[3]; }
typedef int v8i32 __attribute__((ext_vector_type(8)));
typedef int v4i32 __attribute__((ext_vector_type(4)));
__device__ __forceinline__ v8i32 cat32(bf16x8 lo, bf16x8 hi) { const v4i32 a = __builtin_bit_cast(v4i32, lo), b = __builtin_bit_cast(v4i32, hi); return __builtin_shufflevector(a, b, 0, 1, 2, 3, 4, 5, 6, 7); }
#define PG8_MMA(ai, bj, At, Bt) do { __builtin_amdgcn_s_setprio(1); _Pragma("unroll") for (int m = 0; m < 4; ++m) _Pragma("unroll") for (int n = 0; n < 2; ++n) { \
        if constexpr (EB == 1) { if constexpr (ACC16) set4(accT[ai][bj][m >> 1], (m & 1) * 2 + n, __builtin_amdgcn_mfma_scale_f32_16x16x128_f8f6f4(Bt##8[n], At##8[m], get4(accT[ai][bj][m >> 1], (m & 1) * 2 + n), 0, 0, 0, Sched::WSCALE, 0, Sched::ASCALE)); \
            else acc[ai][bj][m][n] = __builtin_amdgcn_mfma_scale_f32_16x16x128_f8f6f4(Bt##8[n], At##8[m], acc[ai][bj][m][n], 0, 0, 0, Sched::WSCALE, 0, Sched::ASCALE); } \
        else { _Pragma("unroll") for (int k = 0; k < 2; ++k) acc[ai][bj][m][n] = __builtin_amdgcn_mfma_f32_16x16x32_bf16(Bt[n][k], At[m][k], acc[ai][bj][m][n], 0, 0, 0); } } \
        __builtin_amdgcn_s_setprio(0); } while (0)
#define PG8_WAIT_V(n) asm volatile("s_waitcnt vmcnt(" #n ")" ::: "memory")
#define PG8_WAIT_K do { if constexpr (NBJ == 2) asm volatile("s_waitcnt vmcnt(8)" ::: "memory"); else asm volatile("s_waitcnt vmcnt(6)" ::: "memory"); } while (0)
#define PG8_WAIT_L(n) asm volatile("s_waitcnt lgkmcnt(" #n ")" ::: "memory")
#define PG8_BAR __builtin_amdgcn_s_barrier()
#define PG8_SCHED __builtin_amdgcn_sched_barrier(0)

template <class Epi, class Sched, bool ALIGN_EPI>
__device__ __forceinline__ void gemm_phase(LAS unsigned char* lds, const char* Abase, const int K, const Sched& S, const Epi& E) {
    const int tid = my_tid(), wid = __builtin_amdgcn_readfirstlane(tid >> 6), lane = tid & 63, wr = wid >> 2, wc = wid & 3, fr = lane & 15, fq = lane >> 4;
    constexpr int EB = Sched::EB, NBJ = Sched::NBJ; constexpr bool ACC16 = (EB == 1 && NBJ == 2);
    const int nt = K * EB / 128;
    unsigned voffB[2];
#pragma unroll
    for (int i = 0; i < 2; ++i) { int R, C; stage_rc(tid * 16 + i * 8192, R, C); const int Rb = Epi::PERM ? ((R & ~31) + perm32(R & 31)) : R; voffB[i] = (unsigned)(Rb * K * EB + C * 2); }
#define PG8_AOFF(dst, unit) do { int l_ = (int)__builtin_amdgcn_mbcnt_hi(~0u, __builtin_amdgcn_mbcnt_lo(~0u, 0u)); asm volatile("" : "+v"(l_)); const int tid_ = wid * 64 + l_; _Pragma("unroll") for (int h = 0; h < 2; ++h) _Pragma("unroll") for (int i = 0; i < 2; ++i) { int R_, C_; stage_rc(tid_ * 16 + i * 8192, R_, C_); \
        dst[h][i] = (unsigned)S.a_row(unit, h * HALF + R_) * (unsigned)(K * EB) + (unsigned)(C_ * 2); } } while (0)
    const size_t kstep = 128;
    const size_t hstep = (size_t)HALF * K * EB;
    const unsigned ldsw = (unsigned)wid * 1024u;
    const int aoff = lds_byte(wr * 64 + fr, fq * 8), boff = lds_byte(wc * 32 + fr, fq * 8);
    Unit cur, nxt; int ui = 0;
#ifdef PROBE_FAKEK
    bool stage_on = true;
#endif
    if (!S.next(0, cur)) return;
#ifdef PROBE_FAKEK
#define PG8_UIX(i) (((PROBE_FAKEK >> (EB == 1 ? 0 : 1)) & 1) ? (i) >> 1 : (i))
#else
#define PG8_UIX(i) (i)
#endif
    f32x4 acc[2][NBJ][4][2];
#pragma unroll
    for (int a = 0; a < 2; ++a)
#pragma unroll
        for (int b = 0; b < NBJ; ++b)
#pragma unroll
            for (int m = 0; m < 4; ++m)
#pragma unroll
                for (int n = 0; n < 2; ++n) acc[a][b][m][n] = (f32x4){0.f, 0.f, 0.f, 0.f};
    f32x16 accT[2][NBJ][2];
#pragma unroll
    for (int a = 0; a < 2; ++a)
#pragma unroll
        for (int b = 0; b < NBJ; ++b)
#pragma unroll
            for (int m = 0; m < 2; ++m)
#pragma unroll
                for (int j = 0; j < 16; ++j) accT[a][b][m][j] = 0.f;
    bf16x8 At[4][2], B0[2][2], B1[2][2];
    v8i32 At8[4], B08[2], B18[2];
    unsigned offc[2][2], offn[2][2];
    PG8_AOFF(offc, cur);
    const char* cB = S.b_ptr(cur);
    PG8_STAGE(PG8_SB(0, 0), cB, voffB); if constexpr (NBJ == 2) PG8_STAGE(PG8_SB(0, 1), cB + hstep, voffB); PG8_STAGE(PG8_SA(0, 0), Abase, offc[0]); PG8_STAGE(PG8_SA(0, 1), Abase, offc[1]);
    if (wr == 1) PG8_BAR;
    PG8_WAIT_V(2); PG8_BAR;
    PG8_STAGE(PG8_SB(1, 0), cB + kstep, voffB); PG8_STAGE(PG8_SA(1, 0), Abase + kstep, offc[0]); if constexpr (NBJ == 2) PG8_STAGE(PG8_SB(1, 1), cB + hstep + kstep, voffB);
    if constexpr (NBJ == 2) PG8_WAIT_V(6); else PG8_WAIT_V(4);
    PG8_BAR;
    for (;;) {
        const bool has_next = S.next(PG8_UIX(ui + 1), nxt);
        const char* nB = cB;
        if (has_next) {
            nB = S.b_ptr(nxt);
            PG8_AOFF(offn, nxt);
        } else {
#pragma unroll
            for (int h = 0; h < 2; ++h)
#pragma unroll
                for (int i = 0; i < 2; ++i) offn[h][i] = offc[h][i];
        }
#pragma unroll 1
        for (int t = 0; t < nt; t += 2) {
            const bool last = (t == nt - 2);
#ifdef PROBE_FAKEK
            stage_on = !((PROBE_FAKEK >> (EB == 1 ? 0 : 1)) & 1) || !(ui & 1) || last;
#endif
            const char* kp1 = Abase + (size_t)(t + 1) * kstep;
            const char* kp2 = last ? Abase : Abase + (size_t)(t + 2) * kstep; const char* b2 = last ? nB : cB + (size_t)(t + 2) * kstep;
            const char* kp3 = kp2 + kstep; const char* b3 = b2 + kstep;
            unsigned o2[2][2];
#pragma unroll
            for (int h = 0; h < 2; ++h)
#pragma unroll
                for (int i = 0; i < 2; ++i) o2[h][i] = last ? offn[h][i] : offc[h][i];
            PG8_LDB(B0, 0, 0); if constexpr (NBJ == 2) PG8_LDB(B1, 0, 1); PG8_SCHED; PG8_LDA(At, 0, 0); PG8_STAGE(PG8_SA(1, 1), kp1, offc[1]);
            PG8_WAIT_K; PG8_WAIT_L(0); PG8_BAR; PG8_MMA(0, 0, At, B0); if constexpr (NBJ == 2) PG8_MMA(0, 1, At, B1); PG8_BAR; PG8_SCHED;
            PG8_LDA(At, 0, 1); PG8_STAGE(PG8_SB(0, 0), b2, voffB); if constexpr (NBJ == 2) PG8_STAGE(PG8_SB(0, 1), b2 + hstep, voffB); PG8_STAGE(PG8_SA(0, 0), kp2, o2[0]);
            PG8_WAIT_K; PG8_WAIT_L(0); PG8_BAR; PG8_MMA(1, 0, At, B0); if constexpr (NBJ == 2) PG8_MMA(1, 1, At, B1); PG8_BAR; PG8_SCHED;
            PG8_LDB(B0, 1, 0); if constexpr (NBJ == 2) PG8_LDB(B1, 1, 1); PG8_SCHED; PG8_LDA(At, 1, 0); PG8_STAGE(PG8_SA(0, 1), kp2, o2[1]);
            PG8_WAIT_K; PG8_WAIT_L(0); PG8_BAR; PG8_MMA(0, 0, At, B0); if constexpr (NBJ == 2) PG8_MMA(0, 1, At, B1); PG8_BAR; PG8_SCHED;
            PG8_LDA(At, 1, 1); PG8_STAGE(PG8_SB(1, 0), b3, voffB); if constexpr (NBJ == 2) PG8_STAGE(PG8_SB(1, 1), b3 + hstep, voffB); PG8_STAGE(PG8_SA(1, 0), kp3, o2[0]);
            PG8_WAIT_K; PG8_WAIT_L(0); PG8_BAR; PG8_MMA(1, 0, At, B0); if constexpr (NBJ == 2) PG8_MMA(1, 1, At, B1); PG8_BAR; PG8_SCHED;
        }
        if constexpr (ALIGN_EPI) { if (wr == 0) PG8_BAR; }
        if constexpr (ACC16) {
#pragma unroll
            for (int a = 0; a < 2; ++a)
#pragma unroll
                for (int b = 0; b < NBJ; ++b)
#pragma unroll
                    for (int m = 0; m < 4; ++m)
#pragma unroll
                        for (int n = 0; n < 2; ++n) acc[a][b][m][n] = get4(accT[a][b][m >> 1], (m & 1) * 2 + n);
        }
#ifdef PROBE_FAKEK
        if (!(((PROBE_FAKEK >> (EB == 1 ? 0 : 1)) & 1) && (ui & 1)))
#endif
        { int l2 = (int)__builtin_amdgcn_mbcnt_hi(~0u, __builtin_amdgcn_mbcnt_lo(~0u, 0u)); asm volatile("" : "+v"(l2)); E(acc, cur, wr, wc, l2 & 15, l2 >> 4); }
#ifdef PROBE_EPI2
        if constexpr (((PROBE_EPI2 >> (EB == 1 ? 0 : 1)) & 1) != 0) { int l2 = (int)__builtin_amdgcn_mbcnt_hi(~0u, __builtin_amdgcn_mbcnt_lo(~0u, 0u)); asm volatile("" : "+v"(l2)); E(acc, cur, wr, wc, l2 & 15, l2 >> 4); }
#endif
        if (!has_next) break;
#pragma unroll
        for (int a = 0; a < 2; ++a)
#pragma unroll
            for (int b = 0; b < NBJ; ++b)
#pragma unroll
                for (int m = 0; m < 4; ++m)
#pragma unroll
                    for (int n = 0; n < 2; ++n) acc[a][b][m][n] = (f32x4){0.f, 0.f, 0.f, 0.f};
#pragma unroll
        for (int a = 0; a < 2; ++a)
#pragma unroll
            for (int b = 0; b < NBJ; ++b)
#pragma unroll
                for (int m = 0; m < 2; ++m)
#pragma unroll
                    for (int j = 0; j < 16; ++j) accT[a][b][m][j] = 0.f;
        cur = nxt; cB = nB; ++ui;
#pragma unroll
        for (int h = 0; h < 2; ++h)
#pragma unroll
            for (int i = 0; i < 2; ++i) offc[h][i] = offn[h][i];
        if constexpr (ALIGN_EPI) { if (wr == 1) PG8_BAR; }
    }
    PG8_WAIT_V(0);
    if constexpr (!ALIGN_EPI) { if (wr == 0) PG8_BAR; }
    PG8_BAR;
}
#undef PG8_AOFF
#undef PG8_SA
#undef PG8_SB
#undef PG8_STAGE
#undef PG8_LDA
#undef PG8_LDB
#undef PG8_MMA
#undef PG8_WAIT_V
#undef PG8_WAIT_L
#undef PG8_WAIT_K
#undef PG8_BAR
#undef PG8_SCHED
}

struct EpiStore {
    static constexpr bool PERM = true;
    bf16_t* out; int ld;
    __device__ __forceinline__ void operator()(const f32x4 (&acc)[2][2][4][2], const pg8::Unit& u, int wr, int wc, int fr, int fq) const {
        const int row0 = u.pm * 256 + wr * 64 + fr, col0 = u.pn * 256 + wc * 32 + 8 * fq;
#pragma unroll
        for (int ai = 0; ai < 2; ++ai)
#pragma unroll
            for (int m = 0; m < 4; ++m) { bf16_t* rowp = out + (size_t)(row0 + ai * 128 + m * 16) * ld + col0;
#pragma unroll
                for (int bj = 0; bj < 2; ++bj) { const f32x4 v0 = acc[ai][bj][m][0], v1 = acc[ai][bj][m][1];
                    u32x4 w; w.x = pk2bf(v0[0], v0[1]); w.y = pk2bf(v0[2], v0[3]); w.z = pk2bf(v1[0], v1[1]); w.w = pk2bf(v1[2], v1[3]);
                    *(u32x4*)(rowp + bj * 128) = w; } }
    }
};
template <bool XIN_F32>
struct EpiResidB {
    static constexpr bool PERM = true;
    const float* xin_f; bf16_t* xs; const float* modl; int g_off;
    __device__ __forceinline__ void operator()(const f32x4 (&acc)[2][2][4][2], const pg8::Unit& u, int wr, int wc, int fr, int fq) const {
        const int row0 = u.pm * 256 + wr * 64 + fr;
        const float* gp = modl + ((u.pm * 256) / SEQ) * NMOD + g_off;
#pragma unroll
        for (int bj = 0; bj < 2; ++bj) {
            const int c = u.pn * 256 + bj * 128 + wc * 32 + 8 * fq;
            const f32x4 g0 = *(const f32x4*)(gp + c), g1 = *(const f32x4*)(gp + c + 4);
#pragma unroll
            for (int ai = 0; ai < 2; ++ai)
#pragma unroll
                for (int m = 0; m < 4; ++m) {
                    const size_t o = (size_t)(row0 + ai * 128 + m * 16) * DM + c;
                    f32x4 x0, x1;
                    if (XIN_F32) { x0 = *(const f32x4*)(xin_f + o); x1 = *(const f32x4*)(xin_f + o + 4); }
                    else { const u32x4 w = *(const u32x4*)(xs + o);
                        x0 = (f32x4){bf2f((bf16_t)(w.x & 0xffff)), bf2f((bf16_t)(w.x >> 16)), bf2f((bf16_t)(w.y & 0xffff)), bf2f((bf16_t)(w.y >> 16))};
                        x1 = (f32x4){bf2f((bf16_t)(w.z & 0xffff)), bf2f((bf16_t)(w.z >> 16)), bf2f((bf16_t)(w.w & 0xffff)), bf2f((bf16_t)(w.w >> 16))}; }
                    const f32x4 y0 = x0 + g0 * acc[ai][bj][m][0], y1 = x1 + g1 * acc[ai][bj][m][1];
                    u32x4 w; w.x = pk2bf(y0[0], y0[1]); w.y = pk2bf(y0[2], y0[3]); w.z = pk2bf(y1[0], y1[1]); w.w = pk2bf(y1[2], y1[3]);
                    *(u32x4*)(xs + o) = w;
                }
        }
    }
};

#ifndef MOE_NBJ
#define MOE_NBJ 2
#endif
constexpr int MNB = MOE_NBJ, GU_NPN = 16 / MNB, DN_NPN = 8 / MNB;
struct SchedMoeGU {
    static constexpr int EB = 1, NBJ = MNB, WSCALE = 0x7F7F7F7F, ASCALE = 0x7F7F7F7F;
    const int* sidx; const char* Wgu; int G, v, nunits;
    __device__ __forceinline__ void init(const int* sidx_, const bf16_t* Wgu_layer, int G_, int c_, bool has_ctx) { sidx = sidx_; Wgu = (const char*)Wgu_layer; G = G_; v = (G_ % 8 == 0) ? (c_ % 8) * (G_ / 8) + c_ / 8 : c_; nunits = 32 * 8 * GU_NPN + (has_ctx ? 32 * GU_NPN : 0); }
    __device__ __forceinline__ bool next(int i, pg8::Unit& u) const {
        const int U = i * G + v; if (U >= nunits) return false;
        if (U < 32 * 8 * GU_NPN) { u.grp = U / (8 * GU_NPN); u.pm = (U % (8 * GU_NPN)) / GU_NPN; u.pn = U % GU_NPN; } else { const int w = U - 32 * 8 * GU_NPN; u.grp = 32 + w / GU_NPN; u.pm = 0; u.pn = w % GU_NPN; }
        return true; }
    __device__ __forceinline__ int a_row(const pg8::Unit& u, int r) const {
        if (u.grp < 32) return (u.grp >> 4) * SEQ + sidx[u.grp * CAP_L + u.pm * 256 + r];
        const int gc = u.grp - 32; return r < CAP_C ? NLAT + (gc >> 4) * CTX + sidx[32 * CAP_L + gc * CAP_C + r] : 0; }
    __device__ __forceinline__ const char* b_ptr(const pg8::Unit& u) const { return Wgu + ((size_t)(u.grp & 15) * 2048 + (size_t)u.pn * (128 * MNB)) * DM; }
};
struct EpiHidMk {
    static constexpr bool PERM = true;
    bf16_t* hid;
    __device__ __forceinline__ void operator()(const f32x4 (&acc)[2][MNB][4][2], const pg8::Unit& u, int wr, int wc, int fr, int fq) const {
        const bool isctx = u.grp >= 32;
        const size_t rbase = isctx ? (size_t)32 * CAP_L + (size_t)(u.grp - 32) * CAP_C : (size_t)u.grp * CAP_L + u.pm * 256;
        const int r0 = wr * 64 + fr + fq * 16, c0 = (u.pn * (128 * MNB) + wc * 32) >> 1;
#pragma unroll
        for (int ai = 0; ai < 2; ++ai)
#pragma unroll
            for (int bj = 0; bj < MNB; ++bj) {
                unsigned w[4];
#pragma unroll
                for (int m = 0; m < 4; ++m) { const f32x4 v0 = acc[ai][bj][m][0] * (1.f / 32.f), v1 = acc[ai][bj][m][1] * (1.f / 32.f);
                    w[m] = pk4fp8(silu_f(v0[0]) * v0[1], silu_f(v0[2]) * v0[3], silu_f(v1[0]) * v1[1], silu_f(v1[2]) * v1[3]); }
                { auto t = __builtin_amdgcn_permlane32_swap(w[0], w[2], false, false); w[0] = t[0]; w[2] = t[1]; }
                { auto t = __builtin_amdgcn_permlane32_swap(w[1], w[3], false, false); w[1] = t[0]; w[3] = t[1]; }
                { auto t = __builtin_amdgcn_permlane16_swap(w[0], w[1], false, false); w[0] = t[0]; w[1] = t[1]; }
                { auto t = __builtin_amdgcn_permlane16_swap(w[2], w[3], false, false); w[2] = t[0]; w[3] = t[1]; }
                const int r = r0 + ai * 128; if (isctx && r >= CAP_C) continue;
                u32x4 o; o.x = w[0]; o.y = w[1]; o.z = w[2]; o.w = w[3];
                *(u32x4*)((unsigned char*)hid + (rbase + r) * DFF + c0 + bj * 64) = o; }
    }
};
struct SchedMoeDown {
    static constexpr int EB = 1, NBJ = MNB, WSCALE = 0x7F7F7F7F, ASCALE = 0x7F7F7F7F;
    const char* Wd; int G, v, nunits;
    __device__ __forceinline__ void init(const bf16_t* Wd_layer, int G_, int c_, bool has_ctx) { Wd = (const char*)Wd_layer; G = G_; v = (G_ % 8 == 0) ? (c_ % 8) * (G_ / 8) + c_ / 8 : c_; nunits = 32 * 8 * DN_NPN + (has_ctx ? 32 * DN_NPN : 0); }
    __device__ __forceinline__ bool next(int i, pg8::Unit& u) const {
        const int U = i * G + v; if (U >= nunits) return false;
        if (U < 32 * 8 * DN_NPN) { u.grp = U / (8 * DN_NPN); u.pm = (U % (8 * DN_NPN)) / DN_NPN; u.pn = U % DN_NPN; } else { const int w = U - 32 * 8 * DN_NPN; u.grp = 32 + w / DN_NPN; u.pm = 0; u.pn = w % DN_NPN; }
        return true; }
    __device__ __forceinline__ int a_row(const pg8::Unit& u, int r) const { return u.grp < 32 ? u.grp * CAP_L + u.pm * 256 + r : 32 * CAP_L + (u.grp - 32) * CAP_C + r; }
    __device__ __forceinline__ const char* b_ptr(const pg8::Unit& u) const { return Wd + ((size_t)(u.grp & 15) * 1024 + (size_t)u.pn * (128 * MNB)) * DFF; }
};
struct EpiYeMk {
    static constexpr bool PERM = true;
    bf16_t* ye; const float* sg;
    __device__ __forceinline__ void operator()(const f32x4 (&acc)[2][MNB][4][2], const pg8::Unit& u, int wr, int wc, int fr, int fq) const {
        const bool isctx = u.grp >= 32;
        const size_t rbase = isctx ? (size_t)32 * CAP_L + (size_t)(u.grp - 32) * CAP_C : (size_t)u.grp * CAP_L + u.pm * 256;
        const int r0 = wr * 64 + fr, c0 = u.pn * (128 * MNB) + wc * 32 + 8 * fq;
#pragma unroll
        for (int ai = 0; ai < 2; ++ai)
#pragma unroll
            for (int m = 0; m < 4; ++m) { const int r = r0 + ai * 128 + m * 16; if (isctx && r >= CAP_C) continue;
                const float g = sg[rbase + r] * (1.f / 32.f);
#pragma unroll
              for (int bj = 0; bj < MNB; ++bj) {
                const f32x4 v0 = acc[ai][bj][m][0] * g, v1 = acc[ai][bj][m][1] * g;
                u32x4 w; w.x = pk2bf(v0[0], v0[1]); w.y = pk2bf(v0[2], v0[3]); w.z = pk2bf(v1[0], v1[1]); w.w = pk2bf(v1[2], v1[3]);
                *(u32x4*)(ye + (rbase + r) * DM + c0 + bj * 128) = w; } }
    }
};

struct Frame {
    LAS unsigned char* lds; int tid, lane, wave, G, bid;
};
__device__ __forceinline__ Params lds_params(const Frame& F) {
    Params P;
    const LAS unsigned* t = (const LAS unsigned*)(F.lds + LDS_MISC + 64);
#pragma unroll
    for (int i = 0; i < 26; ++i) {
        const unsigned lo = (unsigned)__builtin_amdgcn_readfirstlane((int)t[2 * i]), hi = (unsigned)__builtin_amdgcn_readfirstlane((int)t[2 * i + 1]);
        const unsigned long long v = ((unsigned long long)hi << 32) | lo;
        if (i < 24) P.in[i] = (const float*)(const __attribute__((address_space(1))) float*)v; else if (i == 24) P.out = (float*)(__attribute__((address_space(1))) float*)v; else P.ws = (unsigned char*)(__attribute__((address_space(1))) unsigned char*)v;
    }
    P.ph_lo = 0; P.ph_hi = 0;
    return P;
}
enum { MAP_PLAIN = 0, MAP_GU = 1, MAP_QPERM = 2, MAP_SWAPERM = 3 };
struct CvtJob { const float* s0; const float* s1; bf16_t* dst; int ld_src, Ksrc, koff, nvalid, mode, ld_dst, ntr, ntk; float scale; int scale_rows; int fp8; };
__device__ __forceinline__ void cvt_load(const CvtJob& J, int tile, float (&v)[16]) {
    const int tr = tile % J.ntr, tk = tile / J.ntr, r0 = tr * 64, k0 = tk * 128, tid = my_tid();
    if (J.fp8 == 1) {
      const int g4 = tid & 15, kq = tid >> 4; const bool gu = J.mode == MAP_GU;
      const float* s4 = (gu && (g4 & 1)) ? J.s1 : J.s0; const int colb = gu ? (r0 >> 1) + (g4 >> 1) * 4 : r0 + g4 * 4;
#pragma unroll
      for (int j = 0; j < 4; ++j) { const f32x4 t4 = *(const f32x4*)(s4 + (size_t)(k0 + kq + 32 * j) * J.ld_src + colb); v[4 * j] = t4[0]; v[4 * j + 1] = t4[1]; v[4 * j + 2] = t4[2]; v[4 * j + 3] = t4[3]; }
      return; }
    const int rr = tid & 63, r = r0 + rr;
    const float* s = J.s0; int col = r;
    if (J.mode == MAP_GU) { s = (r & 1) ? J.s1 : J.s0; col = r >> 1; }
    else if (J.mode == MAP_QPERM) { const int h = r / 96, dd = r % 96; if (dd >= 64) { const int q = dd - 64, p = q >> 1; col = h * 96 + 64 + (p >> 3) * 16 + (q & 1) * 8 + (p & 7); } }
    else if (J.mode == MAP_SWAPERM) { if (r < 1280) { const int hh = r >> 6, dd = r & 63, p = dd >> 1; col = hh * 64 + (p >> 4) * 32 + (dd & 1) * 16 + (p & 15); } }
#pragma unroll
    for (int j = 0; j < 16; ++j) {
        const int kk = (tid >> 6) + 8 * j, ks = k0 + kk - J.koff;
        v[j] = (r < J.nvalid && ks >= 0 && ks < J.Ksrc) ? s[(size_t)ks * J.ld_src + col] : 0.f;
    }
}
__device__ __forceinline__ void cvt_store(const CvtJob& J, int tile, const float (&v)[16], LAS float* scr) {
    const int tr = tile % J.ntr, tk = tile / J.ntr, r0 = tr * 64, k0 = tk * 128, tid = my_tid();
    const int rr = tid & 63, r = r0 + rr;
    const float sc = ((r < J.scale_rows) ? J.scale : 1.f) * (J.fp8 == 2 ? 32.f : 1.f);
    if (J.fp8 == 1) { const int g4 = tid & 15, kq = tid >> 4; const bool gu = J.mode == MAP_GU;
#pragma unroll
      for (int j = 0; j < 4; ++j)
#pragma unroll
        for (int i = 0; i < 4; ++i) scr[(kq + 32 * j) * 65 + (gu ? 2 * ((g4 >> 1) * 4 + i) + (g4 & 1) : g4 * 4 + i)] = v[4 * j + i] * J.scale; }
    else {
#pragma unroll
    for (int j = 0; j < 16; ++j) scr[((tid >> 6) + 8 * j) * 65 + rr] = v[j] * sc; }
    __syncthreads();
    if (J.fp8) { const int r2 = tid >> 3, kc = (tid & 7) * 16; const LAS float* sp = scr + kc * 65 + r2;
      u32x4 w; w.x = pk4fp8(sp[0], sp[65], sp[2 * 65], sp[3 * 65]); w.y = pk4fp8(sp[4 * 65], sp[5 * 65], sp[6 * 65], sp[7 * 65]);
      w.z = pk4fp8(sp[8 * 65], sp[9 * 65], sp[10 * 65], sp[11 * 65]); w.w = pk4fp8(sp[12 * 65], sp[13 * 65], sp[14 * 65], sp[15 * 65]);
      *(u32x4*)((unsigned char*)J.dst + (size_t)(r0 + r2) * J.ld_dst + k0 + kc) = w; }
    else { const int r2 = tid >> 3, kc = (tid & 7) * 8; const LAS float* sp = scr + kc * 65 + r2; const LAS float* sq = sp + 64 * 65;
      u32x4 w0, w1;
      w0.x = pk2bf(sp[0], sp[65]); w0.y = pk2bf(sp[2 * 65], sp[3 * 65]); w0.z = pk2bf(sp[4 * 65], sp[5 * 65]); w0.w = pk2bf(sp[6 * 65], sp[7 * 65]);
      w1.x = pk2bf(sq[0], sq[65]); w1.y = pk2bf(sq[2 * 65], sq[3 * 65]); w1.z = pk2bf(sq[4 * 65], sq[5 * 65]); w1.w = pk2bf(sq[6 * 65], sq[7 * 65]);
      bf16_t* d = J.dst + (size_t)(r0 + r2) * J.ld_dst + k0 + kc;
      *(u32x4*)d = w0; *(u32x4*)(d + 64) = w1; }
}
constexpr int CVT_DENSE = 256 + 128 + 192 + 48 + 64 + 128 + 192, CVT_MOE = 16 * 384;
__device__ __forceinline__ void cvt_job(const Params& P, int g, CvtJob& J, int& tile) {
    unsigned char* W = P.ws + WS_W;
    if (g < 256) { J = CvtJob{P.in[8], nullptr, (bf16_t*)(W + OFF_WIN), AB_IN, DM, 0, AB_IN, MAP_PLAIN, DM, 32, 8, 1.f, 0, 0}; tile = g; return; } g -= 256;
    if (g < 128) { J = CvtJob{P.in[15], nullptr, (bf16_t*)(W + OFF_WOUT), DM, DM, 0, DM, MAP_PLAIN, DM, 16, 8, 1.f, 0, 0}; tile = g; return; } g -= 128;
    if (g < 192) { J = CvtJob{P.in[16], nullptr, (bf16_t*)(W + OFF_WQKV), 1536, DM, 0, 1536, MAP_SWAPERM, DM, 24, 8, 0.125f * LOG2E, 1024, 0}; tile = g; return; } g -= 192;
    if (g < 48) { J = CvtJob{P.in[12], nullptr, (bf16_t*)(W + OFF_WUP), 768, 256, 0, 768, MAP_QPERM, 512, 12, 4, 0.10206207261596575f * LOG2E * QF8_SCALE, 768, 2}; tile = g; return; } g -= 48;
    if (g < 64) { J = CvtJob{P.in[14], nullptr, (bf16_t*)((unsigned char*)(W + OFF_WUP) + (size_t)768 * 512), 1024, 128, 256, 1024, MAP_PLAIN, 512, 16, 4, 1.f, 0, 2}; tile = g; return; } g -= 64;
    if (g < 128) { J = CvtJob{P.in[18], nullptr, (bf16_t*)(W + OFF_WSO), DM, DM, 0, DM, MAP_PLAIN, DM, 16, 8, 1.f, 0, 2}; tile = g; return; } g -= 128;
    J = CvtJob{P.in[16], nullptr, (bf16_t*)(W + OFF_WQKV8), 1536, DM, 0, 1536, MAP_SWAPERM, DM, 24, 8, 0.125f * LOG2E * QF8_SCALE, 1024, 2}; tile = g;
}
__device__ __forceinline__ void cvt_job_moe(const Params& P, int layer, int g, CvtJob& J, int& tile) {
    unsigned char* W = P.ws + WS_W;
    const int e = g / 384, r = g % 384, le = layer * 16 + e;
    if (r < 256) { J = CvtJob{P.in[20] + (size_t)le * DM * DFF, P.in[21] + (size_t)le * DM * DFF, (bf16_t*)(W + OFF_WGU + (size_t)e * 2048 * DM), DFF, DM, 0, 2048, MAP_GU, DM, 32, 8, 32.f, 1 << 30, 1}; tile = r; }
    else { J = CvtJob{P.in[22] + (size_t)le * DFF * DM, nullptr, (bf16_t*)(W + OFF_WD + (size_t)e * 1024 * DFF), DM, DFF, 0, DM, MAP_PLAIN, DFF, 16, 8, 32.f, 1 << 30, 1}; tile = r - 256; }
}
template <bool MOE>
__device__ __forceinline__ void cvt_run(const Params& P, LAS float* scr, int layer, int first, int step, int total) {
    int g = first, par = 0; CvtJob Jc{}; int tc = 0; float vc[16];
    bool have = g < total;
    if (have) { if (MOE) cvt_job_moe(P, layer, g, Jc, tc); else cvt_job(P, g, Jc, tc); cvt_load(Jc, tc, vc); }
    while (have) {
        const int gn = g + step; const bool hn = gn < total; CvtJob Jn{}; int tn = 0; float vn[16];
        if (hn) { if (MOE) cvt_job_moe(P, layer, gn, Jn, tn); else cvt_job(P, gn, Jn, tn); cvt_load(Jn, tn, vn); }
        cvt_store(Jc, tc, vc, scr + par * (128 * 65)); par ^= 1;
        Jc = Jn; tc = tn; g = gn; have = hn;
#pragma unroll
        for (int j = 0; j < 16; ++j) vc[j] = vn[j];
    }
}

__device__ __forceinline__ void phase_prologue(Frame& F) {
  const Params P = lds_params(F);
    LAS float* scr = (LAS float*)F.lds;
    cvt_run<false>(P, scr, 0, F.bid, F.G, CVT_DENSE);
    {
        LAS float* sv = (LAS float*)(F.lds + 32768);
        LAS float* red = (LAS float*)(F.lds + 32768 + 12288);
        const float* c = P.in[1]; const float* c_ctx = P.in[3]; const float* mod_w = P.in[4]; const float* mod_b = P.in[5];
        float* modv = (float*)(P.ws + WS_MODV);
        __syncthreads();
        for (int i = F.tid; i < DM; i += NTHREADS) { sv[i] = silu_f(c[i]); sv[DM + i] = silu_f(c[DM + i]); sv[2 * DM + i] = silu_f(c_ctx[i]); }
        __syncthreads();
        for (int ch = F.bid; ch < 256; ch += F.G) {
            const int jg = ch * 48, l = jg / NMOD, j0 = jg % NMOD, rg = F.tid >> 4, ct = F.tid & 15;
            const float* w = mod_w + (size_t)l * DM * NMOD + j0 + 3 * ct;
            float a[3][3];
#pragma unroll
            for (int x = 0; x < 3; ++x)
#pragma unroll
                for (int y = 0; y < 3; ++y) a[x][y] = 0.f;
            for (int d = rg; d < DM; d += 32) { const float w0 = w[(size_t)d * NMOD], w1 = w[(size_t)d * NMOD + 1], w2 = w[(size_t)d * NMOD + 2];
#pragma unroll
                for (int x = 0; x < 3; ++x) { const float s = sv[x * DM + d]; a[x][0] += s * w0; a[x][1] += s * w1; a[x][2] += s * w2; } }
#pragma unroll
            for (int x = 0; x < 3; ++x)
#pragma unroll
                for (int y = 0; y < 3; ++y) red[rg * 144 + x * 48 + 3 * ct + y] = a[x][y];
            __syncthreads();
            if (F.tid < 144) { float s = 0.f; for (int r = 0; r < 32; ++r) s += red[r * 144 + F.tid]; const int x = F.tid / 48, jj = j0 + F.tid % 48; modv[(l * 3 + x) * NMOD + jj] = s + mod_b[l * NMOD + jj]; }
            __syncthreads();
        }
    }
    {
        float* tab = (float*)(P.ws + WS_ROPE);
        for (int i = F.bid * 64 + F.tid; i < 256 * 16 && F.tid < 64; i += F.G * 64) {
            if (i < 256 * 8) { const int p = i / 8, f = i % 8; const double fr = pow(10000.0, -(double)(2 * f) / 16.0); const double a = (double)p * fr; tab[i] = (float)cos(a); tab[2048 + i] = (float)sin(a); }
            { const int p = i / 16, f = i % 16; const double fr = pow(10000.0, -(double)(2 * f) / 32.0); const double a = (double)p * fr; tab[4096 + i] = (float)cos(a); tab[8192 + i] = (float)sin(a); }
        }
    }
}


namespace att {
using f32x16 = __attribute__((ext_vector_type(16))) float;
using s16x4  = __attribute__((ext_vector_type(4))) short;
__device__ __forceinline__ int crow(int r, int hi) { return (r & 3) + 8 * (r >> 2) + 4 * hi; }
__device__ __forceinline__ unsigned cvtpk(float lo, float hi) { unsigned r;
#ifdef PROBE_FP8ATT
  if (PROBE_FP8ATT & 4) { lo = fp8rt(lo, 1.f); hi = fp8rt(hi, 1.f); }
#endif
  asm volatile("v_cvt_pk_bf16_f32 %0, %1, %2" : "=v"(r) : "v"(lo), "v"(hi)); return r; }
__device__ __forceinline__ int v_rd_base(int lane) { return ((lane & 3) << 3) | (((lane >> 2) & 3) << 6) | (((lane >> 4) & 1) << 5) | (((lane >> 5) & 1) << 8); }
constexpr int v_rd_off(int d0, int ks, int half) { return d0 * 512 + ks * 2048 + half * 1024; }
template <int OFF> __device__ __forceinline__ s16x4 tr_read(int vb) {
  s16x4 r; asm volatile("ds_read_b64_tr_b16 %0, %1 offset:%2" : "=&v"(r) : "v"(vb), "i"(OFF) : "memory"); return r;
}
}


namespace att2 {
using att::f32x16; using att::s16x4; using att::crow; using att::cvtpk; using att::v_rd_base; using att::v_rd_off; using att::tr_read;
constexpr int VT = 8192, NSLOT = 4, LDS_WS = NSLOT * (12288 + VT);
#ifndef A2_PIPE
#define A2_PIPE 2
#endif
constexpr float THR = 8.f, P8_BIAS = 4.f;
#define A2_SBAR() __builtin_amdgcn_sched_barrier(0)
template <bool FAST, int ABL = 0, bool PACK = true>
__device__ __forceinline__ void softmax_blk(f32x16& p0, f32x16& p1, float& m_reg, float& l_reg, float& alpha, bf16x8& pa0, bf16x8& pa1, bf16x8& pa2, bf16x8& pa3) {
  if (FAST) {
    float ps = 0.f;
#pragma unroll
    for (int r = 0; r < 16; ++r) { if (ABL != 1) { p0[r] = __builtin_amdgcn_exp2f(p0[r]); p1[r] = __builtin_amdgcn_exp2f(p1[r]); } }
    if (ABL != 1) {
#pragma unroll
    for (int r = 0; r < 16; ++r) ps += p0[r] + p1[r];
    { auto rr = __builtin_amdgcn_permlane32_swap(__float_as_uint(ps), __float_as_uint(ps), false, false);
      ps = __uint_as_float(rr[0]) + __uint_as_float(rr[1]); }
    } else ps = 1.f;
    l_reg += ps; alpha = 1.f;
  } else {
  float pmax = fmaxf(p0[0], p1[0]);
#pragma unroll
  for (int r = 1; r < 16; ++r) pmax = fmaxf(fmaxf(pmax, p0[r]), p1[r]);
  { auto rr = __builtin_amdgcn_permlane32_swap(__float_as_uint(pmax), __float_as_uint(pmax), false, false);
    pmax = fmaxf(__uint_as_float(rr[0]), __uint_as_float(rr[1])); }
  float mn;
  if (__builtin_expect(__all(pmax - m_reg <= THR), 1)) { mn = m_reg; alpha = 1.f; }
  else { mn = fmaxf(m_reg, pmax); alpha = __builtin_amdgcn_exp2f(m_reg - mn); m_reg = mn; }
  float ps = 0.f;
#pragma unroll
  for (int r = 0; r < 16; ++r) { p0[r] = __builtin_amdgcn_exp2f(p0[r] - mn); p1[r] = __builtin_amdgcn_exp2f(p1[r] - mn); }
#pragma unroll
  for (int r = 0; r < 16; ++r) ps += p0[r] + p1[r];
  { auto rr = __builtin_amdgcn_permlane32_swap(__float_as_uint(ps), __float_as_uint(ps), false, false);
    ps = __uint_as_float(rr[0]) + __uint_as_float(rr[1]); }
  l_reg = l_reg * alpha + ps;
  }
#define A2_PK4(P, BASE, OUT) do { unsigned a0 = cvtpk(P[BASE + 0], P[BASE + 1]), a1 = cvtpk(P[BASE + 2], P[BASE + 3]);   \
    unsigned b0 = cvtpk(P[BASE + 4], P[BASE + 5]), b1 = cvtpk(P[BASE + 6], P[BASE + 7]);                              \
    auto r0 = __builtin_amdgcn_permlane32_swap(a0, b0, false, false); auto r1 = __builtin_amdgcn_permlane32_swap(a1, b1, false, false); \
    u32x4 w = {r0[0], r1[0], r0[1], r1[1]}; OUT = *reinterpret_cast<bf16x8*>(&w); } while (0)
  if constexpr (PACK) { A2_PK4(p0, 0, pa0); A2_PK4(p0, 8, pa1); A2_PK4(p1, 0, pa2); A2_PK4(p1, 8, pa3); }
#undef A2_PK4
}

template <bool FAST, int ABL = 0, int DK = 96, bool SWA = false, bool F8 = false>
__device__ __forceinline__ bool attn_unit(const bf16_t* __restrict__ Qb_, const int rows_valid, const char* __restrict__ Kimg, const char* __restrict__ Vimg,
                                          bf16_t* __restrict__ Ob_, const int NT, LAS unsigned char* lds, const int lt0 = 0, const int q0 = 0, const float* sinkp = nullptr) {
  constexpr bool PIPED = (A2_PIPE != 0) && F8 && FAST && ABL == 0 && DK == 96;
  constexpr int ND = DK / 16, KT = F8 ? DK * 64 : DK * 128, VTX = F8 ? 4096 : VT, ONESB = PIPED ? 2048 : 0, VO = KT + ONESB, SLOT = KT + ONESB + VTX;
  constexpr int QB = F8 ? 1 : 2;
  const bf16_t* Qb = Qb_; bf16_t* Ob = Ob_;
  const int tid = my_tid(), wid = __builtin_amdgcn_readfirstlane(tid >> 6), lane = tid & 63, r32 = lane & 31, hi = lane >> 5;
  LAS float* ws = (LAS float*)(lds + LDS_WS) + wid * 128;
  float mA = -1e30f, mB = -1e30f, lA = 0.f, lB = 0.f; f32x16 oA[2] = {}, oB[2] = {};
  bf16x8 qA[ND], qB[ND]; pg8::v8i32 qA8[2], qB8[2];
  const int wrow0 = SWA ? (wid >> 2) * 64 : wid * 64;
  if (SWA) { Qb = (const bf16_t*)((const char*)Qb + (size_t)(wid & 3) * SEQ * DK * QB); Ob = (bf16_t*)((unsigned char*)Ob + (wid & 3) * 64); }
  { int ra = wrow0 + r32, rb = ra + 32; if (ra >= rows_valid) ra = 0; if (rb >= rows_valid) rb = 0;
    if constexpr (F8) { const char* pa_ = (const char*)Qb + (size_t)ra * DK; const char* pb_ = (const char*)Qb + (size_t)rb * DK;
      const pg8::v8i32 z8 = {0, 0, 0, 0, 0, 0, 0, 0};
      qA8[0] = *reinterpret_cast<const pg8::v8i32*>(pa_ + hi * 32); qB8[0] = *reinterpret_cast<const pg8::v8i32*>(pb_ + hi * 32);
      if constexpr (DK == 96) { const pg8::v8i32 ta = *reinterpret_cast<const pg8::v8i32*>(pa_ + 64), tb = *reinterpret_cast<const pg8::v8i32*>(pb_ + 64);
        pg8::v8i32 zb = z8; if constexpr (PIPED) zb[0] = 0xE8;
        qA8[1] = hi ? zb : ta; qB8[1] = hi ? zb : tb; } else { qA8[1] = z8; qB8[1] = z8; }
      asm volatile("" : "+v"(qA8[0]), "+v"(qA8[1]), "+v"(qB8[0]), "+v"(qB8[1]));
    } else {
    const bf16_t* pa_ = Qb + (size_t)ra * DK + hi * 8; const bf16_t* pb_ = Qb + (size_t)rb * DK + hi * 8;
#pragma unroll
    for (int d0 = 0; d0 < ND; ++d0) { qA[d0] = *reinterpret_cast<const bf16x8*>(pa_ + d0 * 16); qB[d0] = *reinterpret_cast<const bf16x8*>(pb_ + d0 * 16); } } }
  const bool two = F8 ? false : (DK == 96) && wid < 4;
  const bool hasK = F8 ? wid < 6 : true, hasV = F8 ? (wid < 2 || wid >= 6) : true;
  const int vpiece = F8 ? (wid >= 6 ? wid - 6 : wid + 2) : wid;
  const char* ksrc = Kimg + wid * 1024 + lane * 16; const char* vsrc = Vimg + vpiece * 1024 + lane * 16;
  constexpr int NKP = KT / 1024;
  const char* f8a = (wid < NKP) ? Kimg + wid * 1024 : Vimg + (wid - NKP) * 1024; const int f8as = (wid < NKP) ? KT : VTX, f8ad = (wid < NKP) ? wid * 1024 : VO + (wid - NKP) * 1024;
  const char* f8b = (wid < 2) ? Vimg + (wid + 2) * 1024 : f8a; const int f8bs = (wid < 2) ? VTX : f8as, f8bd = (wid < 2) ? VO + (wid + 2) * 1024 : LDS_WS + 8192 + wid * 1024; const bool f8breal = wid < 2;
#define A2_DMA8(t, s) do { const int it8_ = (SWA && (t) >= 4) ? lt0 + (t) : (t); const char* ga_ = f8a + (size_t)it8_ * f8as; const char* gb_ = f8b + (size_t)it8_ * f8bs; unsigned vo_ = (unsigned)lane * 16u; asm volatile("" : "+s"(ga_)); asm volatile("" : "+s"(gb_)); asm volatile("" : "+v"(vo_)); \
    __builtin_amdgcn_global_load_lds((const unsigned*)(ga_ + vo_), (LAS unsigned*)(lds + (s) * SLOT + f8ad), 16, 0, 0); \
    if constexpr (DK == 96) __builtin_amdgcn_global_load_lds((const unsigned*)(gb_ + vo_), (LAS unsigned*)(lds + (f8breal ? (s) * SLOT : 0) + f8bd), 16, 0, 0); } while (0)
#define A2_DMA(t, s) do { if constexpr (F8) { A2_DMA8(t, s); break; } const int it_ = (SWA && (t) >= 4) ? lt0 + (t) : (t); \
    if (hasK) __builtin_amdgcn_global_load_lds((const unsigned*)(ksrc + (size_t)it_ * KT), (LAS unsigned*)(lds + (s) * SLOT + wid * 1024), 16, 0, 0); \
    if (two) __builtin_amdgcn_global_load_lds((const unsigned*)(ksrc + (size_t)it_ * KT + 8192), (LAS unsigned*)(lds + (s) * SLOT + 8192 + wid * 1024), 16, 0, 0); \
    if (hasV) __builtin_amdgcn_global_load_lds((const unsigned*)(vsrc + (size_t)it_ * VTX), (LAS unsigned*)(lds + (s) * SLOT + KT + vpiece * 1024), 16, 0, 0); } while (0)
  LAS unsigned* flag = (LAS unsigned*)(lds + LDS_WS + 4096);
  if (FAST && tid == 0) *flag = 0u;
  asm volatile("s_waitcnt vmcnt(0)" ::: "memory");
  A2_DMA(0, 0); A2_DMA(1, 1);
  if constexpr (A2_PIPE == 2 && F8 && FAST && ABL == 0 && DK == 96) { A2_DMA(2, 2); }
  const int vb0 = (int)(uintptr_t)(lds + KT) + v_rd_base(lane);
  const int kb0 = hi * 1024 + r32 * 16;
  const int qpA = q0 + wrow0 + r32;
#define A2_PK(L, H) (bf16x8){L[0], L[1], L[2], L[3], H[0], H[1], H[2], H[3]}
#define A2_PV(D0, VB) do { \
      const s16x4 l0 = tr_read<v_rd_off(D0, 0, 0)>(VB), h0 = tr_read<v_rd_off(D0, 0, 1)>(VB), l1 = tr_read<v_rd_off(D0, 1, 0)>(VB), h1 = tr_read<v_rd_off(D0, 1, 1)>(VB); \
      const s16x4 l2 = tr_read<v_rd_off(D0, 2, 0)>(VB), h2 = tr_read<v_rd_off(D0, 2, 1)>(VB), l3 = tr_read<v_rd_off(D0, 3, 0)>(VB), h3 = tr_read<v_rd_off(D0, 3, 1)>(VB); \
      asm volatile("s_waitcnt lgkmcnt(0)" ::: "memory"); A2_SBAR(); \
      const bf16x8 v0_ = A2_PK(l0, h0), v1_ = A2_PK(l1, h1), v2_ = A2_PK(l2, h2), v3_ = A2_PK(l3, h3); \
      if (ABL == 3) { asm volatile("" :: "v"(v0_), "v"(v1_), "v"(v2_), "v"(v3_), "v"(a0), "v"(a1), "v"(a2), "v"(a3), "v"(b0), "v"(b1), "v"(b2), "v"(b3)); } else { \
      oA[D0] = __builtin_amdgcn_mfma_f32_32x32x16_bf16(a0, v0_, oA[D0], 0, 0, 0); oB[D0] = __builtin_amdgcn_mfma_f32_32x32x16_bf16(b0, v0_, oB[D0], 0, 0, 0); \
      oA[D0] = __builtin_amdgcn_mfma_f32_32x32x16_bf16(a1, v1_, oA[D0], 0, 0, 0); oB[D0] = __builtin_amdgcn_mfma_f32_32x32x16_bf16(b1, v1_, oB[D0], 0, 0, 0); \
      oA[D0] = __builtin_amdgcn_mfma_f32_32x32x16_bf16(a2, v2_, oA[D0], 0, 0, 0); oB[D0] = __builtin_amdgcn_mfma_f32_32x32x16_bf16(b2, v2_, oB[D0], 0, 0, 0); \
      oA[D0] = __builtin_amdgcn_mfma_f32_32x32x16_bf16(a3, v3_, oA[D0], 0, 0, 0); oB[D0] = __builtin_amdgcn_mfma_f32_32x32x16_bf16(b3, v3_, oB[D0], 0, 0, 0); } } while (0)
#define A2_PV2(VB) do { \
      const s16x4 l0 = tr_read<v_rd_off(0, 0, 0)>(VB), h0 = tr_read<v_rd_off(0, 0, 1)>(VB), l1 = tr_read<v_rd_off(0, 1, 0)>(VB), h1 = tr_read<v_rd_off(0, 1, 1)>(VB); \
      const s16x4 l2 = tr_read<v_rd_off(0, 2, 0)>(VB), h2 = tr_read<v_rd_off(0, 2, 1)>(VB), l3 = tr_read<v_rd_off(0, 3, 0)>(VB), h3 = tr_read<v_rd_off(0, 3, 1)>(VB); \
      const s16x4 m0 = tr_read<v_rd_off(1, 0, 0)>(VB), n0 = tr_read<v_rd_off(1, 0, 1)>(VB), m1 = tr_read<v_rd_off(1, 1, 0)>(VB), n1 = tr_read<v_rd_off(1, 1, 1)>(VB); \
      const s16x4 m2 = tr_read<v_rd_off(1, 2, 0)>(VB), n2 = tr_read<v_rd_off(1, 2, 1)>(VB), m3 = tr_read<v_rd_off(1, 3, 0)>(VB), n3 = tr_read<v_rd_off(1, 3, 1)>(VB); \
      asm volatile("s_waitcnt lgkmcnt(0)" ::: "memory"); A2_SBAR(); \
      const bf16x8 v0_ = A2_PK(l0, h0), v1_ = A2_PK(l1, h1), v2_ = A2_PK(l2, h2), v3_ = A2_PK(l3, h3); \
      const bf16x8 w0_ = A2_PK(m0, n0), w1_ = A2_PK(m1, n1), w2_ = A2_PK(m2, n2), w3_ = A2_PK(m3, n3); \
      oA[0] = __builtin_amdgcn_mfma_f32_32x32x16_bf16(a0, v0_, oA[0], 0, 0, 0); oB[0] = __builtin_amdgcn_mfma_f32_32x32x16_bf16(b0, v0_, oB[0], 0, 0, 0); \
      oA[1] = __builtin_amdgcn_mfma_f32_32x32x16_bf16(a0, w0_, oA[1], 0, 0, 0); oB[1] = __builtin_amdgcn_mfma_f32_32x32x16_bf16(b0, w0_, oB[1], 0, 0, 0); \
      oA[0] = __builtin_amdgcn_mfma_f32_32x32x16_bf16(a1, v1_, oA[0], 0, 0, 0); oB[0] = __builtin_amdgcn_mfma_f32_32x32x16_bf16(b1, v1_, oB[0], 0, 0, 0); \
      oA[1] = __builtin_amdgcn_mfma_f32_32x32x16_bf16(a1, w1_, oA[1], 0, 0, 0); oB[1] = __builtin_amdgcn_mfma_f32_32x32x16_bf16(b1, w1_, oB[1], 0, 0, 0); \
      oA[0] = __builtin_amdgcn_mfma_f32_32x32x16_bf16(a2, v2_, oA[0], 0, 0, 0); oB[0] = __builtin_amdgcn_mfma_f32_32x32x16_bf16(b2, v2_, oB[0], 0, 0, 0); \
      oA[1] = __builtin_amdgcn_mfma_f32_32x32x16_bf16(a2, w2_, oA[1], 0, 0, 0); oB[1] = __builtin_amdgcn_mfma_f32_32x32x16_bf16(b2, w2_, oB[1], 0, 0, 0); \
      oA[0] = __builtin_amdgcn_mfma_f32_32x32x16_bf16(a3, v3_, oA[0], 0, 0, 0); oB[0] = __builtin_amdgcn_mfma_f32_32x32x16_bf16(b3, v3_, oB[0], 0, 0, 0); \
      oA[1] = __builtin_amdgcn_mfma_f32_32x32x16_bf16(a3, w3_, oA[1], 0, 0, 0); oB[1] = __builtin_amdgcn_mfma_f32_32x32x16_bf16(b3, w3_, oB[1], 0, 0, 0); } while (0)
#define A2_WAITV(more) do { if (ABL == 5) break; if constexpr (F8) { if (more) { if constexpr (DK == 96) asm volatile("s_waitcnt vmcnt(2)" ::: "memory"); else asm volatile("s_waitcnt vmcnt(1)" ::: "memory"); } else asm volatile("s_waitcnt vmcnt(0)" ::: "memory"); break; } if (more) { if (two) asm volatile("s_waitcnt vmcnt(3)" ::: "memory"); else if (hasK && hasV) asm volatile("s_waitcnt vmcnt(2)" ::: "memory"); else asm volatile("s_waitcnt vmcnt(1)" ::: "memory"); } \
    else asm volatile("s_waitcnt vmcnt(0)" ::: "memory"); } while (0)
#define A2_MF8(KF, QF, ACC) __builtin_amdgcn_mfma_scale_f32_32x32x64_f8f6f4(KF, QF, ACC, 0, 0, 0, 0x7B7B7B7B, 0, 0x7F7F7F7F)
#define A2_MF8P(PF, VF, ACC) __builtin_amdgcn_mfma_scale_f32_32x32x64_f8f6f4(PF, VF, ACC, 0, 0, 0, 0x7F7F7F7F, 0, 0x7F7F7F7F)
#define A2_TILE(S, t) do { \
    A2_WAITV((t) + 1 < NT); \
    if (ABL != 5) __builtin_amdgcn_s_barrier(); \
    A2_SBAR(); \
    if ((t) + 2 < NT) { A2_DMA((t) + 2, ((S) + 2) % 4); } \
    const LAS unsigned char* Ks = lds + (S) * SLOT + kb0; \
    f32x16 pA0 = {}, pA1 = {}, pB0 = {}, pB1 = {}; \
    if constexpr (F8 && FAST) { _Pragma("unroll") for (int r = 0; r < 16; ++r) { pA0[r] = -P8_BIAS; pA1[r] = -P8_BIAS; pB0[r] = -P8_BIAS; pB1[r] = -P8_BIAS; } }     \
    if constexpr (F8 && DK == 64) { const LAS unsigned char* K0 = lds + (S) * SLOT + hi * 2048 + r32 * 16; \
      const pg8::v8i32 k00 = pg8::cat32(*(const LAS bf16x8*)(K0), *(const LAS bf16x8*)(K0 + 1024)), k01 = pg8::cat32(*(const LAS bf16x8*)(K0 + 512), *(const LAS bf16x8*)(K0 + 1536)); \
      pA0 = A2_MF8(k00, qA8[0], pA0); pA1 = A2_MF8(k01, qA8[0], pA1); pB0 = A2_MF8(k00, qB8[0], pB0); pB1 = A2_MF8(k01, qB8[0], pB1); \
      asm volatile("" : "+v"(pA0), "+v"(pA1), "+v"(pB0), "+v"(pB1)); A2_SBAR(); } else \
    if constexpr (F8) { const LAS unsigned char* K0 = lds + (S) * SLOT + hi * 2048 + r32 * 16; const LAS unsigned char* K1 = lds + (S) * SLOT + 4096 + r32 * 16; \
      const pg8::v8i32 k00 = pg8::cat32(*(const LAS bf16x8*)(K0), *(const LAS bf16x8*)(K0 + 1024)), k01 = pg8::cat32(*(const LAS bf16x8*)(K0 + 512), *(const LAS bf16x8*)(K0 + 1536)); \
      const pg8::v8i32 k10 = pg8::cat32(*(const LAS bf16x8*)(K1), *(const LAS bf16x8*)(K1 + 1024)), k11 = pg8::cat32(*(const LAS bf16x8*)(K1 + 512), *(const LAS bf16x8*)(K1 + 1536)); \
      if (ABL == 2) { asm volatile("" :: "v"(k00), "v"(k01), "v"(k10), "v"(k11)); pA0[0] += 0.01f; pB1[1] += 0.02f; } else { \
      pA0 = A2_MF8(k00, qA8[0], pA0); pA1 = A2_MF8(k01, qA8[0], pA1); pB0 = A2_MF8(k00, qB8[0], pB0); pB1 = A2_MF8(k01, qB8[0], pB1); \
      pA0 = A2_MF8(k10, qA8[1], pA0); pA1 = A2_MF8(k11, qA8[1], pA1); pB0 = A2_MF8(k10, qB8[1], pB0); pB1 = A2_MF8(k11, qB8[1], pB1); } \
      asm volatile("" : "+v"(pA0), "+v"(pA1), "+v"(pB0), "+v"(pB1)); A2_SBAR(); } else { \
    bf16x8 kf[2][2]; if (ABL == 4) { kf[0][0] = qA[0]; kf[0][1] = qB[0]; } else { kf[0][0] = *(const LAS bf16x8*)(Ks); kf[0][1] = *(const LAS bf16x8*)(Ks + 512); } \
    _Pragma("unroll") for (int d0 = 0; d0 < ND; ++d0) {              \
      if (d0 + 1 < ND) { if (ABL == 4) { kf[(d0 + 1) & 1][0] = qA[d0 + 1]; kf[(d0 + 1) & 1][1] = qB[d0 + 1]; } else { kf[(d0 + 1) & 1][0] = *(const LAS bf16x8*)(Ks + (d0 + 1) * 2048); kf[(d0 + 1) & 1][1] = *(const LAS bf16x8*)(Ks + (d0 + 1) * 2048 + 512); } } \
      const bf16x8 k0 = kf[d0 & 1][0], k1 = kf[d0 & 1][1]; \
      if (ABL == 2) { asm volatile("" :: "v"(k0), "v"(k1)); pA0[d0] += 0.01f; pB1[d0] += 0.02f; } else { \
      pA0 = __builtin_amdgcn_mfma_f32_32x32x16_bf16(k0, qA[d0], pA0, 0, 0, 0); pA1 = __builtin_amdgcn_mfma_f32_32x32x16_bf16(k1, qA[d0], pA1, 0, 0, 0); \
      pB0 = __builtin_amdgcn_mfma_f32_32x32x16_bf16(k0, qB[d0], pB0, 0, 0, 0); pB1 = __builtin_amdgcn_mfma_f32_32x32x16_bf16(k1, qB[d0], pB1, 0, 0, 0); } \
      A2_SBAR(); } } \
    if (SWA && (t) >= 4) { const int kb_ = 64 * (lt0 + (t) - 4) - qpA;          \
      _Pragma("unroll") for (int r = 0; r < 16; ++r) { const int dA = kb_ + crow(r, hi), dB = dA - 32; \
        if (dA > 128 || dA < -128) pA0[r] = -INFINITY; if (dA + 32 > 128 || dA + 32 < -128) pA1[r] = -INFINITY; \
        if (dB > 128 || dB < -128) pB0[r] = -INFINITY; if (dB + 32 > 128 || dB + 32 < -128) pB1[r] = -INFINITY; } } \
    float alA, alB; bf16x8 a0, a1, a2, a3, b0, b1, b2, b3; \
    pg8::v8i32 pa8, pb8; \
    softmax_blk<FAST, ABL, !F8>(pA0, pA1, mA, lA, alA, a0, a1, a2, a3); \
    if constexpr (F8) { _Pragma("unroll") for (int j = 0; j < 4; ++j) { pa8[j] = (int)pk4fp8(pA0[4 * j], pA0[4 * j + 1], pA0[4 * j + 2], pA0[4 * j + 3]); pa8[4 + j] = (int)pk4fp8(pA1[4 * j], pA1[4 * j + 1], pA1[4 * j + 2], pA1[4 * j + 3]); } asm volatile("" : "+v"(pa8)); } \
    A2_SBAR(); \
    A2_MID((t) + 2 < NT); \
    A2_SBAR(); \
    softmax_blk<FAST, ABL, !F8>(pB0, pB1, mB, lB, alB, b0, b1, b2, b3); \
    if (!FAST && __any(alA < 1.f || alB < 1.f)) {                            \
      if (hi == 0) { ws[64 + r32] = alA; ws[96 + r32] = alB; } \
      asm volatile("s_waitcnt lgkmcnt(0)" ::: "memory"); \
      _Pragma("unroll") for (int d = 0; d < 2; ++d) _Pragma("unroll") for (int r = 0; r < 16; ++r) { oA[d][r] *= ws[64 + crow(r, hi)]; oB[d][r] *= ws[96 + crow(r, hi)]; } } \
    if constexpr (F8) { const LAS unsigned char* Vs = lds + (S) * SLOT + VO + hi * 512 + r32 * 16; \
      const pg8::v8i32 v0_ = pg8::cat32(*(const LAS bf16x8*)(Vs), *(const LAS bf16x8*)(Vs + 1024)), v1_ = pg8::cat32(*(const LAS bf16x8*)(Vs + 2048), *(const LAS bf16x8*)(Vs + 3072)); \
      _Pragma("unroll") for (int j = 0; j < 4; ++j) { pb8[j] = (int)pk4fp8(pB0[4 * j], pB0[4 * j + 1], pB0[4 * j + 2], pB0[4 * j + 3]); pb8[4 + j] = (int)pk4fp8(pB1[4 * j], pB1[4 * j + 1], pB1[4 * j + 2], pB1[4 * j + 3]); } asm volatile("" : "+v"(pb8)); \
      asm volatile("s_waitcnt lgkmcnt(0)" ::: "memory"); A2_SBAR(); \
      if (ABL == 3) { asm volatile("" :: "v"(v0_), "v"(v1_), "v"(pa8), "v"(pb8)); } else { \
      oA[0] = A2_MF8P(pa8, v0_, oA[0]); oB[0] = A2_MF8P(pb8, v0_, oB[0]); oA[1] = A2_MF8P(pa8, v1_, oA[1]); oB[1] = A2_MF8P(pb8, v1_, oB[1]); } \
      asm volatile("" : "+v"(oA[0]), "+v"(oA[1]), "+v"(oB[0]), "+v"(oB[1])); \
    } else { A2_PV(0, vb0 + (S) * SLOT); A2_PV(1, vb0 + (S) * SLOT); } \
    asm volatile("s_waitcnt lgkmcnt(0)" ::: "memory"); \
  } while (0)
#ifdef A2_NOSTAGGER
#define A2_MID(more) do { } while (0)
#else
#define A2_MID(more) do { A2_WAITV(more); if (ABL != 5) __builtin_amdgcn_s_barrier(); } while (0)
#endif
  if constexpr (A2_PIPE && F8 && FAST && ABL == 0 && DK == 96) {
#define P8_LD(p) (*(const LAS bf16x8*)(p))
#define P8_ADD(a_, b_) ({ float o_ = (a_) + (b_); asm("" : "+v"(o_)); o_; })
    const LAS unsigned char* kp0 = lds + hi * 2048 + r32 * 16; const LAS unsigned char* kp1 = hi ? lds + KT : lds + 4096 + r32 * 16; const LAS unsigned char* vp0 = lds + VO + hi * 512 + r32 * 16;
    asm volatile("" : "+v"(kp0), "+v"(kp1), "+v"(vp0));
#define P8_KA(S) const LAS unsigned char* K0_ = kp0 + (S) * SLOT; const pg8::v8i32 k00 = pg8::cat32(P8_LD(K0_), P8_LD(K0_ + 1024)), k01 = pg8::cat32(P8_LD(K0_ + 512), P8_LD(K0_ + 1536));
#define P8_KB(S) const LAS unsigned char* K1_ = kp1 + (S) * SLOT; const pg8::v8i32 k10 = pg8::cat32(P8_LD(K1_), P8_LD(K1_ + 1024)), k11 = pg8::cat32(P8_LD(K1_ + 512), P8_LD(K1_ + 1536));
#define P8_VF(S) const LAS unsigned char* Vs_ = vp0 + (S) * SLOT; \
      const pg8::v8i32 v0_ = pg8::cat32(P8_LD(Vs_), P8_LD(Vs_ + 1024)), v1_ = pg8::cat32(P8_LD(Vs_ + 2048), P8_LD(Vs_ + 3072));
#define P8_BIAS16(name)
#define P8_SMG(g, p0, p1, lreg, p8) do { _Pragma("unroll") for (int r_ = 4 * (g); r_ < 4 * (g) + 4; ++r_) { p0[r_] = __builtin_amdgcn_exp2f(p0[r_]); p1[r_] = __builtin_amdgcn_exp2f(p1[r_]); } \
      { float s0_ = P8_ADD(p0[4 * (g)], p1[4 * (g)]), s1_ = P8_ADD(p0[4 * (g) + 1], p1[4 * (g) + 1]), s2_ = P8_ADD(p0[4 * (g) + 2], p1[4 * (g) + 2]), s3_ = P8_ADD(p0[4 * (g) + 3], p1[4 * (g) + 3]); \
        s0_ = P8_ADD(s0_, s1_); s2_ = P8_ADD(s2_, s3_); s0_ = P8_ADD(s0_, s2_); lreg = P8_ADD(lreg, s0_); } asm volatile("" : "+v"(lreg)); \
      p8[g] = (int)pk4fp8(p0[4 * (g)], p0[4 * (g) + 1], p0[4 * (g) + 2], p0[4 * (g) + 3]); p8[4 + (g)] = (int)pk4fp8(p1[4 * (g)], p1[4 * (g) + 1], p1[4 * (g) + 2], p1[4 * (g) + 3]); } while (0)
#define P8_EXP(g, p0, p1) do { _Pragma("unroll") for (int r_ = 4 * (g); r_ < 4 * (g) + 4; ++r_) { p0[r_] = __builtin_amdgcn_exp2f(p0[r_]); p1[r_] = __builtin_amdgcn_exp2f(p1[r_]); } } while (0)
#define P8_EXH(g, px) do { _Pragma("unroll") for (int r_ = 4 * (g); r_ < 4 * (g) + 4; ++r_) px[r_] = __builtin_amdgcn_exp2f(px[r_]); } while (0)
#define P8_PK(g, p0, p1, p8) do { p8[g] = (int)pk4fp8(p0[4 * (g)], p0[4 * (g) + 1], p0[4 * (g) + 2], p0[4 * (g) + 3]); p8[4 + (g)] = (int)pk4fp8(p1[4 * (g)], p1[4 * (g) + 1], p1[4 * (g) + 2], p1[4 * (g) + 3]); } while (0)
#define P8_FIN(g, p0, p1, lreg, p8) do { \
        \
      lreg = (((((((lreg + p0[4 * (g)]) + p1[4 * (g)]) + p0[4 * (g) + 1]) + p1[4 * (g) + 1]) + p0[4 * (g) + 2]) + p1[4 * (g) + 2]) + p0[4 * (g) + 3]) + p1[4 * (g) + 3]; asm volatile("" : "+v"(lreg)); \
      p8[g] = (int)pk4fp8(p0[4 * (g)], p0[4 * (g) + 1], p0[4 * (g) + 2], p0[4 * (g) + 3]); p8[4 + (g)] = (int)pk4fp8(p1[4 * (g)], p1[4 * (g) + 1], p1[4 * (g) + 2], p1[4 * (g) + 3]); } while (0)
    f32x16 pA0, pA1, pB0, pB1; pg8::v8i32 pa8 = {0, 0, 0, 0, 0, 0, 0, 0}, pb8 = {0, 0, 0, 0, 0, 0, 0, 0};
    const f32x16 b16 = {};
    for (int i_ = tid; i_ < 5 * (ONESB / 16); i_ += NTHREADS) *(LAS u32x4*)(lds + (i_ / (ONESB / 16)) * SLOT + KT + (i_ % (ONESB / 16)) * 16) = (u32x4){0x38383838u, 0x38383838u, 0x38383838u, 0x38383838u};
    asm volatile("s_waitcnt lgkmcnt(0)" ::: "memory");
    pg8::v8i32 ones8; { int lo_ = lane; asm volatile("" : "+v"(lo_));
      const int j_ = lo_ & 15, kq_ = lo_ >> 4; const int w_ = ((j_ == 0 && !(kq_ & 1)) || (j_ == 1 && (kq_ & 1))) ? 0x38383838 : 0;
#pragma unroll
      for (int r_ = 0; r_ < 8; ++r_) ones8[r_] = w_; }
    asm volatile("" : "+v"(ones8));
    f32x4 lAcc = {0.f, 0.f, 0.f, 0.f}, lBcc = {0.f, 0.f, 0.f, 0.f};
#define P8_LSUM(P8V, ACC) ACC = __builtin_amdgcn_mfma_scale_f32_16x16x128_f8f6f4(P8V, ones8, ACC, 0, 0, 0, 0x7F7F7F7F, 0, 0x7F7F7F7F)
    if constexpr (A2_PIPE == 2) asm volatile("s_waitcnt vmcnt(4)" ::: "memory"); else A2_WAITV(1 < NT);
    __builtin_amdgcn_s_barrier();
    { P8_KA(0); P8_KB(0); P8_BIAS16(b16); pA0 = A2_MF8(k00, qA8[0], b16); pA1 = A2_MF8(k01, qA8[0], b16); pA0 = A2_MF8(k10, qA8[1], pA0); pA1 = A2_MF8(k11, qA8[1], pA1); }
    asm volatile("" : "+v"(pA0), "+v"(pA1)); A2_SBAR();
#define P8_TILE(S, t, FIRST) do { \
        \
      __builtin_amdgcn_s_barrier(); A2_SBAR(); \
      if ((t) + 2 < NT) { A2_DMA((t) + 2, ((S) + 2) % 4); } \
      { P8_KA(S); \
        if (!(FIRST)) { P8_VF(((S) + 3) % 4); A2_SBAR(); oB[0] = A2_MF8P(pb8, v0_, oB[0]); A2_SBAR(); P8_SMG(0, pA0, pA1, lA, pa8); A2_SBAR(); oB[1] = A2_MF8P(pb8, v1_, oB[1]); A2_SBAR(); } else { A2_SBAR(); P8_SMG(0, pA0, pA1, lA, pa8); A2_SBAR(); } \
        pB0 = A2_MF8(k00, qB8[0], b16); A2_SBAR(); P8_KB(S); P8_SMG(1, pA0, pA1, lA, pa8); A2_SBAR(); pB1 = A2_MF8(k01, qB8[0], b16); A2_SBAR(); P8_SMG(2, pA0, pA1, lA, pa8); A2_SBAR(); \
        pB0 = A2_MF8(k10, qB8[1], pB0); A2_SBAR(); P8_SMG(3, pA0, pA1, lA, pa8); A2_SBAR(); pB1 = A2_MF8(k11, qB8[1], pB1); } \
      asm volatile("" : "+v"(pB0), "+v"(pB1), "+v"(pa8), "+v"(oB[0]), "+v"(oB[1])); A2_SBAR(); \
        \
      A2_WAITV((t) + 2 < NT); __builtin_amdgcn_s_barrier(); A2_SBAR(); \
      { P8_VF(S); P8_KA(((S) + 1) % 4); A2_SBAR(); \
        oA[0] = A2_MF8P(pa8, v0_, oA[0]); A2_SBAR(); P8_SMG(0, pB0, pB1, lB, pb8); A2_SBAR(); oA[1] = A2_MF8P(pa8, v1_, oA[1]); A2_SBAR(); \
        pA0 = A2_MF8(k00, qA8[0], b16); A2_SBAR(); P8_KB(((S) + 1) % 4); P8_SMG(1, pB0, pB1, lB, pb8); A2_SBAR(); pA1 = A2_MF8(k01, qA8[0], b16); A2_SBAR(); P8_SMG(2, pB0, pB1, lB, pb8); A2_SBAR(); \
        pA0 = A2_MF8(k10, qA8[1], pA0); A2_SBAR(); P8_SMG(3, pB0, pB1, lB, pb8); A2_SBAR(); pA1 = A2_MF8(k11, qA8[1], pA1); } \
      asm volatile("" : "+v"(pA0), "+v"(pA1), "+v"(pb8), "+v"(oA[0]), "+v"(oA[1])); A2_SBAR(); \
    } while (0)
#define P8_TILE5(S, t, FIRST) do { \
      A2_WAITV((t) + 2 < NT); __builtin_amdgcn_s_barrier(); A2_SBAR(); \
      if ((t) + 3 < NT) { A2_DMA((t) + 3, ((S) + 3) % 5); } \
        \
      { P8_KA(S); \
        if (!(FIRST)) { P8_VF(((S) + 4) % 5); A2_SBAR(); oB[0] = A2_MF8P(pb8, v0_, oB[0]); A2_SBAR(); P8_EXH(0, pA0); A2_SBAR(); oB[1] = A2_MF8P(pb8, v1_, oB[1]); A2_SBAR(); P8_EXH(0, pA1); A2_SBAR(); P8_LSUM(pb8, lBcc); A2_SBAR(); } \
        else { A2_SBAR(); P8_EXH(0, pA0); P8_EXH(0, pA1); A2_SBAR(); } \
        P8_EXH(1, pA0); A2_SBAR(); \
        pB0 = A2_MF8(k00, qB8[0], b16); A2_SBAR(); P8_KB(S); P8_EXH(1, pA1); P8_PK(0, pA0, pA1, pa8); A2_SBAR(); \
        pB1 = A2_MF8(k01, qB8[0], b16); A2_SBAR(); P8_EXH(2, pA0); P8_PK(1, pA0, pA1, pa8); A2_SBAR(); \
        pB0 = A2_MF8(k10, qB8[1], pB0); A2_SBAR(); P8_EXH(2, pA1); A2_SBAR(); \
        pB1 = A2_MF8(k11, qB8[1], pB1); A2_SBAR(); P8_EXH(3, pA0); P8_PK(2, pA0, pA1, pa8); P8_EXH(3, pA1); A2_SBAR(); P8_PK(3, pA0, pA1, pa8); } \
      asm volatile("" : "+v"(pB0), "+v"(pB1), "+v"(pa8), "+v"(oB[0]), "+v"(oB[1]), "+v"(lBcc)); A2_SBAR(); \
      { P8_VF(S); P8_KA(((S) + 1) % 5); A2_SBAR(); \
        oA[0] = A2_MF8P(pa8, v0_, oA[0]); A2_SBAR(); P8_EXH(0, pB0); A2_SBAR(); oA[1] = A2_MF8P(pa8, v1_, oA[1]); A2_SBAR(); P8_EXH(0, pB1); A2_SBAR(); P8_LSUM(pa8, lAcc); A2_SBAR(); \
        P8_EXH(1, pB0); A2_SBAR(); \
        pA0 = A2_MF8(k00, qA8[0], b16); A2_SBAR(); P8_KB(((S) + 1) % 5); P8_EXH(1, pB1); P8_PK(0, pB0, pB1, pb8); A2_SBAR(); \
        pA1 = A2_MF8(k01, qA8[0], b16); A2_SBAR(); P8_EXH(2, pB0); P8_PK(1, pB0, pB1, pb8); A2_SBAR(); \
        pA0 = A2_MF8(k10, qA8[1], pA0); A2_SBAR(); P8_EXH(2, pB1); A2_SBAR(); \
        pA1 = A2_MF8(k11, qA8[1], pA1); A2_SBAR(); P8_EXH(3, pB0); P8_PK(2, pB0, pB1, pb8); P8_EXH(3, pB1); A2_SBAR(); P8_PK(3, pB0, pB1, pb8); } \
      asm volatile("" : "+v"(pA0), "+v"(pA1), "+v"(pb8), "+v"(oA[0]), "+v"(oA[1]), "+v"(lAcc)); A2_SBAR(); \
    } while (0)
    if constexpr (A2_PIPE == 2) {
#ifdef A2_PEEL
      P8_TILE5(0, 0, true); P8_TILE5(1, 1, false); P8_TILE5(2, 2, false); P8_TILE5(3, 3, false); P8_TILE5(4, 4, false);
      for (int t = 5; t + 4 < NT; t += 5) { P8_TILE5(0, t, false); P8_TILE5(1, t + 1, false); P8_TILE5(2, t + 2, false); P8_TILE5(3, t + 3, false); P8_TILE5(4, t + 4, false); }
#else
      for (int t = 0; t + 4 < NT; t += 5) { P8_TILE5(0, t, t == 0); P8_TILE5(1, t + 1, false); P8_TILE5(2, t + 2, false); P8_TILE5(3, t + 3, false); P8_TILE5(4, t + 4, false); }
#endif
      { P8_VF(4); oB[0] = A2_MF8P(pb8, v0_, oB[0]); oB[1] = A2_MF8P(pb8, v1_, oB[1]); P8_LSUM(pb8, lBcc); }
      { const int j_ = lane & 15, rg_ = lane >> 4;
        if (j_ < 2) {
#pragma unroll
          for (int r_ = 0; r_ < 4; ++r_) { ws[j_ * 16 + 4 * rg_ + r_] = lAcc[r_]; ws[32 + j_ * 16 + 4 * rg_ + r_] = lBcc[r_]; } }
        asm volatile("s_waitcnt lgkmcnt(0)" ::: "memory");
        lA = 0.5f * ws[r32]; lB = 0.5f * ws[32 + r32]; asm volatile("s_waitcnt lgkmcnt(0)" ::: "memory"); }
    } else {
    P8_TILE(0, 0, true); P8_TILE(1, 1, false); P8_TILE(2, 2, false); P8_TILE(3, 3, false);
    for (int t = 4; t + 3 < NT; t += 4) { P8_TILE(0, t, false); P8_TILE(1, t + 1, false); P8_TILE(2, t + 2, false); P8_TILE(3, t + 3, false); }
    { P8_VF(3); oB[0] = A2_MF8P(pb8, v0_, oB[0]); oB[1] = A2_MF8P(pb8, v1_, oB[1]); }
    }
    { auto rr = __builtin_amdgcn_permlane32_swap(__float_as_uint(lA), __float_as_uint(lA), false, false); lA = __uint_as_float(rr[0]) + __uint_as_float(rr[1]); }
    { auto rr = __builtin_amdgcn_permlane32_swap(__float_as_uint(lB), __float_as_uint(lB), false, false); lB = __uint_as_float(rr[0]) + __uint_as_float(rr[1]); }
#undef P8_TILE
#undef P8_TILE5
#undef P8_SMG
#undef P8_EXP
#undef P8_PK
#undef P8_EXH
#undef P8_LSUM
#undef P8_FIN
#undef P8_VF
#undef P8_KA
#undef P8_KB
#undef P8_BIAS16
#undef P8_LD
#undef P8_ADD
  } else {
#ifndef A2_NOSTAGGER
  if (wid >= 4 && ABL != 5) { A2_WAITV(true); __builtin_amdgcn_s_barrier(); }
#endif
#ifdef A2_PRIO
  if (wid >= 4) __builtin_amdgcn_s_setprio(1);
#endif
  int t = 0;
  for (; t + 3 < NT; t += 4) { A2_TILE(0, t); A2_TILE(1, t + 1); A2_TILE(2, t + 2); A2_TILE(3, t + 3); }
  if (t < NT) { A2_TILE(0, t); if (t + 1 < NT) { A2_TILE(1, t + 1); if (t + 2 < NT) { A2_TILE(2, t + 2); } } }
#ifndef A2_NOSTAGGER
  if (wid < 4 && ABL != 5) __builtin_amdgcn_s_barrier();
#endif
#ifdef A2_PRIO
  __builtin_amdgcn_s_setprio(0);
#endif
  }
#undef A2_MID
#undef A2_WAITV
#undef A2_TILE
#undef A2_MF8
#undef A2_MF8P
#undef A2_PV
#undef A2_PV2
#undef A2_PK
  if (SWA) { const float sk = sinkp[wid & 3] * LOG2E - ((F8 && FAST) ? P8_BIAS : 0.f); lA += __builtin_amdgcn_exp2f(FAST ? sk : sk - mA); lB += __builtin_amdgcn_exp2f(FAST ? sk : sk - mB); }
#ifdef A2_FORCE_FALLBACK
  if (FAST) { if (lane == 0) *flag = 1u; }
#else
  if (FAST) { bool bad = !(lA >= 1e-30f && lA <= 1e30f) || !(lB >= 1e-30f && lB <= 1e30f);
    if constexpr (F8) { float z = 0.f;
#pragma unroll
      for (int r = 0; r < 16; ++r) z += (oA[0][r] + oA[1][r] + oB[0][r] + oB[1][r]) * 0.f;
      bad = bad || !(z == 0.f); }
    if (__any(bad) && lane == 0) *flag = 1u; }
#endif
  if (hi == 0) { ws[r32] = lA; ws[32 + r32] = lB; }
  asm volatile("s_waitcnt lgkmcnt(0)" ::: "memory");
  int hi_e = hi, r32_e = r32; asm volatile("" : "+v"(hi_e), "+v"(r32_e));
#pragma unroll
  for (int blk = 0; blk < 2; ++blk) {
    const int rbase = wrow0 + blk * 32;
    if (rbase < rows_valid) {
#pragma unroll
      for (int r = 0; r < 16; ++r) { const int orow = crow(r, hi_e); const float il = __builtin_amdgcn_rcpf(ws[blk * 32 + orow]);
        if constexpr (SWA) { unsigned char* op = (unsigned char*)Ob + (size_t)(rbase + orow) * DM + r32_e;
          const float il16 = il * 16.f; op[0] = f2fp8((blk ? oB[0][r] : oA[0][r]) * il16); op[32] = f2fp8((blk ? oB[1][r] : oA[1][r]) * il16); }
        else { bf16_t* op = Ob + (size_t)(rbase + orow) * DM + r32_e;
        op[0] = f2bf((blk ? oB[0][r] : oA[0][r]) * il); op[32] = f2bf((blk ? oB[1][r] : oA[1][r]) * il); } }
    }
  }
  asm volatile("s_waitcnt vmcnt(0) lgkmcnt(0)" ::: "memory");
  __builtin_amdgcn_s_barrier();
  bool ok = true;
  if (FAST) { ok = (*flag == 0u); asm volatile("s_waitcnt lgkmcnt(0)" ::: "memory"); __builtin_amdgcn_s_barrier(); }
  return ok;
#undef A2_DMA
#undef A2_DMA8
}
#undef A2_SBAR
}

#ifdef PROBE_RND
__device__ __forceinline__ void phase_rnd(Frame& F, size_t off, size_t nbytes) {
  const Params P = lds_params(F);
  u32x4* base = (u32x4*)(P.ws + off); const size_t n = nbytes / 16;
  for (size_t i = (size_t)F.bid * NTHREADS + F.tid; i < n; i += (size_t)F.G * NTHREADS) {
    u32x4 w = base[i]; unsigned* wp = (unsigned*)&w;
#pragma unroll
    for (int j = 0; j < 4; ++j) { const float a = fp8rt(bf2f((bf16_t)(wp[j] & 0xffff)), 16.f), b = fp8rt(bf2f((bf16_t)(wp[j] >> 16)), 16.f); wp[j] = pk2bf(a, b); }
    base[i] = w; }
}
#endif
#ifdef PROBE_UB
__device__ __forceinline__ void phase_ubench(Frame& F) {
  const Params P = lds_params(F);
  pg8::v8i32 a, b; for (int j = 0; j < 8; ++j) { a[j] = 0x38383838 + F.lane; b[j] = 0x30303030 + j; }
  att::f32x16 c0 = {}, c1 = {}; float e[16];
#pragma unroll
  for (int j = 0; j < 16; ++j) e[j] = -0.001f * (float)(F.lane + j);
#pragma unroll 1
  for (int i = 0; i < 2048; ++i) {
    if (PROBE_UB & 1) c0 = __builtin_amdgcn_mfma_scale_f32_32x32x64_f8f6f4(a, b, c0, 0, 0, 0, 0x7F7F7F7F, 0, 0x7F7F7F7F);
    __builtin_amdgcn_sched_barrier(0);
    if (PROBE_UB & 2) {
#pragma unroll
      for (int j = 0; j < 8; ++j) e[j] = (PROBE_UB & 4) ? e[j] + 1.0009765625f : __builtin_amdgcn_exp2f(e[j]); }
    __builtin_amdgcn_sched_barrier(0);
    if (PROBE_UB & 1) c1 = __builtin_amdgcn_mfma_scale_f32_32x32x64_f8f6f4(a, b, c1, 0, 0, 0, 0x7F7F7F7F, 0, 0x7F7F7F7F);
    __builtin_amdgcn_sched_barrier(0);
    if (PROBE_UB & 2) {
#pragma unroll
      for (int j = 8; j < 16; ++j) e[j] = (PROBE_UB & 4) ? e[j] + 1.0009765625f : __builtin_amdgcn_exp2f(e[j]); }
    __builtin_amdgcn_sched_barrier(0);
    asm volatile("" : "+v"(c0), "+v"(c1));
  }
  float r = 0.f;
#pragma unroll
  for (int j = 0; j < 16; ++j) r += e[j] + c0[j] + c1[j];
  ((float*)(P.ws + WS_PB))[(size_t)F.bid * NTHREADS + F.tid] = r;
}
#endif
__device__ __forceinline__ void phase_attn_mla(Frame& F) {
  const Params P = lds_params(F);
  const bf16_t* Q = (const bf16_t*)(P.ws + WS_QKV + OFF_Q); const bf16_t* QC = (const bf16_t*)(P.ws + WS_QKV + OFF_QC);
  const char* Kimg = (const char*)(P.ws + WS_QKV + OFF_K); const char* Vimg = (const char*)(P.ws + WS_QKV + OFF_V);
  bf16_t* CAT = (bf16_t*)(P.ws + WS_CAT);
  const int v = (F.G % 8 == 0) ? (F.bid % 8) * (F.G / 8) + F.bid / 8 : F.bid;
  for (int U = v; U < 512 + 16; U += F.G) {
    if (U < 512) { const int bh = U >> 5, qb = U & 31, b = bh >> 3, h = bh & 7;
      const bf16_t* Qu = (const bf16_t*)((const char*)Q + ((size_t)bh * SEQ + qb * 512) * 96);
      if (!att2::attn_unit<true, 0, 96, false, true>(Qu, 512, Kimg + (size_t)bh * NKEY * 96, Vimg + (size_t)bh * NKEY * 64,
                                 CAT + ((size_t)b * SEQ + qb * 512) * DM + 512 + h * 64, NKEY / 64, F.lds))
        att2::attn_unit<false, 0, 96, false, true>(Qu, 512, Kimg + (size_t)bh * NKEY * 96, Vimg + (size_t)bh * NKEY * 64,
                               CAT + ((size_t)b * SEQ + qb * 512) * DM + 512 + h * 64, NKEY / 64, F.lds);
    } else { const int bh = U - 512, b = bh >> 3, h = bh & 7;
      att2::attn_unit<false, 0, 96, false, true>((const bf16_t*)((const char*)QC + (size_t)bh * CTX * 96), 256, Kimg + (size_t)bh * NKEY * 96, Vimg + (size_t)bh * NKEY * 64,
                             CAT + ((size_t)NLAT + b * CTX) * DM + 512 + h * 64, CTX / 64, F.lds);
    }
  }
}
#ifdef PROBE_ATT_ABL
__device__ __forceinline__ void phase_attn_probe(Frame& F) {
  const Params P = lds_params(F);
  const bf16_t* Q = (const bf16_t*)(P.ws + WS_QKV + OFF_Q);
  const char* Kimg = (const char*)(P.ws + WS_QKV + OFF_K); const char* Vimg = (const char*)(P.ws + WS_QKV + OFF_V);
  bf16_t* SCR = (bf16_t*)(P.ws + WS_PB);
  const int v = (F.G % 8 == 0) ? (F.bid % 8) * (F.G / 8) + F.bid / 8 : F.bid;
  for (int U = v; U < 512; U += F.G) { const int bh = U >> 5, qb = U & 31, b = bh >> 3, h = bh & 7;
    att2::attn_unit<true, PROBE_ATT_ABL, 96, false, true>((const bf16_t*)((const char*)Q + ((size_t)bh * SEQ + qb * 512) * 96), 512, Kimg + (size_t)bh * NKEY * 96, Vimg + (size_t)bh * NKEY * 64,
                                         SCR + ((size_t)b * SEQ + qb * 512) * DM + 512 + h * 64, NKEY / 64, F.lds); }
}
#endif
__device__ __forceinline__ void phase_attn_swa(Frame& F) {
  const Params P = lds_params(F);
  const bf16_t* Q2 = (const bf16_t*)(P.ws + WS_QKV + OFF_Q2); const char* K2 = (const char*)(P.ws + WS_QKV + OFF_K2); const char* V2 = (const char*)(P.ws + WS_QKV + OFF_V2);
  bf16_t* CAT = (bf16_t*)(P.ws + WS_CAT); const float* sink = P.in[17];
  const int v = (F.G % 8 == 0) ? (F.bid % 8) * (F.G / 8) + F.bid / 8 : F.bid;
  for (int U = v; U < NB * 4 * 128; U += F.G) {
    const int bk = U >> 7, qb = U & 127, b = bk >> 2, kvh = bk & 3, q0 = qb * 128;
    int lo = q0 - 128, hi2 = q0 + 256; if (lo < 0) lo = 0; if (hi2 > SEQ) hi2 = SEQ;
    const int lt0 = lo >> 6, NT = 4 + ((hi2 - lo) >> 6);
    const bf16_t* Qb = (const bf16_t*)((const char*)Q2 + ((size_t)(b * 16 + kvh * 4) * SEQ + q0) * 64); const char* Kb = K2 + (size_t)bk * NKEY * 64; const char* Vb = V2 + (size_t)bk * NKEY * 64;
    bf16_t* Ob = (bf16_t*)((unsigned char*)CAT + ((size_t)b * SEQ + q0) * DM + kvh * 256);
    if (!att2::attn_unit<true, 0, 64, true, true>(Qb, 128, Kb, Vb, Ob, NT, F.lds, lt0, q0, sink + kvh * 4))
      att2::attn_unit<false, 0, 64, true, true>(Qb, 128, Kb, Vb, Ob, NT, F.lds, lt0, q0, sink + kvh * 4);
  }
}
__device__ __forceinline__ float wave_sum(float v) {
#pragma unroll
  for (int o = 1; o < 64; o <<= 1) v += __shfl_xor(v, o);
  return v;
}
__device__ __forceinline__ void row_load(const float* row, int lane, f32x4 (&x)[4]) {
#pragma unroll
  for (int j = 0; j < 4; ++j) x[j] = *(const f32x4*)(row + 4 * lane + 256 * j);
}
__device__ __forceinline__ float row_ssq(const f32x4 (&x)[4]) {
  float s = 0.f;
#pragma unroll
  for (int j = 0; j < 4; ++j) s += (x[j][0] * x[j][0] + x[j][1] * x[j][1]) + (x[j][2] * x[j][2] + x[j][3] * x[j][3]);
  return wave_sum(s);
}
__device__ __forceinline__ void xs_load(const bf16_t* xsb, const float* xcx, int r, int lane, f32x4 (&x)[4]) {
  if (r < NLAT) { const bf16_t* p = xsb + (size_t)r * DM + 4 * lane;
#pragma unroll
    for (int j = 0; j < 4; ++j) { const u32x2 w = *(const u32x2*)(p + 256 * j);
      x[j] = (f32x4){bf2f((bf16_t)(w.x & 0xffff)), bf2f((bf16_t)(w.x >> 16)), bf2f((bf16_t)(w.y & 0xffff)), bf2f((bf16_t)(w.y >> 16))}; } }
  else row_load(xcx + (size_t)(r - NLAT) * DM, lane, x);
}
__device__ __forceinline__ void row_norm_mod_fp8(f32x4 (&x)[4], float inv, const float* g, const float* sh, const float* sc, unsigned char* orow, int lane) {
#pragma unroll
  for (int j = 0; j < 4; ++j) {
    const int c = 4 * lane + 256 * j;
    const f32x4 gg = *(const f32x4*)(g + c), s1 = *(const f32x4*)(sh + c), s2 = *(const f32x4*)(sc + c);
    x[j] = x[j] * inv * gg * (s2 + 1.f) + s1;
    *(unsigned*)(orow + c) = pk4fp8(x[j][0], x[j][1], x[j][2], x[j][3]);
  }
}
__device__ __forceinline__ void row_norm_mod(f32x4 (&x)[4], float inv, const float* g, const float* sh, const float* sc, bf16_t* orow, int lane) {
#pragma unroll
  for (int j = 0; j < 4; ++j) {
    const int c = 4 * lane + 256 * j;
    const f32x4 gg = *(const f32x4*)(g + c), s1 = *(const f32x4*)(sh + c), s2 = *(const f32x4*)(sc + c);
    x[j] = x[j] * inv * gg * (s2 + 1.f) + s1;
    u32x2 w; w.x = pk2bf(x[j][0], x[j][1]); w.y = pk2bf(x[j][2], x[j][3]);
    *(u32x2*)(orow + c) = w;
  }
}

__device__ __forceinline__ void phase_norm1_l0(Frame& F) {
  const Params P = lds_params(F);
  const float* x = P.in[0]; const float* ctx = P.in[2]; const float* g = P.in[6]; const float* modv = (const float*)(P.ws + WS_MODV);
  bf16_t* HB = (bf16_t*)(P.ws + WS_HB);
  for (int row = F.bid * 8 + F.wave; row < NROW; row += F.G * 8) {
    const float* src; int v;
    if (row < NLAT) { src = x + (size_t)row * DM; v = row / SEQ; } else { src = ctx + (size_t)(row - NLAT) * DM; v = 2; }
    f32x4 xv[4]; row_load(src, F.lane, xv);
    const float inv = rsqrtf(row_ssq(xv) * (1.f / DM) + EPS);
    row_norm_mod(xv, inv, g, modv + v * NMOD, modv + v * NMOD + DM, HB + (size_t)row * DM, F.lane);
  }
}

__device__ __forceinline__ void phase_norm2(Frame& F, int layer) {
  const Params P = lds_params(F);
  const float* g = P.in[7] + layer * DM; const float* modl = (const float*)(P.ws + WS_MODV) + (size_t)layer * 3 * NMOD;
  const float* rw = P.in[19] + (size_t)layer * DM * NE;
  const bf16_t* xsb = (const bf16_t*)(P.ws + WS_XSB); const float* xcx = (const float*)(P.ws + WS_XC);
  bf16_t* HB = (bf16_t*)(P.ws + WS_HB); float* aff = (float*)(P.ws + WS_AFF);
  const int nrows = layer == 0 ? NROW : NLAT, lane = F.lane;
  __syncthreads();
  for (int f = F.tid; f < DM * 4; f += NTHREADS) { const int c = f >> 2, q = f & 3, j = c >> 8, ln = (c & 255) >> 2, i = c & 3;
    *(LAS f32x4*)(F.lds + ((4 * j + i) * 4 + q) * 1024 + 16 * ln) = *(const f32x4*)(rw + 4 * f); }
  __syncthreads();
  const unsigned wl = (unsigned)(uintptr_t)(F.lds + 16 * lane);
  const int stride = F.G * 8;
  int row = F.bid * 8 + F.wave;
  f32x4 xv[4], xn[4], xm[4];
  if (row < nrows) xs_load(xsb, xcx, row, lane, xv);
  if (row + stride < nrows) xs_load(xsb, xcx, row + stride, lane, xn);
  int cv = -1; f32x4 ga[4], sb[4];
  while (row < nrows) {
    const int nrow = row + stride, mrow = nrow + stride;
    if (mrow < nrows) xs_load(xsb, xcx, mrow, lane, xm);
    const int v = row < NLAT ? row / SEQ : 2;
    if (v != cv) { cv = v; const float* shp = modl + v * NMOD + 3 * DM; const float* scp = shp + DM;
#pragma unroll
      for (int j = 0; j < 4; ++j) { const int c = 4 * lane + 256 * j; ga[j] = *(const f32x4*)(g + c) * (*(const f32x4*)(scp + c) + 1.f); sb[j] = *(const f32x4*)(shp + c); } }
    const float inv = rsqrtf(row_ssq(xv) * (1.f / DM) + EPS);
    { unsigned char* orow = (unsigned char*)HB + (size_t)row * DM;
#pragma unroll
      for (int j = 0; j < 4; ++j) { xv[j] = xv[j] * inv * ga[j] + sb[j]; *(unsigned*)(orow + 4 * lane + 256 * j) = pk4fp8(xv[j][0], xv[j][1], xv[j][2], xv[j][3]); } }
    typedef float f32x2 __attribute__((ext_vector_type(2)));
    f32x2 pp[8];
#pragma unroll
    for (int e = 0; e < 8; ++e) pp[e] = (f32x2){0.f, 0.f};
#pragma unroll
    for (int j = 0; j < 4; ++j) {
      unsigned wb = wl + j * 16384; asm volatile("" : "+v"(wb));
#pragma unroll
      for (int i = 0; i < 4; ++i)
#pragma unroll
        for (int q = 0; q < 4; ++q) {
          const f32x4 w = *(const LAS f32x4*)(wb + (i * 4 + q) * 1024); const f32x2 hv = (f32x2){xv[j][i], xv[j][i]};
          pp[2 * q] = __builtin_elementwise_fma(hv, (f32x2){w[0], w[1]}, pp[2 * q]); pp[2 * q + 1] = __builtin_elementwise_fma(hv, (f32x2){w[2], w[3]}, pp[2 * q + 1]);
        }
      __builtin_amdgcn_sched_barrier(0);
    }
    float p[16];
#pragma unroll
    for (int e = 0; e < 8; ++e) { p[2 * e] = pp[e][0]; p[2 * e + 1] = pp[e][1]; }
    float q8[8];
#pragma unroll
    for (int e = 0; e < 8; ++e) { auto rr = __builtin_amdgcn_permlane32_swap(__float_as_uint(p[e]), __float_as_uint(p[e + 8]), false, false); q8[e] = __uint_as_float(rr[0]) + __uint_as_float(rr[1]); }
    float q4[4];
#pragma unroll
    for (int e = 0; e < 4; ++e) { const bool up = (lane & 16) != 0; const float snd = up ? q8[e] : q8[e + 4], keep = up ? q8[e + 4] : q8[e]; q4[e] = keep + __shfl_xor(snd, 16); }
    float q2[2];
#pragma unroll
    for (int e = 0; e < 2; ++e) { const bool up = (lane & 8) != 0; const float snd = up ? q4[e] : q4[e + 2], keep = up ? q4[e + 2] : q4[e]; q2[e] = keep + __shfl_xor(snd, 8); }
    float lg; { const bool up = (lane & 4) != 0; const float snd = up ? q2[0] : q2[1], keep = up ? q2[1] : q2[0]; lg = keep + __shfl_xor(snd, 4); }
    lg += __shfl_xor(lg, 2); lg += __shfl_xor(lg, 1);
    float mx = lg;
    mx = fmaxf(mx, __shfl_xor(mx, 4)); mx = fmaxf(mx, __shfl_xor(mx, 8)); mx = fmaxf(mx, __shfl_xor(mx, 16)); mx = fmaxf(mx, __shfl_xor(mx, 32));
    const float ex = expf(lg - mx);
    float sum = ex;
    sum += __shfl_xor(sum, 4); sum += __shfl_xor(sum, 8); sum += __shfl_xor(sum, 16); sum += __shfl_xor(sum, 32);
    if ((lane & 3) == 0) {
      const float a = ex / sum; const int e = 8 * (lane >> 5) + 4 * ((lane >> 4) & 1) + 2 * ((lane >> 3) & 1) + ((lane >> 2) & 1);
      if (row < NLAT) { const int b = row / SEQ, t = row % SEQ; aff[((size_t)(b * NE + e)) * SEQ + t] = a; }
      else { const int jj = row - NLAT, b = jj / CTX, t = jj % CTX; aff[(size_t)NB * NE * SEQ + ((size_t)(b * NE + e)) * CTX + t] = a; }
    }
#pragma unroll
    for (int j = 0; j < 4; ++j) { xv[j] = xn[j]; xn[j] = xm[j]; }
    row = nrow;
  }
  __syncthreads();
}

__device__ __forceinline__ void phase_preup(Frame& F) {
  const Params P = lds_params(F);
  const bf16_t* Pm = (const bf16_t*)(P.ws + WS_PB); bf16_t* QKN = (bf16_t*)(P.ws + WS_QN); bf16_t* CAT = (bf16_t*)(P.ws + WS_CAT);
  bf16_t* Kk = (bf16_t*)(P.ws + WS_QKV + OFF_K); const float* tab = (const float*)(P.ws + WS_ROPE);
  const float* cw = P.in[9]; const float* cb = P.in[10]; const float* qg = P.in[11]; const float* kg = P.in[13];
  const int lane = F.lane;
  for (int row = F.bid * 8 + F.wave; row < NROW; row += F.G * 8) {
    const bf16_t* pr = Pm + (size_t)row * PPITCH;
    const bool lat = row < NLAT; int b, pos, t = 0, lo, hi;
    if (lat) { b = row / SEQ; t = row % SEQ; pos = CTX + t; lo = b * SEQ; hi = lo + SEQ; } else { const int j = row - NLAT; b = j / CTX; pos = j % CTX; lo = NLAT + b * CTX; hi = lo + CTX; }
    { const u32x2 qw = *(const u32x2*)(pr + 1536 + 4 * lane); const unsigned kw = *(const unsigned*)(pr + 1792 + 2 * lane);
      const float q0 = bf2f((bf16_t)(qw.x & 0xffff)), q1 = bf2f((bf16_t)(qw.x >> 16)), q2 = bf2f((bf16_t)(qw.y & 0xffff)), q3 = bf2f((bf16_t)(qw.y >> 16));
      const float k0 = bf2f((bf16_t)(kw & 0xffff)), k1 = bf2f((bf16_t)(kw >> 16));
      const float sq = wave_sum((q0 * q0 + q1 * q1) + (q2 * q2 + q3 * q3)), sk = wave_sum(k0 * k0 + k1 * k1);
      const float iq = rsqrtf(sq * (1.f / 256.f) + EPS), ik = rsqrtf(sk * (1.f / 128.f) + EPS);
      const f32x4 gq = *(const f32x4*)(qg + 4 * lane); const float gk0 = kg[2 * lane], gk1 = kg[2 * lane + 1];
      unsigned char* qrow = (unsigned char*)QKN + (size_t)row * 512;
      *(unsigned*)(qrow + 4 * lane) = pk4fp8(q0 * iq * gq[0], q1 * iq * gq[1], q2 * iq * gq[2], q3 * iq * gq[3]);
      *(unsigned short*)(qrow + 256 + 2 * lane) = (unsigned short)__builtin_amdgcn_cvt_pk_fp8_f32(k0 * ik * gk0, k1 * ik * gk1, 0, false);
      if (lane < 32) *(unsigned*)(qrow + 384 + 4 * lane) = 0u; }
    { const int p = lane & 15, a = p >> 3, ii = p & 7, hq = lane >> 4;
      const float x1 = bf2f(pr[1920 + a * 16 + ii]), x2 = bf2f(pr[1920 + a * 16 + 8 + ii]);
      float cs = 1.f, sn = 0.f;
      if (lat) { const int pp = a == 0 ? (t >> 6) : (t & 63); cs = tab[pp * 8 + ii]; sn = tab[2048 + pp * 8 + ii]; }
      const unsigned short w = (unsigned short)__builtin_amdgcn_cvt_pk_fp8_f32(x1 * cs - x2 * sn, x1 * sn + x2 * cs, 0, false);
#pragma unroll
      for (int hh = 0; hh < 2; ++hh) { const int h = 2 * hq + hh;
        *(unsigned short*)((char*)Kk + (size_t)(b * 8 + h) * NKEY * 96 + (size_t)(pos >> 6) * 6144 + (4 + (p >> 3)) * 1024 + (pos & 63) * 16 + (p & 7) * 2) = w; } }
    { const int c = 8 * lane;
      const u32x4 gbv = *(const u32x4*)(pr + c), gc1 = *(const u32x4*)(pr + 512 + c), u1 = *(const u32x4*)(pr + 1024 + c);
      u32x4 gc0 = {0u, 0u, 0u, 0u}, u0 = gc0, gc2 = gc0, u2 = gc0;
      if (row - 1 >= lo) { gc0 = *(const u32x4*)(pr - PPITCH + 512 + c); u0 = *(const u32x4*)(pr - PPITCH + 1024 + c); }
      if (row + 1 < hi) { gc2 = *(const u32x4*)(pr + PPITCH + 512 + c); u2 = *(const u32x4*)(pr + PPITCH + 1024 + c); }
      float y[8];
#pragma unroll
      for (int i = 0; i < 8; ++i) {
        const int sh = (i & 1) * 16; const int wi = i >> 1;
        const float z0 = bf2f((bf16_t)((gc0[wi] >> sh) & 0xffff)) * bf2f((bf16_t)((u0[wi] >> sh) & 0xffff));
        const float z1 = bf2f((bf16_t)((gc1[wi] >> sh) & 0xffff)) * bf2f((bf16_t)((u1[wi] >> sh) & 0xffff));
        const float z2 = bf2f((bf16_t)((gc2[wi] >> sh) & 0xffff)) * bf2f((bf16_t)((u2[wi] >> sh) & 0xffff));
        const float yy = z0 * cw[c + i] + z1 * cw[512 + c + i] + z2 * cw[1024 + c + i] + cb[c + i];
        y[i] = bf2f((bf16_t)((gbv[wi] >> sh) & 0xffff)) * yy;
      }
      u32x4 w; w.x = pk2bf(y[0], y[1]); w.y = pk2bf(y[2], y[3]); w.z = pk2bf(y[4], y[5]); w.w = pk2bf(y[6], y[7]);
      *(u32x4*)(CAT + (size_t)row * DM + c) = w; }
  }
}

template <bool PROBE = false>
__device__ __forceinline__ void phase_combine(Frame& F, int layer) {
  const Params P = lds_params(F);
  const float* modv = (const float*)(P.ws + WS_MODV); const float* modl = modv + (size_t)layer * 3 * NMOD;
  const bf16_t* YE = (const bf16_t*)(P.ws + WS_QKV); const int* slot = (const int*)(P.ws + WS_SLOT);
  bf16_t* xsb = (bf16_t*)(P.ws + WS_XSB); float* xcx = (float*)(P.ws + WS_XC); bf16_t* HB = (bf16_t*)(P.ws + WS_HB);
  const int nrows = layer == 0 ? NROW : NLAT, lane = F.lane, stride = F.G * 8;
#define CB_SLOT(r) (((r) < NLAT) ? slot[((size_t)(((r) / SEQ) * NE + (lane & 15))) * SEQ + (r) % SEQ] \
                                 : slot[(size_t)NB * NE * SEQ + ((size_t)((((r) - NLAT) / CTX) * NE + (lane & 15))) * CTX + ((r) - NLAT) % CTX])
  int row = F.bid * 8 + F.wave;
  f32x4 xv[4], xn[4]; int sl = -1, sln = -1;
  int cv = -1; f32x4 g2v[4], ga[4], sb[4];
  if (row < nrows) { sl = CB_SLOT(row); xs_load(xsb, xcx, row, lane, xv); }
  while (row < nrows) {
    const int nrow = row + stride;
    if (nrow < nrows) { sln = CB_SLOT(nrow); xs_load(xsb, xcx, nrow, lane, xn); }
    int v; size_t ybase; int cap;
    if (row < NLAT) { const int b = row / SEQ; v = b; cap = CAP_L; ybase = (size_t)(b * NE) * CAP_L; }
    else { const int b = (row - NLAT) / CTX; v = 2; cap = CAP_C; ybase = (size_t)32 * CAP_L + (size_t)(b * NE) * CAP_C; }
    f32x4 acc[4];
#pragma unroll
    for (int j = 0; j < 4; ++j) acc[j] = (f32x4){0.f, 0.f, 0.f, 0.f};
    unsigned emask = (unsigned)(__ballot(sl >= 0) & 0xFFFFull);
    while (emask) {
      int ee[4]; u32x2 w[4][4];
#pragma unroll
      for (int k = 0; k < 4; ++k) { ee[k] = emask ? __builtin_ctz(emask) : -1; if (emask) emask &= emask - 1; }
#pragma unroll
      for (int k = 0; k < 4; ++k) if (ee[k] >= 0) { const int s_ = __shfl(sl, ee[k]); const bf16_t* yr = YE + (ybase + (size_t)ee[k] * cap + s_) * DM;
#pragma unroll
        for (int j = 0; j < 4; ++j) w[k][j] = *(const u32x2*)(yr + 4 * lane + 256 * j); }
#pragma unroll
      for (int k = 0; k < 4; ++k) if (ee[k] >= 0) {
#pragma unroll
        for (int j = 0; j < 4; ++j) { acc[j][0] += bf2f((bf16_t)(w[k][j].x & 0xffff)); acc[j][1] += bf2f((bf16_t)(w[k][j].x >> 16)); acc[j][2] += bf2f((bf16_t)(w[k][j].y & 0xffff)); acc[j][3] += bf2f((bf16_t)(w[k][j].y >> 16)); } }
    }
    if (v != cv) { cv = v;
      const float* m1 = modv + 3 * NMOD + v * NMOD;
#pragma unroll
      for (int j = 0; j < 4; ++j) { const int c = 4 * lane + 256 * j; g2v[j] = *(const f32x4*)(modl + v * NMOD + 5 * DM + c);
        if (layer == 0) { ga[j] = *(const f32x4*)(P.in[6] + DM + c) * (*(const f32x4*)(m1 + DM + c) + 1.f); sb[j] = *(const f32x4*)(m1 + c); }
        else ga[j] = *(const f32x4*)(P.in[23] + c); } }
#pragma unroll
    for (int j = 0; j < 4; ++j) xv[j] = xv[j] + g2v[j] * acc[j];
    const float inv = rsqrtf(row_ssq(xv) * (1.f / DM) + EPS);
    if (layer == 0) {
      if (PROBE) { }
      else if (row < NLAT) {
#pragma unroll
        for (int j = 0; j < 4; ++j) { u32x2 w; w.x = pk2bf(xv[j][0], xv[j][1]); w.y = pk2bf(xv[j][2], xv[j][3]); *(u32x2*)(xsb + (size_t)row * DM + 4 * lane + 256 * j) = w; } }
      else {
#pragma unroll
        for (int j = 0; j < 4; ++j) *(f32x4*)(xcx + (size_t)(row - NLAT) * DM + 4 * lane + 256 * j) = xv[j]; }
#pragma unroll
      for (int j = 0; j < 4; ++j) xv[j] = xv[j] * inv * ga[j] + sb[j];
      if (PROBE) { }
      else if (row < NLAT) { unsigned char* orow = (unsigned char*)HB + (size_t)row * DM;
#pragma unroll
        for (int j = 0; j < 4; ++j) *(unsigned*)(orow + 4 * lane + 256 * j) = pk4fp8(xv[j][0], xv[j][1], xv[j][2], xv[j][3]); }
      else { bf16_t* orow = HB + (size_t)row * DM;
#pragma unroll
        for (int j = 0; j < 4; ++j) { u32x2 w; w.x = pk2bf(xv[j][0], xv[j][1]); w.y = pk2bf(xv[j][2], xv[j][3]); *(u32x2*)(orow + 4 * lane + 256 * j) = w; } }
    } else {
      float* op = (PROBE ? (float*)(P.ws + WS_PB) : P.out) + (size_t)row * DM;
#pragma unroll
      for (int j = 0; j < 4; ++j) *(f32x4*)(op + 4 * lane + 256 * j) = xv[j] * inv * ga[j];
    }
#pragma unroll
    for (int j = 0; j < 4; ++j) xv[j] = xn[j];
    sl = sln; row = nrow;
  }
#undef CB_SLOT
}

__device__ __forceinline__ unsigned block_sum_u(unsigned v, LAS unsigned* red, int par, int wave, int lane) {
#pragma unroll
  for (int o = 1; o < 64; o <<= 1) v += __shfl_xor(v, o);
  if (lane == 0) red[par * 8 + wave] = v;
  __syncthreads();
  unsigned s = 0;
#pragma unroll
  for (int i = 0; i < 8; ++i) s += red[par * 8 + i];
  return s;
}
__device__ __forceinline__ void phase_topk(Frame& F, int layer) {
  const Params P = lds_params(F);
  const float* aff = (const float*)(P.ws + WS_AFF); int* sidx = (int*)(P.ws + WS_SIDX); float* sg = (float*)(P.ws + WS_SG); int* slot = (int*)(P.ws + WS_SLOT);
  LAS unsigned* red = (LAS unsigned*)F.lds;
  const int nprob = layer == 0 ? 64 : 32, tid = F.tid, lane = F.lane, wave = F.wave;
  for (int pb = F.bid; pb < nprob; pb += F.G) {
    const bool isctx = pb >= 32; const int ge = isctx ? pb - 32 : pb, n = isctx ? CTX : SEQ, cap = isctx ? CAP_C : CAP_L;
    const size_t aoff = isctx ? (size_t)NB * NE * SEQ + (size_t)ge * CTX : (size_t)ge * SEQ;
    const size_t soff = isctx ? (size_t)NB * NE * CAP_L + (size_t)ge * CAP_C : (size_t)ge * CAP_L;
    unsigned key[32];
#pragma unroll
    for (int j = 0; j < 8; ++j) {
      u32x4 w = {0u, 0u, 0u, 0u};
      if (32 * tid + 4 * j < n) w = *(const u32x4*)(aff + aoff + 32 * tid + 4 * j);
      key[4 * j] = w.x; key[4 * j + 1] = w.y; key[4 * j + 2] = w.z; key[4 * j + 3] = w.w;
    }
    __syncthreads();
    unsigned T = 0u; int par = 0;
    for (int bit = 30; bit >= 0; --bit) {
      const unsigned cand = T | (1u << bit);
      unsigned c = 0;
#pragma unroll
      for (int i = 0; i < 32; ++i) c += (key[i] >= cand) ? 1u : 0u;
      const unsigned tot = block_sum_u(c, red, par, wave, lane); par = (par + 1) & 3;
      if (tot >= (unsigned)cap) T = cand;
    }
    unsigned cg = 0, ce = 0;
#pragma unroll
    for (int i = 0; i < 32; ++i) { cg += (key[i] > T) ? 1u : 0u; ce += (key[i] == T) ? 1u : 0u; }
    const unsigned ngt = block_sum_u(cg, red, par, wave, lane); par = (par + 1) & 3;
    const unsigned need_eq = (unsigned)cap - ngt;
    unsigned pk = cg | (ce << 16), inc = pk;
#pragma unroll
    for (int o = 1; o < 64; o <<= 1) { const unsigned up = __shfl_up(inc, o); if (lane >= o) inc += up; }
    LAS unsigned* wtot = red + 32;
    __syncthreads();
    if (lane == 63) wtot[wave] = inc;
    __syncthreads();
    unsigned base = 0;
#pragma unroll
    for (int i = 0; i < 8; ++i) base += (i < wave) ? wtot[i] : 0u;
    unsigned excl = base + inc - pk;
    unsigned g_before = excl & 0xffffu, e_before = excl >> 16;
    int sl[32];
#pragma unroll
    for (int i = 0; i < 32; ++i) {
      const bool gt = key[i] > T, eq = key[i] == T;
      const bool take = gt || (eq && e_before < need_eq);
      const unsigned s = g_before + (e_before < need_eq ? e_before : need_eq);
      sl[i] = take ? (int)s : -1;
      if (take) { sidx[soff + s] = 32 * tid + i; sg[soff + s] = __uint_as_float(key[i]); }
      g_before += gt ? 1u : 0u; e_before += eq ? 1u : 0u;
    }
    if (32 * tid < n) {
#pragma unroll
      for (int j = 0; j < 8; ++j) { int4 w; w.x = sl[4 * j]; w.y = sl[4 * j + 1]; w.z = sl[4 * j + 2]; w.w = sl[4 * j + 3]; *(int4*)(slot + aoff + 32 * tid + 4 * j) = w; }
    }
    __syncthreads();
  }
  __syncthreads();
  if (F.G > 32) { if (F.bid >= 32) { cvt_run<true>(P, (LAS float*)(F.lds + 1024), layer, F.bid - 32, F.G - 32, CVT_MOE);
#ifdef PROBE_CVT2
      __syncthreads(); cvt_run<true>(P, (LAS float*)(F.lds + 1024), layer, F.bid - 32, F.G - 32, CVT_MOE);
#endif
  } }
  else cvt_run<true>(P, (LAS float*)(F.lds + 1024), layer, F.bid, F.G, CVT_MOE);
}

__device__ __forceinline__ void rope4(f32x4& v0, f32x4& v1, const f32x4 cs, const f32x4 sn) {
  f32x4 w0, w1;
  w0[0] = v0[0] * cs[0] - v0[1] * sn[0]; w0[1] = v0[0] * sn[0] + v0[1] * cs[0]; w0[2] = v0[2] * cs[1] - v0[3] * sn[1]; w0[3] = v0[2] * sn[1] + v0[3] * cs[1];
  w1[0] = v1[0] * cs[2] - v1[1] * sn[2]; w1[1] = v1[0] * sn[2] + v1[1] * cs[2]; w1[2] = v1[2] * cs[3] - v1[3] * sn[3]; w1[3] = v1[2] * sn[3] + v1[3] * cs[3];
  v0 = w0; v1 = w1;
}
__device__ __forceinline__ int v_img(int k, int c) { const int kk = (k & ~0xC) | ((k & 4) << 1) | ((k & 8) >> 1); return ((kk >> 3) * 2 + (c >> 5)) * 512 + ((kk & 7) * 32 + (c & 31)) * 2; }
template <int KIND, bool ROT>
__device__ __forceinline__ void up_store(const f32x4 (&acc)[2][2][4][2], const int bj, char* base, const int pos0, const int dd, const float* tabp, const int tl, const int a) {
#pragma unroll
  for (int ai = 0; ai < 2; ++ai)
#pragma unroll
    for (int m = 0; m < 4; ++m) {
      const int ro = ai * 128 + m * 16;
      f32x4 v0 = acc[ai][bj][m][0], v1 = acc[ai][bj][m][1];
      if (ROT) { const int t = tl + ro; const int pp = a == 0 ? (t >> 6) : (t & 63); rope4(v0, v1, *(const f32x4*)(tabp + pp * 8), *(const f32x4*)(tabp + 2048 + pp * 8)); }
      const int pos = pos0 + ro;
      if (KIND == 2) {
        const unsigned w0 = pk4fp8(v0[0], v0[1], v0[2], v0[3]), w1 = pk4fp8(v1[0], v1[1], v1[2], v1[3]);
        const int qi = pos & 3; const unsigned sel = (unsigned)qi | ((unsigned)(4 + qi) << 8);
        unsigned o[2];
#pragma unroll
        for (int e = 0; e < 2; ++e) { const unsigned w = e ? w1 : w0;
          const unsigned t0 = (unsigned)__builtin_amdgcn_update_dpp(0, (int)w, 0x00, 0xF, 0xF, false), t1 = (unsigned)__builtin_amdgcn_update_dpp(0, (int)w, 0x55, 0xF, 0xF, false);
          const unsigned t2 = (unsigned)__builtin_amdgcn_update_dpp(0, (int)w, 0xAA, 0xF, 0xF, false), t3 = (unsigned)__builtin_amdgcn_update_dpp(0, (int)w, 0xFF, 0xF, 0xF, false);
          const unsigned x01 = __builtin_amdgcn_perm(t1, t0, sel), x23 = __builtin_amdgcn_perm(t3, t2, sel);
          o[e] = (x01 & 0xffffu) | (x23 << 16); }
        const int kk = pos & 63, a_ = kk >> 5, hi_ = (kk >> 2) & 1, j_ = (kk & 31) >> 3;
        char* tb = base + (size_t)(pos >> 6) * 4096 + (a_ * 2 + hi_) * 512 + j_ * 4;
#pragma unroll
        for (int e = 0; e < 2; ++e) { const int d = dd + 4 * e + qi; *(unsigned*)(tb + (d >> 5) * 2048 + (d & 31) * 16) = o[e]; } }
      else { u32x2 w; w.x = pk4fp8(v0[0], v0[1], v0[2], v0[3]); w.y = pk4fp8(v1[0], v1[1], v1[2], v1[3]);
        char* dst = KIND == 0 ? base + (size_t)pos * 96 + dd : base + (size_t)(pos >> 6) * 6144 + (dd >> 4) * 1024 + (pos & 63) * 16 + (dd & 15);
        *(u32x2*)dst = w; }
    }
}
struct EpiUp {
  static constexpr bool PERM = true;
  bf16_t* Q; bf16_t* QC; bf16_t* K; bf16_t* V; const float* tab;
  __device__ __forceinline__ void operator()(const f32x4 (&acc)[2][2][4][2], const pg8::Unit& u, int wr, int wc, int fr, int fq) const {
    const int trow0 = u.pm * 256; const bool isctx = trow0 >= NLAT;
    const int b = isctx ? (trow0 - NLAT) / CTX : trow0 / SEQ;
    const int tl = (isctx ? 0 : trow0 % SEQ) + wr * 64 + fr;
#pragma unroll
    for (int bj = 0; bj < 2; ++bj) {
      const int cg = u.pn * 256 + bj * 128 + wc * 32;
      if (cg < 768) { const int h = cg / 96, ddg = cg % 96;
        char* base = isctx ? (char*)QC + (size_t)(b * 8 + h) * CTX * 96 : (char*)Q + (size_t)(b * 8 + h) * SEQ * 96;
        if (ddg >= 64 && !isctx) up_store<0, true>(acc, bj, base, tl, ddg + 8 * fq, tab + ((4 * fq) & 7), tl, (4 * fq) >> 3);
        else up_store<0, false>(acc, bj, base, tl, ddg + 8 * fq, tab, tl, 0); }
      else { const int j = cg - 768, h = j >> 7, ddg = j & 127; const int pos0 = (isctx ? 0 : CTX) + tl;
        if (ddg < 64) up_store<1, false>(acc, bj, (char*)K + (size_t)(b * 8 + h) * NKEY * 96, pos0, ddg + 8 * fq, tab, tl, 0);
        else up_store<2, false>(acc, bj, (char*)V + (size_t)(b * 8 + h) * NKEY * 64, pos0, (ddg - 64) + 8 * fq, tab, tl, 0); }
    }
  }
};
struct EpiQkv2 {
  static constexpr bool PERM = true;
  bf16_t* Q2; bf16_t* K2; bf16_t* V2; const float* tab;
  __device__ __forceinline__ void operator()(const f32x4 (&acc)[2][2][4][2], const pg8::Unit& u, int wr, int wc, int fr, int fq) const {
    const int trow0 = u.pm * 256; const bool isctx = trow0 >= NLAT;
    const int b = isctx ? (trow0 - NLAT) / CTX : trow0 / SEQ;
    const int tl = (isctx ? 0 : trow0 % SEQ) + wr * 64 + fr;
#pragma unroll
    for (int bj = 0; bj < 2; ++bj) {
      const int cg = u.pn * 256 + bj * 128 + wc * 32;
      if (isctx && cg < 1024) continue;
      const int hh = cg >> 6, dd = (cg & 63) + 8 * fq; const int pos = (isctx ? 0 : CTX) + tl;
      const bool rot = (cg < 1280) && !isctx;
      const int kind = cg < 1024 ? 0 : (cg < 1280 ? 1 : 2);
      char* dst0;
      if (kind == 0) dst0 = (char*)Q2 + ((size_t)(b * 16 + hh) * SEQ + tl) * 64 + dd;
      else if (kind == 1) dst0 = (char*)K2 + (size_t)(b * 4 + hh - 16) * NKEY * 64;
      else dst0 = (char*)V2 + (size_t)(b * 4 + hh - 20) * NKEY * 64;
      const int p0 = dd >> 1, a = p0 >> 4, i0 = p0 & 15;
#pragma unroll
      for (int ai = 0; ai < 2; ++ai)
#pragma unroll
        for (int m = 0; m < 4; ++m) {
          const int ro = ai * 128 + m * 16;
          f32x4 v0 = acc[ai][bj][m][0], v1 = acc[ai][bj][m][1];
          if (rot) { const int t = tl + ro; const int pp = a == 0 ? (t >> 6) : (t & 63);
            rope4(v0, v1, *(const f32x4*)(tab + 4096 + pp * 16 + i0), *(const f32x4*)(tab + 8192 + pp * 16 + i0)); }
          const int ps = pos + ro;
          const unsigned w0 = pk4fp8(v0[0], v0[1], v0[2], v0[3]), w1 = pk4fp8(v1[0], v1[1], v1[2], v1[3]);
          if (kind < 2) { u32x2 w; w.x = w0; w.y = w1;
            char* dst = kind == 0 ? dst0 + (size_t)ro * 64 : dst0 + (size_t)(ps >> 6) * 4096 + (dd >> 4) * 1024 + (ps & 63) * 16 + (dd & 15);
            *(u32x2*)dst = w; }
          else {
            const int qi = ps & 3; const unsigned sel = (unsigned)qi | ((unsigned)(4 + qi) << 8);
            const int kk = ps & 63, a_ = kk >> 5, hi_ = (kk >> 2) & 1, j_ = (kk & 31) >> 3;
            char* tb = dst0 + (size_t)(ps >> 6) * 4096 + (a_ * 2 + hi_) * 512 + j_ * 4;
#pragma unroll
            for (int e = 0; e < 2; ++e) { const unsigned w = e ? w1 : w0;
              const unsigned t0 = (unsigned)__builtin_amdgcn_update_dpp(0, (int)w, 0x00, 0xF, 0xF, false), t1 = (unsigned)__builtin_amdgcn_update_dpp(0, (int)w, 0x55, 0xF, 0xF, false);
              const unsigned t2 = (unsigned)__builtin_amdgcn_update_dpp(0, (int)w, 0xAA, 0xF, 0xF, false), t3 = (unsigned)__builtin_amdgcn_update_dpp(0, (int)w, 0xFF, 0xF, 0xF, false);
              const unsigned x01 = __builtin_amdgcn_perm(t1, t0, sel), x23 = __builtin_amdgcn_perm(t3, t2, sel);
              const int d = dd + 4 * e + qi; *(unsigned*)(tb + (d >> 5) * 2048 + (d & 31) * 16) = (x01 & 0xffffu) | (x23 << 16); } }
        }
    }
  }
};

enum { PH_PRO = 0, PH_L0_NORM1, PH_L0_WIN, PH_L0_PREUP, PH_L0_UP, PH_L0_ATTN, PH_L0_WOUT, PH_L0_NORM2, PH_L0_TOPK, PH_L0_GU, PH_L0_DOWN, PH_L0_COMB,
       PH_L1_QKV, PH_L1_ATTN, PH_L1_WOUT, PH_L1_NORM2, PH_L1_TOPK, PH_L1_GU, PH_L1_DOWN, PH_L1_COMB, PH_COUNT };

template <class Epi>
__device__ __forceinline__ void sg_tile(const bf16_t* __restrict__ X, const bf16_t* __restrict__ Wt, const int K, const int row0, const int col0, const int lane, const Epi& E) {
    using att::f32x16;
    const int r32 = lane & 31, hi = lane >> 5;
    const bf16_t* xp = X + (size_t)(row0 + r32) * K + hi * 8;
    const bf16_t* w0 = Wt + (size_t)(col0 + r32) * K + hi * 8;
    f32x16 a0 = {}, a1 = {};
#pragma unroll 16
    for (int s = 0; s < K; s += 32) {
        const bf16x8 x0 = *reinterpret_cast<const bf16x8*>(xp + s), wa = *reinterpret_cast<const bf16x8*>(w0 + s);
        const bf16x8 x1 = *reinterpret_cast<const bf16x8*>(xp + s + 16), wb = *reinterpret_cast<const bf16x8*>(w0 + s + 16);
        a0 = __builtin_amdgcn_mfma_f32_32x32x16_bf16(wa, x0, a0, 0, 0, 0); a1 = __builtin_amdgcn_mfma_f32_32x32x16_bf16(wb, x1, a1, 0, 0, 0);
    }
#pragma unroll
    for (int g = 0; g < 4; ++g)
        E(row0 + r32, col0 + 8 * g + 4 * hi, (f32x4){a0[4 * g] + a1[4 * g], a0[4 * g + 1] + a1[4 * g + 1], a0[4 * g + 2] + a1[4 * g + 2], a0[4 * g + 3] + a1[4 * g + 3]});
}
template <class Epi>
__device__ __forceinline__ void sg_ctx(Frame& F, const bf16_t* X, const bf16_t* Wt, int K, int col_lo, int col_hi, const Epi& E) {
    const int ncb = (col_hi - col_lo) / 32, nu = (NCTX / 32) * ncb;
    for (int u = F.bid + F.wave * F.G; u < nu; u += 8 * F.G) sg_tile(X, Wt, K, NLAT + 32 * (u / ncb), col_lo + 32 * (u % ncb), F.lane, E);
}
struct SgStore { bf16_t* out; int ld; __device__ __forceinline__ void operator()(int row, int col, f32x4 v) const { u32x2 w; w.x = pk2bf(v[0], v[1]); w.y = pk2bf(v[2], v[3]); *(u32x2*)(out + (size_t)row * ld + col) = w; } };
struct SgResidCtx { const float* xin; float* xo; const float* gate;
    __device__ __forceinline__ void operator()(int row, int col, f32x4 v) const { const size_t o = (size_t)(row - NLAT) * DM + col; *(f32x4*)(xo + o) = *(const f32x4*)(xin + o) + *(const f32x4*)(gate + col) * v; } };
struct SgKv2Ctx { char* K2; char* V2;
    __device__ __forceinline__ void operator()(int row, int col, f32x4 v) const {
        const int j = row - NLAT, b = j / CTX, pos = j % CTX, hh = (col - 1024) >> 6, dd = col & 63;
        if (hh < 4) *(unsigned*)(K2 + (size_t)(b * 4 + hh) * NKEY * 64 + (size_t)(pos >> 6) * 4096 + (dd >> 4) * 1024 + (pos & 63) * 16 + (dd & 15)) = pk4fp8(v[0], v[1], v[2], v[3]);
        else { const int kk = pos & 63, a_ = kk >> 5, hi_ = (kk >> 2) & 1, tt = (kk & 3) + 4 * ((kk & 31) >> 3);
          char* tb = V2 + (size_t)(b * 4 + hh - 4) * NKEY * 64 + (size_t)(pos >> 6) * 4096 + (a_ * 2 + hi_) * 512 + tt;
#pragma unroll
          for (int e = 0; e < 4; ++e) { const int d = dd + e; *(unsigned char*)(tb + (d >> 5) * 2048 + (d & 31) * 16) = f2fp8(v[e]); } } } };

__device__ __forceinline__ void sg_tile64(const bf16_t* __restrict__ xr0, const bf16_t* __restrict__ xr1, const bf16_t* __restrict__ Wt, const int K, const int col0, const int lane,
                                          att::f32x16 (&acc)[2][2]) {
    const int r32 = lane & 31, hi = lane >> 5;
    const bf16_t* x0 = xr0 + hi * 8; const bf16_t* x1 = xr1 + hi * 8;
    const bf16_t* w0 = Wt + (size_t)(col0 + r32) * K + hi * 8; const bf16_t* w1 = w0 + (size_t)32 * K;
#pragma unroll
    for (int a = 0; a < 2; ++a)
#pragma unroll
        for (int b = 0; b < 2; ++b) acc[a][b] = att::f32x16{};
#pragma unroll 8
    for (int s = 0; s < K; s += 16) {
        const bf16x8 xa = *reinterpret_cast<const bf16x8*>(x0 + s), xb = *reinterpret_cast<const bf16x8*>(x1 + s);
        const bf16x8 wa = *reinterpret_cast<const bf16x8*>(w0 + s), wb = *reinterpret_cast<const bf16x8*>(w1 + s);
        acc[0][0] = __builtin_amdgcn_mfma_f32_32x32x16_bf16(wa, xa, acc[0][0], 0, 0, 0); acc[0][1] = __builtin_amdgcn_mfma_f32_32x32x16_bf16(wa, xb, acc[0][1], 0, 0, 0);
        acc[1][0] = __builtin_amdgcn_mfma_f32_32x32x16_bf16(wb, xa, acc[1][0], 0, 0, 0); acc[1][1] = __builtin_amdgcn_mfma_f32_32x32x16_bf16(wb, xb, acc[1][1], 0, 0, 0);
    }
}
__device__ __forceinline__ void sg_moe_gu_ctx(Frame& F, const Params& P) {
    const bf16_t* HB = (const bf16_t*)(P.ws + WS_HB); const int* sidx = (const int*)(P.ws + WS_SIDX) + 32 * CAP_L;
    bf16_t* HID = (bf16_t*)(P.ws + WS_PB) + (size_t)32 * CAP_L * DFF;
    const int lane = F.lane, r32 = lane & 31, hi = lane >> 5;
    for (int u = F.bid + F.wave * F.G; u < 16 * 32; u += 8 * F.G) {
        const int e = u >> 5, cb = u & 31;
        const int t0 = sidx[(0 * 16 + e) * CAP_C + r32], t1 = sidx[(1 * 16 + e) * CAP_C + r32];
        att::f32x16 acc[2][2];
        sg_tile64(HB + ((size_t)NLAT + 0 * CTX + t0) * DM, HB + ((size_t)NLAT + 1 * CTX + t1) * DM, (const bf16_t*)(P.ws + WS_W + OFF_WGU) + (size_t)e * 2048 * DM, DM, cb * 64, lane, acc);
#pragma unroll
        for (int rb = 0; rb < 2; ++rb) { bf16_t* hrow = HID + ((size_t)(rb * 16 + e) * CAP_C + r32) * DFF;
#pragma unroll
            for (int c2 = 0; c2 < 2; ++c2)
#pragma unroll
                for (int g = 0; g < 4; ++g) { const int col = cb * 64 + c2 * 32 + 8 * g + 4 * hi;
                    const att::f32x16& a = acc[c2][rb];
                    *(unsigned*)(hrow + (col >> 1)) = pk2bf(silu_f(a[4 * g]) * a[4 * g + 1], silu_f(a[4 * g + 2]) * a[4 * g + 3]); } }
    }
}
__device__ __forceinline__ void sg_moe_down_ctx(Frame& F, const Params& P) {
    const bf16_t* HID = (const bf16_t*)(P.ws + WS_PB) + (size_t)32 * CAP_L * DFF; bf16_t* YE = (bf16_t*)(P.ws + WS_QKV) + (size_t)32 * CAP_L * DM;
    const float* sg = (const float*)(P.ws + WS_SG) + 32 * CAP_L;
    const int lane = F.lane, r32 = lane & 31, hi = lane >> 5;
    for (int u = F.bid + F.wave * F.G; u < 16 * 16; u += 8 * F.G) {
        const int e = u >> 4, cb = u & 15;
        att::f32x16 acc[2][2];
        sg_tile64(HID + ((size_t)(0 * 16 + e) * CAP_C + r32) * DFF, HID + ((size_t)(1 * 16 + e) * CAP_C + r32) * DFF, (const bf16_t*)(P.ws + WS_W + OFF_WD) + (size_t)e * 1024 * DFF, DFF, cb * 64, lane, acc);
#pragma unroll
        for (int rb = 0; rb < 2; ++rb) { const size_t r = (size_t)(rb * 16 + e) * CAP_C + r32; const float gv = sg[r]; bf16_t* yrow = YE + r * DM;
#pragma unroll
            for (int c2 = 0; c2 < 2; ++c2)
#pragma unroll
                for (int g = 0; g < 4; ++g) { const int col = cb * 64 + c2 * 32 + 8 * g + 4 * hi; const att::f32x16& a = acc[c2][rb];
                    u32x2 w; w.x = pk2bf(a[4 * g] * gv, a[4 * g + 1] * gv); w.y = pk2bf(a[4 * g + 2] * gv, a[4 * g + 3] * gv); *(u32x2*)(yrow + col) = w; } }
    }
}

__device__ __forceinline__ void phase_gemm_win(Frame& F) {
    const Params P = lds_params(F);
    pg8::SchedPlain S; S.init(NLAT, 2048, DM, (const bf16_t*)(P.ws + WS_W + OFF_WIN), F.G, F.bid);
    EpiStore E{(bf16_t*)(P.ws + WS_PB), PPITCH};
    pg8::gemm_phase<EpiStore, pg8::SchedPlain, true>(F.lds, (const char*)(P.ws + WS_HB), DM, S, E);
    sg_ctx(F, (const bf16_t*)(P.ws + WS_HB), (const bf16_t*)(P.ws + WS_W + OFF_WIN), DM, 0, 1984, SgStore{(bf16_t*)(P.ws + WS_PB), PPITCH});
}
__device__ __forceinline__ void phase_gemm_up(Frame& F) {
    const Params P = lds_params(F);
    pg8::SchedPlainT<1> S; S.init(NROW, 1792, 512, (const bf16_t*)(P.ws + WS_W + OFF_WUP), F.G, F.bid);
    EpiUp E{(bf16_t*)(P.ws + WS_QKV + OFF_Q), (bf16_t*)(P.ws + WS_QKV + OFF_QC), (bf16_t*)(P.ws + WS_QKV + OFF_K), (bf16_t*)(P.ws + WS_QKV + OFF_V), (const float*)(P.ws + WS_ROPE)};
    pg8::gemm_phase<EpiUp, pg8::SchedPlainT<1>, true>(F.lds, (const char*)(P.ws + WS_QN), 512, S, E);
}
__device__ __forceinline__ void phase_gemm_wout(Frame& F, int layer) {
    const Params P = lds_params(F);
    float* modv = (float*)(P.ws + WS_MODV); float* xc = (float*)(P.ws + WS_XC);
    if (layer == 0) {
        pg8::SchedPlain S; S.init(NLAT, DM, DM, (const bf16_t*)(P.ws + WS_W + OFF_WOUT), F.G, F.bid);
        EpiResidB<true> E{P.in[0], (bf16_t*)(P.ws + WS_XSB), modv, 2 * DM};
        pg8::gemm_phase<EpiResidB<true>, pg8::SchedPlain, true>(F.lds, (const char*)(P.ws + WS_CAT), DM, S, E);
        sg_ctx(F, (const bf16_t*)(P.ws + WS_CAT), (const bf16_t*)(P.ws + WS_W + OFF_WOUT), DM, 0, DM, SgResidCtx{P.in[2], xc, modv + 2 * NMOD + 2 * DM});
    } else {
        pg8::SchedPlainT<1, 0x7B7B7B7B> S; S.init(NLAT, DM, DM, (const bf16_t*)(P.ws + WS_W + OFF_WSO), F.G, F.bid);
        EpiResidB<false> E{nullptr, (bf16_t*)(P.ws + WS_XSB), modv + 3 * NMOD, 2 * DM};
        pg8::gemm_phase<EpiResidB<false>, pg8::SchedPlainT<1, 0x7B7B7B7B>, true>(F.lds, (const char*)(P.ws + WS_CAT), DM, S, E);
    }
}
__device__ __forceinline__ void phase_gemm_gu(Frame& F, int layer) {
    const Params P = lds_params(F);
    SchedMoeGU S; S.init((const int*)(P.ws + WS_SIDX), (const bf16_t*)(P.ws + WS_W + OFF_WGU), F.G, F.bid, layer == 0);
    EpiHidMk E{(bf16_t*)(P.ws + WS_PB)};
    pg8::gemm_phase<EpiHidMk, SchedMoeGU, true>(F.lds, (const char*)(P.ws + WS_HB), DM, S, E);
}
__device__ __forceinline__ void phase_gemm_down(Frame& F, int layer) {
    const Params P = lds_params(F);
    SchedMoeDown S; S.init((const bf16_t*)(P.ws + WS_W + OFF_WD), F.G, F.bid, layer == 0);
    EpiYeMk E{(bf16_t*)(P.ws + WS_QKV), (const float*)(P.ws + WS_SG)};
    pg8::gemm_phase<EpiYeMk, SchedMoeDown, true>(F.lds, (const char*)(P.ws + WS_PB), DFF, S, E);
}
__device__ __forceinline__ void phase_gemm_qkv2(Frame& F) {
    const Params P = lds_params(F);
    pg8::SchedPlainT<1> S; S.init(NLAT, 1536, DM, (const bf16_t*)(P.ws + WS_W + OFF_WQKV8), F.G, F.bid);
    EpiQkv2 E{(bf16_t*)(P.ws + WS_QKV + OFF_Q2), (bf16_t*)(P.ws + WS_QKV + OFF_K2), (bf16_t*)(P.ws + WS_QKV + OFF_V2), (const float*)(P.ws + WS_ROPE)};
    pg8::gemm_phase<EpiQkv2, pg8::SchedPlainT<1>, true>(F.lds, (const char*)(P.ws + WS_HB), DM, S, E);
    sg_ctx(F, (const bf16_t*)(P.ws + WS_HB), (const bf16_t*)(P.ws + WS_W + OFF_WQKV), DM, 1024, 1536, SgKv2Ctx{(char*)(P.ws + WS_QKV + OFF_K2), (char*)(P.ws + WS_QKV + OFF_V2)});
}

__global__ void __launch_bounds__(NTHREADS, 2) mk_fwd(Params KP) {
    extern __shared__ __attribute__((aligned(16))) unsigned char lds_raw[];
    Frame F;
    F.lds = (LAS unsigned char*)lds_raw; F.tid = threadIdx.x; F.lane = F.tid & 63; F.wave = __builtin_amdgcn_readfirstlane(F.tid >> 6); F.G = gridDim.x; F.bid = blockIdx.x;
    volatile LAS unsigned* MISC = (volatile LAS unsigned*)(F.lds + LDS_MISC);
    if (F.tid < 16) MISC[F.tid] = 0u;
    if (F.tid < 26) { const unsigned long long v = F.tid < 24 ? (unsigned long long)KP.in[F.tid] : (F.tid == 24 ? (unsigned long long)KP.out : (unsigned long long)KP.ws);
        ((LAS unsigned long long*)(F.lds + LDS_MISC + 64))[F.tid] = v; }
    if ((threadIdx.x & 63) == 0) ((LAS unsigned*)(F.lds + LDS_MISC + 512))[(unsigned)__builtin_amdgcn_s_getreg(0x2804) & 63u] = threadIdx.x >> 6;
    __syncthreads();
    const int lo = KP.ph_lo, hi = KP.ph_hi;
    const bool multi = (hi - lo) > 1;
    XcdBarrier bar; bar.bar = (unsigned*)(KP.ws + WS_CTL); bar.x = 0; bar.st = nullptr;
    if (multi) bar = xcd_barrier_post((unsigned*)(KP.ws + WS_CTL), MISC);
#ifndef PHMASK
#define PHMASK 0xFFFFFu
#endif
#define IN(k) ((((PHMASK) >> (k)) & 1u) && lo <= (k) && (k) < hi)
#define SEAM(k) do { if (IN(k) && IN((k) + 1)) xcd_barrier(bar); } while (0)
#ifndef PROBE_DUP
#define PROBE_DUP 0u
#endif
#define RUN(k, call) do { if (IN(k)) { Frame F; { int t_ = my_tid(); asm volatile("" : "+v"(t_)); F.lds = (LAS unsigned char*)lds_raw; F.tid = t_; F.lane = t_ & 63; \
        F.wave = __builtin_amdgcn_readfirstlane(t_ >> 6); F.G = gridDim.x; F.bid = blockIdx.x; } \
        call; if (((PROBE_DUP) >> (k)) & 1u) { xcd_barrier(bar); call; } } SEAM(k); } while (0)
#ifdef PROBE_UB
    RUN(PH_PRO, phase_ubench(F));
#endif
    RUN(PH_PRO, phase_prologue(F));
    RUN(PH_L0_NORM1, phase_norm1_l0(F));
#ifdef PROBE_RND
    if (PROBE_RND & 1) { RUN(PH_L0_WIN, phase_rnd(F, WS_HB, (size_t)NROW * DM * 2)); if (IN(PH_L0_WIN)) xcd_barrier(bar); }
#endif
    RUN(PH_L0_WIN, phase_gemm_win(F));
    RUN(PH_L0_PREUP, phase_preup(F));
#ifdef PROBE_RND
    if (PROBE_RND & 16) { RUN(PH_L0_UP, phase_rnd(F, WS_QN, (size_t)NROW * 384 * 2)); if (IN(PH_L0_UP)) xcd_barrier(bar); }
#endif
    RUN(PH_L0_UP, phase_gemm_up(F));
    RUN(PH_L0_ATTN, phase_attn_mla(F));
#ifdef PROBE_ATT_ABL
    RUN(PH_L0_ATTN, phase_attn_probe(F)); if (IN(PH_L0_ATTN)) xcd_barrier(bar);
#endif
#ifdef PROBE_RND
    if (PROBE_RND & 2) { RUN(PH_L0_WOUT, phase_rnd(F, WS_CAT, (size_t)NROW * DM * 2)); if (IN(PH_L0_WOUT)) xcd_barrier(bar); }
#endif
    RUN(PH_L0_WOUT, phase_gemm_wout(F, 0));
    RUN(PH_L0_NORM2, phase_norm2(F, 0));
    RUN(PH_L0_TOPK, phase_topk(F, 0));
    RUN(PH_L0_GU, phase_gemm_gu(F, 0));
    RUN(PH_L0_DOWN, phase_gemm_down(F, 0));
    RUN(PH_L0_COMB, phase_combine(F, 0));
#ifdef PROBE_COMB
    if (IN(PH_L0_COMB)) { Frame F; F.lds = (LAS unsigned char*)lds_raw; F.tid = my_tid(); F.lane = F.tid & 63; F.wave = __builtin_amdgcn_readfirstlane(F.tid >> 6); F.G = gridDim.x; F.bid = blockIdx.x; phase_combine<true>(F, PROBE_COMB); xcd_barrier(bar); }
#endif
#ifdef PROBE_RND
    if (PROBE_RND & 4) { RUN(PH_L1_QKV, phase_rnd(F, WS_HB, (size_t)NROW * DM * 2)); if (IN(PH_L1_QKV)) xcd_barrier(bar); }
#endif
    RUN(PH_L1_QKV, phase_gemm_qkv2(F));
#ifdef PROBE_RND
    if (PROBE_RND & 32) { RUN(PH_L1_ATTN, phase_rnd(F, WS_QKV + OFF_Q2, OFF_V2 + (size_t)NB * 4 * NKEY * 64 * 2 - OFF_Q2)); if (IN(PH_L1_ATTN)) xcd_barrier(bar); }
#endif
    RUN(PH_L1_ATTN, phase_attn_swa(F));
#ifdef PROBE_RND
    if (PROBE_RND & 8) { RUN(PH_L1_WOUT, phase_rnd(F, WS_CAT, (size_t)NLAT * DM * 2)); if (IN(PH_L1_WOUT)) xcd_barrier(bar); }
#endif
    RUN(PH_L1_WOUT, phase_gemm_wout(F, 1));
    RUN(PH_L1_NORM2, phase_norm2(F, 1));
    RUN(PH_L1_TOPK, phase_topk(F, 1));
    RUN(PH_L1_GU, phase_gemm_gu(F, 1));
    RUN(PH_L1_DOWN, phase_gemm_down(F, 1));
    RUN(PH_L1_COMB, phase_combine(F, 1));
#undef IN
#undef SEAM
#undef RUN
}

static void launch_phase(hipStream_t s, int grid, const Params& base, int lo, int hi) {
  Params p = base; p.ph_lo = lo; p.ph_hi = hi;
  hipLaunchKernelGGL(mk_fwd, dim3(grid), dim3(NTHREADS), LDS_BYTES, s, p);
}

extern "C" void kernel_launch(void* const* d_in, const int* in_sizes, int n_in, void* d_out, int out_size, void* d_ws, size_t ws_size, hipStream_t stream) {
  static int grid = 0;
  if (grid == 0) {
    if (n_in != 24 || ws_size < WS_END || out_size != NLAT * DM) { fprintf(stderr, "kernel_launch: bad sizes n_in %d ws %zu (need %zu) out %d\n", n_in, ws_size, (size_t)WS_END, out_size); grid = -1; return; }
    int dev = 0, cus = 0;
    if (hipGetDevice(&dev) != hipSuccess || hipDeviceGetAttribute(&cus, hipDeviceAttributeMultiprocessorCount, dev) != hipSuccess) { grid = -1; return; }
    if (hipFuncSetAttribute((const void*)mk_fwd, hipFuncAttributeMaxDynamicSharedMemorySize, LDS_BYTES) != hipSuccess) { fprintf(stderr, "kernel_launch: hipFuncSetAttribute failed\n"); grid = -1; return; }
    int per_cu = 0;
    if (hipOccupancyMaxActiveBlocksPerMultiprocessor(&per_cu, (const void*)mk_fwd, NTHREADS, LDS_BYTES) != hipSuccess || per_cu < 1) { fprintf(stderr, "kernel_launch: occupancy query says %d\n", per_cu); grid = -1; return; }
    grid = cus;
  }
  if (grid < 0) return;
  Params P{};
  for (int i = 0; i < 24; ++i) P.in[i] = (const float*)d_in[i];
  P.out = (float*)d_out; P.ws = (unsigned char*)d_ws; P.ph_lo = 0; P.ph_hi = 0;
  if (hipMemsetAsync((char*)d_ws + WS_CTL, 0, CTL_BYTES, stream) != hipSuccess) return;
#ifdef MK_PER_PHASE
  for (int ph = 0; ph < PH_COUNT; ++ph) launch_phase(stream, grid, P, ph, ph + 1);
#else
  launch_phase(stream, grid, P, 0, PH_COUNT);
#endif
}
```

```cpp
#include <hip/hip_runtime.h>
#include <hip/hip_bf16.h>
#include <cstdio>
#include <cstdint>

typedef unsigned short bf16_t;

constexpr int NB = 2, SEQ = 16384, DM = 1024, CTX = 256;
constexpr int NLAT = NB * SEQ;
constexpr int NCTX = NB * CTX;
constexpr int NROW = NLAT + NCTX;
constexpr int NKEY = CTX + SEQ;
constexpr int AB_IN = 1952, PPITCH = 2048;
constexpr int NE = 16, CAP_L = 2048, CAP_C = 32, DFF = 1024;
constexpr int NMOD = 6 * DM;
constexpr float EPS = 1e-6f;
constexpr float LOG2E = 1.4426950408889634f;
constexpr float QF8_SCALE = 16.f;

constexpr size_t al256(size_t x) { return (x + 255) / 256 * 256; }
constexpr size_t CTL_BYTES = 65536;
constexpr size_t WS_CTL  = 0;
constexpr size_t WS_MODV = WS_CTL + CTL_BYTES;
constexpr size_t WS_ROPE = WS_MODV + al256(2 * 3 * NMOD * 4);
constexpr size_t WS_XC   = WS_ROPE + al256(256 * 48 * 4);
constexpr size_t WS_AFF  = WS_XC + al256((size_t)NCTX * DM * 4);
constexpr size_t WS_SIDX = WS_AFF + al256((size_t)(NB * NE * SEQ + NB * NE * CTX) * 4);
constexpr size_t WS_SG   = WS_SIDX + al256((size_t)(NB * NE * CAP_L + NB * NE * CAP_C) * 4);
constexpr size_t WS_SLOT = WS_SG + al256((size_t)(NB * NE * CAP_L + NB * NE * CAP_C) * 4);
constexpr size_t WS_HB   = WS_SLOT + al256((size_t)(NB * NE * SEQ + NB * NE * CTX) * 4);
constexpr size_t MOE_ROWS = (size_t)NB * NE * CAP_L + NB * NE * CAP_C;
constexpr size_t WS_PB   = WS_HB + al256((size_t)NROW * DM * 2);
constexpr size_t WS_QN   = WS_PB + al256(MOE_ROWS * DM * 2 + (1u << 20));
constexpr size_t WS_KVN  = WS_QN + al256((size_t)NROW * 256 * 2);
constexpr size_t WS_QKV  = WS_KVN + al256((size_t)NROW * 128 * 2);
constexpr size_t QKV_BYTES = MOE_ROWS * DM * 2;
constexpr size_t WS_W    = WS_QKV + al256(QKV_BYTES);
constexpr size_t WS_CAT  = WS_HB;
constexpr size_t OFF_WIN = 0;
constexpr size_t OFF_WUP = OFF_WIN + (size_t)2048 * 1024 * 2;
constexpr size_t OFF_WOUT = OFF_WUP + al256((size_t)1792 * 384 * 2);
constexpr size_t OFF_WQKV = OFF_WOUT + (size_t)1024 * 1024 * 2;
constexpr size_t OFF_WSO = OFF_WQKV + (size_t)1536 * 1024 * 2;
constexpr size_t OFF_WGU = OFF_WSO + (size_t)1024 * 1024 * 2;
constexpr size_t OFF_WD  = OFF_WGU + (size_t)16 * 2048 * 1024;
constexpr size_t OFF_WQKV8 = OFF_WD + (size_t)16 * 1024 * 1024;
constexpr size_t WS_XSB  = WS_W + OFF_WQKV8 + (size_t)1536 * 1024;
constexpr size_t WS_END  = WS_XSB + (size_t)NLAT * DM * 2;
constexpr size_t OFF_Q  = 0;
constexpr size_t OFF_QC = OFF_Q + (size_t)NB * 8 * SEQ * 96 * 2;
constexpr size_t OFF_K  = OFF_QC + (size_t)NB * 8 * CTX * 96 * 2;
constexpr size_t OFF_V  = OFF_K + (size_t)NB * 8 * NKEY * 96 * 2;
static_assert(OFF_V + (size_t)NB * 8 * NKEY * 64 * 2 <= QKV_BYTES, "qkv region");
constexpr size_t OFF_Q2 = 0;
constexpr size_t OFF_K2 = OFF_Q2 + (size_t)NB * 16 * SEQ * 64 * 2;
constexpr size_t OFF_V2 = OFF_K2 + (size_t)NB * 4 * NKEY * 64 * 2;
static_assert(OFF_V2 + (size_t)NB * 4 * NKEY * 64 * 2 <= QKV_BYTES, "qkv2 region");

__device__ __forceinline__ float bf2f(bf16_t v) { return __uint_as_float(((unsigned)v) << 16); }
__device__ __forceinline__ bf16_t f2bf(float f) { unsigned u = __float_as_uint(f); u += 0x7FFFu + ((u >> 16) & 1u); return (bf16_t)(u >> 16); }
__device__ __forceinline__ float silu_f(float x) { return x * __builtin_amdgcn_rcpf(1.f + __builtin_amdgcn_exp2f(x * -1.44269504088896f)); }

__device__ __forceinline__ float block_sum(float v, float* red) {
  for (int d = 32; d > 0; d >>= 1) v += __shfl_xor(v, d, 64);
  __syncthreads();
  if ((threadIdx.x & 63) == 0) red[threadIdx.x >> 6] = v;
  __syncthreads();
  float s = 0.f;
  for (int i = 0; i < (int)(blockDim.x >> 6); ++i) s += red[i];
  return s;
}

#define LAS __attribute__((address_space(3)))
typedef short bf16x8 __attribute__((ext_vector_type(8)));
typedef float f32x4 __attribute__((ext_vector_type(4)));
typedef unsigned u32x4 __attribute__((ext_vector_type(4)));
typedef unsigned u32x2 __attribute__((ext_vector_type(2)));

constexpr int NTHREADS = 512;
constexpr int RING_BYTES = 131072;
constexpr int LDS_MISC = RING_BYTES;
constexpr int LDS_BYTES = RING_BYTES + 1024;
__device__ __forceinline__ int my_tid() {
    extern __shared__ __attribute__((aligned(16))) unsigned char lds_raw[];
    const unsigned key = (unsigned)__builtin_amdgcn_s_getreg(0x2804) & 63u;
    const int w = __builtin_amdgcn_readfirstlane((int)((const LAS unsigned*)((LAS unsigned char*)lds_raw + LDS_MISC + 512))[key]);
    return w * 64 + (int)__builtin_amdgcn_mbcnt_hi(~0u, __builtin_amdgcn_mbcnt_lo(~0u, 0u));
}

struct Params { const float* in[24]; float* out; unsigned char* ws; int ph_lo, ph_hi; };

__device__ __forceinline__ unsigned pk4fp8(float a, float b, float c, float d) { unsigned r;
  asm("v_cvt_pk_fp8_f32 %0, %1, %2" : "=v"(r) : "v"(a), "v"(b)); asm("v_cvt_pk_fp8_f32 %0, %1, %2 op_sel:[0,0,1]" : "+v"(r) : "v"(c), "v"(d)); return r; }
__device__ __forceinline__ unsigned char f2fp8(float x) { return (unsigned char)((unsigned)__builtin_amdgcn_cvt_pk_fp8_f32(x, 0.f, 0, false) & 0xffu); }
__device__ __forceinline__ unsigned pk2bf(float lo, float hi) { return (unsigned)f2bf(lo) | ((unsigned)f2bf(hi) << 16); }
#if defined(PROBE_FP8ATT) || defined(PROBE_RND)
__device__ __forceinline__ float fp8rt(float x, float sc) { const unsigned r = (unsigned)__builtin_amdgcn_cvt_pk_fp8_f32(x * sc, 0.f, 0, false); return __builtin_amdgcn_cvt_f32_fp8((int)r, 0) * (1.f / sc); }
#endif

#define XB_TMO      128
#define XB_XCNT(j)  (256  + 64 * (j))
#define XB_XSUB(j)  (1280 + 64 * (j))
#define XB_XGEN(j)  (2304 + 64 * (j))
#define XB_TOP      3328
#define XB_TOPGEN   3392
#define XCD_BAR_WORDS 3456
#define XB_SPIN_CAP (1u << 18)
__device__ __forceinline__ unsigned xb_ld(unsigned* p)              { return __hip_atomic_load(p, __ATOMIC_RELAXED, __HIP_MEMORY_SCOPE_AGENT); }
__device__ __forceinline__ unsigned xb_add(unsigned* p, unsigned v) { return __hip_atomic_fetch_add(p, v, __ATOMIC_RELAXED, __HIP_MEMORY_SCOPE_AGENT); }
__device__ __forceinline__ unsigned xb_xcc_id() { return (unsigned)__builtin_amdgcn_s_getreg((3 << 11) | 20) & 0xFu; }
#define XB_SPIN(cond, bar) do { unsigned _sp = 0; while (cond) { __builtin_amdgcn_s_sleep(1); \
    if ((++_sp & 255u) == 0u) { if (xb_ld(&(bar)[XB_TMO])) break; if (_sp > XB_SPIN_CAP) { atomicAdd(&(bar)[XB_TMO], 1u); break; } } } } while (0)
struct XcdBarrier { unsigned* bar; unsigned x; volatile LAS unsigned* st; };
__device__ __forceinline__ XcdBarrier xcd_barrier_post(unsigned* bar, volatile LAS unsigned* st) {
    XcdBarrier b; b.bar = bar; b.x = xb_xcc_id(); b.st = st;
    if (my_tid() == 0) (void)xb_add(&bar[XB_XCNT(b.x)], 1u);
    return b;
}
__device__ __forceinline__ void xcd_barrier_complete(unsigned* bar, unsigned x, unsigned& nloc, unsigned& nx) {
    const unsigned G = gridDim.x * gridDim.y * gridDim.z;
    unsigned sum, cnt, mine, sp = 0u;
    for (;;) {
        sum = 0u; cnt = 0u; mine = 0u;
#pragma unroll
        for (unsigned j = 0; j < 16; ++j) { const unsigned c = xb_ld(&bar[XB_XCNT(j)]); sum += c; cnt += (c > 0u) ? 1u : 0u; mine = (j == x) ? c : mine; }
        if (sum == G) break;
        __builtin_amdgcn_s_sleep(1);
        if ((++sp & 255u) == 0u) { if (xb_ld(&bar[XB_TMO])) break; if (sp > XB_SPIN_CAP) { atomicAdd(&bar[XB_TMO], 1u); break; } }
    }
    nloc = mine > 0u ? mine : 1u; nx = cnt > 0u ? cnt : 1u;
}
__device__ __forceinline__ void xcd_barrier(const XcdBarrier& b) {
    asm volatile("s_waitcnt vmcnt(0)" ::: "memory");
    __syncthreads();
    if (my_tid() == 0) {
        unsigned* bar = b.bar;
        __builtin_amdgcn_s_waitcnt(0);
        unsigned nloc = b.st[0], nx = b.st[1];
        if (nloc == 0u) { xcd_barrier_complete(bar, b.x, nloc, nx); b.st[0] = nloc; b.st[1] = nx; }
        const unsigned old = xb_add(&bar[XB_XSUB(b.x)], 1u);
        const unsigned gen = old / nloc;
        if (old + 1u == (gen + 1u) * nloc) {
            __builtin_amdgcn_fence(__ATOMIC_RELEASE, "agent");
            asm volatile("s_waitcnt vmcnt(0)" ::: "memory");
            const unsigned og = xb_add(&bar[XB_TOP], 1u);
            const unsigned tg = og / nx;
            if (og + 1u == (tg + 1u) * nx) xb_add(&bar[XB_TOPGEN], 1u);
            else XB_SPIN(xb_ld(&bar[XB_TOPGEN]) == tg, bar);
            __builtin_amdgcn_fence(__ATOMIC_ACQUIRE, "agent");
            xb_add(&bar[XB_XGEN(b.x)], 1u);
            asm volatile("s_waitcnt vmcnt(0)" ::: "memory");
        } else {
            XB_SPIN(xb_ld(&bar[XB_XGEN(b.x)]) == gen, bar);
            __builtin_amdgcn_fence(__ATOMIC_ACQUIRE, "agent");
            asm volatile("s_waitcnt vmcnt(0)" ::: "memory");
        }
    }
    __syncthreads();
}

namespace pg8 {
constexpr int BM = 256, BK = 64, HALF = 128, HTB = HALF * BK * 2, STAGE_BYTES = 8 * HTB, NXCD = 8, WGM = 8;
__host__ __device__ __forceinline__ int lds_byte(int r, int c) { const int st = (r >> 4) * 2 + (c >> 5), rr = r & 15, cc = c & 31, ob = rr * 64 + cc * 2; return st * 1024 + (ob ^ (((ob >> 9) & 1) << 5)); }
__host__ __device__ __forceinline__ void stage_rc(int b, int& R, int& C) { const int st = b / 1024, sb = b % 1024, swz = sb ^ (((sb >> 9) & 1) << 5); R = (st >> 1) * 16 + swz / 64; C = (st & 1) * 32 + (swz % 64) / 2; }
__host__ __device__ __forceinline__ int perm32(int rho) { const int n = rho >> 4, i = rho & 15; return 8 * (i >> 2) + 4 * n + (i & 3); }
struct Unit { int pm, pn, grp; };

template <int EB_, int ASC_ = 0x7F7F7F7F>
struct SchedPlainT {
    static constexpr int EB = EB_, NBJ = 2, WSCALE = EB_ == 1 ? 0x7A7A7A7A : 0x7F7F7F7F, ASCALE = ASC_;
    int nM, nN, nwg, G, c; const char* Bt; int K;
    __device__ __forceinline__ void init(int M, int N, int K_, const bf16_t* Bt_, int G_, int c_) { nM = M / BM; nN = N / BM; nwg = nM * nN; G = G_; c = c_; Bt = (const char*)Bt_; K = K_; }
    __device__ __forceinline__ bool next(int i, Unit& u) const {
        const long L = (long)i * G + c; if (L >= nwg) return false;
        int wgid = (int)L; { const int q = nwg / NXCD, r = nwg % NXCD, xcd = wgid % NXCD, off = wgid / NXCD; wgid = (xcd < r ? xcd * (q + 1) : r * (q + 1) + (xcd - r) * q) + off; }
        const int nig = WGM * nN, gid = wgid / nig, fm = gid * WGM, gsz = (nM - fm) < WGM ? (nM - fm) : WGM;
        u.pm = fm + ((wgid % nig) % gsz); u.pn = (wgid % nig) / gsz; u.grp = 0; return true;
    }
    __device__ __forceinline__ int a_row(const Unit& u, int r) const { return u.pm * BM + r; }
    __device__ __forceinline__ const char* b_ptr(const Unit& u) const { return Bt + (size_t)u.pn * BM * K * EB; }
};
using SchedPlain = SchedPlainT<2>;

#define PG8_SA(b, h) (((b) * 2 + (h)) * HTB)
#define PG8_SB(b, h) ((4 + (b) * 2 + (h)) * HTB)
#ifdef PROBE_FAKEK
#define PG8_FK_B(x) (stage_on ? (x) : Abase)
#define PG8_FK_V(x) (stage_on ? (x) : 0u)
#else
#define PG8_FK_B(x) (x)
#define PG8_FK_V(x) (x)
#endif
#define PG8_STAGE(bufoff, gbase, voff) do { const char* gb_ = PG8_FK_B((const char*)(gbase)); asm volatile("" : "+s"(gb_)); _Pragma("unroll") for (int _i = 0; _i < 2; ++_i) { unsigned vo_ = PG8_FK_V((voff)[_i]); asm volatile("" : "+v"(vo_)); \
        __builtin_amdgcn_global_load_lds((const unsigned*)(gb_ + vo_), (LAS unsigned*)(lds + (bufoff) + ldsw + _i * 8192), 16, 0, 0); } } while (0)
#define PG8_LDA(dst, b, h) do { _Pragma("unroll") for (int m = 0; m < 4; ++m) { \
        if constexpr (EB == 1) dst##8[m] = cat32(*(const LAS bf16x8*)(lds + PG8_SA(b, h) + aoff + m * 2048), *(const LAS bf16x8*)(lds + PG8_SA(b, h) + aoff + m * 2048 + 1024)); \
        else { _Pragma("unroll") for (int k = 0; k < 2; ++k) dst[m][k] = *(const LAS bf16x8*)(lds + PG8_SA(b, h) + aoff + m * 2048 + k * 1024); } } } while (0)
#define PG8_LDB(dst, b, h) do { _Pragma("unroll") for (int n = 0; n < 2; ++n) { \
        if constexpr (EB == 1) dst##8[n] = cat32(*(const LAS bf16x8*)(lds + PG8_SB(b, h) + boff + n * 2048), *(const LAS bf16x8*)(lds + PG8_SB(b, h) + boff + n * 2048 + 1024)); \
        else { _Pragma("unroll") for (int k = 0; k < 2; ++k) dst[n][k] = *(const LAS bf16x8*)(lds + PG8_SB(b, h) + boff + n * 2048 + k * 1024); } } } while (0)
typedef float f32x16 __attribute__((ext_vector_type(16)));
__device__ __forceinline__ f32x4 get4(const f32x16& v, int k) { return (f32x4){v[4 * k], v[4 * k + 1], v[4 * k + 2], v[4 * k + 3]}; }
__device__ __forceinline__ void set4(f32x16& v, int k, f32x4 x) { v[4 * k] = x[0]; v[4 * k + 1] = x[1]; v[4 * k + 2] = x[2]; v[4 * k + 3] = x[3]; }
typedef int v8i32 __attribute__((ext_vector_type(8)));
typedef int v4i32 __attribute__((ext_vector_type(4)));
__device__ __forceinline__ v8i32 cat32(bf16x8 lo, bf16x8 hi) { const v4i32 a = __builtin_bit_cast(v4i32, lo), b = __builtin_bit_cast(v4i32, hi); return __builtin_shufflevector(a, b, 0, 1, 2, 3, 4, 5, 6, 7); }
#define PG8_MMA(ai, bj, At, Bt) do { __builtin_amdgcn_s_setprio(1); _Pragma("unroll") for (int m = 0; m < 4; ++m) _Pragma("unroll") for (int n = 0; n < 2; ++n) { \
        if constexpr (EB == 1) { if constexpr (ACC16) set4(accT[ai][bj][m >> 1], (m & 1) * 2 + n, __builtin_amdgcn_mfma_scale_f32_16x16x128_f8f6f4(Bt##8[n], At##8[m], get4(accT[ai][bj][m >> 1], (m & 1) * 2 + n), 0, 0, 0, Sched::WSCALE, 0, Sched::ASCALE)); \
            else acc[ai][bj][m][n] = __builtin_amdgcn_mfma_scale_f32_16x16x128_f8f6f4(Bt##8[n], At##8[m], acc[ai][bj][m][n], 0, 0, 0, Sched::WSCALE, 0, Sched::ASCALE); } \
        else { _Pragma("unroll") for (int k = 0; k < 2; ++k) acc[ai][bj][m][n] = __builtin_amdgcn_mfma_f32_16x16x32_bf16(Bt[n][k], At[m][k], acc[ai][bj][m][n], 0, 0, 0); } } \
        __builtin_amdgcn_s_setprio(0); } while (0)
#define PG8_WAIT_V(n) asm volatile("s_waitcnt vmcnt(" #n ")" ::: "memory")
#define PG8_WAIT_K do { if constexpr (NBJ == 2) asm volatile("s_waitcnt vmcnt(8)" ::: "memory"); else asm volatile("s_waitcnt vmcnt(6)" ::: "memory"); } while (0)
#define PG8_WAIT_L(n) asm volatile("s_waitcnt lgkmcnt(" #n ")" ::: "memory")
#define PG8_BAR __builtin_amdgcn_s_barrier()
#define PG8_SCHED __builtin_amdgcn_sched_barrier(0)

template <class Epi, class Sched, bool ALIGN_EPI>
__device__ __forceinline__ void gemm_phase(LAS unsigned char* lds, const char* Abase, const int K, const Sched& S, const Epi& E) {
    const int tid = my_tid(), wid = __builtin_amdgcn_readfirstlane(tid >> 6), lane = tid & 63, wr = wid >> 2, wc = wid & 3, fr = lane & 15, fq = lane >> 4;
    constexpr int EB = Sched::EB, NBJ = Sched::NBJ; constexpr bool ACC16 = (EB == 1 && NBJ == 2);
    const int nt = K * EB / 128;
    unsigned voffB[2];
#pragma unroll
    for (int i = 0; i < 2; ++i) { int R, C; stage_rc(tid * 16 + i * 8192, R, C); const int Rb = Epi::PERM ? ((R & ~31) + perm32(R & 31)) : R; voffB[i] = (unsigned)(Rb * K * EB + C * 2); }
#define PG8_AOFF(dst, unit) do { int l_ = (int)__builtin_amdgcn_mbcnt_hi(~0u, __builtin_amdgcn_mbcnt_lo(~0u, 0u)); asm volatile("" : "+v"(l_)); const int tid_ = wid * 64 + l_; _Pragma("unroll") for (int h = 0; h < 2; ++h) _Pragma("unroll") for (int i = 0; i < 2; ++i) { int R_, C_; stage_rc(tid_ * 16 + i * 8192, R_, C_); \
        dst[h][i] = (unsigned)S.a_row(unit, h * HALF + R_) * (unsigned)(K * EB) + (unsigned)(C_ * 2); } } while (0)
    const size_t kstep = 128;
    const size_t hstep = (size_t)HALF * K * EB;
    const unsigned ldsw = (unsigned)wid * 1024u;
    const int aoff = lds_byte(wr * 64 + fr, fq * 8), boff = lds_byte(wc * 32 + fr, fq * 8);
    Unit cur, nxt; int ui = 0;
#ifdef PROBE_FAKEK
    bool stage_on = true;
#endif
    if (!S.next(0, cur)) return;
#ifdef PROBE_FAKEK
#define PG8_UIX(i) (((PROBE_FAKEK >> (EB == 1 ? 0 : 1)) & 1) ? (i) >> 1 : (i))
#else
#define PG8_UIX(i) (i)
#endif
    f32x4 acc[2][NBJ][4][2];
#pragma unroll
    for (int a = 0; a < 2; ++a)
#pragma unroll
        for (int b = 0; b < NBJ; ++b)
#pragma unroll
            for (int m = 0; m < 4; ++m)
#pragma unroll
                for (int n = 0; n < 2; ++n) acc[a][b][m][n] = (f32x4){0.f, 0.f, 0.f, 0.f};
    f32x16 accT[2][NBJ][2];
#pragma unroll
    for (int a = 0; a < 2; ++a)
#pragma unroll
        for (int b = 0; b < NBJ; ++b)
#pragma unroll
            for (int m = 0; m < 2; ++m)
#pragma unroll
                for (int j = 0; j < 16; ++j) accT[a][b][m][j] = 0.f;
    bf16x8 At[4][2], B0[2][2], B1[2][2];
    v8i32 At8[4], B08[2], B18[2];
    unsigned offc[2][2], offn[2][2];
    PG8_AOFF(offc, cur);
    const char* cB = S.b_ptr(cur);
    PG8_STAGE(PG8_SB(0, 0), cB, voffB); if constexpr (NBJ == 2) PG8_STAGE(PG8_SB(0, 1), cB + hstep, voffB); PG8_STAGE(PG8_SA(0, 0), Abase, offc[0]); PG8_STAGE(PG8_SA(0, 1), Abase, offc[1]);
    if (wr == 1) PG8_BAR;
    PG8_WAIT_V(2); PG8_BAR;
    PG8_STAGE(PG8_SB(1, 0), cB + kstep, voffB); PG8_STAGE(PG8_SA(1, 0), Abase + kstep, offc[0]); if constexpr (NBJ == 2) PG8_STAGE(PG8_SB(1, 1), cB + hstep + kstep, voffB);
    if constexpr (NBJ == 2) PG8_WAIT_V(6); else PG8_WAIT_V(4);
    PG8_BAR;
    for (;;) {
        const bool has_next = S.next(PG8_UIX(ui + 1), nxt);
        const char* nB = cB;
        if (has_next) {
            nB = S.b_ptr(nxt);
            PG8_AOFF(offn, nxt);
        } else {
#pragma unroll
            for (int h = 0; h < 2; ++h)
#pragma unroll
                for (int i = 0; i < 2; ++i) offn[h][i] = offc[h][i];
        }
#pragma unroll 1
        for (int t = 0; t < nt; t += 2) {
            const bool last = (t == nt - 2);
#ifdef PROBE_FAKEK
            stage_on = !((PROBE_FAKEK >> (EB == 1 ? 0 : 1)) & 1) || !(ui & 1) || last;
#endif
            const char* kp1 = Abase + (size_t)(t + 1) * kstep;
            const char* kp2 = last ? Abase : Abase + (size_t)(t + 2) * kstep; const char* b2 = last ? nB : cB + (size_t)(t + 2) * kstep;
            const char* kp3 = kp2 + kstep; const char* b3 = b2 + kstep;
            unsigned o2[2][2];
#pragma unroll
            for (int h = 0; h < 2; ++h)
#pragma unroll
                for (int i = 0; i < 2; ++i) o2[h][i] = last ? offn[h][i] : offc[h][i];
            PG8_LDB(B0, 0, 0); if constexpr (NBJ == 2) PG8_LDB(B1, 0, 1); PG8_SCHED; PG8_LDA(At, 0, 0); PG8_STAGE(PG8_SA(1, 1), kp1, offc[1]);
            PG8_WAIT_K; PG8_WAIT_L(0); PG8_BAR; PG8_MMA(0, 0, At, B0); if constexpr (NBJ == 2) PG8_MMA(0, 1, At, B1); PG8_BAR; PG8_SCHED;
            PG8_LDA(At, 0, 1); PG8_STAGE(PG8_SB(0, 0), b2, voffB); if constexpr (NBJ == 2) PG8_STAGE(PG8_SB(0, 1), b2 + hstep, voffB); PG8_STAGE(PG8_SA(0, 0), kp2, o2[0]);
            PG8_WAIT_K; PG8_WAIT_L(0); PG8_BAR; PG8_MMA(1, 0, At, B0); if constexpr (NBJ == 2) PG8_MMA(1, 1, At, B1); PG8_BAR; PG8_SCHED;
            PG8_LDB(B0, 1, 0); if constexpr (NBJ == 2) PG8_LDB(B1, 1, 1); PG8_SCHED; PG8_LDA(At, 1, 0); PG8_STAGE(PG8_SA(0, 1), kp2, o2[1]);
            PG8_WAIT_K; PG8_WAIT_L(0); PG8_BAR; PG8_MMA(0, 0, At, B0); if constexpr (NBJ == 2) PG8_MMA(0, 1, At, B1); PG8_BAR; PG8_SCHED;
            PG8_LDA(At, 1, 1); PG8_STAGE(PG8_SB(1, 0), b3, voffB); if constexpr (NBJ == 2) PG8_STAGE(PG8_SB(1, 1), b3 + hstep, voffB); PG8_STAGE(PG8_SA(1, 0), kp3, o2[0]);
            PG8_WAIT_K; PG8_WAIT_L(0); PG8_BAR; PG8_MMA(1, 0, At, B0); if constexpr (NBJ == 2) PG8_MMA(1, 1, At, B1); PG8_BAR; PG8_SCHED;
        }
        if constexpr (ALIGN_EPI) { if (wr == 0) PG8_BAR; }
        if constexpr (ACC16) {
#pragma unroll
            for (int a = 0; a < 2; ++a)
#pragma unroll
                for (int b = 0; b < NBJ; ++b)
#pragma unroll
                    for (int m = 0; m < 4; ++m)
#pragma unroll
                        for (int n = 0; n < 2; ++n) acc[a][b][m][n] = get4(accT[a][b][m >> 1], (m & 1) * 2 + n);
        }
#ifdef PROBE_FAKEK
        if (!(((PROBE_FAKEK >> (EB == 1 ? 0 : 1)) & 1) && (ui & 1)))
#endif
        { int l2 = (int)__builtin_amdgcn_mbcnt_hi(~0u, __builtin_amdgcn_mbcnt_lo(~0u, 0u)); asm volatile("" : "+v"(l2)); E(acc, cur, wr, wc, l2 & 15, l2 >> 4); }
#ifdef PROBE_EPI2
        if constexpr (((PROBE_EPI2 >> (EB == 1 ? 0 : 1)) & 1) != 0) { int l2 = (int)__builtin_amdgcn_mbcnt_hi(~0u, __builtin_amdgcn_mbcnt_lo(~0u, 0u)); asm volatile("" : "+v"(l2)); E(acc, cur, wr, wc, l2 & 15, l2 >> 4); }
#endif
        if (!has_next) break;
#pragma unroll
        for (int a = 0; a < 2; ++a)
#pragma unroll
            for (int b = 0; b < NBJ; ++b)
#pragma unroll
                for (int m = 0; m < 4; ++m)
#pragma unroll
                    for (int n = 0; n < 2; ++n) acc[a][b][m][n] = (f32x4){0.f, 0.f, 0.f, 0.f};
#pragma unroll
        for (int a = 0; a < 2; ++a)
#pragma unroll
            for (int b = 0; b < NBJ; ++b)
#pragma unroll
                for (int m = 0; m < 2; ++m)
#pragma unroll
                    for (int j = 0; j < 16; ++j) accT[a][b][m][j] = 0.f;
        cur = nxt; cB = nB; ++ui;
#pragma unroll
        for (int h = 0; h < 2; ++h)
#pragma unroll
            for (int i = 0; i < 2; ++i) offc[h][i] = offn[h][i];
        if constexpr (ALIGN_EPI) { if (wr == 1) PG8_BAR; }
    }
    PG8_WAIT_V(0);
    if constexpr (!ALIGN_EPI) { if (wr == 0) PG8_BAR; }
    PG8_BAR;
}
#undef PG8_AOFF
#undef PG8_SA
#undef PG8_SB
#undef PG8_STAGE
#undef PG8_LDA
#undef PG8_LDB
#undef PG8_MMA
#undef PG8_WAIT_V
#undef PG8_WAIT_L
#undef PG8_WAIT_K
#undef PG8_BAR
#undef PG8_SCHED
}

struct EpiStore {
    static constexpr bool PERM = true;
    bf16_t* out; int ld;
    __device__ __forceinline__ void operator()(const f32x4 (&acc)[2][2][4][2], const pg8::Unit& u, int wr, int wc, int fr, int fq) const {
        const int row0 = u.pm * 256 + wr * 64 + fr, col0 = u.pn * 256 + wc * 32 + 8 * fq;
#pragma unroll
        for (int ai = 0; ai < 2; ++ai)
#pragma unroll
            for (int m = 0; m < 4; ++m) { bf16_t* rowp = out + (size_t)(row0 + ai * 128 + m * 16) * ld + col0;
#pragma unroll
                for (int bj = 0; bj < 2; ++bj) { const f32x4 v0 = acc[ai][bj][m][0], v1 = acc[ai][bj][m][1];
                    u32x4 w; w.x = pk2bf(v0[0], v0[1]); w.y = pk2bf(v0[2], v0[3]); w.z = pk2bf(v1[0], v1[1]); w.w = pk2bf(v1[2], v1[3]);
                    *(u32x4*)(rowp + bj * 128) = w; } }
    }
};
template <bool XIN_F32>
struct EpiResidB {
    static constexpr bool PERM = true;
    const float* xin_f; bf16_t* xs; const float* modl; int g_off;
    __device__ __forceinline__ void operator()(const f32x4 (&acc)[2][2][4][2], const pg8::Unit& u, int wr, int wc, int fr, int fq) const {
        const int row0 = u.pm * 256 + wr * 64 + fr;
        const float* gp = modl + ((u.pm * 256) / SEQ) * NMOD + g_off;
#pragma unroll
        for (int bj = 0; bj < 2; ++bj) {
            const int c = u.pn * 256 + bj * 128 + wc * 32 + 8 * fq;
            const f32x4 g0 = *(const f32x4*)(gp + c), g1 = *(const f32x4*)(gp + c + 4);
#pragma unroll
            for (int ai = 0; ai < 2; ++ai)
#pragma unroll
                for (int m = 0; m < 4; ++m) {
                    const size_t o = (size_t)(row0 + ai * 128 + m * 16) * DM + c;
                    f32x4 x0, x1;
                    if (XIN_F32) { x0 = *(const f32x4*)(xin_f + o); x1 = *(const f32x4*)(xin_f + o + 4); }
                    else { const u32x4 w = *(const u32x4*)(xs + o);
                        x0 = (f32x4){bf2f((bf16_t)(w.x & 0xffff)), bf2f((bf16_t)(w.x >> 16)), bf2f((bf16_t)(w.y & 0xffff)), bf2f((bf16_t)(w.y >> 16))};
                        x1 = (f32x4){bf2f((bf16_t)(w.z & 0xffff)), bf2f((bf16_t)(w.z >> 16)), bf2f((bf16_t)(w.w & 0xffff)), bf2f((bf16_t)(w.w >> 16))}; }
                    const f32x4 y0 = x0 + g0 * acc[ai][bj][m][0], y1 = x1 + g1 * acc[ai][bj][m][1];
                    u32x4 w; w.x = pk2bf(y0[0], y0[1]); w.y = pk2bf(y0[2], y0[3]); w.z = pk2bf(y1[0], y1[1]); w.w = pk2bf(y1[2], y1[3]);
                    *(u32x4*)(xs + o) = w;
                }
        }
    }
};

#ifndef MOE_NBJ
#define MOE_NBJ 2
#endif
constexpr int MNB = MOE_NBJ, GU_NPN = 16 / MNB, DN_NPN = 8 / MNB;
struct SchedMoeGU {
    static constexpr int EB = 1, NBJ = MNB, WSCALE = 0x7A7A7A7A, ASCALE = 0x7F7F7F7F;
    const int* sidx; const char* Wgu; int G, v, nunits;
    __device__ __forceinline__ void init(const int* sidx_, const bf16_t* Wgu_layer, int G_, int c_, bool has_ctx) { sidx = sidx_; Wgu = (const char*)Wgu_layer; G = G_; v = (G_ % 8 == 0) ? (c_ % 8) * (G_ / 8) + c_ / 8 : c_; nunits = 32 * 8 * GU_NPN + (has_ctx ? 32 * GU_NPN : 0); }
    __device__ __forceinline__ bool next(int i, pg8::Unit& u) const {
        const int U = i * G + v; if (U >= nunits) return false;
        if (U < 32 * 8 * GU_NPN) { u.grp = U / (8 * GU_NPN); u.pm = (U % (8 * GU_NPN)) / GU_NPN; u.pn = U % GU_NPN; } else { const int w = U - 32 * 8 * GU_NPN; u.grp = 32 + w / GU_NPN; u.pm = 0; u.pn = w % GU_NPN; }
        return true; }
    __device__ __forceinline__ int a_row(const pg8::Unit& u, int r) const {
        if (u.grp < 32) return (u.grp >> 4) * SEQ + sidx[u.grp * CAP_L + u.pm * 256 + r];
        const int gc = u.grp - 32; return r < CAP_C ? NLAT + (gc >> 4) * CTX + sidx[32 * CAP_L + gc * CAP_C + r] : 0; }
    __device__ __forceinline__ const char* b_ptr(const pg8::Unit& u) const { return Wgu + ((size_t)(u.grp & 15) * 2048 + (size_t)u.pn * (128 * MNB)) * DM; }
};
struct EpiHidMk {
    static constexpr bool PERM = true;
    bf16_t* hid;
    __device__ __forceinline__ void operator()(const f32x4 (&acc)[2][MNB][4][2], const pg8::Unit& u, int wr, int wc, int fr, int fq) const {
        const bool isctx = u.grp >= 32;
        const size_t rbase = isctx ? (size_t)32 * CAP_L + (size_t)(u.grp - 32) * CAP_C : (size_t)u.grp * CAP_L + u.pm * 256;
        const int r0 = wr * 64 + fr + fq * 16, c0 = (u.pn * (128 * MNB) + wc * 32) >> 1;
#pragma unroll
        for (int ai = 0; ai < 2; ++ai)
#pragma unroll
            for (int bj = 0; bj < MNB; ++bj) {
                unsigned w[4];
#pragma unroll
                for (int m = 0; m < 4; ++m) { const f32x4 v0 = acc[ai][bj][m][0], v1 = acc[ai][bj][m][1];
                    w[m] = pk4fp8(silu_f(v0[0]) * v0[1], silu_f(v0[2]) * v0[3], silu_f(v1[0]) * v1[1], silu_f(v1[2]) * v1[3]); }
                { auto t = __builtin_amdgcn_permlane32_swap(w[0], w[2], false, false); w[0] = t[0]; w[2] = t[1]; }
                { auto t = __builtin_amdgcn_permlane32_swap(w[1], w[3], false, false); w[1] = t[0]; w[3] = t[1]; }
                { auto t = __builtin_amdgcn_permlane16_swap(w[0], w[1], false, false); w[0] = t[0]; w[1] = t[1]; }
                { auto t = __builtin_amdgcn_permlane16_swap(w[2], w[3], false, false); w[2] = t[0]; w[3] = t[1]; }
                const int r = r0 + ai * 128; if (isctx && r >= CAP_C) continue;
                u32x4 o; o.x = w[0]; o.y = w[1]; o.z = w[2]; o.w = w[3];
                *(u32x4*)((unsigned char*)hid + (rbase + r) * DFF + c0 + bj * 64) = o; }
    }
};
struct SchedMoeDown {
    static constexpr int EB = 1, NBJ = MNB, WSCALE = 0x7A7A7A7A, ASCALE = 0x7F7F7F7F;
    const char* Wd; int G, v, nunits;
    __device__ __forceinline__ void init(const bf16_t* Wd_layer, int G_, int c_, bool has_ctx) { Wd = (const char*)Wd_layer; G = G_; v = (G_ % 8 == 0) ? (c_ % 8) * (G_ / 8) + c_ / 8 : c_; nunits = 32 * 8 * DN_NPN + (has_ctx ? 32 * DN_NPN : 0); }
    __device__ __forceinline__ bool next(int i, pg8::Unit& u) const {
        const int U = i * G + v; if (U >= nunits) return false;
        if (U < 32 * 8 * DN_NPN) { u.grp = U / (8 * DN_NPN); u.pm = (U % (8 * DN_NPN)) / DN_NPN; u.pn = U % DN_NPN; } else { const int w = U - 32 * 8 * DN_NPN; u.grp = 32 + w / DN_NPN; u.pm = 0; u.pn = w % DN_NPN; }
        return true; }
    __device__ __forceinline__ int a_row(const pg8::Unit& u, int r) const { return u.grp < 32 ? u.grp * CAP_L + u.pm * 256 + r : 32 * CAP_L + (u.grp - 32) * CAP_C + r; }
    __device__ __forceinline__ const char* b_ptr(const pg8::Unit& u) const { return Wd + ((size_t)(u.grp & 15) * 1024 + (size_t)u.pn * (128 * MNB)) * DFF; }
};
struct EpiYeMk {
    static constexpr bool PERM = true;
    bf16_t* ye; const float* sg;
    __device__ __forceinline__ void operator()(const f32x4 (&acc)[2][MNB][4][2], const pg8::Unit& u, int wr, int wc, int fr, int fq) const {
        const bool isctx = u.grp >= 32;
        const size_t rbase = isctx ? (size_t)32 * CAP_L + (size_t)(u.grp - 32) * CAP_C : (size_t)u.grp * CAP_L + u.pm * 256;
        const int r0 = wr * 64 + fr, c0 = u.pn * (128 * MNB) + wc * 32 + 8 * fq;
#pragma unroll
        for (int ai = 0; ai < 2; ++ai)
#pragma unroll
            for (int m = 0; m < 4; ++m) { const int r = r0 + ai * 128 + m * 16; if (isctx && r >= CAP_C) continue;
                const float g = sg[rbase + r];
#pragma unroll
              for (int bj = 0; bj < MNB; ++bj) {
                const f32x4 v0 = acc[ai][bj][m][0] * g, v1 = acc[ai][bj][m][1] * g;
                u32x4 w; w.x = pk2bf(v0[0], v0[1]); w.y = pk2bf(v0[2], v0[3]); w.z = pk2bf(v1[0], v1[1]); w.w = pk2bf(v1[2], v1[3]);
                *(u32x4*)(ye + (rbase + r) * DM + c0 + bj * 128) = w; } }
    }
};

struct Frame {
    LAS unsigned char* lds; int tid, lane, wave, G, bid;
};
__device__ __forceinline__ Params lds_params(const Frame& F) {
    Params P;
    const LAS unsigned* t = (const LAS unsigned*)(F.lds + LDS_MISC + 64);
#pragma unroll
    for (int i = 0; i < 26; ++i) {
        const unsigned lo = (unsigned)__builtin_amdgcn_readfirstlane((int)t[2 * i]), hi = (unsigned)__builtin_amdgcn_readfirstlane((int)t[2 * i + 1]);
        const unsigned long long v = ((unsigned long long)hi << 32) | lo;
        if (i < 24) P.in[i] = (const float*)(const __attribute__((address_space(1))) float*)v; else if (i == 24) P.out = (float*)(__attribute__((address_space(1))) float*)v; else P.ws = (unsigned char*)(__attribute__((address_space(1))) unsigned char*)v;
    }
    P.ph_lo = 0; P.ph_hi = 0;
    return P;
}
enum { MAP_PLAIN = 0, MAP_GU = 1, MAP_QPERM = 2, MAP_SWAPERM = 3 };
struct CvtJob { const float* s0; const float* s1; bf16_t* dst; int ld_src, Ksrc, koff, nvalid, mode, ld_dst, ntr, ntk; float scale; int scale_rows; int fp8; };
__device__ __forceinline__ void cvt_load(const CvtJob& J, int tile, float (&v)[16]) {
    const int tr = tile % J.ntr, tk = tile / J.ntr, r0 = tr * 64, k0 = tk * 128, tid = my_tid();
    if (J.fp8 == 1) {
      const int g4 = tid & 15, kq = tid >> 4; const bool gu = J.mode == MAP_GU;
      const float* s4 = (gu && (g4 & 1)) ? J.s1 : J.s0; const int colb = gu ? (r0 >> 1) + (g4 >> 1) * 4 : r0 + g4 * 4;
#pragma unroll
      for (int j = 0; j < 4; ++j) { const f32x4 t4 = *(const f32x4*)(s4 + (size_t)(k0 + kq + 32 * j) * J.ld_src + colb); v[4 * j] = t4[0]; v[4 * j + 1] = t4[1]; v[4 * j + 2] = t4[2]; v[4 * j + 3] = t4[3]; }
      return; }
    const int rr = tid & 63, r = r0 + rr;
    const float* s = J.s0; int col = r;
    if (J.mode == MAP_GU) { s = (r & 1) ? J.s1 : J.s0; col = r >> 1; }
    else if (J.mode == MAP_QPERM) { const int h = r / 96, dd = r % 96; if (dd >= 64) { const int q = dd - 64, p = q >> 1; col = h * 96 + 64 + (p >> 3) * 16 + (q & 1) * 8 + (p & 7); } }
    else if (J.mode == MAP_SWAPERM) { if (r < 1280) { const int hh = r >> 6, dd = r & 63, p = dd >> 1; col = hh * 64 + (p >> 4) * 32 + (dd & 1) * 16 + (p & 15); } }
#pragma unroll
    for (int j = 0; j < 16; ++j) {
        const int kk = (tid >> 6) + 8 * j, ks = k0 + kk - J.koff;
        v[j] = (r < J.nvalid && ks >= 0 && ks < J.Ksrc) ? s[(size_t)ks * J.ld_src + col] : 0.f;
    }
}
__device__ __forceinline__ void cvt_store(const CvtJob& J, int tile, const float (&v)[16], LAS float* scr) {
    const int tr = tile % J.ntr, tk = tile / J.ntr, r0 = tr * 64, k0 = tk * 128, tid = my_tid();
    const int rr = tid & 63, r = r0 + rr;
    const float sc = ((r < J.scale_rows) ? J.scale : 1.f) * (J.fp8 == 2 ? 32.f : 1.f);
    if (J.fp8 == 1) { const int g4 = tid & 15, kq = tid >> 4; const bool gu = J.mode == MAP_GU;
#pragma unroll
      for (int j = 0; j < 4; ++j)
#pragma unroll
        for (int i = 0; i < 4; ++i) scr[(kq + 32 * j) * 65 + (gu ? 2 * ((g4 >> 1) * 4 + i) + (g4 & 1) : g4 * 4 + i)] = v[4 * j + i] * J.scale; }
    else {
#pragma unroll
    for (int j = 0; j < 16; ++j) scr[((tid >> 6) + 8 * j) * 65 + rr] = v[j] * sc; }
    __syncthreads();
    if (J.fp8) { const int r2 = tid >> 3, kc = (tid & 7) * 16; const LAS float* sp = scr + kc * 65 + r2;
      u32x4 w; w.x = pk4fp8(sp[0], sp[65], sp[2 * 65], sp[3 * 65]); w.y = pk4fp8(sp[4 * 65], sp[5 * 65], sp[6 * 65], sp[7 * 65]);
      w.z = pk4fp8(sp[8 * 65], sp[9 * 65], sp[10 * 65], sp[11 * 65]); w.w = pk4fp8(sp[12 * 65], sp[13 * 65], sp[14 * 65], sp[15 * 65]);
      *(u32x4*)((unsigned char*)J.dst + (size_t)(r0 + r2) * J.ld_dst + k0 + kc) = w; }
    else { const int r2 = tid >> 3, kc = (tid & 7) * 8; const LAS float* sp = scr + kc * 65 + r2; const LAS float* sq = sp + 64 * 65;
      u32x4 w0, w1;
      w0.x = pk2bf(sp[0], sp[65]); w0.y = pk2bf(sp[2 * 65], sp[3 * 65]); w0.z = pk2bf(sp[4 * 65], sp[5 * 65]); w0.w = pk2bf(sp[6 * 65], sp[7 * 65]);
      w1.x = pk2bf(sq[0], sq[65]); w1.y = pk2bf(sq[2 * 65], sq[3 * 65]); w1.z = pk2bf(sq[4 * 65], sq[5 * 65]); w1.w = pk2bf(sq[6 * 65], sq[7 * 65]);
      bf16_t* d = J.dst + (size_t)(r0 + r2) * J.ld_dst + k0 + kc;
      *(u32x4*)d = w0; *(u32x4*)(d + 64) = w1; }
}
constexpr int CVT_DENSE = 256 + 128 + 192 + 48 + 64 + 128 + 192, CVT_MOE = 16 * 384;
__device__ __forceinline__ void cvt_job(const Params& P, int g, CvtJob& J, int& tile) {
    unsigned char* W = P.ws + WS_W;
    if (g < 256) { J = CvtJob{P.in[8], nullptr, (bf16_t*)(W + OFF_WIN), AB_IN, DM, 0, AB_IN, MAP_PLAIN, DM, 32, 8, 1.f, 0, 0}; tile = g; return; } g -= 256;
    if (g < 128) { J = CvtJob{P.in[15], nullptr, (bf16_t*)(W + OFF_WOUT), DM, DM, 0, DM, MAP_PLAIN, DM, 16, 8, 1.f, 0, 0}; tile = g; return; } g -= 128;
    if (g < 192) { J = CvtJob{P.in[16], nullptr, (bf16_t*)(W + OFF_WQKV), 1536, DM, 0, 1536, MAP_SWAPERM, DM, 24, 8, 0.125f * LOG2E, 1024, 0}; tile = g; return; } g -= 192;
    if (g < 48) { J = CvtJob{P.in[12], nullptr, (bf16_t*)(W + OFF_WUP), 768, 256, 0, 768, MAP_QPERM, 512, 12, 4, 0.10206207261596575f * LOG2E * QF8_SCALE, 768, 2}; tile = g; return; } g -= 48;
    if (g < 64) { J = CvtJob{P.in[14], nullptr, (bf16_t*)((unsigned char*)(W + OFF_WUP) + (size_t)768 * 512), 1024, 128, 256, 1024, MAP_PLAIN, 512, 16, 4, 1.f, 0, 2}; tile = g; return; } g -= 64;
    if (g < 128) { J = CvtJob{P.in[18], nullptr, (bf16_t*)(W + OFF_WSO), DM, DM, 0, DM, MAP_PLAIN, DM, 16, 8, 1.f, 0, 2}; tile = g; return; } g -= 128;
    J = CvtJob{P.in[16], nullptr, (bf16_t*)(W + OFF_WQKV8), 1536, DM, 0, 1536, MAP_SWAPERM, DM, 24, 8, 0.125f * LOG2E * QF8_SCALE, 1024, 2}; tile = g;
}
__device__ __forceinline__ void cvt_job_moe(const Params& P, int layer, int g, CvtJob& J, int& tile) {
    unsigned char* W = P.ws + WS_W;
    const int e = g / 384, r = g % 384, le = layer * 16 + e;
    if (r < 256) { J = CvtJob{P.in[20] + (size_t)le * DM * DFF, P.in[21] + (size_t)le * DM * DFF, (bf16_t*)(W + OFF_WGU + (size_t)e * 2048 * DM), DFF, DM, 0, 2048, MAP_GU, DM, 32, 8, 32.f, 1 << 30, 1}; tile = r; }
    else { J = CvtJob{P.in[22] + (size_t)le * DFF * DM, nullptr, (bf16_t*)(W + OFF_WD + (size_t)e * 1024 * DFF), DM, DFF, 0, DM, MAP_PLAIN, DFF, 16, 8, 32.f, 1 << 30, 1}; tile = r - 256; }
}
template <bool MOE>
__device__ __forceinline__ void cvt_run(const Params& P, LAS float* scr, int layer, int first, int step, int total) {
    int g = first, par = 0; CvtJob Jc{}; int tc = 0; float vc[16];
    bool have = g < total;
    if (have) { if (MOE) cvt_job_moe(P, layer, g, Jc, tc); else cvt_job(P, g, Jc, tc); cvt_load(Jc, tc, vc); }
    while (have) {
        const int gn = g + step; const bool hn = gn < total; CvtJob Jn{}; int tn = 0; float vn[16];
        if (hn) { if (MOE) cvt_job_moe(P, layer, gn, Jn, tn); else cvt_job(P, gn, Jn, tn); cvt_load(Jn, tn, vn); }
        cvt_store(Jc, tc, vc, scr + par * (128 * 65)); par ^= 1;
        Jc = Jn; tc = tn; g = gn; have = hn;
#pragma unroll
        for (int j = 0; j < 16; ++j) vc[j] = vn[j];
    }
}

__device__ __forceinline__ void phase_prologue(Frame& F) {
  const Params P = lds_params(F);
    LAS float* scr = (LAS float*)F.lds;
    cvt_run<false>(P, scr, 0, F.bid, F.G, CVT_DENSE);
    {
        LAS float* sv = (LAS float*)(F.lds + 32768);
        LAS float* red = (LAS float*)(F.lds + 32768 + 12288);
        const float* c = P.in[1]; const float* c_ctx = P.in[3]; const float* mod_w = P.in[4]; const float* mod_b = P.in[5];
        float* modv = (float*)(P.ws + WS_MODV);
        __syncthreads();
        for (int i = F.tid; i < DM; i += NTHREADS) { sv[i] = silu_f(c[i]); sv[DM + i] = silu_f(c[DM + i]); sv[2 * DM + i] = silu_f(c_ctx[i]); }
        __syncthreads();
        for (int ch = F.bid; ch < 256; ch += F.G) {
            const int jg = ch * 48, l = jg / NMOD, j0 = jg % NMOD, rg = F.tid >> 4, ct = F.tid & 15;
            const float* w = mod_w + (size_t)l * DM * NMOD + j0 + 3 * ct;
            float a[3][3];
#pragma unroll
            for (int x = 0; x < 3; ++x)
#pragma unroll
                for (int y = 0; y < 3; ++y) a[x][y] = 0.f;
            for (int d = rg; d < DM; d += 32) { const float w0 = w[(size_t)d * NMOD], w1 = w[(size_t)d * NMOD + 1], w2 = w[(size_t)d * NMOD + 2];
#pragma unroll
                for (int x = 0; x < 3; ++x) { const float s = sv[x * DM + d]; a[x][0] += s * w0; a[x][1] += s * w1; a[x][2] += s * w2; } }
#pragma unroll
            for (int x = 0; x < 3; ++x)
#pragma unroll
                for (int y = 0; y < 3; ++y) red[rg * 144 + x * 48 + 3 * ct + y] = a[x][y];
            __syncthreads();
            if (F.tid < 144) { float s = 0.f; for (int r = 0; r < 32; ++r) s += red[r * 144 + F.tid]; const int x = F.tid / 48, jj = j0 + F.tid % 48; modv[(l * 3 + x) * NMOD + jj] = s + mod_b[l * NMOD + jj]; }
            __syncthreads();
        }
    }
    {
        float* tab = (float*)(P.ws + WS_ROPE);
        for (int i = F.bid * 64 + F.tid; i < 256 * 16 && F.tid < 64; i += F.G * 64) {
            if (i < 256 * 8) { const int p = i / 8, f = i % 8; const double fr = pow(10000.0, -(double)(2 * f) / 16.0); const double a = (double)p * fr; tab[i] = (float)cos(a); tab[2048 + i] = (float)sin(a); }
            { const int p = i / 16, f = i % 16; const double fr = pow(10000.0, -(double)(2 * f) / 32.0); const double a = (double)p * fr; tab[4096 + i] = (float)cos(a); tab[8192 + i] = (float)sin(a); }
        }
    }
}


namespace att {
using f32x16 = __attribute__((ext_vector_type(16))) float;
using s16x4  = __attribute__((ext_vector_type(4))) short;
__device__ __forceinline__ int crow(int r, int hi) { return (r & 3) + 8 * (r >> 2) + 4 * hi; }
__device__ __forceinline__ unsigned cvtpk(float lo, float hi) { unsigned r;
#ifdef PROBE_FP8ATT
  if (PROBE_FP8ATT & 4) { lo = fp8rt(lo, 1.f); hi = fp8rt(hi, 1.f); }
#endif
  asm volatile("v_cvt_pk_bf16_f32 %0, %1, %2" : "=v"(r) : "v"(lo), "v"(hi)); return r; }
__device__ __forceinline__ int v_rd_base(int lane) { return ((lane & 3) << 3) | (((lane >> 2) & 3) << 6) | (((lane >> 4) & 1) << 5) | (((lane >> 5) & 1) << 8); }
constexpr int v_rd_off(int d0, int ks, int half) { return d0 * 512 + ks * 2048 + half * 1024; }
template <int OFF> __device__ __forceinline__ s16x4 tr_read(int vb) {
  s16x4 r; asm volatile("ds_read_b64_tr_b16 %0, %1 offset:%2" : "=&v"(r) : "v"(vb), "i"(OFF) : "memory"); return r;
}
}


namespace att2 {
using att::f32x16; using att::s16x4; using att::crow; using att::cvtpk; using att::v_rd_base; using att::v_rd_off; using att::tr_read;
constexpr int VT = 8192, NSLOT = 4, LDS_WS = NSLOT * (12288 + VT);
#ifndef A2_PIPE
#define A2_PIPE 2
#endif
constexpr float THR = 8.f, P8_BIAS = 4.f;
#define A2_SBAR() __builtin_amdgcn_sched_barrier(0)
template <bool FAST, int ABL = 0, bool PACK = true>
__device__ __forceinline__ void softmax_blk(f32x16& p0, f32x16& p1, float& m_reg, float& l_reg, float& alpha, bf16x8& pa0, bf16x8& pa1, bf16x8& pa2, bf16x8& pa3) {
  if (FAST) {
    float ps = 0.f;
#pragma unroll
    for (int r = 0; r < 16; ++r) { if (ABL != 1) { p0[r] = __builtin_amdgcn_exp2f(p0[r]); p1[r] = __builtin_amdgcn_exp2f(p1[r]); } }
    if (ABL != 1) {
#pragma unroll
    for (int r = 0; r < 16; ++r) ps += p0[r] + p1[r];
    { auto rr = __builtin_amdgcn_permlane32_swap(__float_as_uint(ps), __float_as_uint(ps), false, false);
      ps = __uint_as_float(rr[0]) + __uint_as_float(rr[1]); }
    } else ps = 1.f;
    l_reg += ps; alpha = 1.f;
  } else {
  float pmax = fmaxf(p0[0], p1[0]);
#pragma unroll
  for (int r = 1; r < 16; ++r) pmax = fmaxf(fmaxf(pmax, p0[r]), p1[r]);
  { auto rr = __builtin_amdgcn_permlane32_swap(__float_as_uint(pmax), __float_as_uint(pmax), false, false);
    pmax = fmaxf(__uint_as_float(rr[0]), __uint_as_float(rr[1])); }
  float mn;
  if (__builtin_expect(__all(pmax - m_reg <= THR), 1)) { mn = m_reg; alpha = 1.f; }
  else { mn = fmaxf(m_reg, pmax); alpha = __builtin_amdgcn_exp2f(m_reg - mn); m_reg = mn; }
  float ps = 0.f;
#pragma unroll
  for (int r = 0; r < 16; ++r) { p0[r] = __builtin_amdgcn_exp2f(p0[r] - mn); p1[r] = __builtin_amdgcn_exp2f(p1[r] - mn); }
#pragma unroll
  for (int r = 0; r < 16; ++r) ps += p0[r] + p1[r];
  { auto rr = __builtin_amdgcn_permlane32_swap(__float_as_uint(ps), __float_as_uint(ps), false, false);
    ps = __uint_as_float(rr[0]) + __uint_as_float(rr[1]); }
  l_reg = l_reg * alpha + ps;
  }
#define A2_PK4(P, BASE, OUT) do { unsigned a0 = cvtpk(P[BASE + 0], P[BASE + 1]), a1 = cvtpk(P[BASE + 2], P[BASE + 3]);   \
    unsigned b0 = cvtpk(P[BASE + 4], P[BASE + 5]), b1 = cvtpk(P[BASE + 6], P[BASE + 7]);                              \
    auto r0 = __builtin_amdgcn_permlane32_swap(a0, b0, false, false); auto r1 = __builtin_amdgcn_permlane32_swap(a1, b1, false, false); \
    u32x4 w = {r0[0], r1[0], r0[1], r1[1]}; OUT = *reinterpret_cast<bf16x8*>(&w); } while (0)
  if constexpr (PACK) { A2_PK4(p0, 0, pa0); A2_PK4(p0, 8, pa1); A2_PK4(p1, 0, pa2); A2_PK4(p1, 8, pa3); }
#undef A2_PK4
}

template <bool FAST, int ABL = 0, int DK = 96, bool SWA = false, bool F8 = false>
__device__ __forceinline__ bool attn_unit(const bf16_t* __restrict__ Qb_, const int rows_valid, const char* __restrict__ Kimg, const char* __restrict__ Vimg,
                                          bf16_t* __restrict__ Ob_, const int NT, LAS unsigned char* lds, const int lt0 = 0, const int q0 = 0, const float* sinkp = nullptr) {
  constexpr bool PIPED = (A2_PIPE != 0) && F8 && FAST && ABL == 0 && DK == 96;
  constexpr int ND = DK / 16, KT = F8 ? DK * 64 : DK * 128, VTX = F8 ? 4096 : VT, ONESB = PIPED ? 2048 : 0, VO = KT + ONESB, SLOT = KT + ONESB + VTX;
  constexpr int QB = F8 ? 1 : 2;
  const bf16_t* Qb = Qb_; bf16_t* Ob = Ob_;
  const int tid = my_tid(), wid = __builtin_amdgcn_readfirstlane(tid >> 6), lane = tid & 63, r32 = lane & 31, hi = lane >> 5;
  LAS float* ws = (LAS float*)(lds + LDS_WS) + wid * 128;
  float mA = -1e30f, mB = -1e30f, lA = 0.f, lB = 0.f; f32x16 oA[2] = {}, oB[2] = {};
  bf16x8 qA[ND], qB[ND]; pg8::v8i32 qA8[2], qB8[2];
  const int wrow0 = SWA ? (wid >> 2) * 64 : wid * 64;
  if (SWA) { Qb = (const bf16_t*)((const char*)Qb + (size_t)(wid & 3) * SEQ * DK * QB); Ob = (bf16_t*)((unsigned char*)Ob + (wid & 3) * 64); }
  { int ra = wrow0 + r32, rb = ra + 32; if (ra >= rows_valid) ra = 0; if (rb >= rows_valid) rb = 0;
    if constexpr (F8) { const char* pa_ = (const char*)Qb + (size_t)ra * DK; const char* pb_ = (const char*)Qb + (size_t)rb * DK;
      const pg8::v8i32 z8 = {0, 0, 0, 0, 0, 0, 0, 0};
      qA8[0] = *reinterpret_cast<const pg8::v8i32*>(pa_ + hi * 32); qB8[0] = *reinterpret_cast<const pg8::v8i32*>(pb_ + hi * 32);
      if constexpr (DK == 96) { const pg8::v8i32 ta = *reinterpret_cast<const pg8::v8i32*>(pa_ + 64), tb = *reinterpret_cast<const pg8::v8i32*>(pb_ + 64);
        pg8::v8i32 zb = z8; if constexpr (PIPED) zb[0] = 0xE8;
        qA8[1] = hi ? zb : ta; qB8[1] = hi ? zb : tb; } else { qA8[1] = z8; qB8[1] = z8; }
      asm volatile("" : "+v"(qA8[0]), "+v"(qA8[1]), "+v"(qB8[0]), "+v"(qB8[1]));
    } else {
    const bf16_t* pa_ = Qb + (size_t)ra * DK + hi * 8; const bf16_t* pb_ = Qb + (size_t)rb * DK + hi * 8;
#pragma unroll
    for (int d0 = 0; d0 < ND; ++d0) { qA[d0] = *reinterpret_cast<const bf16x8*>(pa_ + d0 * 16); qB[d0] = *reinterpret_cast<const bf16x8*>(pb_ + d0 * 16); } } }
  const bool two = F8 ? false : (DK == 96) && wid < 4;
  const bool hasK = F8 ? wid < 6 : true, hasV = F8 ? (wid < 2 || wid >= 6) : true;
  const int vpiece = F8 ? (wid >= 6 ? wid - 6 : wid + 2) : wid;
  const char* ksrc = Kimg + wid * 1024 + lane * 16; const char* vsrc = Vimg + vpiece * 1024 + lane * 16;
  constexpr int NKP = KT / 1024;
  const char* f8a = (wid < NKP) ? Kimg + wid * 1024 : Vimg + (wid - NKP) * 1024; const int f8as = (wid < NKP) ? KT : VTX, f8ad = (wid < NKP) ? wid * 1024 : VO + (wid - NKP) * 1024;
  const char* f8b = (wid < 2) ? Vimg + (wid + 2) * 1024 : f8a; const int f8bs = (wid < 2) ? VTX : f8as, f8bd = (wid < 2) ? VO + (wid + 2) * 1024 : LDS_WS + 8192 + wid * 1024; const bool f8breal = wid < 2;
#define A2_DMA8(t, s) do { const int it8_ = (SWA && (t) >= 4) ? lt0 + (t) : (t); const char* ga_ = f8a + (size_t)it8_ * f8as; const char* gb_ = f8b + (size_t)it8_ * f8bs; unsigned vo_ = (unsigned)lane * 16u; asm volatile("" : "+s"(ga_)); asm volatile("" : "+s"(gb_)); asm volatile("" : "+v"(vo_)); \
    __builtin_amdgcn_global_load_lds((const unsigned*)(ga_ + vo_), (LAS unsigned*)(lds + (s) * SLOT + f8ad), 16, 0, 0); \
    if constexpr (DK == 96) __builtin_amdgcn_global_load_lds((const unsigned*)(gb_ + vo_), (LAS unsigned*)(lds + (f8breal ? (s) * SLOT : 0) + f8bd), 16, 0, 0); } while (0)
#define A2_DMA(t, s) do { if constexpr (F8) { A2_DMA8(t, s); break; } const int it_ = (SWA && (t) >= 4) ? lt0 + (t) : (t); \
    if (hasK) __builtin_amdgcn_global_load_lds((const unsigned*)(ksrc + (size_t)it_ * KT), (LAS unsigned*)(lds + (s) * SLOT + wid * 1024), 16, 0, 0); \
    if (two) __builtin_amdgcn_global_load_lds((const unsigned*)(ksrc + (size_t)it_ * KT + 8192), (LAS unsigned*)(lds + (s) * SLOT + 8192 + wid * 1024), 16, 0, 0); \
    if (hasV) __builtin_amdgcn_global_load_lds((const unsigned*)(vsrc + (size_t)it_ * VTX), (LAS unsigned*)(lds + (s) * SLOT + KT + vpiece * 1024), 16, 0, 0); } while (0)
  LAS unsigned* flag = (LAS unsigned*)(lds + LDS_WS + 4096);
  if (FAST && tid == 0) *flag = 0u;
  asm volatile("s_waitcnt vmcnt(0)" ::: "memory");
  A2_DMA(0, 0); A2_DMA(1, 1);
  if constexpr (A2_PIPE == 2 && F8 && FAST && ABL == 0 && DK == 96) { A2_DMA(2, 2); }
  const int vb0 = (int)(uintptr_t)(lds + KT) + v_rd_base(lane);
  const int kb0 = hi * 1024 + r32 * 16;
  const int qpA = q0 + wrow0 + r32;
#define A2_PK(L, H) (bf16x8){L[0], L[1], L[2], L[3], H[0], H[1], H[2], H[3]}
#define A2_PV(D0, VB) do { \
      const s16x4 l0 = tr_read<v_rd_off(D0, 0, 0)>(VB), h0 = tr_read<v_rd_off(D0, 0, 1)>(VB), l1 = tr_read<v_rd_off(D0, 1, 0)>(VB), h1 = tr_read<v_rd_off(D0, 1, 1)>(VB); \
      const s16x4 l2 = tr_read<v_rd_off(D0, 2, 0)>(VB), h2 = tr_read<v_rd_off(D0, 2, 1)>(VB), l3 = tr_read<v_rd_off(D0, 3, 0)>(VB), h3 = tr_read<v_rd_off(D0, 3, 1)>(VB); \
      asm volatile("s_waitcnt lgkmcnt(0)" ::: "memory"); A2_SBAR(); \
      const bf16x8 v0_ = A2_PK(l0, h0), v1_ = A2_PK(l1, h1), v2_ = A2_PK(l2, h2), v3_ = A2_PK(l3, h3); \
      if (ABL == 3) { asm volatile("" :: "v"(v0_), "v"(v1_), "v"(v2_), "v"(v3_), "v"(a0), "v"(a1), "v"(a2), "v"(a3), "v"(b0), "v"(b1), "v"(b2), "v"(b3)); } else { \
      oA[D0] = __builtin_amdgcn_mfma_f32_32x32x16_bf16(a0, v0_, oA[D0], 0, 0, 0); oB[D0] = __builtin_amdgcn_mfma_f32_32x32x16_bf16(b0, v0_, oB[D0], 0, 0, 0); \
      oA[D0] = __builtin_amdgcn_mfma_f32_32x32x16_bf16(a1, v1_, oA[D0], 0, 0, 0); oB[D0] = __builtin_amdgcn_mfma_f32_32x32x16_bf16(b1, v1_, oB[D0], 0, 0, 0); \
      oA[D0] = __builtin_amdgcn_mfma_f32_32x32x16_bf16(a2, v2_, oA[D0], 0, 0, 0); oB[D0] = __builtin_amdgcn_mfma_f32_32x32x16_bf16(b2, v2_, oB[D0], 0, 0, 0); \
      oA[D0] = __builtin_amdgcn_mfma_f32_32x32x16_bf16(a3, v3_, oA[D0], 0, 0, 0); oB[D0] = __builtin_amdgcn_mfma_f32_32x32x16_bf16(b3, v3_, oB[D0], 0, 0, 0); } } while (0)
#define A2_PV2(VB) do { \
      const s16x4 l0 = tr_read<v_rd_off(0, 0, 0)>(VB), h0 = tr_read<v_rd_off(0, 0, 1)>(VB), l1 = tr_read<v_rd_off(0, 1, 0)>(VB), h1 = tr_read<v_rd_off(0, 1, 1)>(VB); \
      const s16x4 l2 = tr_read<v_rd_off(0, 2, 0)>(VB), h2 = tr_read<v_rd_off(0, 2, 1)>(VB), l3 = tr_read<v_rd_off(0, 3, 0)>(VB), h3 = tr_read<v_rd_off(0, 3, 1)>(VB); \
      const s16x4 m0 = tr_read<v_rd_off(1, 0, 0)>(VB), n0 = tr_read<v_rd_off(1, 0, 1)>(VB), m1 = tr_read<v_rd_off(1, 1, 0)>(VB), n1 = tr_read<v_rd_off(1, 1, 1)>(VB); \
      const s16x4 m2 = tr_read<v_rd_off(1, 2, 0)>(VB), n2 = tr_read<v_rd_off(1, 2, 1)>(VB), m3 = tr_read<v_rd_off(1, 3, 0)>(VB), n3 = tr_read<v_rd_off(1, 3, 1)>(VB); \
      asm volatile("s_waitcnt lgkmcnt(0)" ::: "memory"); A2_SBAR(); \
      const bf16x8 v0_ = A2_PK(l0, h0), v1_ = A2_PK(l1, h1), v2_ = A2_PK(l2, h2), v3_ = A2_PK(l3, h3); \
      const bf16x8 w0_ = A2_PK(m0, n0), w1_ = A2_PK(m1, n1), w2_ = A2_PK(m2, n2), w3_ = A2_PK(m3, n3); \
      oA[0] = __builtin_amdgcn_mfma_f32_32x32x16_bf16(a0, v0_, oA[0], 0, 0, 0); oB[0] = __builtin_amdgcn_mfma_f32_32x32x16_bf16(b0, v0_, oB[0], 0, 0, 0); \
      oA[1] = __builtin_amdgcn_mfma_f32_32x32x16_bf16(a0, w0_, oA[1], 0, 0, 0); oB[1] = __builtin_amdgcn_mfma_f32_32x32x16_bf16(b0, w0_, oB[1], 0, 0, 0); \
      oA[0] = __builtin_amdgcn_mfma_f32_32x32x16_bf16(a1, v1_, oA[0], 0, 0, 0); oB[0] = __builtin_amdgcn_mfma_f32_32x32x16_bf16(b1, v1_, oB[0], 0, 0, 0); \
      oA[1] = __builtin_amdgcn_mfma_f32_32x32x16_bf16(a1, w1_, oA[1], 0, 0, 0); oB[1] = __builtin_amdgcn_mfma_f32_32x32x16_bf16(b1, w1_, oB[1], 0, 0, 0); \
      oA[0] = __builtin_amdgcn_mfma_f32_32x32x16_bf16(a2, v2_, oA[0], 0, 0, 0); oB[0] = __builtin_amdgcn_mfma_f32_32x32x16_bf16(b2, v2_, oB[0], 0, 0, 0); \
      oA[1] = __builtin_amdgcn_mfma_f32_32x32x16_bf16(a2, w2_, oA[1], 0, 0, 0); oB[1] = __builtin_amdgcn_mfma_f32_32x32x16_bf16(b2, w2_, oB[1], 0, 0, 0); \
      oA[0] = __builtin_amdgcn_mfma_f32_32x32x16_bf16(a3, v3_, oA[0], 0, 0, 0); oB[0] = __builtin_amdgcn_mfma_f32_32x32x16_bf16(b3, v3_, oB[0], 0, 0, 0); \
      oA[1] = __builtin_amdgcn_mfma_f32_32x32x16_bf16(a3, w3_, oA[1], 0, 0, 0); oB[1] = __builtin_amdgcn_mfma_f32_32x32x16_bf16(b3, w3_, oB[1], 0, 0, 0); } while (0)
#define A2_WAITV(more) do { if (ABL == 5) break; if constexpr (F8) { if (more) { if constexpr (DK == 96) asm volatile("s_waitcnt vmcnt(2)" ::: "memory"); else asm volatile("s_waitcnt vmcnt(1)" ::: "memory"); } else asm volatile("s_waitcnt vmcnt(0)" ::: "memory"); break; } if (more) { if (two) asm volatile("s_waitcnt vmcnt(3)" ::: "memory"); else if (hasK && hasV) asm volatile("s_waitcnt vmcnt(2)" ::: "memory"); else asm volatile("s_waitcnt vmcnt(1)" ::: "memory"); } \
    else asm volatile("s_waitcnt vmcnt(0)" ::: "memory"); } while (0)
#define A2_MF8(KF, QF, ACC) __builtin_amdgcn_mfma_scale_f32_32x32x64_f8f6f4(KF, QF, ACC, 0, 0, 0, 0x7B7B7B7B, 0, 0x7F7F7F7F)
#define A2_MF8P(PF, VF, ACC) __builtin_amdgcn_mfma_scale_f32_32x32x64_f8f6f4(PF, VF, ACC, 0, 0, 0, 0x7F7F7F7F, 0, 0x7F7F7F7F)
#define A2_TILE(S, t) do { \
    A2_WAITV((t) + 1 < NT); \
    if (ABL != 5) __builtin_amdgcn_s_barrier(); \
    A2_SBAR(); \
    if ((t) + 2 < NT) { A2_DMA((t) + 2, ((S) + 2) % 4); } \
    const LAS unsigned char* Ks = lds + (S) * SLOT + kb0; \
    f32x16 pA0 = {}, pA1 = {}, pB0 = {}, pB1 = {}; \
    if constexpr (F8 && FAST) { _Pragma("unroll") for (int r = 0; r < 16; ++r) { pA0[r] = -P8_BIAS; pA1[r] = -P8_BIAS; pB0[r] = -P8_BIAS; pB1[r] = -P8_BIAS; } }     \
    if constexpr (F8 && DK == 64) { const LAS unsigned char* K0 = lds + (S) * SLOT + hi * 2048 + r32 * 16; \
      const pg8::v8i32 k00 = pg8::cat32(*(const LAS bf16x8*)(K0), *(const LAS bf16x8*)(K0 + 1024)), k01 = pg8::cat32(*(const LAS bf16x8*)(K0 + 512), *(const LAS bf16x8*)(K0 + 1536)); \
      pA0 = A2_MF8(k00, qA8[0], pA0); pA1 = A2_MF8(k01, qA8[0], pA1); pB0 = A2_MF8(k00, qB8[0], pB0); pB1 = A2_MF8(k01, qB8[0], pB1); \
      asm volatile("" : "+v"(pA0), "+v"(pA1), "+v"(pB0), "+v"(pB1)); A2_SBAR(); } else \
    if constexpr (F8) { const LAS unsigned char* K0 = lds + (S) * SLOT + hi * 2048 + r32 * 16; const LAS unsigned char* K1 = lds + (S) * SLOT + 4096 + r32 * 16; \
      const pg8::v8i32 k00 = pg8::cat32(*(const LAS bf16x8*)(K0), *(const LAS bf16x8*)(K0 + 1024)), k01 = pg8::cat32(*(const LAS bf16x8*)(K0 + 512), *(const LAS bf16x8*)(K0 + 1536)); \
      const pg8::v8i32 k10 = pg8::cat32(*(const LAS bf16x8*)(K1), *(const LAS bf16x8*)(K1 + 1024)), k11 = pg8::cat32(*(const LAS bf16x8*)(K1 + 512), *(const LAS bf16x8*)(K1 + 1536)); \
      if (ABL == 2) { asm volatile("" :: "v"(k00), "v"(k01), "v"(k10), "v"(k11)); pA0[0] += 0.01f; pB1[1] += 0.02f; } else { \
      pA0 = A2_MF8(k00, qA8[0], pA0); pA1 = A2_MF8(k01, qA8[0], pA1); pB0 = A2_MF8(k00, qB8[0], pB0); pB1 = A2_MF8(k01, qB8[0], pB1); \
      pA0 = A2_MF8(k10, qA8[1], pA0); pA1 = A2_MF8(k11, qA8[1], pA1); pB0 = A2_MF8(k10, qB8[1], pB0); pB1 = A2_MF8(k11, qB8[1], pB1); } \
      asm volatile("" : "+v"(pA0), "+v"(pA1), "+v"(pB0), "+v"(pB1)); A2_SBAR(); } else { \
    bf16x8 kf[2][2]; if (ABL == 4) { kf[0][0] = qA[0]; kf[0][1] = qB[0]; } else { kf[0][0] = *(const LAS bf16x8*)(Ks); kf[0][1] = *(const LAS bf16x8*)(Ks + 512); } \
    _Pragma("unroll") for (int d0 = 0; d0 < ND; ++d0) {              \
      if (d0 + 1 < ND) { if (ABL == 4) { kf[(d0 + 1) & 1][0] = qA[d0 + 1]; kf[(d0 + 1) & 1][1] = qB[d0 + 1]; } else { kf[(d0 + 1) & 1][0] = *(const LAS bf16x8*)(Ks + (d0 + 1) * 2048); kf[(d0 + 1) & 1][1] = *(const LAS bf16x8*)(Ks + (d0 + 1) * 2048 + 512); } } \
      const bf16x8 k0 = kf[d0 & 1][0], k1 = kf[d0 & 1][1]; \
      if (ABL == 2) { asm volatile("" :: "v"(k0), "v"(k1)); pA0[d0] += 0.01f; pB1[d0] += 0.02f; } else { \
      pA0 = __builtin_amdgcn_mfma_f32_32x32x16_bf16(k0, qA[d0], pA0, 0, 0, 0); pA1 = __builtin_amdgcn_mfma_f32_32x32x16_bf16(k1, qA[d0], pA1, 0, 0, 0); \
      pB0 = __builtin_amdgcn_mfma_f32_32x32x16_bf16(k0, qB[d0], pB0, 0, 0, 0); pB1 = __builtin_amdgcn_mfma_f32_32x32x16_bf16(k1, qB[d0], pB1, 0, 0, 0); } \
      A2_SBAR(); } } \
    if (SWA && (t) >= 4) { const int kb_ = 64 * (lt0 + (t) - 4) - qpA;          \
      _Pragma("unroll") for (int r = 0; r < 16; ++r) { const int dA = kb_ + crow(r, hi), dB = dA - 32; \
        if (dA > 128 || dA < -128) pA0[r] = -INFINITY; if (dA + 32 > 128 || dA + 32 < -128) pA1[r] = -INFINITY; \
        if (dB > 128 || dB < -128) pB0[r] = -INFINITY; if (dB + 32 > 128 || dB + 32 < -128) pB1[r] = -INFINITY; } } \
    float alA, alB; bf16x8 a0, a1, a2, a3, b0, b1, b2, b3; \
    pg8::v8i32 pa8, pb8; \
    softmax_blk<FAST, ABL, !F8>(pA0, pA1, mA, lA, alA, a0, a1, a2, a3); \
    if constexpr (F8) { _Pragma("unroll") for (int j = 0; j < 4; ++j) { pa8[j] = (int)pk4fp8(pA0[4 * j], pA0[4 * j + 1], pA0[4 * j + 2], pA0[4 * j + 3]); pa8[4 + j] = (int)pk4fp8(pA1[4 * j], pA1[4 * j + 1], pA1[4 * j + 2], pA1[4 * j + 3]); } asm volatile("" : "+v"(pa8)); } \
    A2_SBAR(); \
    A2_MID((t) + 2 < NT); \
    A2_SBAR(); \
    softmax_blk<FAST, ABL, !F8>(pB0, pB1, mB, lB, alB, b0, b1, b2, b3); \
    if (!FAST && __any(alA < 1.f || alB < 1.f)) {                            \
      if (hi == 0) { ws[64 + r32] = alA; ws[96 + r32] = alB; } \
      asm volatile("s_waitcnt lgkmcnt(0)" ::: "memory"); \
      _Pragma("unroll") for (int d = 0; d < 2; ++d) _Pragma("unroll") for (int r = 0; r < 16; ++r) { oA[d][r] *= ws[64 + crow(r, hi)]; oB[d][r] *= ws[96 + crow(r, hi)]; } } \
    if constexpr (F8) { const LAS unsigned char* Vs = lds + (S) * SLOT + VO + hi * 512 + r32 * 16; \
      const pg8::v8i32 v0_ = pg8::cat32(*(const LAS bf16x8*)(Vs), *(const LAS bf16x8*)(Vs + 1024)), v1_ = pg8::cat32(*(const LAS bf16x8*)(Vs + 2048), *(const LAS bf16x8*)(Vs + 3072)); \
      _Pragma("unroll") for (int j = 0; j < 4; ++j) { pb8[j] = (int)pk4fp8(pB0[4 * j], pB0[4 * j + 1], pB0[4 * j + 2], pB0[4 * j + 3]); pb8[4 + j] = (int)pk4fp8(pB1[4 * j], pB1[4 * j + 1], pB1[4 * j + 2], pB1[4 * j + 3]); } asm volatile("" : "+v"(pb8)); \
      asm volatile("s_waitcnt lgkmcnt(0)" ::: "memory"); A2_SBAR(); \
      if (ABL == 3) { asm volatile("" :: "v"(v0_), "v"(v1_), "v"(pa8), "v"(pb8)); } else { \
      oA[0] = A2_MF8P(pa8, v0_, oA[0]); oB[0] = A2_MF8P(pb8, v0_, oB[0]); oA[1] = A2_MF8P(pa8, v1_, oA[1]); oB[1] = A2_MF8P(pb8, v1_, oB[1]); } \
      asm volatile("" : "+v"(oA[0]), "+v"(oA[1]), "+v"(oB[0]), "+v"(oB[1])); \
    } else { A2_PV(0, vb0 + (S) * SLOT); A2_PV(1, vb0 + (S) * SLOT); } \
    asm volatile("s_waitcnt lgkmcnt(0)" ::: "memory"); \
  } while (0)
#ifdef A2_NOSTAGGER
#define A2_MID(more) do { } while (0)
#else
#define A2_MID(more) do { A2_WAITV(more); if (ABL != 5) __builtin_amdgcn_s_barrier(); } while (0)
#endif
  if constexpr (A2_PIPE && F8 && FAST && ABL == 0 && DK == 96) {
#define P8_LD(p) (*(const LAS bf16x8*)(p))
#define P8_ADD(a_, b_) ({ float o_ = (a_) + (b_); asm("" : "+v"(o_)); o_; })
    const LAS unsigned char* kp0 = lds + hi * 2048 + r32 * 16; const LAS unsigned char* kp1 = hi ? lds + KT : lds + 4096 + r32 * 16; const LAS unsigned char* vp0 = lds + VO + hi * 512 + r32 * 16;
    asm volatile("" : "+v"(kp0), "+v"(kp1), "+v"(vp0));
#define P8_KA(S) const LAS unsigned char* K0_ = kp0 + (S) * SLOT; const pg8::v8i32 k00 = pg8::cat32(P8_LD(K0_), P8_LD(K0_ + 1024)), k01 = pg8::cat32(P8_LD(K0_ + 512), P8_LD(K0_ + 1536));
#define P8_KB(S) const LAS unsigned char* K1_ = kp1 + (S) * SLOT; const pg8::v8i32 k10 = pg8::cat32(P8_LD(K1_), P8_LD(K1_ + 1024)), k11 = pg8::cat32(P8_LD(K1_ + 512), P8_LD(K1_ + 1536));
#define P8_VF(S) const LAS unsigned char* Vs_ = vp0 + (S) * SLOT; \
      const pg8::v8i32 v0_ = pg8::cat32(P8_LD(Vs_), P8_LD(Vs_ + 1024)), v1_ = pg8::cat32(P8_LD(Vs_ + 2048), P8_LD(Vs_ + 3072));
#define P8_BIAS16(name)
#define P8_SMG(g, p0, p1, lreg, p8) do { _Pragma("unroll") for (int r_ = 4 * (g); r_ < 4 * (g) + 4; ++r_) { p0[r_] = __builtin_amdgcn_exp2f(p0[r_]); p1[r_] = __builtin_amdgcn_exp2f(p1[r_]); } \
      { float s0_ = P8_ADD(p0[4 * (g)], p1[4 * (g)]), s1_ = P8_ADD(p0[4 * (g) + 1], p1[4 * (g) + 1]), s2_ = P8_ADD(p0[4 * (g) + 2], p1[4 * (g) + 2]), s3_ = P8_ADD(p0[4 * (g) + 3], p1[4 * (g) + 3]); \
        s0_ = P8_ADD(s0_, s1_); s2_ = P8_ADD(s2_, s3_); s0_ = P8_ADD(s0_, s2_); lreg = P8_ADD(lreg, s0_); } asm volatile("" : "+v"(lreg)); \
      p8[g] = (int)pk4fp8(p0[4 * (g)], p0[4 * (g) + 1], p0[4 * (g) + 2], p0[4 * (g) + 3]); p8[4 + (g)] = (int)pk4fp8(p1[4 * (g)], p1[4 * (g) + 1], p1[4 * (g) + 2], p1[4 * (g) + 3]); } while (0)
#define P8_EXP(g, p0, p1) do { _Pragma("unroll") for (int r_ = 4 * (g); r_ < 4 * (g) + 4; ++r_) { p0[r_] = __builtin_amdgcn_exp2f(p0[r_]); p1[r_] = __builtin_amdgcn_exp2f(p1[r_]); } } while (0)
#define P8_EXH(g, px) do { _Pragma("unroll") for (int r_ = 4 * (g); r_ < 4 * (g) + 4; ++r_) px[r_] = __builtin_amdgcn_exp2f(px[r_]); } while (0)
#define P8_PK(g, p0, p1, p8) do { p8[g] = (int)pk4fp8(p0[4 * (g)], p0[4 * (g) + 1], p0[4 * (g) + 2], p0[4 * (g) + 3]); p8[4 + (g)] = (int)pk4fp8(p1[4 * (g)], p1[4 * (g) + 1], p1[4 * (g) + 2], p1[4 * (g) + 3]); } while (0)
#define P8_FIN(g, p0, p1, lreg, p8) do { \
        \
      lreg = (((((((lreg + p0[4 * (g)]) + p1[4 * (g)]) + p0[4 * (g) + 1]) + p1[4 * (g) + 1]) + p0[4 * (g) + 2]) + p1[4 * (g) + 2]) + p0[4 * (g) + 3]) + p1[4 * (g) + 3]; asm volatile("" : "+v"(lreg)); \
      p8[g] = (int)pk4fp8(p0[4 * (g)], p0[4 * (g) + 1], p0[4 * (g) + 2], p0[4 * (g) + 3]); p8[4 + (g)] = (int)pk4fp8(p1[4 * (g)], p1[4 * (g) + 1], p1[4 * (g) + 2], p1[4 * (g) + 3]); } while (0)
    f32x16 pA0, pA1, pB0, pB1; pg8::v8i32 pa8 = {0, 0, 0, 0, 0, 0, 0, 0}, pb8 = {0, 0, 0, 0, 0, 0, 0, 0};
    const f32x16 b16 = {};
    for (int i_ = tid; i_ < 5 * (ONESB / 16); i_ += NTHREADS) *(LAS u32x4*)(lds + (i_ / (ONESB / 16)) * SLOT + KT + (i_ % (ONESB / 16)) * 16) = (u32x4){0x38383838u, 0x38383838u, 0x38383838u, 0x38383838u};
    asm volatile("s_waitcnt lgkmcnt(0)" ::: "memory");
    pg8::v8i32 ones8; { int lo_ = lane; asm volatile("" : "+v"(lo_));
      const int j_ = lo_ & 15, kq_ = lo_ >> 4; const int w_ = ((j_ == 0 && !(kq_ & 1)) || (j_ == 1 && (kq_ & 1))) ? 0x38383838 : 0;
#pragma unroll
      for (int r_ = 0; r_ < 8; ++r_) ones8[r_] = w_; }
    asm volatile("" : "+v"(ones8));
    f32x4 lAcc = {0.f, 0.f, 0.f, 0.f}, lBcc = {0.f, 0.f, 0.f, 0.f};
#define P8_LSUM(P8V, ACC) ACC = __builtin_amdgcn_mfma_scale_f32_16x16x128_f8f6f4(P8V, ones8, ACC, 0, 0, 0, 0x7F7F7F7F, 0, 0x7F7F7F7F)
    if constexpr (A2_PIPE == 2) asm volatile("s_waitcnt vmcnt(4)" ::: "memory"); else A2_WAITV(1 < NT);
    __builtin_amdgcn_s_barrier();
    { P8_KA(0); P8_KB(0); P8_BIAS16(b16); pA0 = A2_MF8(k00, qA8[0], b16); pA1 = A2_MF8(k01, qA8[0], b16); pA0 = A2_MF8(k10, qA8[1], pA0); pA1 = A2_MF8(k11, qA8[1], pA1); }
    asm volatile("" : "+v"(pA0), "+v"(pA1)); A2_SBAR();
#define P8_TILE(S, t, FIRST) do { \
        \
      __builtin_amdgcn_s_barrier(); A2_SBAR(); \
      if ((t) + 2 < NT) { A2_DMA((t) + 2, ((S) + 2) % 4); } \
      { P8_KA(S); \
        if (!(FIRST)) { P8_VF(((S) + 3) % 4); A2_SBAR(); oB[0] = A2_MF8P(pb8, v0_, oB[0]); A2_SBAR(); P8_SMG(0, pA0, pA1, lA, pa8); A2_SBAR(); oB[1] = A2_MF8P(pb8, v1_, oB[1]); A2_SBAR(); } else { A2_SBAR(); P8_SMG(0, pA0, pA1, lA, pa8); A2_SBAR(); } \
        pB0 = A2_MF8(k00, qB8[0], b16); A2_SBAR(); P8_KB(S); P8_SMG(1, pA0, pA1, lA, pa8); A2_SBAR(); pB1 = A2_MF8(k01, qB8[0], b16); A2_SBAR(); P8_SMG(2, pA0, pA1, lA, pa8); A2_SBAR(); \
        pB0 = A2_MF8(k10, qB8[1], pB0); A2_SBAR(); P8_SMG(3, pA0, pA1, lA, pa8); A2_SBAR(); pB1 = A2_MF8(k11, qB8[1], pB1); } \
      asm volatile("" : "+v"(pB0), "+v"(pB1), "+v"(pa8), "+v"(oB[0]), "+v"(oB[1])); A2_SBAR(); \
        \
      A2_WAITV((t) + 2 < NT); __builtin_amdgcn_s_barrier(); A2_SBAR(); \
      { P8_VF(S); P8_KA(((S) + 1) % 4); A2_SBAR(); \
        oA[0] = A2_MF8P(pa8, v0_, oA[0]); A2_SBAR(); P8_SMG(0, pB0, pB1, lB, pb8); A2_SBAR(); oA[1] = A2_MF8P(pa8, v1_, oA[1]); A2_SBAR(); \
        pA0 = A2_MF8(k00, qA8[0], b16); A2_SBAR(); P8_KB(((S) + 1) % 4); P8_SMG(1, pB0, pB1, lB, pb8); A2_SBAR(); pA1 = A2_MF8(k01, qA8[0], b16); A2_SBAR(); P8_SMG(2, pB0, pB1, lB, pb8); A2_SBAR(); \
        pA0 = A2_MF8(k10, qA8[1], pA0); A2_SBAR(); P8_SMG(3, pB0, pB1, lB, pb8); A2_SBAR(); pA1 = A2_MF8(k11, qA8[1], pA1); } \
      asm volatile("" : "+v"(pA0), "+v"(pA1), "+v"(pb8), "+v"(oA[0]), "+v"(oA[1])); A2_SBAR(); \
    } while (0)
#define P8_TILE5(S, t, FIRST) do { \
      A2_WAITV((t) + 2 < NT); __builtin_amdgcn_s_barrier(); A2_SBAR(); \
      if ((t) + 3 < NT) { A2_DMA((t) + 3, ((S) + 3) % 5); } \
        \
      { P8_KA(S); \
        if (!(FIRST)) { P8_VF(((S) + 4) % 5); A2_SBAR(); oB[0] = A2_MF8P(pb8, v0_, oB[0]); A2_SBAR(); P8_EXH(0, pA0); A2_SBAR(); oB[1] = A2_MF8P(pb8, v1_, oB[1]); A2_SBAR(); P8_EXH(0, pA1); A2_SBAR(); P8_LSUM(pb8, lBcc); A2_SBAR(); } \
        else { A2_SBAR(); P8_EXH(0, pA0); P8_EXH(0, pA1); A2_SBAR(); } \
        P8_EXH(1, pA0); A2_SBAR(); \
        pB0 = A2_MF8(k00, qB8[0], b16); A2_SBAR(); P8_KB(S); P8_EXH(1, pA1); P8_PK(0, pA0, pA1, pa8); A2_SBAR(); \
        pB1 = A2_MF8(k01, qB8[0], b16); A2_SBAR(); P8_EXH(2, pA0); P8_PK(1, pA0, pA1, pa8); A2_SBAR(); \
        pB0 = A2_MF8(k10, qB8[1], pB0); A2_SBAR(); P8_EXH(2, pA1); A2_SBAR(); \
        pB1 = A2_MF8(k11, qB8[1], pB1); A2_SBAR(); P8_EXH(3, pA0); P8_PK(2, pA0, pA1, pa8); P8_EXH(3, pA1); A2_SBAR(); P8_PK(3, pA0, pA1, pa8); } \
      asm volatile("" : "+v"(pB0), "+v"(pB1), "+v"(pa8), "+v"(oB[0]), "+v"(oB[1]), "+v"(lBcc)); A2_SBAR(); \
      { P8_VF(S); P8_KA(((S) + 1) % 5); A2_SBAR(); \
        oA[0] = A2_MF8P(pa8, v0_, oA[0]); A2_SBAR(); P8_EXH(0, pB0); A2_SBAR(); oA[1] = A2_MF8P(pa8, v1_, oA[1]); A2_SBAR(); P8_EXH(0, pB1); A2_SBAR(); P8_LSUM(pa8, lAcc); A2_SBAR(); \
        P8_EXH(1, pB0); A2_SBAR(); \
        pA0 = A2_MF8(k00, qA8[0], b16); A2_SBAR(); P8_KB(((S) + 1) % 5); P8_EXH(1, pB1); P8_PK(0, pB0, pB1, pb8); A2_SBAR(); \
        pA1 = A2_MF8(k01, qA8[0], b16); A2_SBAR(); P8_EXH(2, pB0); P8_PK(1, pB0, pB1, pb8); A2_SBAR(); \
        pA0 = A2_MF8(k10, qA8[1], pA0); A2_SBAR(); P8_EXH(2, pB1); A2_SBAR(); \
        pA1 = A2_MF8(k11, qA8[1], pA1); A2_SBAR(); P8_EXH(3, pB0); P8_PK(2, pB0, pB1, pb8); P8_EXH(3, pB1); A2_SBAR(); P8_PK(3, pB0, pB1, pb8); } \
      asm volatile("" : "+v"(pA0), "+v"(pA1), "+v"(pb8), "+v"(oA[0]), "+v"(oA[1]), "+v"(lAcc)); A2_SBAR(); \
    } while (0)
    if constexpr (A2_PIPE == 2) {
#ifdef A2_PEEL
      P8_TILE5(0, 0, true); P8_TILE5(1, 1, false); P8_TILE5(2, 2, false); P8_TILE5(3, 3, false); P8_TILE5(4, 4, false);
      for (int t = 5; t + 4 < NT; t += 5) { P8_TILE5(0, t, false); P8_TILE5(1, t + 1, false); P8_TILE5(2, t + 2, false); P8_TILE5(3, t + 3, false); P8_TILE5(4, t + 4, false); }
#else
      for (int t = 0; t + 4 < NT; t += 5) { P8_TILE5(0, t, t == 0); P8_TILE5(1, t + 1, false); P8_TILE5(2, t + 2, false); P8_TILE5(3, t + 3, false); P8_TILE5(4, t + 4, false); }
#endif
      { P8_VF(4); oB[0] = A2_MF8P(pb8, v0_, oB[0]); oB[1] = A2_MF8P(pb8, v1_, oB[1]); P8_LSUM(pb8, lBcc); }
      { const int j_ = lane & 15, rg_ = lane >> 4;
        if (j_ < 2) {
#pragma unroll
          for (int r_ = 0; r_ < 4; ++r_) { ws[j_ * 16 + 4 * rg_ + r_] = lAcc[r_]; ws[32 + j_ * 16 + 4 * rg_ + r_] = lBcc[r_]; } }
        asm volatile("s_waitcnt lgkmcnt(0)" ::: "memory");
        lA = 0.5f * ws[r32]; lB = 0.5f * ws[32 + r32]; asm volatile("s_waitcnt lgkmcnt(0)" ::: "memory"); }
    } else {
    P8_TILE(0, 0, true); P8_TILE(1, 1, false); P8_TILE(2, 2, false); P8_TILE(3, 3, false);
    for (int t = 4; t + 3 < NT; t += 4) { P8_TILE(0, t, false); P8_TILE(1, t + 1, false); P8_TILE(2, t + 2, false); P8_TILE(3, t + 3, false); }
    { P8_VF(3); oB[0] = A2_MF8P(pb8, v0_, oB[0]); oB[1] = A2_MF8P(pb8, v1_, oB[1]); }
    }
    { auto rr = __builtin_amdgcn_permlane32_swap(__float_as_uint(lA), __float_as_uint(lA), false, false); lA = __uint_as_float(rr[0]) + __uint_as_float(rr[1]); }
    { auto rr = __builtin_amdgcn_permlane32_swap(__float_as_uint(lB), __float_as_uint(lB), false, false); lB = __uint_as_float(rr[0]) + __uint_as_float(rr[1]); }
#undef P8_TILE
#undef P8_TILE5
#undef P8_SMG
#undef P8_EXP
#undef P8_PK
#undef P8_EXH
#undef P8_LSUM
#undef P8_FIN
#undef P8_VF
#undef P8_KA
#undef P8_KB
#undef P8_BIAS16
#undef P8_LD
#undef P8_ADD
  } else {
#ifndef A2_NOSTAGGER
  if (wid >= 4 && ABL != 5) { A2_WAITV(true); __builtin_amdgcn_s_barrier(); }
#endif
#ifdef A2_PRIO
  if (wid >= 4) __builtin_amdgcn_s_setprio(1);
#endif
  int t = 0;
  for (; t + 3 < NT; t += 4) { A2_TILE(0, t); A2_TILE(1, t + 1); A2_TILE(2, t + 2); A2_TILE(3, t + 3); }
  if (t < NT) { A2_TILE(0, t); if (t + 1 < NT) { A2_TILE(1, t + 1); if (t + 2 < NT) { A2_TILE(2, t + 2); } } }
#ifndef A2_NOSTAGGER
  if (wid < 4 && ABL != 5) __builtin_amdgcn_s_barrier();
#endif
#ifdef A2_PRIO
  __builtin_amdgcn_s_setprio(0);
#endif
  }
#undef A2_MID
#undef A2_WAITV
#undef A2_TILE
#undef A2_MF8
#undef A2_MF8P
#undef A2_PV
#undef A2_PV2
#undef A2_PK
  if (SWA) { const float sk = sinkp[wid & 3] * LOG2E - ((F8 && FAST) ? P8_BIAS : 0.f); lA += __builtin_amdgcn_exp2f(FAST ? sk : sk - mA); lB += __builtin_amdgcn_exp2f(FAST ? sk : sk - mB); }
#ifdef A2_FORCE_FALLBACK
  if (FAST) { if (lane == 0) *flag = 1u; }
#else
  if (FAST) { bool bad = !(lA >= 1e-30f && lA <= 1e30f) || !(lB >= 1e-30f && lB <= 1e30f);
    if constexpr (F8) { float z = 0.f;
#pragma unroll
      for (int r = 0; r < 16; ++r) z += (oA[0][r] + oA[1][r] + oB[0][r] + oB[1][r]) * 0.f;
      bad = bad || !(z == 0.f); }
    if (__any(bad) && lane == 0) *flag = 1u; }
#endif
  if (hi == 0) { ws[r32] = lA; ws[32 + r32] = lB; }
  asm volatile("s_waitcnt lgkmcnt(0)" ::: "memory");
  int hi_e = hi, r32_e = r32; asm volatile("" : "+v"(hi_e), "+v"(r32_e));
#pragma unroll
  for (int blk = 0; blk < 2; ++blk) {
    const int rbase = wrow0 + blk * 32;
    if (rbase < rows_valid) {
#pragma unroll
      for (int r = 0; r < 16; ++r) { const int orow = crow(r, hi_e); const float il = __builtin_amdgcn_rcpf(ws[blk * 32 + orow]);
        if constexpr (SWA) { unsigned char* op = (unsigned char*)Ob + (size_t)(rbase + orow) * DM + r32_e;
          const float il16 = il * 16.f; op[0] = f2fp8((blk ? oB[0][r] : oA[0][r]) * il16); op[32] = f2fp8((blk ? oB[1][r] : oA[1][r]) * il16); }
        else { bf16_t* op = Ob + (size_t)(rbase + orow) * DM + r32_e;
        op[0] = f2bf((blk ? oB[0][r] : oA[0][r]) * il); op[32] = f2bf((blk ? oB[1][r] : oA[1][r]) * il); } }
    }
  }
  asm volatile("s_waitcnt vmcnt(0) lgkmcnt(0)" ::: "memory");
  __builtin_amdgcn_s_barrier();
  bool ok = true;
  if (FAST) { ok = (*flag == 0u); asm volatile("s_waitcnt lgkmcnt(0)" ::: "memory"); __builtin_amdgcn_s_barrier(); }
  return ok;
#undef A2_DMA
#undef A2_DMA8
}
#undef A2_SBAR
}

#ifdef PROBE_RND
__device__ __forceinline__ void phase_rnd(Frame& F, size_t off, size_t nbytes) {
  const Params P = lds_params(F);
  u32x4* base = (u32x4*)(P.ws + off); const size_t n = nbytes / 16;
  for (size_t i = (size_t)F.bid * NTHREADS + F.tid; i < n; i += (size_t)F.G * NTHREADS) {
    u32x4 w = base[i]; unsigned* wp = (unsigned*)&w;
#pragma unroll
    for (int j = 0; j < 4; ++j) { const float a = fp8rt(bf2f((bf16_t)(wp[j] & 0xffff)), 16.f), b = fp8rt(bf2f((bf16_t)(wp[j] >> 16)), 16.f); wp[j] = pk2bf(a, b); }
    base[i] = w; }
}
#endif
#ifdef PROBE_UB
__device__ __forceinline__ void phase_ubench(Frame& F) {
  const Params P = lds_params(F);
  pg8::v8i32 a, b; for (int j = 0; j < 8; ++j) { a[j] = 0x38383838 + F.lane; b[j] = 0x30303030 + j; }
  att::f32x16 c0 = {}, c1 = {}; float e[16];
#pragma unroll
  for (int j = 0; j < 16; ++j) e[j] = -0.001f * (float)(F.lane + j);
#pragma unroll 1
  for (int i = 0; i < 2048; ++i) {
    if (PROBE_UB & 1) c0 = __builtin_amdgcn_mfma_scale_f32_32x32x64_f8f6f4(a, b, c0, 0, 0, 0, 0x7F7F7F7F, 0, 0x7F7F7F7F);
    __builtin_amdgcn_sched_barrier(0);
    if (PROBE_UB & 2) {
#pragma unroll
      for (int j = 0; j < 8; ++j) e[j] = (PROBE_UB & 4) ? e[j] + 1.0009765625f : __builtin_amdgcn_exp2f(e[j]); }
    __builtin_amdgcn_sched_barrier(0);
    if (PROBE_UB & 1) c1 = __builtin_amdgcn_mfma_scale_f32_32x32x64_f8f6f4(a, b, c1, 0, 0, 0, 0x7F7F7F7F, 0, 0x7F7F7F7F);
    __builtin_amdgcn_sched_barrier(0);
    if (PROBE_UB & 2) {
#pragma unroll
      for (int j = 8; j < 16; ++j) e[j] = (PROBE_UB & 4) ? e[j] + 1.0009765625f : __builtin_amdgcn_exp2f(e[j]); }
    __builtin_amdgcn_sched_barrier(0);
    asm volatile("" : "+v"(c0), "+v"(c1));
  }
  float r = 0.f;
#pragma unroll
  for (int j = 0; j < 16; ++j) r += e[j] + c0[j] + c1[j];
  ((float*)(P.ws + WS_PB))[(size_t)F.bid * NTHREADS + F.tid] = r;
}
#endif
__device__ __forceinline__ void phase_attn_mla(Frame& F) {
  const Params P = lds_params(F);
  const bf16_t* Q = (const bf16_t*)(P.ws + WS_QKV + OFF_Q); const bf16_t* QC = (const bf16_t*)(P.ws + WS_QKV + OFF_QC);
  const char* Kimg = (const char*)(P.ws + WS_QKV + OFF_K); const char* Vimg = (const char*)(P.ws + WS_QKV + OFF_V);
  bf16_t* CAT = (bf16_t*)(P.ws + WS_CAT);
  const int v = (F.G % 8 == 0) ? (F.bid % 8) * (F.G / 8) + F.bid / 8 : F.bid;
  for (int U = v; U < 512 + 16; U += F.G) {
    if (U < 512) { const int bh = U >> 5, qb = U & 31, b = bh >> 3, h = bh & 7;
      const bf16_t* Qu = (const bf16_t*)((const char*)Q + ((size_t)bh * SEQ + qb * 512) * 96);
      if (!att2::attn_unit<true, 0, 96, false, true>(Qu, 512, Kimg + (size_t)bh * NKEY * 96, Vimg + (size_t)bh * NKEY * 64,
                                 CAT + ((size_t)b * SEQ + qb * 512) * DM + 512 + h * 64, NKEY / 64, F.lds))
        att2::attn_unit<false, 0, 96, false, true>(Qu, 512, Kimg + (size_t)bh * NKEY * 96, Vimg + (size_t)bh * NKEY * 64,
                               CAT + ((size_t)b * SEQ + qb * 512) * DM + 512 + h * 64, NKEY / 64, F.lds);
    } else { const int bh = U - 512, b = bh >> 3, h = bh & 7;
      att2::attn_unit<false, 0, 96, false, true>((const bf16_t*)((const char*)QC + (size_t)bh * CTX * 96), 256, Kimg + (size_t)bh * NKEY * 96, Vimg + (size_t)bh * NKEY * 64,
                             CAT + ((size_t)NLAT + b * CTX) * DM + 512 + h * 64, CTX / 64, F.lds);
    }
  }
}
#ifdef PROBE_ATT_ABL
__device__ __forceinline__ void phase_attn_probe(Frame& F) {
  const Params P = lds_params(F);
  const bf16_t* Q = (const bf16_t*)(P.ws + WS_QKV + OFF_Q);
  const char* Kimg = (const char*)(P.ws + WS_QKV + OFF_K); const char* Vimg = (const char*)(P.ws + WS_QKV + OFF_V);
  bf16_t* SCR = (bf16_t*)(P.ws + WS_PB);
  const int v = (F.G % 8 == 0) ? (F.bid % 8) * (F.G / 8) + F.bid / 8 : F.bid;
  for (int U = v; U < 512; U += F.G) { const int bh = U >> 5, qb = U & 31, b = bh >> 3, h = bh & 7;
    att2::attn_unit<true, PROBE_ATT_ABL, 96, false, true>((const bf16_t*)((const char*)Q + ((size_t)bh * SEQ + qb * 512) * 96), 512, Kimg + (size_t)bh * NKEY * 96, Vimg + (size_t)bh * NKEY * 64,
                                         SCR + ((size_t)b * SEQ + qb * 512) * DM + 512 + h * 64, NKEY / 64, F.lds); }
}
#endif
__device__ __forceinline__ void phase_attn_swa(Frame& F) {
  const Params P = lds_params(F);
  const bf16_t* Q2 = (const bf16_t*)(P.ws + WS_QKV + OFF_Q2); const char* K2 = (const char*)(P.ws + WS_QKV + OFF_K2); const char* V2 = (const char*)(P.ws + WS_QKV + OFF_V2);
  bf16_t* CAT = (bf16_t*)(P.ws + WS_CAT); const float* sink = P.in[17];
  const int v = (F.G % 8 == 0) ? (F.bid % 8) * (F.G / 8) + F.bid / 8 : F.bid;
  for (int U = v; U < NB * 4 * 128; U += F.G) {
    const int bk = U >> 7, qb = U & 127, b = bk >> 2, kvh = bk & 3, q0 = qb * 128;
    int lo = q0 - 128, hi2 = q0 + 256; if (lo < 0) lo = 0; if (hi2 > SEQ) hi2 = SEQ;
    const int lt0 = lo >> 6, NT = 4 + ((hi2 - lo) >> 6);
    const bf16_t* Qb = (const bf16_t*)((const char*)Q2 + ((size_t)(b * 16 + kvh * 4) * SEQ + q0) * 64); const char* Kb = K2 + (size_t)bk * NKEY * 64; const char* Vb = V2 + (size_t)bk * NKEY * 64;
    bf16_t* Ob = (bf16_t*)((unsigned char*)CAT + ((size_t)b * SEQ + q0) * DM + kvh * 256);
    if (!att2::attn_unit<true, 0, 64, true, true>(Qb, 128, Kb, Vb, Ob, NT, F.lds, lt0, q0, sink + kvh * 4))
      att2::attn_unit<false, 0, 64, true, true>(Qb, 128, Kb, Vb, Ob, NT, F.lds, lt0, q0, sink + kvh * 4);
  }
}
__device__ __forceinline__ float wave_sum(float v) {
#pragma unroll
  for (int o = 1; o < 64; o <<= 1) v += __shfl_xor(v, o);
  return v;
}
__device__ __forceinline__ void row_load(const float* row, int lane, f32x4 (&x)[4]) {
#pragma unroll
  for (int j = 0; j < 4; ++j) x[j] = *(const f32x4*)(row + 4 * lane + 256 * j);
}
__device__ __forceinline__ float row_ssq(const f32x4 (&x)[4]) {
  float s = 0.f;
#pragma unroll
  for (int j = 0; j < 4; ++j) s += (x[j][0] * x[j][0] + x[j][1] * x[j][1]) + (x[j][2] * x[j][2] + x[j][3] * x[j][3]);
  return wave_sum(s);
}
__device__ __forceinline__ void xs_load(const bf16_t* xsb, const float* xcx, int r, int lane, f32x4 (&x)[4]) {
  if (r < NLAT) { const bf16_t* p = xsb + (size_t)r * DM + 4 * lane;
#pragma unroll
    for (int j = 0; j < 4; ++j) { const u32x2 w = *(const u32x2*)(p + 256 * j);
      x[j] = (f32x4){bf2f((bf16_t)(w.x & 0xffff)), bf2f((bf16_t)(w.x >> 16)), bf2f((bf16_t)(w.y & 0xffff)), bf2f((bf16_t)(w.y >> 16))}; } }
  else row_load(xcx + (size_t)(r - NLAT) * DM, lane, x);
}
__device__ __forceinline__ void row_norm_mod_fp8(f32x4 (&x)[4], float inv, const float* g, const float* sh, const float* sc, unsigned char* orow, int lane) {
#pragma unroll
  for (int j = 0; j < 4; ++j) {
    const int c = 4 * lane + 256 * j;
    const f32x4 gg = *(const f32x4*)(g + c), s1 = *(const f32x4*)(sh + c), s2 = *(const f32x4*)(sc + c);
    x[j] = x[j] * inv * gg * (s2 + 1.f) + s1;
    *(unsigned*)(orow + c) = pk4fp8(x[j][0], x[j][1], x[j][2], x[j][3]);
  }
}
__device__ __forceinline__ void row_norm_mod(f32x4 (&x)[4], float inv, const float* g, const float* sh, const float* sc, bf16_t* orow, int lane) {
#pragma unroll
  for (int j = 0; j < 4; ++j) {
    const int c = 4 * lane + 256 * j;
    const f32x4 gg = *(const f32x4*)(g + c), s1 = *(const f32x4*)(sh + c), s2 = *(const f32x4*)(sc + c);
    x[j] = x[j] * inv * gg * (s2 + 1.f) + s1;
    u32x2 w; w.x = pk2bf(x[j][0], x[j][1]); w.y = pk2bf(x[j][2], x[j][3]);
    *(u32x2*)(orow + c) = w;
  }
}

__device__ __forceinline__ void phase_norm1_l0(Frame& F) {
  const Params P = lds_params(F);
  const float* x = P.in[0]; const float* ctx = P.in[2]; const float* g = P.in[6]; const float* modv = (const float*)(P.ws + WS_MODV);
  bf16_t* HB = (bf16_t*)(P.ws + WS_HB);
  for (int row = F.bid * 8 + F.wave; row < NROW; row += F.G * 8) {
    const float* src; int v;
    if (row < NLAT) { src = x + (size_t)row * DM; v = row / SEQ; } else { src = ctx + (size_t)(row - NLAT) * DM; v = 2; }
    f32x4 xv[4]; row_load(src, F.lane, xv);
    const float inv = rsqrtf(row_ssq(xv) * (1.f / DM) + EPS);
    row_norm_mod(xv, inv, g, modv + v * NMOD, modv + v * NMOD + DM, HB + (size_t)row * DM, F.lane);
  }
}

__device__ __forceinline__ void phase_norm2(Frame& F, int layer) {
  const Params P = lds_params(F);
  const float* g = P.in[7] + layer * DM; const float* modl = (const float*)(P.ws + WS_MODV) + (size_t)layer * 3 * NMOD;
  const float* rw = P.in[19] + (size_t)layer * DM * NE;
  const bf16_t* xsb = (const bf16_t*)(P.ws + WS_XSB); const float* xcx = (const float*)(P.ws + WS_XC);
  bf16_t* HB = (bf16_t*)(P.ws + WS_HB); float* aff = (float*)(P.ws + WS_AFF);
  const int nrows = layer == 0 ? NROW : NLAT, lane = F.lane;
  __syncthreads();
  for (int f = F.tid; f < DM * 4; f += NTHREADS) { const int c = f >> 2, q = f & 3, j = c >> 8, ln = (c & 255) >> 2, i = c & 3;
    *(LAS f32x4*)(F.lds + ((4 * j + i) * 4 + q) * 1024 + 16 * ln) = *(const f32x4*)(rw + 4 * f); }
  __syncthreads();
  const unsigned wl = (unsigned)(uintptr_t)(F.lds + 16 * lane);
  const int stride = F.G * 8;
  int row = F.bid * 8 + F.wave;
  f32x4 xv[4], xn[4], xm[4];
  if (row < nrows) xs_load(xsb, xcx, row, lane, xv);
  if (row + stride < nrows) xs_load(xsb, xcx, row + stride, lane, xn);
  int cv = -1; f32x4 ga[4], sb[4];
  while (row < nrows) {
    const int nrow = row + stride, mrow = nrow + stride;
    if (mrow < nrows) xs_load(xsb, xcx, mrow, lane, xm);
    const int v = row < NLAT ? row / SEQ : 2;
    if (v != cv) { cv = v; const float* shp = modl + v * NMOD + 3 * DM; const float* scp = shp + DM;
#pragma unroll
      for (int j = 0; j < 4; ++j) { const int c = 4 * lane + 256 * j; ga[j] = *(const f32x4*)(g + c) * (*(const f32x4*)(scp + c) + 1.f); sb[j] = *(const f32x4*)(shp + c); } }
    const float inv = rsqrtf(row_ssq(xv) * (1.f / DM) + EPS);
    { unsigned char* orow = (unsigned char*)HB + (size_t)row * DM;
#pragma unroll
      for (int j = 0; j < 4; ++j) { xv[j] = xv[j] * inv * ga[j] + sb[j]; *(unsigned*)(orow + 4 * lane + 256 * j) = pk4fp8(xv[j][0], xv[j][1], xv[j][2], xv[j][3]); } }
    typedef float f32x2 __attribute__((ext_vector_type(2)));
    f32x2 pp[8];
#pragma unroll
    for (int e = 0; e < 8; ++e) pp[e] = (f32x2){0.f, 0.f};
#pragma unroll
    for (int j = 0; j < 4; ++j) {
      unsigned wb = wl + j * 16384; asm volatile("" : "+v"(wb));
#pragma unroll
      for (int i = 0; i < 4; ++i)
#pragma unroll
        for (int q = 0; q < 4; ++q) {
          const f32x4 w = *(const LAS f32x4*)(wb + (i * 4 + q) * 1024); const f32x2 hv = (f32x2){xv[j][i], xv[j][i]};
          pp[2 * q] = __builtin_elementwise_fma(hv, (f32x2){w[0], w[1]}, pp[2 * q]); pp[2 * q + 1] = __builtin_elementwise_fma(hv, (f32x2){w[2], w[3]}, pp[2 * q + 1]);
        }
      __builtin_amdgcn_sched_barrier(0);
    }
    float p[16];
#pragma unroll
    for (int e = 0; e < 8; ++e) { p[2 * e] = pp[e][0]; p[2 * e + 1] = pp[e][1]; }
    float q8[8];
#pragma unroll
    for (int e = 0; e < 8; ++e) { auto rr = __builtin_amdgcn_permlane32_swap(__float_as_uint(p[e]), __float_as_uint(p[e + 8]), false, false); q8[e] = __uint_as_float(rr[0]) + __uint_as_float(rr[1]); }
    float q4[4];
#pragma unroll
    for (int e = 0; e < 4; ++e) { const bool up = (lane & 16) != 0; const float snd = up ? q8[e] : q8[e + 4], keep = up ? q8[e + 4] : q8[e]; q4[e] = keep + __shfl_xor(snd, 16); }
    float q2[2];
#pragma unroll
    for (int e = 0; e < 2; ++e) { const bool up = (lane & 8) != 0; const float snd = up ? q4[e] : q4[e + 2], keep = up ? q4[e + 2] : q4[e]; q2[e] = keep + __shfl_xor(snd, 8); }
    float lg; { const bool up = (lane & 4) != 0; const float snd = up ? q2[0] : q2[1], keep = up ? q2[1] : q2[0]; lg = keep + __shfl_xor(snd, 4); }
    lg += __shfl_xor(lg, 2); lg += __shfl_xor(lg, 1);
    float mx = lg;
    mx = fmaxf(mx, __shfl_xor(mx, 4)); mx = fmaxf(mx, __shfl_xor(mx, 8)); mx = fmaxf(mx, __shfl_xor(mx, 16)); mx = fmaxf(mx, __shfl_xor(mx, 32));
    const float ex = expf(lg - mx);
    float sum = ex;
    sum += __shfl_xor(sum, 4); sum += __shfl_xor(sum, 8); sum += __shfl_xor(sum, 16); sum += __shfl_xor(sum, 32);
    if ((lane & 3) == 0) {
      const float a = ex / sum; const int e = 8 * (lane >> 5) + 4 * ((lane >> 4) & 1) + 2 * ((lane >> 3) & 1) + ((lane >> 2) & 1);
      if (row < NLAT) { const int b = row / SEQ, t = row % SEQ; aff[((size_t)(b * NE + e)) * SEQ + t] = a; }
      else { const int jj = row - NLAT, b = jj / CTX, t = jj % CTX; aff[(size_t)NB * NE * SEQ + ((size_t)(b * NE + e)) * CTX + t] = a; }
    }
#pragma unroll
    for (int j = 0; j < 4; ++j) { xv[j] = xn[j]; xn[j] = xm[j]; }
    row = nrow;
  }
  __syncthreads();
}

__device__ __forceinline__ void phase_preup(Frame& F) {
  const Params P = lds_params(F);
  const bf16_t* Pm = (const bf16_t*)(P.ws + WS_PB); bf16_t* QKN = (bf16_t*)(P.ws + WS_QN); bf16_t* CAT = (bf16_t*)(P.ws + WS_CAT);
  bf16_t* Kk = (bf16_t*)(P.ws + WS_QKV + OFF_K); const float* tab = (const float*)(P.ws + WS_ROPE);
  const float* cw = P.in[9]; const float* cb = P.in[10]; const float* qg = P.in[11]; const float* kg = P.in[13];
  const int lane = F.lane;
  for (int row = F.bid * 8 + F.wave; row < NROW; row += F.G * 8) {
    const bf16_t* pr = Pm + (size_t)row * PPITCH;
    const bool lat = row < NLAT; int b, pos, t = 0, lo, hi;
    if (lat) { b = row / SEQ; t = row % SEQ; pos = CTX + t; lo = b * SEQ; hi = lo + SEQ; } else { const int j = row - NLAT; b = j / CTX; pos = j % CTX; lo = NLAT + b * CTX; hi = lo + CTX; }
    { const u32x2 qw = *(const u32x2*)(pr + 1536 + 4 * lane); const unsigned kw = *(const unsigned*)(pr + 1792 + 2 * lane);
      const float q0 = bf2f((bf16_t)(qw.x & 0xffff)), q1 = bf2f((bf16_t)(qw.x >> 16)), q2 = bf2f((bf16_t)(qw.y & 0xffff)), q3 = bf2f((bf16_t)(qw.y >> 16));
      const float k0 = bf2f((bf16_t)(kw & 0xffff)), k1 = bf2f((bf16_t)(kw >> 16));
      const float sq = wave_sum((q0 * q0 + q1 * q1) + (q2 * q2 + q3 * q3)), sk = wave_sum(k0 * k0 + k1 * k1);
      const float iq = rsqrtf(sq * (1.f / 256.f) + EPS), ik = rsqrtf(sk * (1.f / 128.f) + EPS);
      const f32x4 gq = *(const f32x4*)(qg + 4 * lane); const float gk0 = kg[2 * lane], gk1 = kg[2 * lane + 1];
      unsigned char* qrow = (unsigned char*)QKN + (size_t)row * 512;
      *(unsigned*)(qrow + 4 * lane) = pk4fp8(q0 * iq * gq[0], q1 * iq * gq[1], q2 * iq * gq[2], q3 * iq * gq[3]);
      *(unsigned short*)(qrow + 256 + 2 * lane) = (unsigned short)__builtin_amdgcn_cvt_pk_fp8_f32(k0 * ik * gk0, k1 * ik * gk1, 0, false);
      if (lane < 32) *(unsigned*)(qrow + 384 + 4 * lane) = 0u; }
    { const int p = lane & 15, a = p >> 3, ii = p & 7, hq = lane >> 4;
      const float x1 = bf2f(pr[1920 + a * 16 + ii]), x2 = bf2f(pr[1920 + a * 16 + 8 + ii]);
      float cs = 1.f, sn = 0.f;
      if (lat) { const int pp = a == 0 ? (t >> 6) : (t & 63); cs = tab[pp * 8 + ii]; sn = tab[2048 + pp * 8 + ii]; }
      const unsigned short w = (unsigned short)__builtin_amdgcn_cvt_pk_fp8_f32(x1 * cs - x2 * sn, x1 * sn + x2 * cs, 0, false);
#pragma unroll
      for (int hh = 0; hh < 2; ++hh) { const int h = 2 * hq + hh;
        *(unsigned short*)((char*)Kk + (size_t)(b * 8 + h) * NKEY * 96 + (size_t)(pos >> 6) * 6144 + (4 + (p >> 3)) * 1024 + (pos & 63) * 16 + (p & 7) * 2) = w; } }
    { const int c = 8 * lane;
      const u32x4 gbv = *(const u32x4*)(pr + c), gc1 = *(const u32x4*)(pr + 512 + c), u1 = *(const u32x4*)(pr + 1024 + c);
      u32x4 gc0 = {0u, 0u, 0u, 0u}, u0 = gc0, gc2 = gc0, u2 = gc0;
      if (row - 1 >= lo) { gc0 = *(const u32x4*)(pr - PPITCH + 512 + c); u0 = *(const u32x4*)(pr - PPITCH + 1024 + c); }
      if (row + 1 < hi) { gc2 = *(const u32x4*)(pr + PPITCH + 512 + c); u2 = *(const u32x4*)(pr + PPITCH + 1024 + c); }
      float y[8];
#pragma unroll
      for (int i = 0; i < 8; ++i) {
        const int sh = (i & 1) * 16; const int wi = i >> 1;
        const float z0 = bf2f((bf16_t)((gc0[wi] >> sh) & 0xffff)) * bf2f((bf16_t)((u0[wi] >> sh) & 0xffff));
        const float z1 = bf2f((bf16_t)((gc1[wi] >> sh) & 0xffff)) * bf2f((bf16_t)((u1[wi] >> sh) & 0xffff));
        const float z2 = bf2f((bf16_t)((gc2[wi] >> sh) & 0xffff)) * bf2f((bf16_t)((u2[wi] >> sh) & 0xffff));
        const float yy = z0 * cw[c + i] + z1 * cw[512 + c + i] + z2 * cw[1024 + c + i] + cb[c + i];
        y[i] = bf2f((bf16_t)((gbv[wi] >> sh) & 0xffff)) * yy;
      }
      u32x4 w; w.x = pk2bf(y[0], y[1]); w.y = pk2bf(y[2], y[3]); w.z = pk2bf(y[4], y[5]); w.w = pk2bf(y[6], y[7]);
      *(u32x4*)(CAT + (size_t)row * DM + c) = w; }
  }
}

template <bool PROBE = false>
__device__ __forceinline__ void phase_combine(Frame& F, int layer) {
  const Params P = lds_params(F);
  const float* modv = (const float*)(P.ws + WS_MODV); const float* modl = modv + (size_t)layer * 3 * NMOD;
  const bf16_t* YE = (const bf16_t*)(P.ws + WS_QKV); const int* slot = (const int*)(P.ws + WS_SLOT);
  bf16_t* xsb = (bf16_t*)(P.ws + WS_XSB); float* xcx = (float*)(P.ws + WS_XC); bf16_t* HB = (bf16_t*)(P.ws + WS_HB);
  const int nrows = layer == 0 ? NROW : NLAT, lane = F.lane, stride = F.G * 8;
#define CB_SLOT(r) (((r) < NLAT) ? slot[((size_t)(((r) / SEQ) * NE + (lane & 15))) * SEQ + (r) % SEQ] \
                                 : slot[(size_t)NB * NE * SEQ + ((size_t)((((r) - NLAT) / CTX) * NE + (lane & 15))) * CTX + ((r) - NLAT) % CTX])
  int row = F.bid * 8 + F.wave;
  f32x4 xv[4], xn[4]; int sl = -1, sln = -1;
  int cv = -1; f32x4 g2v[4], ga[4], sb[4];
  if (row < nrows) { sl = CB_SLOT(row); xs_load(xsb, xcx, row, lane, xv); }
  while (row < nrows) {
    const int nrow = row + stride;
    if (nrow < nrows) { sln = CB_SLOT(nrow); xs_load(xsb, xcx, nrow, lane, xn); }
    int v; size_t ybase; int cap;
    if (row < NLAT) { const int b = row / SEQ; v = b; cap = CAP_L; ybase = (size_t)(b * NE) * CAP_L; }
    else { const int b = (row - NLAT) / CTX; v = 2; cap = CAP_C; ybase = (size_t)32 * CAP_L + (size_t)(b * NE) * CAP_C; }
    f32x4 acc[4];
#pragma unroll
    for (int j = 0; j < 4; ++j) acc[j] = (f32x4){0.f, 0.f, 0.f, 0.f};
    unsigned emask = (unsigned)(__ballot(sl >= 0) & 0xFFFFull);
    while (emask) {
      int ee[4]; u32x2 w[4][4];
#pragma unroll
      for (int k = 0; k < 4; ++k) { ee[k] = emask ? __builtin_ctz(emask) : -1; if (emask) emask &= emask - 1; }
#pragma unroll
      for (int k = 0; k < 4; ++k) if (ee[k] >= 0) { const int s_ = __shfl(sl, ee[k]); const bf16_t* yr = YE + (ybase + (size_t)ee[k] * cap + s_) * DM;
#pragma unroll
        for (int j = 0; j < 4; ++j) w[k][j] = *(const u32x2*)(yr + 4 * lane + 256 * j); }
#pragma unroll
      for (int k = 0; k < 4; ++k) if (ee[k] >= 0) {
#pragma unroll
        for (int j = 0; j < 4; ++j) { acc[j][0] += bf2f((bf16_t)(w[k][j].x & 0xffff)); acc[j][1] += bf2f((bf16_t)(w[k][j].x >> 16)); acc[j][2] += bf2f((bf16_t)(w[k][j].y & 0xffff)); acc[j][3] += bf2f((bf16_t)(w[k][j].y >> 16)); } }
    }
    if (v != cv) { cv = v;
      const float* m1 = modv + 3 * NMOD + v * NMOD;
#pragma unroll
      for (int j = 0; j < 4; ++j) { const int c = 4 * lane + 256 * j; g2v[j] = *(const f32x4*)(modl + v * NMOD + 5 * DM + c);
        if (layer == 0) { ga[j] = *(const f32x4*)(P.in[6] + DM + c) * (*(const f32x4*)(m1 + DM + c) + 1.f); sb[j] = *(const f32x4*)(m1 + c); }
        else ga[j] = *(const f32x4*)(P.in[23] + c); } }
#pragma unroll
    for (int j = 0; j < 4; ++j) xv[j] = xv[j] + g2v[j] * acc[j];
    const float inv = rsqrtf(row_ssq(xv) * (1.f / DM) + EPS);
    if (layer == 0) {
      if (PROBE) { }
      else if (row < NLAT) {
#pragma unroll
        for (int j = 0; j < 4; ++j) { u32x2 w; w.x = pk2bf(xv[j][0], xv[j][1]); w.y = pk2bf(xv[j][2], xv[j][3]); *(u32x2*)(xsb + (size_t)row * DM + 4 * lane + 256 * j) = w; } }
      else {
#pragma unroll
        for (int j = 0; j < 4; ++j) *(f32x4*)(xcx + (size_t)(row - NLAT) * DM + 4 * lane + 256 * j) = xv[j]; }
#pragma unroll
      for (int j = 0; j < 4; ++j) xv[j] = xv[j] * inv * ga[j] + sb[j];
      if (PROBE) { }
      else if (row < NLAT) { unsigned char* orow = (unsigned char*)HB + (size_t)row * DM;
#pragma unroll
        for (int j = 0; j < 4; ++j) *(unsigned*)(orow + 4 * lane + 256 * j) = pk4fp8(xv[j][0], xv[j][1], xv[j][2], xv[j][3]); }
      else { bf16_t* orow = HB + (size_t)row * DM;
#pragma unroll
        for (int j = 0; j < 4; ++j) { u32x2 w; w.x = pk2bf(xv[j][0], xv[j][1]); w.y = pk2bf(xv[j][2], xv[j][3]); *(u32x2*)(orow + 4 * lane + 256 * j) = w; } }
    } else {
      float* op = (PROBE ? (float*)(P.ws + WS_PB) : P.out) + (size_t)row * DM;
#pragma unroll
      for (int j = 0; j < 4; ++j) *(f32x4*)(op + 4 * lane + 256 * j) = xv[j] * inv * ga[j];
    }
#pragma unroll
    for (int j = 0; j < 4; ++j) xv[j] = xn[j];
    sl = sln; row = nrow;
  }
#undef CB_SLOT
}

__device__ __forceinline__ unsigned block_sum_u(unsigned v, LAS unsigned* red, int par, int wave, int lane) {
#pragma unroll
  for (int o = 1; o < 64; o <<= 1) v += __shfl_xor(v, o);
  if (lane == 0) red[par * 8 + wave] = v;
  __syncthreads();
  unsigned s = 0;
#pragma unroll
  for (int i = 0; i < 8; ++i) s += red[par * 8 + i];
  return s;
}
__device__ __forceinline__ void phase_topk(Frame& F, int layer) {
  const Params P = lds_params(F);
  const float* aff = (const float*)(P.ws + WS_AFF); int* sidx = (int*)(P.ws + WS_SIDX); float* sg = (float*)(P.ws + WS_SG); int* slot = (int*)(P.ws + WS_SLOT);
  LAS unsigned* red = (LAS unsigned*)F.lds;
  const int nprob = layer == 0 ? 64 : 32, tid = F.tid, lane = F.lane, wave = F.wave;
  for (int pb = F.bid; pb < nprob; pb += F.G) {
    const bool isctx = pb >= 32; const int ge = isctx ? pb - 32 : pb, n = isctx ? CTX : SEQ, cap = isctx ? CAP_C : CAP_L;
    const size_t aoff = isctx ? (size_t)NB * NE * SEQ + (size_t)ge * CTX : (size_t)ge * SEQ;
    const size_t soff = isctx ? (size_t)NB * NE * CAP_L + (size_t)ge * CAP_C : (size_t)ge * CAP_L;
    unsigned key[32];
#pragma unroll
    for (int j = 0; j < 8; ++j) {
      u32x4 w = {0u, 0u, 0u, 0u};
      if (32 * tid + 4 * j < n) w = *(const u32x4*)(aff + aoff + 32 * tid + 4 * j);
      key[4 * j] = w.x; key[4 * j + 1] = w.y; key[4 * j + 2] = w.z; key[4 * j + 3] = w.w;
    }
    __syncthreads();
    unsigned T = 0u; int par = 0;
    for (int bit = 30; bit >= 0; --bit) {
      const unsigned cand = T | (1u << bit);
      unsigned c = 0;
#pragma unroll
      for (int i = 0; i < 32; ++i) c += (key[i] >= cand) ? 1u : 0u;
      const unsigned tot = block_sum_u(c, red, par, wave, lane); par = (par + 1) & 3;
      if (tot >= (unsigned)cap) T = cand;
    }
    unsigned cg = 0, ce = 0;
#pragma unroll
    for (int i = 0; i < 32; ++i) { cg += (key[i] > T) ? 1u : 0u; ce += (key[i] == T) ? 1u : 0u; }
    const unsigned ngt = block_sum_u(cg, red, par, wave, lane); par = (par + 1) & 3;
    const unsigned need_eq = (unsigned)cap - ngt;
    unsigned pk = cg | (ce << 16), inc = pk;
#pragma unroll
    for (int o = 1; o < 64; o <<= 1) { const unsigned up = __shfl_up(inc, o); if (lane >= o) inc += up; }
    LAS unsigned* wtot = red + 32;
    __syncthreads();
    if (lane == 63) wtot[wave] = inc;
    __syncthreads();
    unsigned base = 0;
#pragma unroll
    for (int i = 0; i < 8; ++i) base += (i < wave) ? wtot[i] : 0u;
    unsigned excl = base + inc - pk;
    unsigned g_before = excl & 0xffffu, e_before = excl >> 16;
    int sl[32];
#pragma unroll
    for (int i = 0; i < 32; ++i) {
      const bool gt = key[i] > T, eq = key[i] == T;
      const bool take = gt || (eq && e_before < need_eq);
      const unsigned s = g_before + (e_before < need_eq ? e_before : need_eq);
      sl[i] = take ? (int)s : -1;
      if (take) { sidx[soff + s] = 32 * tid + i; sg[soff + s] = __uint_as_float(key[i]); }
      g_before += gt ? 1u : 0u; e_before += eq ? 1u : 0u;
    }
    if (32 * tid < n) {
#pragma unroll
      for (int j = 0; j < 8; ++j) { int4 w; w.x = sl[4 * j]; w.y = sl[4 * j + 1]; w.z = sl[4 * j + 2]; w.w = sl[4 * j + 3]; *(int4*)(slot + aoff + 32 * tid + 4 * j) = w; }
    }
    __syncthreads();
  }
  __syncthreads();
  if (F.G > 32) { if (F.bid >= 32) { cvt_run<true>(P, (LAS float*)(F.lds + 1024), layer, F.bid - 32, F.G - 32, CVT_MOE);
#ifdef PROBE_CVT2
      __syncthreads(); cvt_run<true>(P, (LAS float*)(F.lds + 1024), layer, F.bid - 32, F.G - 32, CVT_MOE);
#endif
  } }
  else cvt_run<true>(P, (LAS float*)(F.lds + 1024), layer, F.bid, F.G, CVT_MOE);
}

__device__ __forceinline__ void rope4(f32x4& v0, f32x4& v1, const f32x4 cs, const f32x4 sn) {
  f32x4 w0, w1;
  w0[0] = v0[0] * cs[0] - v0[1] * sn[0]; w0[1] = v0[0] * sn[0] + v0[1] * cs[0]; w0[2] = v0[2] * cs[1] - v0[3] * sn[1]; w0[3] = v0[2] * sn[1] + v0[3] * cs[1];
  w1[0] = v1[0] * cs[2] - v1[1] * sn[2]; w1[1] = v1[0] * sn[2] + v1[1] * cs[2]; w1[2] = v1[2] * cs[3] - v1[3] * sn[3]; w1[3] = v1[2] * sn[3] + v1[3] * cs[3];
  v0 = w0; v1 = w1;
}
__device__ __forceinline__ int v_img(int k, int c) { const int kk = (k & ~0xC) | ((k & 4) << 1) | ((k & 8) >> 1); return ((kk >> 3) * 2 + (c >> 5)) * 512 + ((kk & 7) * 32 + (c & 31)) * 2; }
template <int KIND, bool ROT>
__device__ __forceinline__ void up_store(const f32x4 (&acc)[2][2][4][2], const int bj, char* base, const int pos0, const int dd, const float* tabp, const int tl, const int a) {
#pragma unroll
  for (int ai = 0; ai < 2; ++ai)
#pragma unroll
    for (int m = 0; m < 4; ++m) {
      const int ro = ai * 128 + m * 16;
      f32x4 v0 = acc[ai][bj][m][0], v1 = acc[ai][bj][m][1];
      if (ROT) { const int t = tl + ro; const int pp = a == 0 ? (t >> 6) : (t & 63); rope4(v0, v1, *(const f32x4*)(tabp + pp * 8), *(const f32x4*)(tabp + 2048 + pp * 8)); }
      const int pos = pos0 + ro;
      if (KIND == 2) {
        const unsigned w0 = pk4fp8(v0[0], v0[1], v0[2], v0[3]), w1 = pk4fp8(v1[0], v1[1], v1[2], v1[3]);
        const int qi = pos & 3; const unsigned sel = (unsigned)qi | ((unsigned)(4 + qi) << 8);
        unsigned o[2];
#pragma unroll
        for (int e = 0; e < 2; ++e) { const unsigned w = e ? w1 : w0;
          const unsigned t0 = (unsigned)__builtin_amdgcn_update_dpp(0, (int)w, 0x00, 0xF, 0xF, false), t1 = (unsigned)__builtin_amdgcn_update_dpp(0, (int)w, 0x55, 0xF, 0xF, false);
          const unsigned t2 = (unsigned)__builtin_amdgcn_update_dpp(0, (int)w, 0xAA, 0xF, 0xF, false), t3 = (unsigned)__builtin_amdgcn_update_dpp(0, (int)w, 0xFF, 0xF, 0xF, false);
          const unsigned x01 = __builtin_amdgcn_perm(t1, t0, sel), x23 = __builtin_amdgcn_perm(t3, t2, sel);
          o[e] = (x01 & 0xffffu) | (x23 << 16); }
        const int kk = pos & 63, a_ = kk >> 5, hi_ = (kk >> 2) & 1, j_ = (kk & 31) >> 3;
        char* tb = base + (size_t)(pos >> 6) * 4096 + (a_ * 2 + hi_) * 512 + j_ * 4;
#pragma unroll
        for (int e = 0; e < 2; ++e) { const int d = dd + 4 * e + qi; *(unsigned*)(tb + (d >> 5) * 2048 + (d & 31) * 16) = o[e]; } }
      else { u32x2 w; w.x = pk4fp8(v0[0], v0[1], v0[2], v0[3]); w.y = pk4fp8(v1[0], v1[1], v1[2], v1[3]);
        char* dst = KIND == 0 ? base + (size_t)pos * 96 + dd : base + (size_t)(pos >> 6) * 6144 + (dd >> 4) * 1024 + (pos & 63) * 16 + (dd & 15);
        *(u32x2*)dst = w; }
    }
}
struct EpiUp {
  static constexpr bool PERM = true;
  bf16_t* Q; bf16_t* QC; bf16_t* K; bf16_t* V; const float* tab;
  __device__ __forceinline__ void operator()(const f32x4 (&acc)[2][2][4][2], const pg8::Unit& u, int wr, int wc, int fr, int fq) const {
    const int trow0 = u.pm * 256; const bool isctx = trow0 >= NLAT;
    const int b = isctx ? (trow0 - NLAT) / CTX : trow0 / SEQ;
    const int tl = (isctx ? 0 : trow0 % SEQ) + wr * 64 + fr;
#pragma unroll
    for (int bj = 0; bj < 2; ++bj) {
      const int cg = u.pn * 256 + bj * 128 + wc * 32;
      if (cg < 768) { const int h = cg / 96, ddg = cg % 96;
        char* base = isctx ? (char*)QC + (size_t)(b * 8 + h) * CTX * 96 : (char*)Q + (size_t)(b * 8 + h) * SEQ * 96;
        if (ddg >= 64 && !isctx) up_store<0, true>(acc, bj, base, tl, ddg + 8 * fq, tab + ((4 * fq) & 7), tl, (4 * fq) >> 3);
        else up_store<0, false>(acc, bj, base, tl, ddg + 8 * fq, tab, tl, 0); }
      else { const int j = cg - 768, h = j >> 7, ddg = j & 127; const int pos0 = (isctx ? 0 : CTX) + tl;
        if (ddg < 64) up_store<1, false>(acc, bj, (char*)K + (size_t)(b * 8 + h) * NKEY * 96, pos0, ddg + 8 * fq, tab, tl, 0);
        else up_store<2, false>(acc, bj, (char*)V + (size_t)(b * 8 + h) * NKEY * 64, pos0, (ddg - 64) + 8 * fq, tab, tl, 0); }
    }
  }
};
struct EpiQkv2 {
  static constexpr bool PERM = true;
  bf16_t* Q2; bf16_t* K2; bf16_t* V2; const float* tab;
  __device__ __forceinline__ void operator()(const f32x4 (&acc)[2][2][4][2], const pg8::Unit& u, int wr, int wc, int fr, int fq) const {
    const int trow0 = u.pm * 256; const bool isctx = trow0 >= NLAT;
    const int b = isctx ? (trow0 - NLAT) / CTX : trow0 / SEQ;
    const int tl = (isctx ? 0 : trow0 % SEQ) + wr * 64 + fr;
#pragma unroll
    for (int bj = 0; bj < 2; ++bj) {
      const int cg = u.pn * 256 + bj * 128 + wc * 32;
      if (isctx && cg < 1024) continue;
      const int hh = cg >> 6, dd = (cg & 63) + 8 * fq; const int pos = (isctx ? 0 : CTX) + tl;
      const bool rot = (cg < 1280) && !isctx;
      const int kind = cg < 1024 ? 0 : (cg < 1280 ? 1 : 2);
      char* dst0;
      if (kind == 0) dst0 = (char*)Q2 + ((size_t)(b * 16 + hh) * SEQ + tl) * 64 + dd;
      else if (kind == 1) dst0 = (char*)K2 + (size_t)(b * 4 + hh - 16) * NKEY * 64;
      else dst0 = (char*)V2 + (size_t)(b * 4 + hh - 20) * NKEY * 64;
      const int p0 = dd >> 1, a = p0 >> 4, i0 = p0 & 15;
#pragma unroll
      for (int ai = 0; ai < 2; ++ai)
#pragma unroll
        for (int m = 0; m < 4; ++m) {
          const int ro = ai * 128 + m * 16;
          f32x4 v0 = acc[ai][bj][m][0], v1 = acc[ai][bj][m][1];
          if (rot) { const int t = tl + ro; const int pp = a == 0 ? (t >> 6) : (t & 63);
            rope4(v0, v1, *(const f32x4*)(tab + 4096 + pp * 16 + i0), *(const f32x4*)(tab + 8192 + pp * 16 + i0)); }
          const int ps = pos + ro;
          const unsigned w0 = pk4fp8(v0[0], v0[1], v0[2], v0[3]), w1 = pk4fp8(v1[0], v1[1], v1[2], v1[3]);
          if (kind < 2) { u32x2 w; w.x = w0; w.y = w1;
            char* dst = kind == 0 ? dst0 + (size_t)ro * 64 : dst0 + (size_t)(ps >> 6) * 4096 + (dd >> 4) * 1024 + (ps & 63) * 16 + (dd & 15);
            *(u32x2*)dst = w; }
          else {
            const int qi = ps & 3; const unsigned sel = (unsigned)qi | ((unsigned)(4 + qi) << 8);
            const int kk = ps & 63, a_ = kk >> 5, hi_ = (kk >> 2) & 1, j_ = (kk & 31) >> 3;
            char* tb = dst0 + (size_t)(ps >> 6) * 4096 + (a_ * 2 + hi_) * 512 + j_ * 4;
#pragma unroll
            for (int e = 0; e < 2; ++e) { const unsigned w = e ? w1 : w0;
              const unsigned t0 = (unsigned)__builtin_amdgcn_update_dpp(0, (int)w, 0x00, 0xF, 0xF, false), t1 = (unsigned)__builtin_amdgcn_update_dpp(0, (int)w, 0x55, 0xF, 0xF, false);
              const unsigned t2 = (unsigned)__builtin_amdgcn_update_dpp(0, (int)w, 0xAA, 0xF, 0xF, false), t3 = (unsigned)__builtin_amdgcn_update_dpp(0, (int)w, 0xFF, 0xF, 0xF, false);
              const unsigned x01 = __builtin_amdgcn_perm(t1, t0, sel), x23 = __builtin_amdgcn_perm(t3, t2, sel);
              const int d = dd + 4 * e + qi; *(unsigned*)(tb + (d >> 5) * 2048 + (d & 31) * 16) = (x01 & 0xffffu) | (x23 << 16); } }
        }
    }
  }
};

enum { PH_PRO = 0, PH_L0_NORM1, PH_L0_WIN, PH_L0_PREUP, PH_L0_UP, PH_L0_ATTN, PH_L0_WOUT, PH_L0_NORM2, PH_L0_TOPK, PH_L0_GU, PH_L0_DOWN, PH_L0_COMB,
       PH_L1_QKV, PH_L1_ATTN, PH_L1_WOUT, PH_L1_NORM2, PH_L1_TOPK, PH_L1_GU, PH_L1_DOWN, PH_L1_COMB, PH_COUNT };

template <class Epi>
__device__ __forceinline__ void sg_tile(const bf16_t* __restrict__ X, const bf16_t* __restrict__ Wt, const int K, const int row0, const int col0, const int lane, const Epi& E) {
    using att::f32x16;
    const int r32 = lane & 31, hi = lane >> 5;
    const bf16_t* xp = X + (size_t)(row0 + r32) * K + hi * 8;
    const bf16_t* w0 = Wt + (size_t)(col0 + r32) * K + hi * 8;
    f32x16 a0 = {}, a1 = {};
#pragma unroll 16
    for (int s = 0; s < K; s += 32) {
        const bf16x8 x0 = *reinterpret_cast<const bf16x8*>(xp + s), wa = *reinterpret_cast<const bf16x8*>(w0 + s);
        const bf16x8 x1 = *reinterpret_cast<const bf16x8*>(xp + s + 16), wb = *reinterpret_cast<const bf16x8*>(w0 + s + 16);
        a0 = __builtin_amdgcn_mfma_f32_32x32x16_bf16(wa, x0, a0, 0, 0, 0); a1 = __builtin_amdgcn_mfma_f32_32x32x16_bf16(wb, x1, a1, 0, 0, 0);
    }
#pragma unroll
    for (int g = 0; g < 4; ++g)
        E(row0 + r32, col0 + 8 * g + 4 * hi, (f32x4){a0[4 * g] + a1[4 * g], a0[4 * g + 1] + a1[4 * g + 1], a0[4 * g + 2] + a1[4 * g + 2], a0[4 * g + 3] + a1[4 * g + 3]});
}
template <class Epi>
__device__ __forceinline__ void sg_ctx(Frame& F, const bf16_t* X, const bf16_t* Wt, int K, int col_lo, int col_hi, const Epi& E) {
    const int ncb = (col_hi - col_lo) / 32, nu = (NCTX / 32) * ncb;
    for (int u = F.bid + F.wave * F.G; u < nu; u += 8 * F.G) sg_tile(X, Wt, K, NLAT + 32 * (u / ncb), col_lo + 32 * (u % ncb), F.lane, E);
}
struct SgStore { bf16_t* out; int ld; __device__ __forceinline__ void operator()(int row, int col, f32x4 v) const { u32x2 w; w.x = pk2bf(v[0], v[1]); w.y = pk2bf(v[2], v[3]); *(u32x2*)(out + (size_t)row * ld + col) = w; } };
struct SgResidCtx { const float* xin; float* xo; const float* gate;
    __device__ __forceinline__ void operator()(int row, int col, f32x4 v) const { const size_t o = (size_t)(row - NLAT) * DM + col; *(f32x4*)(xo + o) = *(const f32x4*)(xin + o) + *(const f32x4*)(gate + col) * v; } };
struct SgKv2Ctx { char* K2; char* V2;
    __device__ __forceinline__ void operator()(int row, int col, f32x4 v) const {
        const int j = row - NLAT, b = j / CTX, pos = j % CTX, hh = (col - 1024) >> 6, dd = col & 63;
        if (hh < 4) *(unsigned*)(K2 + (size_t)(b * 4 + hh) * NKEY * 64 + (size_t)(pos >> 6) * 4096 + (dd >> 4) * 1024 + (pos & 63) * 16 + (dd & 15)) = pk4fp8(v[0], v[1], v[2], v[3]);
        else { const int kk = pos & 63, a_ = kk >> 5, hi_ = (kk >> 2) & 1, tt = (kk & 3) + 4 * ((kk & 31) >> 3);
          char* tb = V2 + (size_t)(b * 4 + hh - 4) * NKEY * 64 + (size_t)(pos >> 6) * 4096 + (a_ * 2 + hi_) * 512 + tt;
#pragma unroll
          for (int e = 0; e < 4; ++e) { const int d = dd + e; *(unsigned char*)(tb + (d >> 5) * 2048 + (d & 31) * 16) = f2fp8(v[e]); } } } };

__device__ __forceinline__ void sg_tile64(const bf16_t* __restrict__ xr0, const bf16_t* __restrict__ xr1, const bf16_t* __restrict__ Wt, const int K, const int col0, const int lane,
                                          att::f32x16 (&acc)[2][2]) {
    const int r32 = lane & 31, hi = lane >> 5;
    const bf16_t* x0 = xr0 + hi * 8; const bf16_t* x1 = xr1 + hi * 8;
    const bf16_t* w0 = Wt + (size_t)(col0 + r32) * K + hi * 8; const bf16_t* w1 = w0 + (size_t)32 * K;
#pragma unroll
    for (int a = 0; a < 2; ++a)
#pragma unroll
        for (int b = 0; b < 2; ++b) acc[a][b] = att::f32x16{};
#pragma unroll 8
    for (int s = 0; s < K; s += 16) {
        const bf16x8 xa = *reinterpret_cast<const bf16x8*>(x0 + s), xb = *reinterpret_cast<const bf16x8*>(x1 + s);
        const bf16x8 wa = *reinterpret_cast<const bf16x8*>(w0 + s), wb = *reinterpret_cast<const bf16x8*>(w1 + s);
        acc[0][0] = __builtin_amdgcn_mfma_f32_32x32x16_bf16(wa, xa, acc[0][0], 0, 0, 0); acc[0][1] = __builtin_amdgcn_mfma_f32_32x32x16_bf16(wa, xb, acc[0][1], 0, 0, 0);
        acc[1][0] = __builtin_amdgcn_mfma_f32_32x32x16_bf16(wb, xa, acc[1][0], 0, 0, 0); acc[1][1] = __builtin_amdgcn_mfma_f32_32x32x16_bf16(wb, xb, acc[1][1], 0, 0, 0);
    }
}
__device__ __forceinline__ void sg_moe_gu_ctx(Frame& F, const Params& P) {
    const bf16_t* HB = (const bf16_t*)(P.ws + WS_HB); const int* sidx = (const int*)(P.ws + WS_SIDX) + 32 * CAP_L;
    bf16_t* HID = (bf16_t*)(P.ws + WS_PB) + (size_t)32 * CAP_L * DFF;
    const int lane = F.lane, r32 = lane & 31, hi = lane >> 5;
    for (int u = F.bid + F.wave * F.G; u < 16 * 32; u += 8 * F.G) {
        const int e = u >> 5, cb = u & 31;
        const int t0 = sidx[(0 * 16 + e) * CAP_C + r32], t1 = sidx[(1 * 16 + e) * CAP_C + r32];
        att::f32x16 acc[2][2];
        sg_tile64(HB + ((size_t)NLAT + 0 * CTX + t0) * DM, HB + ((size_t)NLAT + 1 * CTX + t1) * DM, (const bf16_t*)(P.ws + WS_W + OFF_WGU) + (size_t)e * 2048 * DM, DM, cb * 64, lane, acc);
#pragma unroll
        for (int rb = 0; rb < 2; ++rb) { bf16_t* hrow = HID + ((size_t)(rb * 16 + e) * CAP_C + r32) * DFF;
#pragma unroll
            for (int c2 = 0; c2 < 2; ++c2)
#pragma unroll
                for (int g = 0; g < 4; ++g) { const int col = cb * 64 + c2 * 32 + 8 * g + 4 * hi;
                    const att::f32x16& a = acc[c2][rb];
                    *(unsigned*)(hrow + (col >> 1)) = pk2bf(silu_f(a[4 * g]) * a[4 * g + 1], silu_f(a[4 * g + 2]) * a[4 * g + 3]); } }
    }
}
__device__ __forceinline__ void sg_moe_down_ctx(Frame& F, const Params& P) {
    const bf16_t* HID = (const bf16_t*)(P.ws + WS_PB) + (size_t)32 * CAP_L * DFF; bf16_t* YE = (bf16_t*)(P.ws + WS_QKV) + (size_t)32 * CAP_L * DM;
    const float* sg = (const float*)(P.ws + WS_SG) + 32 * CAP_L;
    const int lane = F.lane, r32 = lane & 31, hi = lane >> 5;
    for (int u = F.bid + F.wave * F.G; u < 16 * 16; u += 8 * F.G) {
        const int e = u >> 4, cb = u & 15;
        att::f32x16 acc[2][2];
        sg_tile64(HID + ((size_t)(0 * 16 + e) * CAP_C + r32) * DFF, HID + ((size_t)(1 * 16 + e) * CAP_C + r32) * DFF, (const bf16_t*)(P.ws + WS_W + OFF_WD) + (size_t)e * 1024 * DFF, DFF, cb * 64, lane, acc);
#pragma unroll
        for (int rb = 0; rb < 2; ++rb) { const size_t r = (size_t)(rb * 16 + e) * CAP_C + r32; const float gv = sg[r]; bf16_t* yrow = YE + r * DM;
#pragma unroll
            for (int c2 = 0; c2 < 2; ++c2)
#pragma unroll
                for (int g = 0; g < 4; ++g) { const int col = cb * 64 + c2 * 32 + 8 * g + 4 * hi; const att::f32x16& a = acc[c2][rb];
                    u32x2 w; w.x = pk2bf(a[4 * g] * gv, a[4 * g + 1] * gv); w.y = pk2bf(a[4 * g + 2] * gv, a[4 * g + 3] * gv); *(u32x2*)(yrow + col) = w; } }
    }
}

__device__ __forceinline__ void phase_gemm_win(Frame& F) {
    const Params P = lds_params(F);
    pg8::SchedPlain S; S.init(NLAT, 2048, DM, (const bf16_t*)(P.ws + WS_W + OFF_WIN), F.G, F.bid);
    EpiStore E{(bf16_t*)(P.ws + WS_PB), PPITCH};
    pg8::gemm_phase<EpiStore, pg8::SchedPlain, true>(F.lds, (const char*)(P.ws + WS_HB), DM, S, E);
    sg_ctx(F, (const bf16_t*)(P.ws + WS_HB), (const bf16_t*)(P.ws + WS_W + OFF_WIN), DM, 0, 1984, SgStore{(bf16_t*)(P.ws + WS_PB), PPITCH});
}
__device__ __forceinline__ void phase_gemm_up(Frame& F) {
    const Params P = lds_params(F);
    pg8::SchedPlainT<1> S; S.init(NROW, 1792, 512, (const bf16_t*)(P.ws + WS_W + OFF_WUP), F.G, F.bid);
    EpiUp E{(bf16_t*)(P.ws + WS_QKV + OFF_Q), (bf16_t*)(P.ws + WS_QKV + OFF_QC), (bf16_t*)(P.ws + WS_QKV + OFF_K), (bf16_t*)(P.ws + WS_QKV + OFF_V), (const float*)(P.ws + WS_ROPE)};
    pg8::gemm_phase<EpiUp, pg8::SchedPlainT<1>, true>(F.lds, (const char*)(P.ws + WS_QN), 512, S, E);
}
__device__ __forceinline__ void phase_gemm_wout(Frame& F, int layer) {
    const Params P = lds_params(F);
    float* modv = (float*)(P.ws + WS_MODV); float* xc = (float*)(P.ws + WS_XC);
    if (layer == 0) {
        pg8::SchedPlain S; S.init(NLAT, DM, DM, (const bf16_t*)(P.ws + WS_W + OFF_WOUT), F.G, F.bid);
        EpiResidB<true> E{P.in[0], (bf16_t*)(P.ws + WS_XSB), modv, 2 * DM};
        pg8::gemm_phase<EpiResidB<true>, pg8::SchedPlain, true>(F.lds, (const char*)(P.ws + WS_CAT), DM, S, E);
        sg_ctx(F, (const bf16_t*)(P.ws + WS_CAT), (const bf16_t*)(P.ws + WS_W + OFF_WOUT), DM, 0, DM, SgResidCtx{P.in[2], xc, modv + 2 * NMOD + 2 * DM});
    } else {
        pg8::SchedPlainT<1, 0x7B7B7B7B> S; S.init(NLAT, DM, DM, (const bf16_t*)(P.ws + WS_W + OFF_WSO), F.G, F.bid);
        EpiResidB<false> E{nullptr, (bf16_t*)(P.ws + WS_XSB), modv + 3 * NMOD, 2 * DM};
        pg8::gemm_phase<EpiResidB<false>, pg8::SchedPlainT<1, 0x7B7B7B7B>, true>(F.lds, (const char*)(P.ws + WS_CAT), DM, S, E);
    }
}
__device__ __forceinline__ void phase_gemm_gu(Frame& F, int layer) {
    const Params P = lds_params(F);
    SchedMoeGU S; S.init((const int*)(P.ws + WS_SIDX), (const bf16_t*)(P.ws + WS_W + OFF_WGU), F.G, F.bid, layer == 0);
    EpiHidMk E{(bf16_t*)(P.ws + WS_PB)};
    pg8::gemm_phase<EpiHidMk, SchedMoeGU, true>(F.lds, (const char*)(P.ws + WS_HB), DM, S, E);
}
__device__ __forceinline__ void phase_gemm_down(Frame& F, int layer) {
    const Params P = lds_params(F);
    SchedMoeDown S; S.init((const bf16_t*)(P.ws + WS_W + OFF_WD), F.G, F.bid, layer == 0);
    EpiYeMk E{(bf16_t*)(P.ws + WS_QKV), (const float*)(P.ws + WS_SG)};
    pg8::gemm_phase<EpiYeMk, SchedMoeDown, true>(F.lds, (const char*)(P.ws + WS_PB), DFF, S, E);
}
__device__ __forceinline__ void phase_gemm_qkv2(Frame& F) {
    const Params P = lds_params(F);
    pg8::SchedPlainT<1> S; S.init(NLAT, 1536, DM, (const bf16_t*)(P.ws + WS_W + OFF_WQKV8), F.G, F.bid);
    EpiQkv2 E{(bf16_t*)(P.ws + WS_QKV + OFF_Q2), (bf16_t*)(P.ws + WS_QKV + OFF_K2), (bf16_t*)(P.ws + WS_QKV + OFF_V2), (const float*)(P.ws + WS_ROPE)};
    pg8::gemm_phase<EpiQkv2, pg8::SchedPlainT<1>, true>(F.lds, (const char*)(P.ws + WS_HB), DM, S, E);
    sg_ctx(F, (const bf16_t*)(P.ws + WS_HB), (const bf16_t*)(P.ws + WS_W + OFF_WQKV), DM, 1024, 1536, SgKv2Ctx{(char*)(P.ws + WS_QKV + OFF_K2), (char*)(P.ws + WS_QKV + OFF_V2)});
}

__global__ void __launch_bounds__(NTHREADS, 2) mk_fwd(Params KP) {
    extern __shared__ __attribute__((aligned(16))) unsigned char lds_raw[];
    Frame F;
    F.lds = (LAS unsigned char*)lds_raw; F.tid = threadIdx.x; F.lane = F.tid & 63; F.wave = __builtin_amdgcn_readfirstlane(F.tid >> 6); F.G = gridDim.x; F.bid = blockIdx.x;
    volatile LAS unsigned* MISC = (volatile LAS unsigned*)(F.lds + LDS_MISC);
    if (F.tid < 16) MISC[F.tid] = 0u;
    if (F.tid < 26) { const unsigned long long v = F.tid < 24 ? (unsigned long long)KP.in[F.tid] : (F.tid == 24 ? (unsigned long long)KP.out : (unsigned long long)KP.ws);
        ((LAS unsigned long long*)(F.lds + LDS_MISC + 64))[F.tid] = v; }
    if ((threadIdx.x & 63) == 0) ((LAS unsigned*)(F.lds + LDS_MISC + 512))[(unsigned)__builtin_amdgcn_s_getreg(0x2804) & 63u] = threadIdx.x >> 6;
    __syncthreads();
    const int lo = KP.ph_lo, hi = KP.ph_hi;
    const bool multi = (hi - lo) > 1;
    XcdBarrier bar; bar.bar = (unsigned*)(KP.ws + WS_CTL); bar.x = 0; bar.st = nullptr;
    if (multi) bar = xcd_barrier_post((unsigned*)(KP.ws + WS_CTL), MISC);
#ifndef PHMASK
#define PHMASK 0xFFFFFu
#endif
#define IN(k) ((((PHMASK) >> (k)) & 1u) && lo <= (k) && (k) < hi)
#define SEAM(k) do { if (IN(k) && IN((k) + 1)) xcd_barrier(bar); } while (0)
#ifndef PROBE_DUP
#define PROBE_DUP 0u
#endif
#define RUN(k, call) do { if (IN(k)) { Frame F; { int t_ = my_tid(); asm volatile("" : "+v"(t_)); F.lds = (LAS unsigned char*)lds_raw; F.tid = t_; F.lane = t_ & 63; \
        F.wave = __builtin_amdgcn_readfirstlane(t_ >> 6); F.G = gridDim.x; F.bid = blockIdx.x; } \
        call; if (((PROBE_DUP) >> (k)) & 1u) { xcd_barrier(bar); call; } } SEAM(k); } while (0)
#ifdef PROBE_UB
    RUN(PH_PRO, phase_ubench(F));
#endif
    RUN(PH_PRO, phase_prologue(F));
    RUN(PH_L0_NORM1, phase_norm1_l0(F));
#ifdef PROBE_RND
    if (PROBE_RND & 1) { RUN(PH_L0_WIN, phase_rnd(F, WS_HB, (size_t)NROW * DM * 2)); if (IN(PH_L0_WIN)) xcd_barrier(bar); }
#endif
    RUN(PH_L0_WIN, phase_gemm_win(F));
    RUN(PH_L0_PREUP, phase_preup(F));
#ifdef PROBE_RND
    if (PROBE_RND & 16) { RUN(PH_L0_UP, phase_rnd(F, WS_QN, (size_t)NROW * 384 * 2)); if (IN(PH_L0_UP)) xcd_barrier(bar); }
#endif
    RUN(PH_L0_UP, phase_gemm_up(F));
    RUN(PH_L0_ATTN, phase_attn_mla(F));
#ifdef PROBE_ATT_ABL
    RUN(PH_L0_ATTN, phase_attn_probe(F)); if (IN(PH_L0_ATTN)) xcd_barrier(bar);
#endif
#ifdef PROBE_RND
    if (PROBE_RND & 2) { RUN(PH_L0_WOUT, phase_rnd(F, WS_CAT, (size_t)NROW * DM * 2)); if (IN(PH_L0_WOUT)) xcd_barrier(bar); }
#endif
    RUN(PH_L0_WOUT, phase_gemm_wout(F, 0));
    RUN(PH_L0_NORM2, phase_norm2(F, 0));
    RUN(PH_L0_TOPK, phase_topk(F, 0));
    RUN(PH_L0_GU, phase_gemm_gu(F, 0));
    RUN(PH_L0_DOWN, phase_gemm_down(F, 0));
    RUN(PH_L0_COMB, phase_combine(F, 0));
#ifdef PROBE_COMB
    if (IN(PH_L0_COMB)) { Frame F; F.lds = (LAS unsigned char*)lds_raw; F.tid = my_tid(); F.lane = F.tid & 63; F.wave = __builtin_amdgcn_readfirstlane(F.tid >> 6); F.G = gridDim.x; F.bid = blockIdx.x; phase_combine<true>(F, PROBE_COMB); xcd_barrier(bar); }
#endif
#ifdef PROBE_RND
    if (PROBE_RND & 4) { RUN(PH_L1_QKV, phase_rnd(F, WS_HB, (size_t)NROW * DM * 2)); if (IN(PH_L1_QKV)) xcd_barrier(bar); }
#endif
    RUN(PH_L1_QKV, phase_gemm_qkv2(F));
#ifdef PROBE_RND
    if (PROBE_RND & 32) { RUN(PH_L1_ATTN, phase_rnd(F, WS_QKV + OFF_Q2, OFF_V2 + (size_t)NB * 4 * NKEY * 64 * 2 - OFF_Q2)); if (IN(PH_L1_ATTN)) xcd_barrier(bar); }
#endif
    RUN(PH_L1_ATTN, phase_attn_swa(F));
#ifdef PROBE_RND
    if (PROBE_RND & 8) { RUN(PH_L1_WOUT, phase_rnd(F, WS_CAT, (size_t)NLAT * DM * 2)); if (IN(PH_L1_WOUT)) xcd_barrier(bar); }
#endif
    RUN(PH_L1_WOUT, phase_gemm_wout(F, 1));
    RUN(PH_L1_NORM2, phase_norm2(F, 1));
    RUN(PH_L1_TOPK, phase_topk(F, 1));
    RUN(PH_L1_GU, phase_gemm_gu(F, 1));
    RUN(PH_L1_DOWN, phase_gemm_down(F, 1));
    RUN(PH_L1_COMB, phase_combine(F, 1));
#undef IN
#undef SEAM
#undef RUN
}

static void launch_phase(hipStream_t s, int grid, const Params& base, int lo, int hi) {
  Params p = base; p.ph_lo = lo; p.ph_hi = hi;
  hipLaunchKernelGGL(mk_fwd, dim3(grid), dim3(NTHREADS), LDS_BYTES, s, p);
}

extern "C" void kernel_launch(void* const* d_in, const int* in_sizes, int n_in, void* d_out, int out_size, void* d_ws, size_t ws_size, hipStream_t stream) {
  static int grid = 0;
  if (grid == 0) {
    if (n_in != 24 || ws_size < WS_END || out_size != NLAT * DM) { fprintf(stderr, "kernel_launch: bad sizes n_in %d ws %zu (need %zu) out %d\n", n_in, ws_size, (size_t)WS_END, out_size); grid = -1; return; }
    int dev = 0, cus = 0;
    if (hipGetDevice(&dev) != hipSuccess || hipDeviceGetAttribute(&cus, hipDeviceAttributeMultiprocessorCount, dev) != hipSuccess) { grid = -1; return; }
    if (hipFuncSetAttribute((const void*)mk_fwd, hipFuncAttributeMaxDynamicSharedMemorySize, LDS_BYTES) != hipSuccess) { fprintf(stderr, "kernel_launch: hipFuncSetAttribute failed\n"); grid = -1; return; }
    int per_cu = 0;
    if (hipOccupancyMaxActiveBlocksPerMultiprocessor(&per_cu, (const void*)mk_fwd, NTHREADS, LDS_BYTES) != hipSuccess || per_cu < 1) { fprintf(stderr, "kernel_launch: occupancy query says %d\n", per_cu); grid = -1; return; }
    grid = cus;
  }
  if (grid < 0) return;
  Params P{};
  for (int i = 0; i < 24; ++i) P.in[i] = (const float*)d_in[i];
  P.out = (float*)d_out; P.ws = (unsigned char*)d_ws; P.ph_lo = 0; P.ph_hi = 0;
  if (hipMemsetAsync((char*)d_ws + WS_CTL, 0, CTL_BYTES, stream) != hipSuccess) return;
#ifdef MK_PER_PHASE
  for (int ph = 0; ph < PH_COUNT; ++ph) launch_phase(stream, grid, P, ph, ph + 1);
#else
  launch_phase(stream, grid, P, 0, PH_COUNT);
#endif
}
```

```cpp
#include <hip/hip_runtime.h>
#include <hip/hip_bf16.h>
#include <cstdio>
#include <cstdint>

typedef unsigned short bf16_t;

constexpr int NB = 2, SEQ = 16384, DM = 1024, CTX = 256;
constexpr int NLAT = NB * SEQ;
constexpr int NCTX = NB * CTX;
constexpr int NROW = NLAT + NCTX;
constexpr int NKEY = CTX + SEQ;
constexpr int AB_IN = 1952, PPITCH = 2048;
constexpr int NE = 16, CAP_L = 2048, CAP_C = 32, DFF = 1024;
constexpr int NMOD = 6 * DM;
constexpr float EPS = 1e-6f;
constexpr float LOG2E = 1.4426950408889634f;
constexpr float QF8_SCALE = 16.f;

constexpr size_t al256(size_t x) { return (x + 255) / 256 * 256; }
constexpr size_t CTL_BYTES = 65536;
constexpr size_t WS_CTL  = 0;
constexpr size_t WS_MODV = WS_CTL + CTL_BYTES;
constexpr size_t WS_ROPE = WS_MODV + al256(2 * 3 * NMOD * 4);
constexpr size_t WS_XC   = WS_ROPE + al256(256 * 48 * 4);
constexpr size_t WS_AFF  = WS_XC + al256((size_t)NCTX * DM * 4);
constexpr size_t WS_SIDX = WS_AFF + al256((size_t)(NB * NE * SEQ + NB * NE * CTX) * 4);
constexpr size_t WS_SG   = WS_SIDX + al256((size_t)(NB * NE * CAP_L + NB * NE * CAP_C) * 4);
constexpr size_t WS_SLOT = WS_SG + al256((size_t)(NB * NE * CAP_L + NB * NE * CAP_C) * 4);
constexpr size_t WS_HB   = WS_SLOT + al256((size_t)(NB * NE * SEQ + NB * NE * CTX) * 4);
constexpr size_t MOE_ROWS = (size_t)NB * NE * CAP_L + NB * NE * CAP_C;
constexpr size_t WS_PB   = WS_HB + al256((size_t)NROW * DM * 2);
constexpr size_t WS_QN   = WS_PB + al256(MOE_ROWS * DM * 2 + (1u << 20));
constexpr size_t WS_KVN  = WS_QN + al256((size_t)NROW * 256 * 2);
constexpr size_t WS_QKV  = WS_KVN + al256((size_t)NROW * 128 * 2);
constexpr size_t QKV_BYTES = MOE_ROWS * DM * 2;
constexpr size_t WS_W    = WS_QKV + al256(QKV_BYTES);
constexpr size_t WS_CAT  = WS_HB;
constexpr size_t OFF_WIN = 0;
constexpr size_t OFF_WUP = OFF_WIN + (size_t)2048 * 1024 * 2;
constexpr size_t OFF_WOUT = OFF_WUP + al256((size_t)1792 * 384 * 2);
constexpr size_t OFF_WQKV = OFF_WOUT + (size_t)1024 * 1024 * 2;
constexpr size_t OFF_WSO = OFF_WQKV + (size_t)1536 * 1024 * 2;
constexpr size_t OFF_WGU = OFF_WSO + (size_t)1024 * 1024 * 2;
constexpr size_t OFF_WD  = OFF_WGU + (size_t)16 * 2048 * 1024;
constexpr size_t OFF_WQKV8 = OFF_WD + (size_t)16 * 1024 * 1024;
constexpr size_t WS_XSB  = WS_W + OFF_WQKV8 + (size_t)1536 * 1024;
constexpr size_t WS_W2   = WS_XSB + (size_t)NLAT * DM * 2;
constexpr size_t W2_WD   = (size_t)16 * 2048 * 1024;
constexpr size_t WS_END  = WS_W2 + W2_WD + (size_t)16 * 1024 * 1024;
constexpr size_t OFF_Q  = 0;
constexpr size_t OFF_QC = OFF_Q + (size_t)NB * 8 * SEQ * 96 * 2;
constexpr size_t OFF_K  = OFF_QC + (size_t)NB * 8 * CTX * 96 * 2;
constexpr size_t OFF_V  = OFF_K + (size_t)NB * 8 * NKEY * 96 * 2;
static_assert(OFF_V + (size_t)NB * 8 * NKEY * 64 * 2 <= QKV_BYTES, "qkv region");
constexpr size_t OFF_Q2 = 0;
constexpr size_t OFF_K2 = OFF_Q2 + (size_t)NB * 16 * SEQ * 64 * 2;
constexpr size_t OFF_V2 = OFF_K2 + (size_t)NB * 4 * NKEY * 64 * 2;
static_assert(OFF_V2 + (size_t)NB * 4 * NKEY * 64 * 2 <= QKV_BYTES, "qkv2 region");

__device__ __forceinline__ float bf2f(bf16_t v) { return __uint_as_float(((unsigned)v) << 16); }
__device__ __forceinline__ bf16_t f2bf(float f) { unsigned u = __float_as_uint(f); u += 0x7FFFu + ((u >> 16) & 1u); return (bf16_t)(u >> 16); }
__device__ __forceinline__ float silu_f(float x) { return x * __builtin_amdgcn_rcpf(1.f + __builtin_amdgcn_exp2f(x * -1.44269504088896f)); }

__device__ __forceinline__ float block_sum(float v, float* red) {
  for (int d = 32; d > 0; d >>= 1) v += __shfl_xor(v, d, 64);
  __syncthreads();
  if ((threadIdx.x & 63) == 0) red[threadIdx.x >> 6] = v;
  __syncthreads();
  float s = 0.f;
  for (int i = 0; i < (int)(blockDim.x >> 6); ++i) s += red[i];
  return s;
}

#define LAS __attribute__((address_space(3)))
typedef short bf16x8 __attribute__((ext_vector_type(8)));
typedef float f32x4 __attribute__((ext_vector_type(4)));
typedef unsigned u32x4 __attribute__((ext_vector_type(4)));
typedef unsigned u32x2 __attribute__((ext_vector_type(2)));

constexpr int NTHREADS = 512;
constexpr int RING_BYTES = 131072;
constexpr int LDS_MISC = RING_BYTES;
constexpr int LDS_BYTES = RING_BYTES + 1024;
__device__ __forceinline__ int my_tid() {
    extern __shared__ __attribute__((aligned(16))) unsigned char lds_raw[];
    const unsigned key = (unsigned)__builtin_amdgcn_s_getreg(0x2804) & 63u;
    const int w = __builtin_amdgcn_readfirstlane((int)((const LAS unsigned*)((LAS unsigned char*)lds_raw + LDS_MISC + 512))[key]);
    return w * 64 + (int)__builtin_amdgcn_mbcnt_hi(~0u, __builtin_amdgcn_mbcnt_lo(~0u, 0u));
}

struct Params { const float* in[24]; float* out; unsigned char* ws; int ph_lo, ph_hi; };

__device__ __forceinline__ unsigned pk4fp8(float a, float b, float c, float d) { unsigned r;
  asm("v_cvt_pk_fp8_f32 %0, %1, %2" : "=v"(r) : "v"(a), "v"(b)); asm("v_cvt_pk_fp8_f32 %0, %1, %2 op_sel:[0,0,1]" : "+v"(r) : "v"(c), "v"(d)); return r; }
template <int CTRL> __device__ __forceinline__ float dpp_mov(float x) { return __uint_as_float((unsigned)__builtin_amdgcn_update_dpp(0, (int)__float_as_uint(x), CTRL, 0xF, 0xF, false)); }
__device__ __forceinline__ unsigned char f2fp8(float x) { return (unsigned char)((unsigned)__builtin_amdgcn_cvt_pk_fp8_f32(x, 0.f, 0, false) & 0xffu); }
__device__ __forceinline__ unsigned pk2bf(float lo, float hi) { return (unsigned)f2bf(lo) | ((unsigned)f2bf(hi) << 16); }
#if defined(PROBE_FP8ATT) || defined(PROBE_RND)
__device__ __forceinline__ float fp8rt(float x, float sc) { const unsigned r = (unsigned)__builtin_amdgcn_cvt_pk_fp8_f32(x * sc, 0.f, 0, false); return __builtin_amdgcn_cvt_f32_fp8((int)r, 0) * (1.f / sc); }
#endif

#define XB_TMO      128
#define XB_XCNT(j)  (256  + 64 * (j))
#define XB_XSUB(j)  (1280 + 64 * (j))
#define XB_XGEN(j)  (2304 + 64 * (j))
#define XB_TOP      3328
#define XB_TOPGEN   3392
#define XCD_BAR_WORDS 3456
#define XB_SPIN_CAP (1u << 18)
__device__ __forceinline__ unsigned xb_ld(unsigned* p)              { return __hip_atomic_load(p, __ATOMIC_RELAXED, __HIP_MEMORY_SCOPE_AGENT); }
__device__ __forceinline__ unsigned xb_add(unsigned* p, unsigned v) { return __hip_atomic_fetch_add(p, v, __ATOMIC_RELAXED, __HIP_MEMORY_SCOPE_AGENT); }
__device__ __forceinline__ unsigned xb_xcc_id() { return (unsigned)__builtin_amdgcn_s_getreg((3 << 11) | 20) & 0xFu; }
#define XB_SPIN(cond, bar) do { unsigned _sp = 0; while (cond) { __builtin_amdgcn_s_sleep(1); \
    if ((++_sp & 255u) == 0u) { if (xb_ld(&(bar)[XB_TMO])) break; if (_sp > XB_SPIN_CAP) { atomicAdd(&(bar)[XB_TMO], 1u); break; } } } } while (0)
struct XcdBarrier { unsigned* bar; unsigned x; volatile LAS unsigned* st; };
__device__ __forceinline__ XcdBarrier xcd_barrier_post(unsigned* bar, volatile LAS unsigned* st) {
    XcdBarrier b; b.bar = bar; b.x = xb_xcc_id(); b.st = st;
    if (my_tid() == 0) (void)xb_add(&bar[XB_XCNT(b.x)], 1u);
    return b;
}
__device__ __forceinline__ void xcd_barrier_complete(unsigned* bar, unsigned x, unsigned& nloc, unsigned& nx) {
    const unsigned G = gridDim.x * gridDim.y * gridDim.z;
    unsigned sum, cnt, mine, sp = 0u;
    for (;;) {
        sum = 0u; cnt = 0u; mine = 0u;
#pragma unroll
        for (unsigned j = 0; j < 16; ++j) { const unsigned c = xb_ld(&bar[XB_XCNT(j)]); sum += c; cnt += (c > 0u) ? 1u : 0u; mine = (j == x) ? c : mine; }
        if (sum == G) break;
        __builtin_amdgcn_s_sleep(1);
        if ((++sp & 255u) == 0u) { if (xb_ld(&bar[XB_TMO])) break; if (sp > XB_SPIN_CAP) { atomicAdd(&bar[XB_TMO], 1u); break; } }
    }
    nloc = mine > 0u ? mine : 1u; nx = cnt > 0u ? cnt : 1u;
}
__device__ __forceinline__ void xcd_barrier(const XcdBarrier& b) {
    asm volatile("s_waitcnt vmcnt(0)" ::: "memory");
    __syncthreads();
    if (my_tid() == 0) {
        unsigned* bar = b.bar;
        __builtin_amdgcn_s_waitcnt(0);
        unsigned nloc = b.st[0], nx = b.st[1];
        if (nloc == 0u) { xcd_barrier_complete(bar, b.x, nloc, nx); b.st[0] = nloc; b.st[1] = nx; }
        const unsigned old = xb_add(&bar[XB_XSUB(b.x)], 1u);
        const unsigned gen = old / nloc;
        if (old + 1u == (gen + 1u) * nloc) {
            __builtin_amdgcn_fence(__ATOMIC_RELEASE, "agent");
            asm volatile("s_waitcnt vmcnt(0)" ::: "memory");
            const unsigned og = xb_add(&bar[XB_TOP], 1u);
            const unsigned tg = og / nx;
            if (og + 1u == (tg + 1u) * nx) xb_add(&bar[XB_TOPGEN], 1u);
            else XB_SPIN(xb_ld(&bar[XB_TOPGEN]) == tg, bar);
            __builtin_amdgcn_fence(__ATOMIC_ACQUIRE, "agent");
            xb_add(&bar[XB_XGEN(b.x)], 1u);
            asm volatile("s_waitcnt vmcnt(0)" ::: "memory");
        } else {
            XB_SPIN(xb_ld(&bar[XB_XGEN(b.x)]) == gen, bar);
            __builtin_amdgcn_fence(__ATOMIC_ACQUIRE, "agent");
            asm volatile("s_waitcnt vmcnt(0)" ::: "memory");
        }
    }
    __syncthreads();
}

namespace pg8 {
constexpr int BM = 256, BK = 64, HALF = 128, HTB = HALF * BK * 2, STAGE_BYTES = 8 * HTB, NXCD = 8, WGM = 8;
__host__ __device__ __forceinline__ int lds_byte(int r, int c) { const int st = (r >> 4) * 2 + (c >> 5), rr = r & 15, cc = c & 31, ob = rr * 64 + cc * 2; return st * 1024 + (ob ^ (((ob >> 9) & 1) << 5)); }
__host__ __device__ __forceinline__ void stage_rc(int b, int& R, int& C) { const int st = b / 1024, sb = b % 1024, swz = sb ^ (((sb >> 9) & 1) << 5); R = (st >> 1) * 16 + swz / 64; C = (st & 1) * 32 + (swz % 64) / 2; }
__host__ __device__ __forceinline__ int perm32(int rho) { const int n = rho >> 4, i = rho & 15; return 8 * (i >> 2) + 4 * n + (i & 3); }
struct Unit { int pm, pn, grp; };

template <int EB_, int ASC_ = 0x7F7F7F7F>
struct SchedPlainT {
    static constexpr int EB = EB_, NBJ = 2, WSCALE = EB_ == 1 ? 0x7A7A7A7A : 0x7F7F7F7F, ASCALE = ASC_;
    int nM, nN, nwg, G, c; const char* Bt; int K;
    __device__ __forceinline__ void init(int M, int N, int K_, const bf16_t* Bt_, int G_, int c_) { nM = M / BM; nN = N / BM; nwg = nM * nN; G = G_; c = c_; Bt = (const char*)Bt_; K = K_; }
    __device__ __forceinline__ bool next(int i, Unit& u) const {
        const long L = (long)i * G + c; if (L >= nwg) return false;
        int wgid = (int)L; { const int q = nwg / NXCD, r = nwg % NXCD, xcd = wgid % NXCD, off = wgid / NXCD; wgid = (xcd < r ? xcd * (q + 1) : r * (q + 1) + (xcd - r) * q) + off; }
        const int nig = WGM * nN, gid = wgid / nig, fm = gid * WGM, gsz = (nM - fm) < WGM ? (nM - fm) : WGM;
        u.pm = fm + ((wgid % nig) % gsz); u.pn = (wgid % nig) / gsz; u.grp = 0; return true;
    }
    __device__ __forceinline__ int a_row(const Unit& u, int r) const { return u.pm * BM + r; }
    __device__ __forceinline__ const char* b_ptr(const Unit& u) const { return Bt + (size_t)u.pn * BM * K * EB; }
    static constexpr int NT_FIXED = 0;
    __device__ __forceinline__ int kwin(const Unit&) const { return 0; }
};
using SchedPlain = SchedPlainT<2>;
struct SchedUp : SchedPlainT<1> {
    static constexpr int NT_FIXED = 2;
    __device__ __forceinline__ int kwin(const Unit& u) const { return u.pn >= 3 ? 256 : 0; }
    __device__ __forceinline__ const char* b_ptr(const Unit& u) const { return Bt + (size_t)u.pn * BM * K + (u.pn >= 3 ? 256 : 0); }
};

#define PG8_SA(b, h) (((b) * 2 + (h)) * HTB)
#define PG8_SB(b, h) ((4 + (b) * 2 + (h)) * HTB)
#ifdef PROBE_FAKEK
#define PG8_FK_B(x) (stage_on ? (x) : Abase)
#define PG8_FK_V(x) (stage_on ? (x) : 0u)
#else
#define PG8_FK_B(x) (x)
#define PG8_FK_V(x) (x)
#endif
#define PG8_STAGE(bufoff, gbase, voff) do { const char* gb_ = PG8_FK_B((const char*)(gbase)); asm volatile("" : "+s"(gb_)); _Pragma("unroll") for (int _i = 0; _i < 2; ++_i) { unsigned vo_ = PG8_FK_V((voff)[_i]); asm volatile("" : "+v"(vo_)); \
        __builtin_amdgcn_global_load_lds((const unsigned*)(gb_ + vo_), (LAS unsigned*)(lds + (bufoff) + ldsw + _i * 8192), 16, 0, 0); } } while (0)
#define PG8_LDA(dst, b, h) do { _Pragma("unroll") for (int m = 0; m < 4; ++m) { \
        if constexpr (EB == 1) dst##8[m] = cat32(*(const LAS bf16x8*)(lds + PG8_SA(b, h) + aoff + m * 2048), *(const LAS bf16x8*)(lds + PG8_SA(b, h) + aoff + m * 2048 + 1024)); \
        else { _Pragma("unroll") for (int k = 0; k < 2; ++k) dst[m][k] = *(const LAS bf16x8*)(lds + PG8_SA(b, h) + aoff + m * 2048 + k * 1024); } } } while (0)
#define PG8_LDB(dst, b, h) do { _Pragma("unroll") for (int n = 0; n < 2; ++n) { \
        if constexpr (EB == 1) dst##8[n] = cat32(*(const LAS bf16x8*)(lds + PG8_SB(b, h) + boff + n * 2048), *(const LAS bf16x8*)(lds + PG8_SB(b, h) + boff + n * 2048 + 1024)); \
        else { _Pragma("unroll") for (int k = 0; k < 2; ++k) dst[n][k] = *(const LAS bf16x8*)(lds + PG8_SB(b, h) + boff + n * 2048 + k * 1024); } } } while (0)
typedef float f32x16 __attribute__((ext_vector_type(16)));
__device__ __forceinline__ f32x4 get4(const f32x16& v, int k) { return (f32x4){v[4 * k], v[4 * k + 1], v[4 * k + 2], v[4 * k + 3]}; }
__device__ __forceinline__ void set4(f32x16& v, int k, f32x4 x) { v[4 * k] = x[0]; v[4 * k + 1] = x[1]; v[4 * k + 2] = x[2]; v[4 * k + 3] = x[3]; }
typedef int v8i32 __attribute__((ext_vector_type(8)));
typedef int v4i32 __attribute__((ext_vector_type(4)));
__device__ __forceinline__ v8i32 cat32(bf16x8 lo, bf16x8 hi) { const v4i32 a = __builtin_bit_cast(v4i32, lo), b = __builtin_bit_cast(v4i32, hi); return __builtin_shufflevector(a, b, 0, 1, 2, 3, 4, 5, 6, 7); }
#define PG8_MMA(ai, bj, At, Bt) do { __builtin_amdgcn_s_setprio(1); _Pragma("unroll") for (int m = 0; m < 4; ++m) _Pragma("unroll") for (int n = 0; n < 2; ++n) { \
        if constexpr (EB == 1) { if constexpr (ACC16) set4(accT[ai][bj][m >> 1], (m & 1) * 2 + n, __builtin_amdgcn_mfma_scale_f32_16x16x128_f8f6f4(Bt##8[n], At##8[m], get4(accT[ai][bj][m >> 1], (m & 1) * 2 + n), 0, 0, 0, Sched::WSCALE, 0, Sched::ASCALE)); \
            else acc[ai][bj][m][n] = __builtin_amdgcn_mfma_scale_f32_16x16x128_f8f6f4(Bt##8[n], At##8[m], acc[ai][bj][m][n], 0, 0, 0, Sched::WSCALE, 0, Sched::ASCALE); } \
        else { _Pragma("unroll") for (int k = 0; k < 2; ++k) acc[ai][bj][m][n] = __builtin_amdgcn_mfma_f32_16x16x32_bf16(Bt[n][k], At[m][k], acc[ai][bj][m][n], 0, 0, 0); } } \
        __builtin_amdgcn_s_setprio(0); } while (0)
#define PG8_WAIT_V(n) asm volatile("s_waitcnt vmcnt(" #n ")" ::: "memory")
#define PG8_WAIT_K do { if constexpr (NBJ == 2) asm volatile("s_waitcnt vmcnt(8)" ::: "memory"); else asm volatile("s_waitcnt vmcnt(6)" ::: "memory"); } while (0)
#define PG8_WAIT_L(n) asm volatile("s_waitcnt lgkmcnt(" #n ")" ::: "memory")
#define PG8_BAR __builtin_amdgcn_s_barrier()
#define PG8_SCHED __builtin_amdgcn_sched_barrier(0)

template <class Epi, class Sched, bool ALIGN_EPI>
__device__ __forceinline__ void gemm_phase(LAS unsigned char* lds, const char* Abase, const int K, const Sched& S, const Epi& E) {
    const int tid = my_tid(), wid = __builtin_amdgcn_readfirstlane(tid >> 6), lane = tid & 63, wr = wid >> 2, wc = wid & 3, fr = lane & 15, fq = lane >> 4;
    constexpr int EB = Sched::EB, NBJ = Sched::NBJ; constexpr bool ACC16 = (EB == 1 && NBJ == 2);
    int nt = Sched::NT_FIXED ? Sched::NT_FIXED : K * EB / 128;
    if constexpr (Sched::NT_FIXED != 0) asm volatile("" : "+s"(nt));
    unsigned voffB[2];
#pragma unroll
    for (int i = 0; i < 2; ++i) { int R, C; stage_rc(tid * 16 + i * 8192, R, C); const int Rb = Epi::PERM ? ((R & ~31) + perm32(R & 31)) : R; voffB[i] = (unsigned)(Rb * K * EB + C * 2); }
#define PG8_AOFF(dst, unit) do { int l_ = (int)__builtin_amdgcn_mbcnt_hi(~0u, __builtin_amdgcn_mbcnt_lo(~0u, 0u)); asm volatile("" : "+v"(l_)); const int tid_ = wid * 64 + l_; _Pragma("unroll") for (int h = 0; h < 2; ++h) _Pragma("unroll") for (int i = 0; i < 2; ++i) { int R_, C_; stage_rc(tid_ * 16 + i * 8192, R_, C_); \
        dst[h][i] = (unsigned)S.a_row(unit, h * HALF + R_) * (unsigned)(K * EB) + (unsigned)(C_ * 2) + (unsigned)S.kwin(unit); } } while (0)
    const size_t kstep = 128;
    const size_t hstep = (size_t)HALF * K * EB;
    const unsigned ldsw = (unsigned)wid * 1024u;
    const int aoff = lds_byte(wr * 64 + fr, fq * 8), boff = lds_byte(wc * 32 + fr, fq * 8);
    Unit cur, nxt; int ui = 0;
#ifdef PROBE_FAKEK
    bool stage_on = true;
#endif
    if (!S.next(0, cur)) return;
#ifdef PROBE_FAKEK
#define PG8_UIX(i) (((PROBE_FAKEK >> (EB == 1 ? 0 : 1)) & 1) ? (i) >> 1 : (i))
#else
#define PG8_UIX(i) (i)
#endif
    f32x4 acc[2][NBJ][4][2];
#pragma unroll
    for (int a = 0; a < 2; ++a)
#pragma unroll
        for (int b = 0; b < NBJ; ++b)
#pragma unroll
            for (int m = 0; m < 4; ++m)
#pragma unroll
                for (int n = 0; n < 2; ++n) acc[a][b][m][n] = (f32x4){0.f, 0.f, 0.f, 0.f};
    f32x16 accT[2][NBJ][2];
#pragma unroll
    for (int a = 0; a < 2; ++a)
#pragma unroll
        for (int b = 0; b < NBJ; ++b)
#pragma unroll
            for (int m = 0; m < 2; ++m)
#pragma unroll
                for (int j = 0; j < 16; ++j) accT[a][b][m][j] = 0.f;
    bf16x8 At[4][2], B0[2][2], B1[2][2];
    v8i32 At8[4], B08[2], B18[2];
    unsigned offc[2][2], offn[2][2];
    PG8_AOFF(offc, cur);
    const char* cB = S.b_ptr(cur);
    PG8_STAGE(PG8_SB(0, 0), cB, voffB); if constexpr (NBJ == 2) PG8_STAGE(PG8_SB(0, 1), cB + hstep, voffB); PG8_STAGE(PG8_SA(0, 0), Abase, offc[0]); PG8_STAGE(PG8_SA(0, 1), Abase, offc[1]);
    if (wr == 1) PG8_BAR;
    PG8_WAIT_V(2); PG8_BAR;
    PG8_STAGE(PG8_SB(1, 0), cB + kstep, voffB); PG8_STAGE(PG8_SA(1, 0), Abase + kstep, offc[0]); if constexpr (NBJ == 2) PG8_STAGE(PG8_SB(1, 1), cB + hstep + kstep, voffB);
    if constexpr (NBJ == 2) PG8_WAIT_V(6); else PG8_WAIT_V(4);
    PG8_BAR;
    for (;;) {
        const bool has_next = S.next(PG8_UIX(ui + 1), nxt);
        const char* nB = cB;
        if (has_next) {
            nB = S.b_ptr(nxt);
            PG8_AOFF(offn, nxt);
        } else {
#pragma unroll
            for (int h = 0; h < 2; ++h)
#pragma unroll
                for (int i = 0; i < 2; ++i) offn[h][i] = offc[h][i];
        }
#pragma unroll 1
        for (int t = 0; t < nt; t += 2) {
            const bool last = (t == nt - 2);
#ifdef PROBE_FAKEK
            stage_on = !((PROBE_FAKEK >> (EB == 1 ? 0 : 1)) & 1) || !(ui & 1) || last;
#endif
            const char* kp1 = Abase + (size_t)(t + 1) * kstep;
            const char* kp2 = last ? Abase : Abase + (size_t)(t + 2) * kstep; const char* b2 = last ? nB : cB + (size_t)(t + 2) * kstep;
            const char* kp3 = kp2 + kstep; const char* b3 = b2 + kstep;
            unsigned o2[2][2];
#pragma unroll
            for (int h = 0; h < 2; ++h)
#pragma unroll
                for (int i = 0; i < 2; ++i) o2[h][i] = last ? offn[h][i] : offc[h][i];
            PG8_LDB(B0, 0, 0); if constexpr (NBJ == 2) PG8_LDB(B1, 0, 1); PG8_SCHED; PG8_LDA(At, 0, 0); PG8_STAGE(PG8_SA(1, 1), kp1, offc[1]);
            PG8_WAIT_K; PG8_WAIT_L(0); PG8_BAR; PG8_MMA(0, 0, At, B0); if constexpr (NBJ == 2) PG8_MMA(0, 1, At, B1); PG8_BAR; PG8_SCHED;
            PG8_LDA(At, 0, 1); PG8_STAGE(PG8_SB(0, 0), b2, voffB); if constexpr (NBJ == 2) PG8_STAGE(PG8_SB(0, 1), b2 + hstep, voffB); PG8_STAGE(PG8_SA(0, 0), kp2, o2[0]);
            PG8_WAIT_K; PG8_WAIT_L(0); PG8_BAR; PG8_MMA(1, 0, At, B0); if constexpr (NBJ == 2) PG8_MMA(1, 1, At, B1); PG8_BAR; PG8_SCHED;
            PG8_LDB(B0, 1, 0); if constexpr (NBJ == 2) PG8_LDB(B1, 1, 1); PG8_SCHED; PG8_LDA(At, 1, 0); PG8_STAGE(PG8_SA(0, 1), kp2, o2[1]);
            PG8_WAIT_K; PG8_WAIT_L(0); PG8_BAR; PG8_MMA(0, 0, At, B0); if constexpr (NBJ == 2) PG8_MMA(0, 1, At, B1); PG8_BAR; PG8_SCHED;
            PG8_LDA(At, 1, 1); PG8_STAGE(PG8_SB(1, 0), b3, voffB); if constexpr (NBJ == 2) PG8_STAGE(PG8_SB(1, 1), b3 + hstep, voffB); PG8_STAGE(PG8_SA(1, 0), kp3, o2[0]);
            PG8_WAIT_K; PG8_WAIT_L(0); PG8_BAR; PG8_MMA(1, 0, At, B0); if constexpr (NBJ == 2) PG8_MMA(1, 1, At, B1); PG8_BAR; PG8_SCHED;
        }
        if constexpr (ALIGN_EPI) { if (wr == 0) PG8_BAR; }
        if constexpr (ACC16) {
#pragma unroll
            for (int a = 0; a < 2; ++a)
#pragma unroll
                for (int b = 0; b < NBJ; ++b)
#pragma unroll
                    for (int m = 0; m < 4; ++m)
#pragma unroll
                        for (int n = 0; n < 2; ++n) acc[a][b][m][n] = get4(accT[a][b][m >> 1], (m & 1) * 2 + n);
        }
#ifdef PROBE_FAKEK
        if (!(((PROBE_FAKEK >> (EB == 1 ? 0 : 1)) & 1) && (ui & 1)))
#endif
        { int l2 = (int)__builtin_amdgcn_mbcnt_hi(~0u, __builtin_amdgcn_mbcnt_lo(~0u, 0u)); asm volatile("" : "+v"(l2)); E(acc, cur, wr, wc, l2 & 15, l2 >> 4); }
#ifdef PROBE_EPI2
        if constexpr (((PROBE_EPI2 >> (EB == 1 ? 0 : 1)) & 1) != 0) { int l2 = (int)__builtin_amdgcn_mbcnt_hi(~0u, __builtin_amdgcn_mbcnt_lo(~0u, 0u)); asm volatile("" : "+v"(l2)); E(acc, cur, wr, wc, l2 & 15, l2 >> 4); }
#endif
        if (!has_next) break;
#pragma unroll
        for (int a = 0; a < 2; ++a)
#pragma unroll
            for (int b = 0; b < NBJ; ++b)
#pragma unroll
                for (int m = 0; m < 4; ++m)
#pragma unroll
                    for (int n = 0; n < 2; ++n) acc[a][b][m][n] = (f32x4){0.f, 0.f, 0.f, 0.f};
#pragma unroll
        for (int a = 0; a < 2; ++a)
#pragma unroll
            for (int b = 0; b < NBJ; ++b)
#pragma unroll
                for (int m = 0; m < 2; ++m)
#pragma unroll
                    for (int j = 0; j < 16; ++j) accT[a][b][m][j] = 0.f;
        cur = nxt; cB = nB; ++ui;
#pragma unroll
        for (int h = 0; h < 2; ++h)
#pragma unroll
            for (int i = 0; i < 2; ++i) offc[h][i] = offn[h][i];
        if constexpr (ALIGN_EPI) { if (wr == 1) PG8_BAR; }
    }
    PG8_WAIT_V(0);
    if constexpr (!ALIGN_EPI) { if (wr == 0) PG8_BAR; }
    PG8_BAR;
}
#undef PG8_AOFF
#undef PG8_SA
#undef PG8_SB
#undef PG8_STAGE
#undef PG8_LDA
#undef PG8_LDB
#undef PG8_MMA
#undef PG8_WAIT_V
#undef PG8_WAIT_L
#undef PG8_WAIT_K
#undef PG8_BAR
#undef PG8_SCHED
}

struct EpiStore {
    static constexpr bool PERM = true;
    bf16_t* out; int ld;
    __device__ __forceinline__ void operator()(const f32x4 (&acc)[2][2][4][2], const pg8::Unit& u, int wr, int wc, int fr, int fq) const {
        const int row0 = u.pm * 256 + wr * 64 + fr, col0 = u.pn * 256 + wc * 32 + 8 * fq;
#pragma unroll
        for (int ai = 0; ai < 2; ++ai)
#pragma unroll
            for (int m = 0; m < 4; ++m) { bf16_t* rowp = out + (size_t)(row0 + ai * 128 + m * 16) * ld + col0;
#pragma unroll
                for (int bj = 0; bj < 2; ++bj) { const f32x4 v0 = acc[ai][bj][m][0], v1 = acc[ai][bj][m][1];
                    u32x4 w; w.x = pk2bf(v0[0], v0[1]); w.y = pk2bf(v0[2], v0[3]); w.z = pk2bf(v1[0], v1[1]); w.w = pk2bf(v1[2], v1[3]);
                    *(u32x4*)(rowp + bj * 128) = w; } }
    }
};
template <bool XIN_F32>
struct EpiResidB {
    static constexpr bool PERM = true;
    const float* xin_f; bf16_t* xs; const float* modl; int g_off;
    __device__ __forceinline__ void operator()(const f32x4 (&acc)[2][2][4][2], const pg8::Unit& u, int wr, int wc, int fr, int fq) const {
        const int row0 = u.pm * 256 + wr * 64 + fr;
        const float* gp = modl + ((u.pm * 256) / SEQ) * NMOD + g_off;
#pragma unroll
        for (int bj = 0; bj < 2; ++bj) {
            const int c = u.pn * 256 + bj * 128 + wc * 32 + 8 * fq;
            const f32x4 g0 = *(const f32x4*)(gp + c), g1 = *(const f32x4*)(gp + c + 4);
#pragma unroll
            for (int ai = 0; ai < 2; ++ai)
#pragma unroll
                for (int m = 0; m < 4; ++m) {
                    const size_t o = (size_t)(row0 + ai * 128 + m * 16) * DM + c;
                    f32x4 x0, x1;
                    if (XIN_F32) { x0 = *(const f32x4*)(xin_f + o); x1 = *(const f32x4*)(xin_f + o + 4); }
                    else { const u32x4 w = *(const u32x4*)(xs + o);
                        x0 = (f32x4){bf2f((bf16_t)(w.x & 0xffff)), bf2f((bf16_t)(w.x >> 16)), bf2f((bf16_t)(w.y & 0xffff)), bf2f((bf16_t)(w.y >> 16))};
                        x1 = (f32x4){bf2f((bf16_t)(w.z & 0xffff)), bf2f((bf16_t)(w.z >> 16)), bf2f((bf16_t)(w.w & 0xffff)), bf2f((bf16_t)(w.w >> 16))}; }
                    const f32x4 y0 = x0 + g0 * acc[ai][bj][m][0], y1 = x1 + g1 * acc[ai][bj][m][1];
                    u32x4 w; w.x = pk2bf(y0[0], y0[1]); w.y = pk2bf(y0[2], y0[3]); w.z = pk2bf(y1[0], y1[1]); w.w = pk2bf(y1[2], y1[3]);
                    *(u32x4*)(xs + o) = w;
                }
        }
    }
};

#ifndef MOE_NBJ
#define MOE_NBJ 2
#endif
constexpr int MNB = MOE_NBJ, GU_NPN = 16 / MNB, DN_NPN = 8 / MNB;
struct SchedMoeGU {
    static constexpr int EB = 1, NBJ = MNB, WSCALE = 0x7A7A7A7A, ASCALE = 0x7F7F7F7F;
    const int* sidx; const char* Wgu; int G, v, nunits;
    __device__ __forceinline__ void init(const int* sidx_, const bf16_t* Wgu_layer, int G_, int c_, bool has_ctx) { sidx = sidx_; Wgu = (const char*)Wgu_layer; G = G_; v = (G_ % 8 == 0) ? (c_ % 8) * (G_ / 8) + c_ / 8 : c_; nunits = 32 * 8 * GU_NPN + (has_ctx ? 32 * GU_NPN : 0); }
    __device__ __forceinline__ bool next(int i, pg8::Unit& u) const {
        const int U = i * G + v; if (U >= nunits) return false;
        if (U < 32 * 8 * GU_NPN) { u.grp = U / (8 * GU_NPN); u.pm = (U % (8 * GU_NPN)) / GU_NPN; u.pn = U % GU_NPN; } else { const int w = U - 32 * 8 * GU_NPN; u.grp = 32 + w / GU_NPN; u.pm = 0; u.pn = w % GU_NPN; }
        return true; }
    __device__ __forceinline__ int a_row(const pg8::Unit& u, int r) const {
        if (u.grp < 32) return (u.grp >> 4) * SEQ + sidx[u.grp * CAP_L + u.pm * 256 + r];
        const int gc = u.grp - 32; return r < CAP_C ? NLAT + (gc >> 4) * CTX + sidx[32 * CAP_L + gc * CAP_C + r] : 0; }
    __device__ __forceinline__ const char* b_ptr(const pg8::Unit& u) const { return Wgu + ((size_t)(u.grp & 15) * 2048 + (size_t)u.pn * (128 * MNB)) * DM; }
    static constexpr int NT_FIXED = 0;
    __device__ __forceinline__ int kwin(const pg8::Unit&) const { return 0; }
};
struct EpiHidMk {
    static constexpr bool PERM = true;
    bf16_t* hid;
    __device__ __forceinline__ void operator()(const f32x4 (&acc)[2][MNB][4][2], const pg8::Unit& u, int wr, int wc, int fr, int fq) const {
        const bool isctx = u.grp >= 32;
        const size_t rbase = isctx ? (size_t)32 * CAP_L + (size_t)(u.grp - 32) * CAP_C : (size_t)u.grp * CAP_L + u.pm * 256;
        const int r0 = wr * 64 + fr + fq * 16, c0 = (u.pn * (128 * MNB) + wc * 32) >> 1;
#pragma unroll
        for (int ai = 0; ai < 2; ++ai)
#pragma unroll
            for (int bj = 0; bj < MNB; ++bj) {
                unsigned w[4];
#pragma unroll
                for (int m = 0; m < 4; ++m) { const f32x4 v0 = acc[ai][bj][m][0], v1 = acc[ai][bj][m][1];
                    w[m] = pk4fp8(silu_f(v0[0]) * v0[1], silu_f(v0[2]) * v0[3], silu_f(v1[0]) * v1[1], silu_f(v1[2]) * v1[3]); }
                { auto t = __builtin_amdgcn_permlane32_swap(w[0], w[2], false, false); w[0] = t[0]; w[2] = t[1]; }
                { auto t = __builtin_amdgcn_permlane32_swap(w[1], w[3], false, false); w[1] = t[0]; w[3] = t[1]; }
                { auto t = __builtin_amdgcn_permlane16_swap(w[0], w[1], false, false); w[0] = t[0]; w[1] = t[1]; }
                { auto t = __builtin_amdgcn_permlane16_swap(w[2], w[3], false, false); w[2] = t[0]; w[3] = t[1]; }
                const int r = r0 + ai * 128; if (isctx && r >= CAP_C) continue;
                u32x4 o; o.x = w[0]; o.y = w[1]; o.z = w[2]; o.w = w[3];
                *(u32x4*)((unsigned char*)hid + (rbase + r) * DFF + c0 + bj * 64) = o; }
    }
};
struct SchedMoeDown {
    static constexpr int EB = 1, NBJ = MNB, WSCALE = 0x7A7A7A7A, ASCALE = 0x7F7F7F7F;
    const char* Wd; int G, v, nunits;
    __device__ __forceinline__ void init(const bf16_t* Wd_layer, int G_, int c_, bool has_ctx) { Wd = (const char*)Wd_layer; G = G_; v = (G_ % 8 == 0) ? (c_ % 8) * (G_ / 8) + c_ / 8 : c_; nunits = 32 * 8 * DN_NPN + (has_ctx ? 32 * DN_NPN : 0); }
    __device__ __forceinline__ bool next(int i, pg8::Unit& u) const {
        const int U = i * G + v; if (U >= nunits) return false;
        if (U < 32 * 8 * DN_NPN) { u.grp = U / (8 * DN_NPN); u.pm = (U % (8 * DN_NPN)) / DN_NPN; u.pn = U % DN_NPN; } else { const int w = U - 32 * 8 * DN_NPN; u.grp = 32 + w / DN_NPN; u.pm = 0; u.pn = w % DN_NPN; }
        return true; }
    __device__ __forceinline__ int a_row(const pg8::Unit& u, int r) const { return u.grp < 32 ? u.grp * CAP_L + u.pm * 256 + r : 32 * CAP_L + (u.grp - 32) * CAP_C + r; }
    __device__ __forceinline__ const char* b_ptr(const pg8::Unit& u) const { return Wd + ((size_t)(u.grp & 15) * 1024 + (size_t)u.pn * (128 * MNB)) * DFF; }
    static constexpr int NT_FIXED = 0;
    __device__ __forceinline__ int kwin(const pg8::Unit&) const { return 0; }
};
struct EpiYeMk {
    static constexpr bool PERM = true;
    bf16_t* ye; const float* sg;
    __device__ __forceinline__ void operator()(const f32x4 (&acc)[2][MNB][4][2], const pg8::Unit& u, int wr, int wc, int fr, int fq) const {
        const bool isctx = u.grp >= 32;
        const size_t rbase = isctx ? (size_t)32 * CAP_L + (size_t)(u.grp - 32) * CAP_C : (size_t)u.grp * CAP_L + u.pm * 256;
        const int r0 = wr * 64 + fr, c0 = u.pn * (128 * MNB) + wc * 32 + 8 * fq;
#pragma unroll
        for (int ai = 0; ai < 2; ++ai)
#pragma unroll
            for (int m = 0; m < 4; ++m) { const int r = r0 + ai * 128 + m * 16; if (isctx && r >= CAP_C) continue;
                const float g = sg[rbase + r];
#pragma unroll
              for (int bj = 0; bj < MNB; ++bj) {
                const f32x4 v0 = acc[ai][bj][m][0] * g, v1 = acc[ai][bj][m][1] * g;
                u32x4 w; w.x = pk2bf(v0[0], v0[1]); w.y = pk2bf(v0[2], v0[3]); w.z = pk2bf(v1[0], v1[1]); w.w = pk2bf(v1[2], v1[3]);
                *(u32x4*)(ye + (rbase + r) * DM + c0 + bj * 128) = w; } }
    }
};

struct Frame {
    LAS unsigned char* lds; int tid, lane, wave, G, bid;
};
__device__ __forceinline__ Params lds_params(const Frame& F) {
    Params P;
    const LAS unsigned* t = (const LAS unsigned*)(F.lds + LDS_MISC + 64);
#pragma unroll
    for (int i = 0; i < 26; ++i) {
        const unsigned lo = (unsigned)__builtin_amdgcn_readfirstlane((int)t[2 * i]), hi = (unsigned)__builtin_amdgcn_readfirstlane((int)t[2 * i + 1]);
        const unsigned long long v = ((unsigned long long)hi << 32) | lo;
        if (i < 24) P.in[i] = (const float*)(const __attribute__((address_space(1))) float*)v; else if (i == 24) P.out = (float*)(__attribute__((address_space(1))) float*)v; else P.ws = (unsigned char*)(__attribute__((address_space(1))) unsigned char*)v;
    }
    P.ph_lo = 0; P.ph_hi = 0;
    return P;
}
enum { MAP_PLAIN = 0, MAP_GU = 1, MAP_QPERM = 2, MAP_SWAPERM = 3 };
struct CvtJob { const float* s0; const float* s1; bf16_t* dst; int ld_src, Ksrc, koff, nvalid, mode, ld_dst, ntr, ntk; float scale; int scale_rows; int fp8; };
__device__ __forceinline__ void cvt_load(const CvtJob& J, int tile, float (&v)[16]) {
    const int tr = tile % J.ntr, tk = tile / J.ntr, r0 = tr * 64, k0 = tk * 128, tid = my_tid();
    if (J.fp8 == 1) {
      const int g4 = tid & 15, kq = tid >> 4; const bool gu = J.mode == MAP_GU;
      const float* s4 = (gu && (tr & 1)) ? J.s1 : J.s0; const int colb = gu ? (tr >> 1) * 64 + g4 * 4 : r0 + g4 * 4;
#pragma unroll
      for (int j = 0; j < 4; ++j) { const f32x4 t4 = *(const f32x4*)(s4 + (size_t)(k0 + 4 * kq + j) * J.ld_src + colb);     v[4 * j] = t4[0]; v[4 * j + 1] = t4[1]; v[4 * j + 2] = t4[2]; v[4 * j + 3] = t4[3]; }
      return; }
    const int rr = tid & 63, r = r0 + rr;
    const float* s = J.s0; int col = r;
    if (J.mode == MAP_GU) { s = (r & 1) ? J.s1 : J.s0; col = r >> 1; }
    else if (J.mode == MAP_QPERM) { const int h = r / 96, dd = r % 96; if (dd >= 64) { const int q = dd - 64, p = q >> 1; col = h * 96 + 64 + (p >> 3) * 16 + (q & 1) * 8 + (p & 7); } }
    else if (J.mode == MAP_SWAPERM) { if (r < 1280) { const int hh = r >> 6, dd = r & 63, p = dd >> 1; col = hh * 64 + (p >> 4) * 32 + (dd & 1) * 16 + (p & 15); } }
#pragma unroll
    for (int j = 0; j < 16; ++j) {
        const int kk = (tid >> 6) + 8 * j, ks = k0 + kk - J.koff;
        v[j] = (r < J.nvalid && ks >= 0 && ks < J.Ksrc) ? s[(size_t)ks * J.ld_src + col] : 0.f;
    }
}
__device__ __forceinline__ void cvt_store(const CvtJob& J, int tile, const float (&v)[16], LAS float* scr) {
    const int tr = tile % J.ntr, tk = tile / J.ntr, r0 = tr * 64, k0 = tk * 128, tid = my_tid();
    const int rr = tid & 63, r = r0 + rr;
    const float sc = ((r < J.scale_rows) ? J.scale : 1.f) * (J.fp8 == 2 ? 32.f : 1.f);
    if (J.fp8 == 1) {
      const int g4 = tid & 15, kq = tid >> 4; LAS unsigned* s8 = (LAS unsigned*)scr;
#pragma unroll
      for (int i = 0; i < 4; ++i) s8[(g4 * 4 + i) * 33 + kq] = pk4fp8(v[i] * J.scale, v[4 + i] * J.scale, v[8 + i] * J.scale, v[12 + i] * J.scale);
      __syncthreads();
      const int r2 = tid >> 3, kc4 = (tid & 7) * 4; const LAS unsigned* sp8 = s8 + r2 * 33 + kc4;
      u32x4 w; w.x = sp8[0]; w.y = sp8[1]; w.z = sp8[2]; w.w = sp8[3];
      const int drow = (J.mode == MAP_GU) ? 2 * ((tr >> 1) * 64 + r2) + (tr & 1) : r0 + r2;
      *(u32x4*)((unsigned char*)J.dst + (size_t)drow * J.ld_dst + k0 + kc4 * 4) = w;
      return; }
    {
#pragma unroll
    for (int j = 0; j < 16; ++j) scr[((tid >> 6) + 8 * j) * 65 + rr] = v[j] * sc; }
    __syncthreads();
    if (J.fp8) { const int r2 = tid >> 3, kc = (tid & 7) * 16; const LAS float* sp = scr + kc * 65 + r2;
      u32x4 w; w.x = pk4fp8(sp[0], sp[65], sp[2 * 65], sp[3 * 65]); w.y = pk4fp8(sp[4 * 65], sp[5 * 65], sp[6 * 65], sp[7 * 65]);
      w.z = pk4fp8(sp[8 * 65], sp[9 * 65], sp[10 * 65], sp[11 * 65]); w.w = pk4fp8(sp[12 * 65], sp[13 * 65], sp[14 * 65], sp[15 * 65]);
      const int drow = (J.fp8 == 1 && J.mode == MAP_GU) ? 2 * ((tr >> 1) * 64 + r2) + (tr & 1) : r0 + r2;
      *(u32x4*)((unsigned char*)J.dst + (size_t)drow * J.ld_dst + k0 + kc) = w; }
    else { const int r2 = tid >> 3, kc = (tid & 7) * 8; const LAS float* sp = scr + kc * 65 + r2; const LAS float* sq = sp + 64 * 65;
      u32x4 w0, w1;
      w0.x = pk2bf(sp[0], sp[65]); w0.y = pk2bf(sp[2 * 65], sp[3 * 65]); w0.z = pk2bf(sp[4 * 65], sp[5 * 65]); w0.w = pk2bf(sp[6 * 65], sp[7 * 65]);
      w1.x = pk2bf(sq[0], sq[65]); w1.y = pk2bf(sq[2 * 65], sq[3 * 65]); w1.z = pk2bf(sq[4 * 65], sq[5 * 65]); w1.w = pk2bf(sq[6 * 65], sq[7 * 65]);
      bf16_t* d = J.dst + (size_t)(r0 + r2) * J.ld_dst + k0 + kc;
      *(u32x4*)d = w0; *(u32x4*)(d + 64) = w1; }
}
constexpr int CVT_DENSE = 256 + 128 + 192 + 48 + 64 + 128 + 192, CVT_MOE = 16 * 384;
__device__ __forceinline__ void cvt_job(const Params& P, int g, CvtJob& J, int& tile) {
    unsigned char* W = P.ws + WS_W;
    if (g < 256) { J = CvtJob{P.in[8], nullptr, (bf16_t*)(W + OFF_WIN), AB_IN, DM, 0, AB_IN, MAP_PLAIN, DM, 32, 8, 1.f, 0, 0}; tile = g; return; } g -= 256;
    if (g < 128) { J = CvtJob{P.in[15], nullptr, (bf16_t*)(W + OFF_WOUT), DM, DM, 0, DM, MAP_PLAIN, DM, 16, 8, 1.f, 0, 0}; tile = g; return; } g -= 128;
    if (g < 192) { J = CvtJob{P.in[16], nullptr, (bf16_t*)(W + OFF_WQKV), 1536, DM, 0, 1536, MAP_SWAPERM, DM, 24, 8, 0.125f * LOG2E, 1024, 0}; tile = g; return; } g -= 192;
    if (g < 48) { J = CvtJob{P.in[12], nullptr, (bf16_t*)(W + OFF_WUP), 768, 256, 0, 768, MAP_QPERM, 512, 12, 4, 0.10206207261596575f * LOG2E * QF8_SCALE, 768, 2}; tile = g; return; } g -= 48;
    if (g < 64) { J = CvtJob{P.in[14], nullptr, (bf16_t*)((unsigned char*)(W + OFF_WUP) + (size_t)768 * 512), 1024, 128, 256, 1024, MAP_PLAIN, 512, 16, 4, 1.f, 0, 2}; tile = g; return; } g -= 64;
    if (g < 128) { J = CvtJob{P.in[18], nullptr, (bf16_t*)(W + OFF_WSO), DM, DM, 0, DM, MAP_PLAIN, DM, 16, 8, 1.f, 0, 2}; tile = g; return; } g -= 128;
    J = CvtJob{P.in[16], nullptr, (bf16_t*)(W + OFF_WQKV8), 1536, DM, 0, 1536, MAP_SWAPERM, DM, 24, 8, 0.125f * LOG2E * QF8_SCALE, 1024, 2}; tile = g;
}
__device__ __forceinline__ void cvt_job_moe(const Params& P, int layer, int g, CvtJob& J, int& tile) {
    unsigned char* W = P.ws + WS_W;
    const int e = g / 384, r = g % 384, le = layer * 16 + e;
    if (r < 256) { J = CvtJob{P.in[20] + (size_t)le * DM * DFF, P.in[21] + (size_t)le * DM * DFF, (bf16_t*)(W + OFF_WGU + (size_t)e * 2048 * DM), DFF, DM, 0, 2048, MAP_GU, DM, 32, 8, 32.f, 1 << 30, 1}; tile = r; }
    else { J = CvtJob{P.in[22] + (size_t)le * DFF * DM, nullptr, (bf16_t*)(W + OFF_WD + (size_t)e * 1024 * DFF), DM, DFF, 0, DM, MAP_PLAIN, DFF, 16, 8, 32.f, 1 << 30, 1}; tile = r - 256; }
}
constexpr int CVT_MOE_BIG = 16 * 96;
struct CvtBig { const float* src; unsigned char* dst; int ld_src, ld_dst, colb, k0, drow0, dstep; };
__device__ __forceinline__ CvtBig cvt_big_job(const Params& P, int layer, int g) {
    unsigned char* W = P.ws + WS_W; const int e = g / 96, r = g % 96, le = layer * 16 + e; CvtBig J;
    if (r < 64) { const int tr = r % 16, tk = r / 16, par = tr & 1, cb = tr >> 1;
      J.src = (par ? P.in[21] : P.in[20]) + (size_t)le * DM * DFF; J.dst = (layer ? P.ws + WS_W2 : W + OFF_WGU) + (size_t)e * 2048 * DM; J.ld_src = DFF; J.ld_dst = DM; J.colb = cb * 128; J.k0 = tk * 256; J.drow0 = 2 * cb * 128 + par; J.dstep = 2; }
    else { const int t = r - 64, tr = t % 8, tk = t / 8;
      J.src = P.in[22] + (size_t)le * DFF * DM; J.dst = (layer ? P.ws + WS_W2 + W2_WD : W + OFF_WD) + (size_t)e * 1024 * DFF; J.ld_src = DM; J.ld_dst = DFF; J.colb = tr * 128; J.k0 = tk * 256; J.drow0 = tr * 128; J.dstep = 1; }
    return J;
}
__device__ __forceinline__ void cvt_big_load(const CvtBig& J, f32x4 (&v)[16]) {
    const int tid = my_tid(), g = tid & 31, kq = tid >> 5; const float* s = J.src + (size_t)(J.k0 + 16 * kq) * J.ld_src + J.colb + 4 * g;
#pragma unroll
    for (int jj = 0; jj < 16; ++jj) v[jj] = *(const f32x4*)(s + (size_t)jj * J.ld_src);
}
__device__ __forceinline__ void cvt_big_store(const CvtBig& J, const f32x4 (&v)[16], LAS unsigned* scr) {
    const int tid = my_tid(), g = tid & 31, kq = tid >> 5;
#pragma unroll
    for (int i = 0; i < 4; ++i)
#pragma unroll
      for (int q = 0; q < 4; ++q) scr[(4 * g + i) * 65 + 4 * kq + q] = pk4fp8(v[4 * q][i] * 32.f, v[4 * q + 1][i] * 32.f, v[4 * q + 2][i] * 32.f, v[4 * q + 3][i] * 32.f);
    __syncthreads();
#pragma unroll
    for (int ps = 0; ps < 4; ++ps) { const int lr = ps * 32 + (tid >> 4), ch = tid & 15; const LAS unsigned* sp = scr + lr * 65 + 4 * ch;
      u32x4 w; w.x = sp[0]; w.y = sp[1]; w.z = sp[2]; w.w = sp[3];
      *(u32x4*)(J.dst + (size_t)(J.drow0 + J.dstep * lr) * J.ld_dst + J.k0 + 16 * ch) = w; }
}
__device__ __forceinline__ void cvt_run_big(const Params& P, LAS unsigned* scr, int layer, int first, int step) {
    int g = first, par = 0; bool have = g < CVT_MOE_BIG; CvtBig Jc{}; f32x4 vc[16];
    if (have) { Jc = cvt_big_job(P, layer, g); cvt_big_load(Jc, vc); }
    while (have) {
        const int gn = g + step; const bool hn = gn < CVT_MOE_BIG; CvtBig Jn{}; f32x4 vn[16];
        if (hn) { Jn = cvt_big_job(P, layer, gn); cvt_big_load(Jn, vn); }
        cvt_big_store(Jc, vc, scr + par * (128 * 65)); par ^= 1;
        Jc = Jn; g = gn; have = hn;
#pragma unroll
        for (int j = 0; j < 16; ++j) vc[j] = vn[j];
    }
}
__device__ __forceinline__ void cvt_run_big2(const Params& P, LAS unsigned* scr, int first, int step) {
    int g = first, par = 0; bool have = g < 2 * CVT_MOE_BIG; CvtBig Jc{}; f32x4 vc[16];
    if (have) { Jc = cvt_big_job(P, g / CVT_MOE_BIG, g % CVT_MOE_BIG); cvt_big_load(Jc, vc); }
    while (have) {
        const int gn = g + step; const bool hn = gn < 2 * CVT_MOE_BIG; CvtBig Jn{}; f32x4 vn[16];
        if (hn) { Jn = cvt_big_job(P, gn / CVT_MOE_BIG, gn % CVT_MOE_BIG); cvt_big_load(Jn, vn); }
        cvt_big_store(Jc, vc, scr + par * (128 * 65)); par ^= 1;
        Jc = Jn; g = gn; have = hn;
#pragma unroll
        for (int j = 0; j < 16; ++j) vc[j] = vn[j];
    }
}
template <class Map>
__device__ __forceinline__ void cvt_run_list(const Params& P, LAS unsigned* scr, int first, int step, int n, const Map map) {
    int j = first, par = 0; bool have = j < n; CvtBig Jc{}; f32x4 vc[16];
    if (have) { const int g = map(j); Jc = cvt_big_job(P, g / CVT_MOE_BIG, g % CVT_MOE_BIG); cvt_big_load(Jc, vc); }
    while (have) {
        const int jn = j + step; const bool hn = jn < n; CvtBig Jn{}; f32x4 vn[16];
        if (hn) { const int g = map(jn); Jn = cvt_big_job(P, g / CVT_MOE_BIG, g % CVT_MOE_BIG); cvt_big_load(Jn, vn); }
        cvt_big_store(Jc, vc, scr + par * (128 * 65)); par ^= 1;
        Jc = Jn; j = jn; have = hn;
#pragma unroll
        for (int q = 0; q < 16; ++q) vc[q] = vn[q];
    }
}
struct CvtMapAttn { int c; __device__ __forceinline__ int operator()(int j) const { return c + 256 * (j + (j >> 1)); } };
struct CvtMapRest { int k0; __device__ __forceinline__ int operator()(int j) const { return (j & 255) + 256 * (k0 + 3 * (j >> 8)); } };
__device__ __forceinline__ void cvt_attn_share(const Params& P, LAS unsigned* scr, int bid, int G) {
    if (G == 256) cvt_run_list(P, scr, 0, 1, 8, CvtMapAttn{bid}); else cvt_run_big2(P, scr, bid, G);
}
template <bool MOE>
__device__ __forceinline__ void cvt_run(const Params& P, LAS float* scr, int layer, int first, int step, int total) {
    int g = first, par = 0; CvtJob Jc{}; int tc = 0; float vc[16];
    bool have = g < total;
    if (have) { if (MOE) cvt_job_moe(P, layer, g, Jc, tc); else cvt_job(P, g, Jc, tc); cvt_load(Jc, tc, vc); }
    while (have) {
        const int gn = g + step; const bool hn = gn < total; CvtJob Jn{}; int tn = 0; float vn[16];
        if (hn) { if (MOE) cvt_job_moe(P, layer, gn, Jn, tn); else cvt_job(P, gn, Jn, tn); cvt_load(Jn, tn, vn); }
        cvt_store(Jc, tc, vc, scr + par * (128 * 65)); par ^= 1;
        Jc = Jn; tc = tn; g = gn; have = hn;
#pragma unroll
        for (int j = 0; j < 16; ++j) vc[j] = vn[j];
    }
}

__device__ __forceinline__ void phase_prologue(Frame& F) {
  const Params P = lds_params(F);
    LAS float* scr = (LAS float*)F.lds;
    cvt_run<false>(P, scr, 0, F.bid, F.G, CVT_DENSE);
    {
        LAS float* sv = (LAS float*)(F.lds + 32768);
        LAS float* red = (LAS float*)(F.lds + 32768 + 12288);
        const float* c = P.in[1]; const float* c_ctx = P.in[3]; const float* mod_w = P.in[4]; const float* mod_b = P.in[5];
        float* modv = (float*)(P.ws + WS_MODV);
        __syncthreads();
        for (int i = F.tid; i < DM; i += NTHREADS) { sv[i] = silu_f(c[i]); sv[DM + i] = silu_f(c[DM + i]); sv[2 * DM + i] = silu_f(c_ctx[i]); }
        __syncthreads();
        for (int ch = F.bid; ch < 256; ch += F.G) {
            const int jg = ch * 48, l = jg / NMOD, j0 = jg % NMOD, rg = F.tid >> 4, ct = F.tid & 15;
            const float* w = mod_w + (size_t)l * DM * NMOD + j0 + 3 * ct;
            float a[3][3];
#pragma unroll
            for (int x = 0; x < 3; ++x)
#pragma unroll
                for (int y = 0; y < 3; ++y) a[x][y] = 0.f;
            for (int d = rg; d < DM; d += 32) { const float w0 = w[(size_t)d * NMOD], w1 = w[(size_t)d * NMOD + 1], w2 = w[(size_t)d * NMOD + 2];
#pragma unroll
                for (int x = 0; x < 3; ++x) { const float s = sv[x * DM + d]; a[x][0] += s * w0; a[x][1] += s * w1; a[x][2] += s * w2; } }
#pragma unroll
            for (int x = 0; x < 3; ++x)
#pragma unroll
                for (int y = 0; y < 3; ++y) red[rg * 144 + x * 48 + 3 * ct + y] = a[x][y];
            __syncthreads();
            if (F.tid < 144) { float s = 0.f; for (int r = 0; r < 32; ++r) s += red[r * 144 + F.tid]; const int x = F.tid / 48, jj = j0 + F.tid % 48; modv[(l * 3 + x) * NMOD + jj] = s + mod_b[l * NMOD + jj]; }
            __syncthreads();
        }
    }
    {
        float* tab = (float*)(P.ws + WS_ROPE);
        for (int i = F.bid * 64 + F.tid; i < 256 * 16 && F.tid < 64; i += F.G * 64) {
            if (i < 256 * 8) { const int p = i / 8, f = i % 8; const double fr = pow(10000.0, -(double)(2 * f) / 16.0); const double a = (double)p * fr; tab[i] = (float)cos(a); tab[2048 + i] = (float)sin(a); }
            { const int p = i / 16, f = i % 16; const double fr = pow(10000.0, -(double)(2 * f) / 32.0); const double a = (double)p * fr; tab[4096 + i] = (float)cos(a); tab[8192 + i] = (float)sin(a); }
        }
    }
}


namespace att {
using f32x16 = __attribute__((ext_vector_type(16))) float;
using s16x4  = __attribute__((ext_vector_type(4))) short;
__device__ __forceinline__ int crow(int r, int hi) { return (r & 3) + 8 * (r >> 2) + 4 * hi; }
__device__ __forceinline__ unsigned cvtpk(float lo, float hi) { unsigned r;
#ifdef PROBE_FP8ATT
  if (PROBE_FP8ATT & 4) { lo = fp8rt(lo, 1.f); hi = fp8rt(hi, 1.f); }
#endif
  asm volatile("v_cvt_pk_bf16_f32 %0, %1, %2" : "=v"(r) : "v"(lo), "v"(hi)); return r; }
__device__ __forceinline__ int v_rd_base(int lane) { return ((lane & 3) << 3) | (((lane >> 2) & 3) << 6) | (((lane >> 4) & 1) << 5) | (((lane >> 5) & 1) << 8); }
constexpr int v_rd_off(int d0, int ks, int half) { return d0 * 512 + ks * 2048 + half * 1024; }
template <int OFF> __device__ __forceinline__ s16x4 tr_read(int vb) {
  s16x4 r; asm volatile("ds_read_b64_tr_b16 %0, %1 offset:%2" : "=&v"(r) : "v"(vb), "i"(OFF) : "memory"); return r;
}
}


namespace att2 {
using att::f32x16; using att::s16x4; using att::crow; using att::cvtpk; using att::v_rd_base; using att::v_rd_off; using att::tr_read;
constexpr int VT = 8192, NSLOT = 4, LDS_WS = NSLOT * (12288 + VT);
#ifndef A2_PIPE
#define A2_PIPE 2
#endif
constexpr float THR = 8.f, P8_BIAS = 4.f;
#define A2_SBAR() __builtin_amdgcn_sched_barrier(0)
template <bool FAST, int ABL = 0, bool PACK = true, bool SUMS = true>
__device__ __forceinline__ void softmax_blk(f32x16& p0, f32x16& p1, float& m_reg, float& l_reg, float& alpha, bf16x8& pa0, bf16x8& pa1, bf16x8& pa2, bf16x8& pa3) {
  if (FAST) {
    float ps = 0.f;
#pragma unroll
    for (int r = 0; r < 16; ++r) { if (ABL != 1) { p0[r] = __builtin_amdgcn_exp2f(p0[r]); p1[r] = __builtin_amdgcn_exp2f(p1[r]); } }
    if (SUMS) {
    if (ABL != 1) {
#pragma unroll
    for (int r = 0; r < 16; ++r) ps += p0[r] + p1[r];
    { auto rr = __builtin_amdgcn_permlane32_swap(__float_as_uint(ps), __float_as_uint(ps), false, false);
      ps = __uint_as_float(rr[0]) + __uint_as_float(rr[1]); }
    } else ps = 1.f;
    l_reg += ps; }
    alpha = 1.f;
  } else {
  float pmax = fmaxf(p0[0], p1[0]);
#pragma unroll
  for (int r = 1; r < 16; ++r) pmax = fmaxf(fmaxf(pmax, p0[r]), p1[r]);
  { auto rr = __builtin_amdgcn_permlane32_swap(__float_as_uint(pmax), __float_as_uint(pmax), false, false);
    pmax = fmaxf(__uint_as_float(rr[0]), __uint_as_float(rr[1])); }
  float mn;
  if (__builtin_expect(__all(pmax - m_reg <= THR), 1)) { mn = m_reg; alpha = 1.f; }
  else { mn = fmaxf(m_reg, pmax); alpha = __builtin_amdgcn_exp2f(m_reg - mn); m_reg = mn; }
  float ps = 0.f;
#pragma unroll
  for (int r = 0; r < 16; ++r) { p0[r] = __builtin_amdgcn_exp2f(p0[r] - mn); p1[r] = __builtin_amdgcn_exp2f(p1[r] - mn); }
#pragma unroll
  for (int r = 0; r < 16; ++r) ps += p0[r] + p1[r];
  { auto rr = __builtin_amdgcn_permlane32_swap(__float_as_uint(ps), __float_as_uint(ps), false, false);
    ps = __uint_as_float(rr[0]) + __uint_as_float(rr[1]); }
  l_reg = l_reg * alpha + ps;
  }
#define A2_PK4(P, BASE, OUT) do { unsigned a0 = cvtpk(P[BASE + 0], P[BASE + 1]), a1 = cvtpk(P[BASE + 2], P[BASE + 3]);   \
    unsigned b0 = cvtpk(P[BASE + 4], P[BASE + 5]), b1 = cvtpk(P[BASE + 6], P[BASE + 7]);                              \
    auto r0 = __builtin_amdgcn_permlane32_swap(a0, b0, false, false); auto r1 = __builtin_amdgcn_permlane32_swap(a1, b1, false, false); \
    u32x4 w = {r0[0], r1[0], r0[1], r1[1]}; OUT = *reinterpret_cast<bf16x8*>(&w); } while (0)
  if constexpr (PACK) { A2_PK4(p0, 0, pa0); A2_PK4(p0, 8, pa1); A2_PK4(p1, 0, pa2); A2_PK4(p1, 8, pa3); }
#undef A2_PK4
}

template <bool FAST, int ABL = 0, int DK = 96, bool SWA = false, bool F8 = false>
__device__ __forceinline__ bool attn_unit(const bf16_t* __restrict__ Qb_, const int rows_valid, const char* __restrict__ Kimg, const char* __restrict__ Vimg,
                                          bf16_t* __restrict__ Ob_, const int NT, LAS unsigned char* lds, const int lt0 = 0, const int q0 = 0, const float* sinkp = nullptr) {
  constexpr bool PIPED = (A2_PIPE != 0) && F8 && FAST && ABL == 0 && DK == 96;
  constexpr bool LS2 = F8 && FAST && !PIPED && ABL == 0;
  constexpr int ND = DK / 16, KT = F8 ? DK * 64 : DK * 128, VTX = F8 ? 4096 : VT, ONESB = PIPED ? 2048 : 0, VO = KT + ONESB, SLOT = KT + ONESB + VTX;
  constexpr int QB = F8 ? 1 : 2;
  const bf16_t* Qb = Qb_; bf16_t* Ob = Ob_;
  const int tid = my_tid(), wid = __builtin_amdgcn_readfirstlane(tid >> 6), lane = tid & 63, r32 = lane & 31, hi = lane >> 5;
  LAS float* ws = (LAS float*)(lds + LDS_WS) + wid * 128;
  float mA = -1e30f, mB = -1e30f, lA = 0.f, lB = 0.f; f32x16 oA[2] = {}, oB[2] = {};
  bf16x8 qA[ND], qB[ND]; pg8::v8i32 qA8[2], qB8[2];
  int onesw = 0; f32x4 lAc2 = {0.f, 0.f, 0.f, 0.f}, lBc2 = {0.f, 0.f, 0.f, 0.f};
  if constexpr (LS2) { int lo_ = lane; asm volatile("" : "+v"(lo_)); const int j_ = lo_ & 15, kq_ = lo_ >> 4; onesw = ((j_ == 0 && !(kq_ & 1)) || (j_ == 1 && (kq_ & 1))) ? 0x38383838 : 0; asm volatile("" : "+v"(onesw)); }
  const int wrow0 = SWA ? (wid >> 2) * 64 : wid * 64;
  if (SWA) { Qb = (const bf16_t*)((const char*)Qb + (size_t)(wid & 3) * SEQ * DK * QB); Ob = (bf16_t*)((unsigned char*)Ob + (wid & 3) * 64); }
  { int ra = wrow0 + r32, rb = ra + 32; if (ra >= rows_valid) ra = 0; if (rb >= rows_valid) rb = 0;
    if constexpr (F8) { const char* pa_ = (const char*)Qb + (size_t)ra * DK; const char* pb_ = (const char*)Qb + (size_t)rb * DK;
      const pg8::v8i32 z8 = {0, 0, 0, 0, 0, 0, 0, 0};
      qA8[0] = *reinterpret_cast<const pg8::v8i32*>(pa_ + hi * 32); qB8[0] = *reinterpret_cast<const pg8::v8i32*>(pb_ + hi * 32);
      if constexpr (DK == 96) { const pg8::v8i32 ta = *reinterpret_cast<const pg8::v8i32*>(pa_ + 64), tb = *reinterpret_cast<const pg8::v8i32*>(pb_ + 64);
        pg8::v8i32 zb = z8; if constexpr (PIPED) zb[0] = 0xE8;
        qA8[1] = hi ? zb : ta; qB8[1] = hi ? zb : tb; } else { qA8[1] = z8; qB8[1] = z8; }

    } else {
    const bf16_t* pa_ = Qb + (size_t)ra * DK + hi * 8; const bf16_t* pb_ = Qb + (size_t)rb * DK + hi * 8;
#pragma unroll
    for (int d0 = 0; d0 < ND; ++d0) { qA[d0] = *reinterpret_cast<const bf16x8*>(pa_ + d0 * 16); qB[d0] = *reinterpret_cast<const bf16x8*>(pb_ + d0 * 16); } } }
  const bool two = F8 ? false : (DK == 96) && wid < 4;
  const bool hasK = F8 ? wid < 6 : true, hasV = F8 ? (wid < 2 || wid >= 6) : true;
  const int vpiece = F8 ? (wid >= 6 ? wid - 6 : wid + 2) : wid;
  const char* ksrc = Kimg + wid * 1024 + lane * 16; const char* vsrc = Vimg + vpiece * 1024 + lane * 16;
  constexpr int NKP = KT / 1024;
  const char* f8a = (wid < NKP) ? Kimg + wid * 1024 : Vimg + (wid - NKP) * 1024; const int f8as = (wid < NKP) ? KT : VTX, f8ad = (wid < NKP) ? wid * 1024 : VO + (wid - NKP) * 1024;
  const char* f8b = (wid < 2) ? Vimg + (wid + 2) * 1024 : f8a; const int f8bs = (wid < 2) ? VTX : f8as, f8bd = (wid < 2) ? VO + (wid + 2) * 1024 : LDS_WS + 8192 + wid * 1024; const bool f8breal = wid < 2;
#define A2_DMA8(t, s) do { const int it8_ = (SWA && (t) >= 4) ? lt0 + (t) : (t); const char* ga_ = f8a + (size_t)it8_ * f8as; const char* gb_ = f8b + (size_t)it8_ * f8bs; unsigned vo_ = (unsigned)lane * 16u; asm volatile("" : "+s"(ga_)); asm volatile("" : "+s"(gb_)); asm volatile("" : "+v"(vo_)); \
    __builtin_amdgcn_global_load_lds((const unsigned*)(ga_ + vo_), (LAS unsigned*)(lds + (s) * SLOT + f8ad), 16, 0, 0); \
    if constexpr (DK == 96) __builtin_amdgcn_global_load_lds((const unsigned*)(gb_ + vo_), (LAS unsigned*)(lds + (f8breal ? (s) * SLOT : 0) + f8bd), 16, 0, 0); } while (0)
#define A2_DMA(t, s) do { if constexpr (F8) { A2_DMA8(t, s); break; } const int it_ = (SWA && (t) >= 4) ? lt0 + (t) : (t); \
    if (hasK) __builtin_amdgcn_global_load_lds((const unsigned*)(ksrc + (size_t)it_ * KT), (LAS unsigned*)(lds + (s) * SLOT + wid * 1024), 16, 0, 0); \
    if (two) __builtin_amdgcn_global_load_lds((const unsigned*)(ksrc + (size_t)it_ * KT + 8192), (LAS unsigned*)(lds + (s) * SLOT + 8192 + wid * 1024), 16, 0, 0); \
    if (hasV) __builtin_amdgcn_global_load_lds((const unsigned*)(vsrc + (size_t)it_ * VTX), (LAS unsigned*)(lds + (s) * SLOT + KT + vpiece * 1024), 16, 0, 0); } while (0)
  LAS unsigned* flag = (LAS unsigned*)(lds + LDS_WS + 4096);
  if (FAST && tid == 0) *flag = 0u;
  A2_DMA(0, 0); A2_DMA(1, 1);
  if constexpr (A2_PIPE == 2 && F8 && FAST && ABL == 0 && DK == 96) { A2_DMA(2, 2); }
  if constexpr (F8) {
    if constexpr (DK == 96) asm volatile("" : "+v"(qA8[0]), "+v"(qA8[1]), "+v"(qB8[0]), "+v"(qB8[1]));
    else asm volatile("" : "+v"(qA8[0]), "+v"(qB8[0])); }
  const int vb0 = (int)(uintptr_t)(lds + KT) + v_rd_base(lane);
  const int kb0 = hi * 1024 + r32 * 16;
  const int qpA = q0 + wrow0 + r32;
#define A2_PK(L, H) (bf16x8){L[0], L[1], L[2], L[3], H[0], H[1], H[2], H[3]}
#define A2_PV(D0, VB) do { \
      const s16x4 l0 = tr_read<v_rd_off(D0, 0, 0)>(VB), h0 = tr_read<v_rd_off(D0, 0, 1)>(VB), l1 = tr_read<v_rd_off(D0, 1, 0)>(VB), h1 = tr_read<v_rd_off(D0, 1, 1)>(VB); \
      const s16x4 l2 = tr_read<v_rd_off(D0, 2, 0)>(VB), h2 = tr_read<v_rd_off(D0, 2, 1)>(VB), l3 = tr_read<v_rd_off(D0, 3, 0)>(VB), h3 = tr_read<v_rd_off(D0, 3, 1)>(VB); \
      asm volatile("s_waitcnt lgkmcnt(0)" ::: "memory"); A2_SBAR(); \
      const bf16x8 v0_ = A2_PK(l0, h0), v1_ = A2_PK(l1, h1), v2_ = A2_PK(l2, h2), v3_ = A2_PK(l3, h3); \
      if (ABL == 3) { asm volatile("" :: "v"(v0_), "v"(v1_), "v"(v2_), "v"(v3_), "v"(a0), "v"(a1), "v"(a2), "v"(a3), "v"(b0), "v"(b1), "v"(b2), "v"(b3)); } else { \
      oA[D0] = __builtin_amdgcn_mfma_f32_32x32x16_bf16(a0, v0_, oA[D0], 0, 0, 0); oB[D0] = __builtin_amdgcn_mfma_f32_32x32x16_bf16(b0, v0_, oB[D0], 0, 0, 0); \
      oA[D0] = __builtin_amdgcn_mfma_f32_32x32x16_bf16(a1, v1_, oA[D0], 0, 0, 0); oB[D0] = __builtin_amdgcn_mfma_f32_32x32x16_bf16(b1, v1_, oB[D0], 0, 0, 0); \
      oA[D0] = __builtin_amdgcn_mfma_f32_32x32x16_bf16(a2, v2_, oA[D0], 0, 0, 0); oB[D0] = __builtin_amdgcn_mfma_f32_32x32x16_bf16(b2, v2_, oB[D0], 0, 0, 0); \
      oA[D0] = __builtin_amdgcn_mfma_f32_32x32x16_bf16(a3, v3_, oA[D0], 0, 0, 0); oB[D0] = __builtin_amdgcn_mfma_f32_32x32x16_bf16(b3, v3_, oB[D0], 0, 0, 0); } } while (0)
#define A2_PV2(VB) do { \
      const s16x4 l0 = tr_read<v_rd_off(0, 0, 0)>(VB), h0 = tr_read<v_rd_off(0, 0, 1)>(VB), l1 = tr_read<v_rd_off(0, 1, 0)>(VB), h1 = tr_read<v_rd_off(0, 1, 1)>(VB); \
      const s16x4 l2 = tr_read<v_rd_off(0, 2, 0)>(VB), h2 = tr_read<v_rd_off(0, 2, 1)>(VB), l3 = tr_read<v_rd_off(0, 3, 0)>(VB), h3 = tr_read<v_rd_off(0, 3, 1)>(VB); \
      const s16x4 m0 = tr_read<v_rd_off(1, 0, 0)>(VB), n0 = tr_read<v_rd_off(1, 0, 1)>(VB), m1 = tr_read<v_rd_off(1, 1, 0)>(VB), n1 = tr_read<v_rd_off(1, 1, 1)>(VB); \
      const s16x4 m2 = tr_read<v_rd_off(1, 2, 0)>(VB), n2 = tr_read<v_rd_off(1, 2, 1)>(VB), m3 = tr_read<v_rd_off(1, 3, 0)>(VB), n3 = tr_read<v_rd_off(1, 3, 1)>(VB); \
      asm volatile("s_waitcnt lgkmcnt(0)" ::: "memory"); A2_SBAR(); \
      const bf16x8 v0_ = A2_PK(l0, h0), v1_ = A2_PK(l1, h1), v2_ = A2_PK(l2, h2), v3_ = A2_PK(l3, h3); \
      const bf16x8 w0_ = A2_PK(m0, n0), w1_ = A2_PK(m1, n1), w2_ = A2_PK(m2, n2), w3_ = A2_PK(m3, n3); \
      oA[0] = __builtin_amdgcn_mfma_f32_32x32x16_bf16(a0, v0_, oA[0], 0, 0, 0); oB[0] = __builtin_amdgcn_mfma_f32_32x32x16_bf16(b0, v0_, oB[0], 0, 0, 0); \
      oA[1] = __builtin_amdgcn_mfma_f32_32x32x16_bf16(a0, w0_, oA[1], 0, 0, 0); oB[1] = __builtin_amdgcn_mfma_f32_32x32x16_bf16(b0, w0_, oB[1], 0, 0, 0); \
      oA[0] = __builtin_amdgcn_mfma_f32_32x32x16_bf16(a1, v1_, oA[0], 0, 0, 0); oB[0] = __builtin_amdgcn_mfma_f32_32x32x16_bf16(b1, v1_, oB[0], 0, 0, 0); \
      oA[1] = __builtin_amdgcn_mfma_f32_32x32x16_bf16(a1, w1_, oA[1], 0, 0, 0); oB[1] = __builtin_amdgcn_mfma_f32_32x32x16_bf16(b1, w1_, oB[1], 0, 0, 0); \
      oA[0] = __builtin_amdgcn_mfma_f32_32x32x16_bf16(a2, v2_, oA[0], 0, 0, 0); oB[0] = __builtin_amdgcn_mfma_f32_32x32x16_bf16(b2, v2_, oB[0], 0, 0, 0); \
      oA[1] = __builtin_amdgcn_mfma_f32_32x32x16_bf16(a2, w2_, oA[1], 0, 0, 0); oB[1] = __builtin_amdgcn_mfma_f32_32x32x16_bf16(b2, w2_, oB[1], 0, 0, 0); \
      oA[0] = __builtin_amdgcn_mfma_f32_32x32x16_bf16(a3, v3_, oA[0], 0, 0, 0); oB[0] = __builtin_amdgcn_mfma_f32_32x32x16_bf16(b3, v3_, oB[0], 0, 0, 0); \
      oA[1] = __builtin_amdgcn_mfma_f32_32x32x16_bf16(a3, w3_, oA[1], 0, 0, 0); oB[1] = __builtin_amdgcn_mfma_f32_32x32x16_bf16(b3, w3_, oB[1], 0, 0, 0); } while (0)
#define A2_WAITV(more) do { if (ABL == 5) break; if constexpr (F8) { if (more) { if constexpr (DK == 96) asm volatile("s_waitcnt vmcnt(2)" ::: "memory"); else asm volatile("s_waitcnt vmcnt(1)" ::: "memory"); } else asm volatile("s_waitcnt vmcnt(0)" ::: "memory"); break; } if (more) { if (two) asm volatile("s_waitcnt vmcnt(3)" ::: "memory"); else if (hasK && hasV) asm volatile("s_waitcnt vmcnt(2)" ::: "memory"); else asm volatile("s_waitcnt vmcnt(1)" ::: "memory"); } \
    else asm volatile("s_waitcnt vmcnt(0)" ::: "memory"); } while (0)
#define A2_MF8(KF, QF, ACC) __builtin_amdgcn_mfma_scale_f32_32x32x64_f8f6f4(KF, QF, ACC, 0, 0, 0, 0x7B7B7B7B, 0, 0x7F7F7F7F)
#define A2_MF8P(PF, VF, ACC) __builtin_amdgcn_mfma_scale_f32_32x32x64_f8f6f4(PF, VF, ACC, 0, 0, 0, 0x7F7F7F7F, 0, 0x7F7F7F7F)
#define A2_TILE(S, t) do { \
    A2_WAITV((t) + 1 < NT); \
    if (ABL != 5) __builtin_amdgcn_s_barrier(); \
    A2_SBAR(); \
    if ((t) + 2 < NT) { A2_DMA((t) + 2, ((S) + 2) % 4); } \
    const LAS unsigned char* Ks = lds + (S) * SLOT + kb0; \
    f32x16 pA0 = {}, pA1 = {}, pB0 = {}, pB1 = {}; \
    if constexpr (F8 && FAST) { _Pragma("unroll") for (int r = 0; r < 16; ++r) { pA0[r] = -P8_BIAS; pA1[r] = -P8_BIAS; pB0[r] = -P8_BIAS; pB1[r] = -P8_BIAS; } }     \
    if constexpr (F8 && DK == 64) { const LAS unsigned char* K0 = lds + (S) * SLOT + hi * 2048 + r32 * 16; \
      const pg8::v8i32 k00 = pg8::cat32(*(const LAS bf16x8*)(K0), *(const LAS bf16x8*)(K0 + 1024)), k01 = pg8::cat32(*(const LAS bf16x8*)(K0 + 512), *(const LAS bf16x8*)(K0 + 1536)); \
      pA0 = A2_MF8(k00, qA8[0], pA0); pA1 = A2_MF8(k01, qA8[0], pA1); pB0 = A2_MF8(k00, qB8[0], pB0); pB1 = A2_MF8(k01, qB8[0], pB1); \
      asm volatile("" : "+v"(pA0), "+v"(pA1), "+v"(pB0), "+v"(pB1)); A2_SBAR(); } else \
    if constexpr (F8) { const LAS unsigned char* K0 = lds + (S) * SLOT + hi * 2048 + r32 * 16; const LAS unsigned char* K1 = lds + (S) * SLOT + 4096 + r32 * 16; \
      const pg8::v8i32 k00 = pg8::cat32(*(const LAS bf16x8*)(K0), *(const LAS bf16x8*)(K0 + 1024)), k01 = pg8::cat32(*(const LAS bf16x8*)(K0 + 512), *(const LAS bf16x8*)(K0 + 1536)); \
      const pg8::v8i32 k10 = pg8::cat32(*(const LAS bf16x8*)(K1), *(const LAS bf16x8*)(K1 + 1024)), k11 = pg8::cat32(*(const LAS bf16x8*)(K1 + 512), *(const LAS bf16x8*)(K1 + 1536)); \
      if (ABL == 2) { asm volatile("" :: "v"(k00), "v"(k01), "v"(k10), "v"(k11)); pA0[0] += 0.01f; pB1[1] += 0.02f; } else { \
      pA0 = A2_MF8(k00, qA8[0], pA0); pA1 = A2_MF8(k01, qA8[0], pA1); pB0 = A2_MF8(k00, qB8[0], pB0); pB1 = A2_MF8(k01, qB8[0], pB1); \
      pA0 = A2_MF8(k10, qA8[1], pA0); pA1 = A2_MF8(k11, qA8[1], pA1); pB0 = A2_MF8(k10, qB8[1], pB0); pB1 = A2_MF8(k11, qB8[1], pB1); } \
      asm volatile("" : "+v"(pA0), "+v"(pA1), "+v"(pB0), "+v"(pB1)); A2_SBAR(); } else { \
    bf16x8 kf[2][2]; if (ABL == 4) { kf[0][0] = qA[0]; kf[0][1] = qB[0]; } else { kf[0][0] = *(const LAS bf16x8*)(Ks); kf[0][1] = *(const LAS bf16x8*)(Ks + 512); } \
    _Pragma("unroll") for (int d0 = 0; d0 < ND; ++d0) {              \
      if (d0 + 1 < ND) { if (ABL == 4) { kf[(d0 + 1) & 1][0] = qA[d0 + 1]; kf[(d0 + 1) & 1][1] = qB[d0 + 1]; } else { kf[(d0 + 1) & 1][0] = *(const LAS bf16x8*)(Ks + (d0 + 1) * 2048); kf[(d0 + 1) & 1][1] = *(const LAS bf16x8*)(Ks + (d0 + 1) * 2048 + 512); } } \
      const bf16x8 k0 = kf[d0 & 1][0], k1 = kf[d0 & 1][1]; \
      if (ABL == 2) { asm volatile("" :: "v"(k0), "v"(k1)); pA0[d0] += 0.01f; pB1[d0] += 0.02f; } else { \
      pA0 = __builtin_amdgcn_mfma_f32_32x32x16_bf16(k0, qA[d0], pA0, 0, 0, 0); pA1 = __builtin_amdgcn_mfma_f32_32x32x16_bf16(k1, qA[d0], pA1, 0, 0, 0); \
      pB0 = __builtin_amdgcn_mfma_f32_32x32x16_bf16(k0, qB[d0], pB0, 0, 0, 0); pB1 = __builtin_amdgcn_mfma_f32_32x32x16_bf16(k1, qB[d0], pB1, 0, 0, 0); } \
      A2_SBAR(); } } \
    if (SWA && (t) >= 4 && (64 * (lt0 + (t) - 4) - (q0 + wrow0) > 65 || 64 * (lt0 + (t) - 4) - (q0 + wrow0) < -65)) {     \
      const int kb_ = 64 * (lt0 + (t) - 4) - qpA;          \
      _Pragma("unroll") for (int r = 0; r < 16; ++r) { const int dA = kb_ + crow(r, hi), dB = dA - 32; \
        if (dA > 128 || dA < -128) pA0[r] = -INFINITY; if (dA + 32 > 128 || dA + 32 < -128) pA1[r] = -INFINITY; \
        if (dB > 128 || dB < -128) pB0[r] = -INFINITY; if (dB + 32 > 128 || dB + 32 < -128) pB1[r] = -INFINITY; } } \
    float alA, alB; bf16x8 a0, a1, a2, a3, b0, b1, b2, b3; \
    pg8::v8i32 pa8, pb8; \
    softmax_blk<FAST, ABL, !F8, !LS2>(pA0, pA1, mA, lA, alA, a0, a1, a2, a3); \
    if constexpr (F8) { _Pragma("unroll") for (int j = 0; j < 4; ++j) { pa8[j] = (int)pk4fp8(pA0[4 * j], pA0[4 * j + 1], pA0[4 * j + 2], pA0[4 * j + 3]); pa8[4 + j] = (int)pk4fp8(pA1[4 * j], pA1[4 * j + 1], pA1[4 * j + 2], pA1[4 * j + 3]); } asm volatile("" : "+v"(pa8)); } \
    A2_SBAR(); \
    A2_MID((t) + 2 < NT); \
    A2_SBAR(); \
    softmax_blk<FAST, ABL, !F8, !LS2>(pB0, pB1, mB, lB, alB, b0, b1, b2, b3); \
    if (!FAST && __any(alA < 1.f || alB < 1.f)) {                            \
      if (hi == 0) { ws[64 + r32] = alA; ws[96 + r32] = alB; } \
      asm volatile("s_waitcnt lgkmcnt(0)" ::: "memory"); \
      _Pragma("unroll") for (int d = 0; d < 2; ++d) _Pragma("unroll") for (int r = 0; r < 16; ++r) { oA[d][r] *= ws[64 + crow(r, hi)]; oB[d][r] *= ws[96 + crow(r, hi)]; } } \
    if constexpr (F8) { const LAS unsigned char* Vs = lds + (S) * SLOT + VO + hi * 512 + r32 * 16; \
      const pg8::v8i32 v0_ = pg8::cat32(*(const LAS bf16x8*)(Vs), *(const LAS bf16x8*)(Vs + 1024)), v1_ = pg8::cat32(*(const LAS bf16x8*)(Vs + 2048), *(const LAS bf16x8*)(Vs + 3072)); \
      _Pragma("unroll") for (int j = 0; j < 4; ++j) { pb8[j] = (int)pk4fp8(pB0[4 * j], pB0[4 * j + 1], pB0[4 * j + 2], pB0[4 * j + 3]); pb8[4 + j] = (int)pk4fp8(pB1[4 * j], pB1[4 * j + 1], pB1[4 * j + 2], pB1[4 * j + 3]); } asm volatile("" : "+v"(pb8)); \
      asm volatile("s_waitcnt lgkmcnt(0)" ::: "memory"); A2_SBAR(); \
      if (ABL == 3) { asm volatile("" :: "v"(v0_), "v"(v1_), "v"(pa8), "v"(pb8)); } else { \
      oA[0] = A2_MF8P(pa8, v0_, oA[0]); oB[0] = A2_MF8P(pb8, v0_, oB[0]); oA[1] = A2_MF8P(pa8, v1_, oA[1]); oB[1] = A2_MF8P(pb8, v1_, oB[1]); \
      if constexpr (LS2) { const pg8::v8i32 ones2 = {onesw, onesw, onesw, onesw, onesw, onesw, onesw, onesw}; \
        lAc2 = __builtin_amdgcn_mfma_scale_f32_16x16x128_f8f6f4(pa8, ones2, lAc2, 0, 0, 0, 0x7F7F7F7F, 0, 0x7F7F7F7F); lBc2 = __builtin_amdgcn_mfma_scale_f32_16x16x128_f8f6f4(pb8, ones2, lBc2, 0, 0, 0, 0x7F7F7F7F, 0, 0x7F7F7F7F); } } \
      asm volatile("" : "+v"(oA[0]), "+v"(oA[1]), "+v"(oB[0]), "+v"(oB[1])); \
    } else { A2_PV(0, vb0 + (S) * SLOT); A2_PV(1, vb0 + (S) * SLOT); } \
    asm volatile("s_waitcnt lgkmcnt(0)" ::: "memory"); \
  } while (0)
#ifdef A2_NOSTAGGER
#define A2_MID(more) do { } while (0)
#else
#define A2_MID(more) do { A2_WAITV(more); if (ABL != 5) __builtin_amdgcn_s_barrier(); } while (0)
#endif
  if constexpr (A2_PIPE && F8 && FAST && ABL == 0 && DK == 96) {
#define P8_LD(p) (*(const LAS bf16x8*)(p))
#define P8_ADD(a_, b_) ({ float o_ = (a_) + (b_); asm("" : "+v"(o_)); o_; })
    const LAS unsigned char* kp0 = lds + hi * 2048 + r32 * 16; const LAS unsigned char* kp1 = hi ? lds + KT : lds + 4096 + r32 * 16; const LAS unsigned char* vp0 = lds + VO + hi * 512 + r32 * 16;
    asm volatile("" : "+v"(kp0), "+v"(kp1), "+v"(vp0));
#define P8_KA(S) const LAS unsigned char* K0_ = kp0 + (S) * SLOT; const pg8::v8i32 k00 = pg8::cat32(P8_LD(K0_), P8_LD(K0_ + 1024)), k01 = pg8::cat32(P8_LD(K0_ + 512), P8_LD(K0_ + 1536));
#define P8_KB(S) const LAS unsigned char* K1_ = kp1 + (S) * SLOT; const pg8::v8i32 k10 = pg8::cat32(P8_LD(K1_), P8_LD(K1_ + 1024)), k11 = pg8::cat32(P8_LD(K1_ + 512), P8_LD(K1_ + 1536));
#define P8_VF(S) const LAS unsigned char* Vs_ = vp0 + (S) * SLOT; \
      const pg8::v8i32 v0_ = pg8::cat32(P8_LD(Vs_), P8_LD(Vs_ + 1024)), v1_ = pg8::cat32(P8_LD(Vs_ + 2048), P8_LD(Vs_ + 3072));
#define P8_VF1(S) const LAS unsigned char* Vs_ = vp0 + (S) * SLOT; const pg8::v8i32 v1_ = pg8::cat32(P8_LD(Vs_ + 2048), P8_LD(Vs_ + 3072));
#define P8_VPRE(S) vnx = pg8::cat32(P8_LD(vp0 + (S) * SLOT), P8_LD(vp0 + (S) * SLOT + 1024))
#define P8_BIAS16(name)
#define P8_SMG(g, p0, p1, lreg, p8) do { _Pragma("unroll") for (int r_ = 4 * (g); r_ < 4 * (g) + 4; ++r_) { p0[r_] = __builtin_amdgcn_exp2f(p0[r_]); p1[r_] = __builtin_amdgcn_exp2f(p1[r_]); } \
      { float s0_ = P8_ADD(p0[4 * (g)], p1[4 * (g)]), s1_ = P8_ADD(p0[4 * (g) + 1], p1[4 * (g) + 1]), s2_ = P8_ADD(p0[4 * (g) + 2], p1[4 * (g) + 2]), s3_ = P8_ADD(p0[4 * (g) + 3], p1[4 * (g) + 3]); \
        s0_ = P8_ADD(s0_, s1_); s2_ = P8_ADD(s2_, s3_); s0_ = P8_ADD(s0_, s2_); lreg = P8_ADD(lreg, s0_); } asm volatile("" : "+v"(lreg)); \
      p8[g] = (int)pk4fp8(p0[4 * (g)], p0[4 * (g) + 1], p0[4 * (g) + 2], p0[4 * (g) + 3]); p8[4 + (g)] = (int)pk4fp8(p1[4 * (g)], p1[4 * (g) + 1], p1[4 * (g) + 2], p1[4 * (g) + 3]); } while (0)
#define P8_EXP(g, p0, p1) do { _Pragma("unroll") for (int r_ = 4 * (g); r_ < 4 * (g) + 4; ++r_) { p0[r_] = __builtin_amdgcn_exp2f(p0[r_]); p1[r_] = __builtin_amdgcn_exp2f(p1[r_]); } } while (0)
#define P8_EXH(g, px) do { _Pragma("unroll") for (int r_ = 4 * (g); r_ < 4 * (g) + 4; ++r_) px[r_] = __builtin_amdgcn_exp2f(px[r_]); } while (0)
#define P8_PK(g, p0, p1, p8) do { p8[g] = (int)pk4fp8(p0[4 * (g)], p0[4 * (g) + 1], p0[4 * (g) + 2], p0[4 * (g) + 3]); p8[4 + (g)] = (int)pk4fp8(p1[4 * (g)], p1[4 * (g) + 1], p1[4 * (g) + 2], p1[4 * (g) + 3]); } while (0)
#define P8_FIN(g, p0, p1, lreg, p8) do { \
        \
      lreg = (((((((lreg + p0[4 * (g)]) + p1[4 * (g)]) + p0[4 * (g) + 1]) + p1[4 * (g) + 1]) + p0[4 * (g) + 2]) + p1[4 * (g) + 2]) + p0[4 * (g) + 3]) + p1[4 * (g) + 3]; asm volatile("" : "+v"(lreg)); \
      p8[g] = (int)pk4fp8(p0[4 * (g)], p0[4 * (g) + 1], p0[4 * (g) + 2], p0[4 * (g) + 3]); p8[4 + (g)] = (int)pk4fp8(p1[4 * (g)], p1[4 * (g) + 1], p1[4 * (g) + 2], p1[4 * (g) + 3]); } while (0)
    f32x16 pA0, pA1, pB0, pB1; pg8::v8i32 pa8 = {0, 0, 0, 0, 0, 0, 0, 0}, pb8 = {0, 0, 0, 0, 0, 0, 0, 0};
    const f32x16 b16 = {};
    for (int i_ = tid; i_ < 5 * (ONESB / 16); i_ += NTHREADS) *(LAS u32x4*)(lds + (i_ / (ONESB / 16)) * SLOT + KT + (i_ % (ONESB / 16)) * 16) = (u32x4){0x38383838u, 0x38383838u, 0x38383838u, 0x38383838u};
    asm volatile("s_waitcnt lgkmcnt(0)" ::: "memory");
    pg8::v8i32 ones8; { int lo_ = lane; asm volatile("" : "+v"(lo_));
      const int j_ = lo_ & 15, kq_ = lo_ >> 4; const int w_ = ((j_ == 0 && !(kq_ & 1)) || (j_ == 1 && (kq_ & 1))) ? 0x38383838 : 0;
#pragma unroll
      for (int r_ = 0; r_ < 8; ++r_) ones8[r_] = w_; }
    asm volatile("" : "+v"(ones8));
    f32x4 lAcc = {0.f, 0.f, 0.f, 0.f}, lBcc = {0.f, 0.f, 0.f, 0.f}; pg8::v8i32 vnx = {0, 0, 0, 0, 0, 0, 0, 0};
#define P8_LSUM(P8V, ACC) ACC = __builtin_amdgcn_mfma_scale_f32_16x16x128_f8f6f4(P8V, ones8, ACC, 0, 0, 0, 0x7F7F7F7F, 0, 0x7F7F7F7F)
    if constexpr (A2_PIPE == 2) asm volatile("s_waitcnt vmcnt(4)" ::: "memory"); else A2_WAITV(1 < NT);
    __builtin_amdgcn_s_barrier();
    { P8_KA(0); P8_KB(0); P8_BIAS16(b16); pA0 = A2_MF8(k00, qA8[0], b16); pA1 = A2_MF8(k01, qA8[0], b16); pA0 = A2_MF8(k10, qA8[1], pA0); pA1 = A2_MF8(k11, qA8[1], pA1); }
    asm volatile("" : "+v"(pA0), "+v"(pA1)); A2_SBAR();
#define P8_TILE(S, t, FIRST) do { \
        \
      __builtin_amdgcn_s_barrier(); A2_SBAR(); \
      if ((t) + 2 < NT) { A2_DMA((t) + 2, ((S) + 2) % 4); } \
      { P8_KA(S); \
        if (!(FIRST)) { P8_VF(((S) + 3) % 4); A2_SBAR(); oB[0] = A2_MF8P(pb8, v0_, oB[0]); A2_SBAR(); P8_SMG(0, pA0, pA1, lA, pa8); A2_SBAR(); oB[1] = A2_MF8P(pb8, v1_, oB[1]); A2_SBAR(); } else { A2_SBAR(); P8_SMG(0, pA0, pA1, lA, pa8); A2_SBAR(); } \
        pB0 = A2_MF8(k00, qB8[0], b16); A2_SBAR(); P8_KB(S); P8_SMG(1, pA0, pA1, lA, pa8); A2_SBAR(); pB1 = A2_MF8(k01, qB8[0], b16); A2_SBAR(); P8_SMG(2, pA0, pA1, lA, pa8); A2_SBAR(); \
        pB0 = A2_MF8(k10, qB8[1], pB0); A2_SBAR(); P8_SMG(3, pA0, pA1, lA, pa8); A2_SBAR(); pB1 = A2_MF8(k11, qB8[1], pB1); } \
      asm volatile("" : "+v"(pB0), "+v"(pB1), "+v"(pa8), "+v"(oB[0]), "+v"(oB[1])); A2_SBAR(); \
        \
      A2_WAITV((t) + 2 < NT); __builtin_amdgcn_s_barrier(); A2_SBAR(); \
      { P8_VF(S); P8_KA(((S) + 1) % 4); A2_SBAR(); \
        oA[0] = A2_MF8P(pa8, v0_, oA[0]); A2_SBAR(); P8_SMG(0, pB0, pB1, lB, pb8); A2_SBAR(); oA[1] = A2_MF8P(pa8, v1_, oA[1]); A2_SBAR(); \
        pA0 = A2_MF8(k00, qA8[0], b16); A2_SBAR(); P8_KB(((S) + 1) % 4); P8_SMG(1, pB0, pB1, lB, pb8); A2_SBAR(); pA1 = A2_MF8(k01, qA8[0], b16); A2_SBAR(); P8_SMG(2, pB0, pB1, lB, pb8); A2_SBAR(); \
        pA0 = A2_MF8(k10, qA8[1], pA0); A2_SBAR(); P8_SMG(3, pB0, pB1, lB, pb8); A2_SBAR(); pA1 = A2_MF8(k11, qA8[1], pA1); } \
      asm volatile("" : "+v"(pA0), "+v"(pA1), "+v"(pb8), "+v"(oA[0]), "+v"(oA[1])); A2_SBAR(); \
    } while (0)
#define P8_TILE5(S, t, FIRST) do { \
      A2_WAITV((t) + 2 < NT); __builtin_amdgcn_s_barrier(); A2_SBAR(); \
      if ((t) + 3 < NT) { A2_DMA((t) + 3, ((S) + 3) % 5); } \
        \
        \
      { P8_KA(S); \
        if (!(FIRST)) { P8_VF1(((S) + 4) % 5); A2_SBAR(); oB[0] = A2_MF8P(pb8, vnx, oB[0]); A2_SBAR(); P8_EXH(0, pA0); A2_SBAR(); oB[1] = A2_MF8P(pb8, v1_, oB[1]); A2_SBAR(); P8_EXH(0, pA1); A2_SBAR(); P8_LSUM(pb8, lBcc); A2_SBAR(); } \
        else { A2_SBAR(); P8_EXH(0, pA0); P8_EXH(0, pA1); A2_SBAR(); } \
        P8_EXH(1, pA0); A2_SBAR(); \
        pB0 = A2_MF8(k00, qB8[0], b16); A2_SBAR(); P8_KB(S); P8_EXH(1, pA1); P8_PK(0, pA0, pA1, pa8); A2_SBAR(); \
        pB1 = A2_MF8(k01, qB8[0], b16); A2_SBAR(); P8_EXH(2, pA0); P8_PK(1, pA0, pA1, pa8); A2_SBAR(); \
        pB0 = A2_MF8(k10, qB8[1], pB0); A2_SBAR(); P8_EXH(2, pA1); P8_VPRE(S); A2_SBAR(); \
        pB1 = A2_MF8(k11, qB8[1], pB1); A2_SBAR(); P8_EXH(3, pA0); P8_PK(2, pA0, pA1, pa8); P8_EXH(3, pA1); A2_SBAR(); P8_PK(3, pA0, pA1, pa8); } \
      asm volatile("" : "+v"(pB0), "+v"(pB1), "+v"(pa8), "+v"(oB[0]), "+v"(oB[1]), "+v"(lBcc), "+v"(vnx)); A2_SBAR(); \
      { P8_VF1(S); P8_KA(((S) + 1) % 5); A2_SBAR(); \
        oA[0] = A2_MF8P(pa8, vnx, oA[0]); A2_SBAR(); P8_EXH(0, pB0); A2_SBAR(); oA[1] = A2_MF8P(pa8, v1_, oA[1]); A2_SBAR(); P8_EXH(0, pB1); A2_SBAR(); P8_LSUM(pa8, lAcc); A2_SBAR(); \
        P8_EXH(1, pB0); A2_SBAR(); \
        pA0 = A2_MF8(k00, qA8[0], b16); A2_SBAR(); P8_KB(((S) + 1) % 5); P8_EXH(1, pB1); P8_PK(0, pB0, pB1, pb8); A2_SBAR(); \
        pA1 = A2_MF8(k01, qA8[0], b16); A2_SBAR(); P8_EXH(2, pB0); P8_PK(1, pB0, pB1, pb8); A2_SBAR(); \
        pA0 = A2_MF8(k10, qA8[1], pA0); A2_SBAR(); P8_EXH(2, pB1); P8_VPRE(S); A2_SBAR(); \
        pA1 = A2_MF8(k11, qA8[1], pA1); A2_SBAR(); P8_EXH(3, pB0); P8_PK(2, pB0, pB1, pb8); P8_EXH(3, pB1); A2_SBAR(); P8_PK(3, pB0, pB1, pb8); } \
      asm volatile("" : "+v"(pA0), "+v"(pA1), "+v"(pb8), "+v"(oA[0]), "+v"(oA[1]), "+v"(lAcc), "+v"(vnx)); A2_SBAR(); \
    } while (0)
    if constexpr (A2_PIPE == 2) {
#ifdef A2_PEEL
      P8_TILE5(0, 0, true); P8_TILE5(1, 1, false); P8_TILE5(2, 2, false); P8_TILE5(3, 3, false); P8_TILE5(4, 4, false);
      for (int t = 5; t + 4 < NT; t += 5) { P8_TILE5(0, t, false); P8_TILE5(1, t + 1, false); P8_TILE5(2, t + 2, false); P8_TILE5(3, t + 3, false); P8_TILE5(4, t + 4, false); }
#else
      for (int t = 0; t + 4 < NT; t += 5) { P8_TILE5(0, t, t == 0); P8_TILE5(1, t + 1, false); P8_TILE5(2, t + 2, false); P8_TILE5(3, t + 3, false); P8_TILE5(4, t + 4, false); }
#endif
      { P8_VF(4); oB[0] = A2_MF8P(pb8, v0_, oB[0]); oB[1] = A2_MF8P(pb8, v1_, oB[1]); P8_LSUM(pb8, lBcc); }
      { const int j_ = lane & 15, rg_ = lane >> 4;
        if (j_ < 2) {
#pragma unroll
          for (int r_ = 0; r_ < 4; ++r_) { ws[j_ * 16 + 4 * rg_ + r_] = lAcc[r_]; ws[32 + j_ * 16 + 4 * rg_ + r_] = lBcc[r_]; } }
        asm volatile("s_waitcnt lgkmcnt(0)" ::: "memory");
        lA = 0.5f * ws[r32]; lB = 0.5f * ws[32 + r32]; asm volatile("s_waitcnt lgkmcnt(0)" ::: "memory"); }
    } else {
    P8_TILE(0, 0, true); P8_TILE(1, 1, false); P8_TILE(2, 2, false); P8_TILE(3, 3, false);
    for (int t = 4; t + 3 < NT; t += 4) { P8_TILE(0, t, false); P8_TILE(1, t + 1, false); P8_TILE(2, t + 2, false); P8_TILE(3, t + 3, false); }
    { P8_VF(3); oB[0] = A2_MF8P(pb8, v0_, oB[0]); oB[1] = A2_MF8P(pb8, v1_, oB[1]); }
    }
    { auto rr = __builtin_amdgcn_permlane32_swap(__float_as_uint(lA), __float_as_uint(lA), false, false); lA = __uint_as_float(rr[0]) + __uint_as_float(rr[1]); }
    { auto rr = __builtin_amdgcn_permlane32_swap(__float_as_uint(lB), __float_as_uint(lB), false, false); lB = __uint_as_float(rr[0]) + __uint_as_float(rr[1]); }
#undef P8_TILE
#undef P8_TILE5
#undef P8_SMG
#undef P8_EXP
#undef P8_PK
#undef P8_EXH
#undef P8_LSUM
#undef P8_FIN
#undef P8_VF
#undef P8_VF1
#undef P8_VPRE
#undef P8_KA
#undef P8_KB
#undef P8_BIAS16
#undef P8_LD
#undef P8_ADD
  } else {
#ifndef A2_NOSTAGGER
  if (wid >= 4 && ABL != 5) { A2_WAITV(true); __builtin_amdgcn_s_barrier(); }
#endif
#ifdef A2_PRIO
  if (wid >= 4) __builtin_amdgcn_s_setprio(1);
#endif
  int t = 0;
  for (; t + 3 < NT; t += 4) { A2_TILE(0, t); A2_TILE(1, t + 1); A2_TILE(2, t + 2); A2_TILE(3, t + 3); }
  if (t < NT) { A2_TILE(0, t); if (t + 1 < NT) { A2_TILE(1, t + 1); if (t + 2 < NT) { A2_TILE(2, t + 2); } } }
#ifndef A2_NOSTAGGER
  if (wid < 4 && ABL != 5) __builtin_amdgcn_s_barrier();
#endif
#ifdef A2_PRIO
  __builtin_amdgcn_s_setprio(0);
#endif
  if constexpr (LS2) { const int j_ = lane & 15, rg_ = lane >> 4;
    if (j_ < 2) {
#pragma unroll
      for (int r_ = 0; r_ < 4; ++r_) { ws[j_ * 16 + 4 * rg_ + r_] = lAc2[r_]; ws[32 + j_ * 16 + 4 * rg_ + r_] = lBc2[r_]; } }
    asm volatile("s_waitcnt lgkmcnt(0)" ::: "memory");
    lA = ws[r32]; lB = ws[32 + r32]; asm volatile("s_waitcnt lgkmcnt(0)" ::: "memory"); }
  }
#undef A2_MID
#undef A2_WAITV
#undef A2_TILE
#undef A2_MF8
#undef A2_MF8P
#undef A2_PV
#undef A2_PV2
#undef A2_PK
  if (SWA) { const float sk = sinkp[wid & 3] * LOG2E - ((F8 && FAST) ? P8_BIAS : 0.f); lA += __builtin_amdgcn_exp2f(FAST ? sk : sk - mA); lB += __builtin_amdgcn_exp2f(FAST ? sk : sk - mB); }
#ifdef A2_FORCE_FALLBACK
  if (FAST) { if (lane == 0) *flag = 1u; }
#else
  if (FAST) { bool bad = !(lA >= 1e-30f && lA <= 1e30f) || !(lB >= 1e-30f && lB <= 1e30f);
    if constexpr (F8) { float z = 0.f;
#pragma unroll
      for (int r = 0; r < 16; ++r) z += (oA[0][r] + oA[1][r] + oB[0][r] + oB[1][r]) * 0.f;
      bad = bad || !(z == 0.f); }
    if (__any(bad) && lane == 0) *flag = 1u; }
#endif
  if (hi == 0) { ws[r32] = lA; ws[32 + r32] = lB; }
  asm volatile("s_waitcnt lgkmcnt(0)" ::: "memory");
  int hi_e = hi, r32_e = r32; asm volatile("" : "+v"(hi_e), "+v"(r32_e));
#pragma unroll
  for (int blk = 0; blk < 2; ++blk) {
    const int rbase = wrow0 + blk * 32;
    if constexpr (SWA) {
      const int qi = r32_e & 3; const unsigned sel = (unsigned)qi | ((unsigned)(4 + qi) << 8);
#pragma unroll
      for (int j = 0; j < 4; ++j) {
        float il4[4];
#pragma unroll
        for (int i4 = 0; i4 < 4; ++i4) il4[i4] = __builtin_amdgcn_rcpf(ws[blk * 32 + crow(4 * j + i4, hi_e)]) * 16.f;
#pragma unroll
        for (int d0 = 0; d0 < 2; ++d0) {
          const f32x16& o = blk ? oB[d0] : oA[d0];
          const unsigned w = pk4fp8(o[4 * j] * il4[0], o[4 * j + 1] * il4[1], o[4 * j + 2] * il4[2], o[4 * j + 3] * il4[3]);
          const unsigned t0 = (unsigned)__builtin_amdgcn_update_dpp(0, (int)w, 0x00, 0xF, 0xF, false), t1 = (unsigned)__builtin_amdgcn_update_dpp(0, (int)w, 0x55, 0xF, 0xF, false);
          const unsigned t2 = (unsigned)__builtin_amdgcn_update_dpp(0, (int)w, 0xAA, 0xF, 0xF, false), t3 = (unsigned)__builtin_amdgcn_update_dpp(0, (int)w, 0xFF, 0xF, 0xF, false);
          const unsigned x01 = __builtin_amdgcn_perm(t1, t0, sel), x23 = __builtin_amdgcn_perm(t3, t2, sel);
          *(unsigned*)((unsigned char*)Ob + (size_t)(rbase + crow(4 * j + qi, hi_e)) * DM + (r32_e & ~3) + 32 * d0) = (x01 & 0xffffu) | (x23 << 16);
        }
      }
    } else
    if (rbase < rows_valid) {
      const int qi = r32_e & 3; const bool hiw = (qi & 2) != 0; const unsigned selh = (qi & 1) ? 0x07060302u : 0x05040100u;
#pragma unroll
      for (int j = 0; j < 4; ++j) {
        float il4[4];
#pragma unroll
        for (int i4 = 0; i4 < 4; ++i4) il4[i4] = __builtin_amdgcn_rcpf(ws[blk * 32 + crow(4 * j + i4, hi_e)]);
#pragma unroll
        for (int d0 = 0; d0 < 2; ++d0) {
          const f32x16& o = blk ? oB[d0] : oA[d0];
          const unsigned wA = pk2bf(o[4 * j] * il4[0], o[4 * j + 1] * il4[1]), wB = pk2bf(o[4 * j + 2] * il4[2], o[4 * j + 3] * il4[3]);
          unsigned sk[4];
#define A2_QB(K_, CTRL) { const unsigned ta = (unsigned)__builtin_amdgcn_update_dpp(0, (int)wA, CTRL, 0xF, 0xF, false), tb = (unsigned)__builtin_amdgcn_update_dpp(0, (int)wB, CTRL, 0xF, 0xF, false); sk[K_] = hiw ? tb : ta; }
          A2_QB(0, 0x00) A2_QB(1, 0x55) A2_QB(2, 0xAA) A2_QB(3, 0xFF)
#undef A2_QB
          u32x2 w; w.x = __builtin_amdgcn_perm(sk[1], sk[0], selh); w.y = __builtin_amdgcn_perm(sk[3], sk[2], selh);
          *(u32x2*)(Ob + (size_t)(rbase + crow(4 * j + qi, hi_e)) * DM + (r32_e & ~3) + 32 * d0) = w;
        }
      }
    }
    if (false) {
#pragma unroll
      for (int r = 0; r < 16; ++r) { const int orow = crow(r, hi_e); const float il = __builtin_amdgcn_rcpf(ws[blk * 32 + orow]);
        if constexpr (SWA) { unsigned char* op = (unsigned char*)Ob + (size_t)(rbase + orow) * DM + r32_e;
          const float il16 = il * 16.f; op[0] = f2fp8((blk ? oB[0][r] : oA[0][r]) * il16); op[32] = f2fp8((blk ? oB[1][r] : oA[1][r]) * il16); }
        else { bf16_t* op = Ob + (size_t)(rbase + orow) * DM + r32_e;
        op[0] = f2bf((blk ? oB[0][r] : oA[0][r]) * il); op[32] = f2bf((blk ? oB[1][r] : oA[1][r]) * il); } }
    }
  }
  asm volatile("s_waitcnt vmcnt(0) lgkmcnt(0)" ::: "memory");
  __builtin_amdgcn_s_barrier();
  bool ok = true;
  if (FAST) { ok = (*flag == 0u); asm volatile("s_waitcnt lgkmcnt(0)" ::: "memory"); __builtin_amdgcn_s_barrier(); }
  return ok;
#undef A2_DMA
#undef A2_DMA8
}
#undef A2_SBAR
}

#ifdef PROBE_RND
__device__ __forceinline__ void phase_rnd(Frame& F, size_t off, size_t nbytes) {
  const Params P = lds_params(F);
  u32x4* base = (u32x4*)(P.ws + off); const size_t n = nbytes / 16;
  for (size_t i = (size_t)F.bid * NTHREADS + F.tid; i < n; i += (size_t)F.G * NTHREADS) {
    u32x4 w = base[i]; unsigned* wp = (unsigned*)&w;
#pragma unroll
    for (int j = 0; j < 4; ++j) { const float a = fp8rt(bf2f((bf16_t)(wp[j] & 0xffff)), 16.f), b = fp8rt(bf2f((bf16_t)(wp[j] >> 16)), 16.f); wp[j] = pk2bf(a, b); }
    base[i] = w; }
}
#endif
#ifdef PROBE_UB
__device__ __forceinline__ void phase_ubench(Frame& F) {
  const Params P = lds_params(F);
  pg8::v8i32 a, b; for (int j = 0; j < 8; ++j) { a[j] = 0x38383838 + F.lane; b[j] = 0x30303030 + j; }
  att::f32x16 c0 = {}, c1 = {}; float e[16];
#pragma unroll
  for (int j = 0; j < 16; ++j) e[j] = -0.001f * (float)(F.lane + j);
#pragma unroll 1
  for (int i = 0; i < 2048; ++i) {
    if (PROBE_UB & 1) c0 = __builtin_amdgcn_mfma_scale_f32_32x32x64_f8f6f4(a, b, c0, 0, 0, 0, 0x7F7F7F7F, 0, 0x7F7F7F7F);
    __builtin_amdgcn_sched_barrier(0);
    if (PROBE_UB & 2) {
#pragma unroll
      for (int j = 0; j < 8; ++j) e[j] = (PROBE_UB & 4) ? e[j] + 1.0009765625f : __builtin_amdgcn_exp2f(e[j]); }
    __builtin_amdgcn_sched_barrier(0);
    if (PROBE_UB & 1) c1 = __builtin_amdgcn_mfma_scale_f32_32x32x64_f8f6f4(a, b, c1, 0, 0, 0, 0x7F7F7F7F, 0, 0x7F7F7F7F);
    __builtin_amdgcn_sched_barrier(0);
    if (PROBE_UB & 2) {
#pragma unroll
      for (int j = 8; j < 16; ++j) e[j] = (PROBE_UB & 4) ? e[j] + 1.0009765625f : __builtin_amdgcn_exp2f(e[j]); }
    __builtin_amdgcn_sched_barrier(0);
    asm volatile("" : "+v"(c0), "+v"(c1));
  }
  float r = 0.f;
#pragma unroll
  for (int j = 0; j < 16; ++j) r += e[j] + c0[j] + c1[j];
  ((float*)(P.ws + WS_PB))[(size_t)F.bid * NTHREADS + F.tid] = r;
}
#endif
__device__ __forceinline__ void phase_attn_mla(Frame& F) {
  const Params P = lds_params(F);
  const bf16_t* Q = (const bf16_t*)(P.ws + WS_QKV + OFF_Q); const bf16_t* QC = (const bf16_t*)(P.ws + WS_QKV + OFF_QC);
  const char* Kimg = (const char*)(P.ws + WS_QKV + OFF_K); const char* Vimg = (const char*)(P.ws + WS_QKV + OFF_V);
  bf16_t* CAT = (bf16_t*)(P.ws + WS_CAT);
  const int v = (F.G % 8 == 0) ? (F.bid % 8) * (F.G / 8) + F.bid / 8 : F.bid;
  if (((blockIdx.x >> 3) & 1) == 0) { cvt_attn_share(P, (LAS unsigned*)(F.lds + 1024), F.bid, F.G); __syncthreads(); }
  for (int U = v; U < 512 + 16; U += F.G) {
    if (U < 512) { const int bh = U >> 5, qb = U & 31, b = bh >> 3, h = bh & 7;
      const bf16_t* Qu = (const bf16_t*)((const char*)Q + ((size_t)bh * SEQ + qb * 512) * 96);
      if (!att2::attn_unit<true, 0, 96, false, true>(Qu, 512, Kimg + (size_t)bh * NKEY * 96, Vimg + (size_t)bh * NKEY * 64,
                                 CAT + ((size_t)b * SEQ + qb * 512) * DM + 512 + h * 64, NKEY / 64, F.lds))
        att2::attn_unit<false, 0, 96, false, true>(Qu, 512, Kimg + (size_t)bh * NKEY * 96, Vimg + (size_t)bh * NKEY * 64,
                               CAT + ((size_t)b * SEQ + qb * 512) * DM + 512 + h * 64, NKEY / 64, F.lds);
    } else { const int bh = U - 512, b = bh >> 3, h = bh & 7;
      att2::attn_unit<false, 0, 96, false, true>((const bf16_t*)((const char*)QC + (size_t)bh * CTX * 96), 256, Kimg + (size_t)bh * NKEY * 96, Vimg + (size_t)bh * NKEY * 64,
                             CAT + ((size_t)NLAT + b * CTX) * DM + 512 + h * 64, CTX / 64, F.lds);
    }
  }
  if (((blockIdx.x >> 3) & 1) == 1) { __syncthreads(); cvt_attn_share(P, (LAS unsigned*)(F.lds + 1024), F.bid, F.G); __syncthreads(); }
}
#ifdef PROBE_ATT_ABL
__device__ __forceinline__ void phase_attn_probe(Frame& F) {
  const Params P = lds_params(F);
  const bf16_t* Q = (const bf16_t*)(P.ws + WS_QKV + OFF_Q);
  const char* Kimg = (const char*)(P.ws + WS_QKV + OFF_K); const char* Vimg = (const char*)(P.ws + WS_QKV + OFF_V);
  bf16_t* SCR = (bf16_t*)(P.ws + WS_PB);
  const int v = (F.G % 8 == 0) ? (F.bid % 8) * (F.G / 8) + F.bid / 8 : F.bid;
  for (int U = v; U < 512; U += F.G) { const int bh = U >> 5, qb = U & 31, b = bh >> 3, h = bh & 7;
    att2::attn_unit<true, PROBE_ATT_ABL, 96, false, true>((const bf16_t*)((const char*)Q + ((size_t)bh * SEQ + qb * 512) * 96), 512, Kimg + (size_t)bh * NKEY * 96, Vimg + (size_t)bh * NKEY * 64,
                                         SCR + ((size_t)b * SEQ + qb * 512) * DM + 512 + h * 64, NKEY / 64, F.lds); }
}
#endif
__device__ __forceinline__ void phase_attn_swa(Frame& F) {
  const Params P = lds_params(F);
  const bf16_t* Q2 = (const bf16_t*)(P.ws + WS_QKV + OFF_Q2); const char* K2 = (const char*)(P.ws + WS_QKV + OFF_K2); const char* V2 = (const char*)(P.ws + WS_QKV + OFF_V2);
  bf16_t* CAT = (bf16_t*)(P.ws + WS_CAT); const float* sink = P.in[17];
  const int v = (F.G % 8 == 0) ? (F.bid % 8) * (F.G / 8) + F.bid / 8 : F.bid;
  for (int U = v; U < NB * 4 * 128; U += F.G) {
    const int bk = U >> 7, qb = U & 127, b = bk >> 2, kvh = bk & 3, q0 = qb * 128;
    int lo = q0 - 128, hi2 = q0 + 256; if (lo < 0) lo = 0; if (hi2 > SEQ) hi2 = SEQ;
    const int lt0 = lo >> 6, NT = 4 + ((hi2 - lo) >> 6);
    const bf16_t* Qb = (const bf16_t*)((const char*)Q2 + ((size_t)(b * 16 + kvh * 4) * SEQ + q0) * 64); const char* Kb = K2 + (size_t)bk * NKEY * 64; const char* Vb = V2 + (size_t)bk * NKEY * 64;
    bf16_t* Ob = (bf16_t*)((unsigned char*)CAT + ((size_t)b * SEQ + q0) * DM + kvh * 256);
    if (!att2::attn_unit<true, 0, 64, true, true>(Qb, 128, Kb, Vb, Ob, NT, F.lds, lt0, q0, sink + kvh * 4))
      att2::attn_unit<false, 0, 64, true, true>(Qb, 128, Kb, Vb, Ob, NT, F.lds, lt0, q0, sink + kvh * 4);
  }
}
__device__ __forceinline__ float wave_sum(float v) {
  v += dpp_mov<0xB1>(v); v += dpp_mov<0x4E>(v); v += dpp_mov<0x124>(v); v += dpp_mov<0x128>(v);
  { auto rr = __builtin_amdgcn_permlane16_swap(__float_as_uint(v), __float_as_uint(v), false, false); v = __uint_as_float(rr[0]) + __uint_as_float(rr[1]); }
  { auto rr = __builtin_amdgcn_permlane32_swap(__float_as_uint(v), __float_as_uint(v), false, false); v = __uint_as_float(rr[0]) + __uint_as_float(rr[1]); }
  return v;
}
__device__ __forceinline__ void row_load(const float* row, int lane, f32x4 (&x)[4]) {
#pragma unroll
  for (int j = 0; j < 4; ++j) x[j] = *(const f32x4*)(row + 4 * lane + 256 * j);
}
__device__ __forceinline__ float row_ssq(const f32x4 (&x)[4]) {
  float s = 0.f;
#pragma unroll
  for (int j = 0; j < 4; ++j) s += (x[j][0] * x[j][0] + x[j][1] * x[j][1]) + (x[j][2] * x[j][2] + x[j][3] * x[j][3]);
  return wave_sum(s);
}
__device__ __forceinline__ void xs_load(const bf16_t* xsb, const float* xcx, int r, int lane, f32x4 (&x)[4]) {
  if (r < NLAT) { const bf16_t* p = xsb + (size_t)r * DM + 4 * lane;
#pragma unroll
    for (int j = 0; j < 4; ++j) { const u32x2 w = *(const u32x2*)(p + 256 * j);
      x[j] = (f32x4){bf2f((bf16_t)(w.x & 0xffff)), bf2f((bf16_t)(w.x >> 16)), bf2f((bf16_t)(w.y & 0xffff)), bf2f((bf16_t)(w.y >> 16))}; } }
  else row_load(xcx + (size_t)(r - NLAT) * DM, lane, x);
}
__device__ __forceinline__ void row_norm_mod_fp8(f32x4 (&x)[4], float inv, const float* g, const float* sh, const float* sc, unsigned char* orow, int lane) {
#pragma unroll
  for (int j = 0; j < 4; ++j) {
    const int c = 4 * lane + 256 * j;
    const f32x4 gg = *(const f32x4*)(g + c), s1 = *(const f32x4*)(sh + c), s2 = *(const f32x4*)(sc + c);
    x[j] = x[j] * inv * gg * (s2 + 1.f) + s1;
    *(unsigned*)(orow + c) = pk4fp8(x[j][0], x[j][1], x[j][2], x[j][3]);
  }
}
__device__ __forceinline__ void row_norm_mod(f32x4 (&x)[4], float inv, const float* g, const float* sh, const float* sc, bf16_t* orow, int lane) {
#pragma unroll
  for (int j = 0; j < 4; ++j) {
    const int c = 4 * lane + 256 * j;
    const f32x4 gg = *(const f32x4*)(g + c), s1 = *(const f32x4*)(sh + c), s2 = *(const f32x4*)(sc + c);
    x[j] = x[j] * inv * gg * (s2 + 1.f) + s1;
    u32x2 w; w.x = pk2bf(x[j][0], x[j][1]); w.y = pk2bf(x[j][2], x[j][3]);
    *(u32x2*)(orow + c) = w;
  }
}

__device__ __forceinline__ void phase_norm1_l0(Frame& F) {
  const Params P = lds_params(F);
  const float* x = P.in[0]; const float* ctx = P.in[2]; const float* g = P.in[6]; const float* modv = (const float*)(P.ws + WS_MODV);
  bf16_t* HB = (bf16_t*)(P.ws + WS_HB);
  int cv = -1; f32x4 ga[4], sb[4];
  const int lane = F.lane;
  for (int row = F.bid * 8 + F.wave; row < NROW; row += F.G * 8) {
    const float* src; int v;
    if (row < NLAT) { src = x + (size_t)row * DM; v = row / SEQ; } else { src = ctx + (size_t)(row - NLAT) * DM; v = 2; }
    f32x4 xv[4]; row_load(src, lane, xv);
    if (v != cv) { cv = v;
#pragma unroll
      for (int j = 0; j < 4; ++j) { const int c = 4 * lane + 256 * j; ga[j] = *(const f32x4*)(g + c) * (*(const f32x4*)(modv + v * NMOD + DM + c) + 1.f); sb[j] = *(const f32x4*)(modv + v * NMOD + c); } }
    const float inv = rsqrtf(row_ssq(xv) * (1.f / DM) + EPS);
    bf16_t* orow = HB + (size_t)row * DM;
#pragma unroll
    for (int j = 0; j < 4; ++j) { const f32x4 y = xv[j] * inv * ga[j] + sb[j]; u32x2 w; w.x = pk2bf(y[0], y[1]); w.y = pk2bf(y[2], y[3]); *(u32x2*)(orow + 4 * lane + 256 * j) = w; }
  }
}

__device__ __forceinline__ void phase_norm2(Frame& F, int layer, const int row_lo, const int nrows) {
  if (row_lo + F.bid * 8 >= nrows) return;
  const Params P = lds_params(F);
  const float* g = P.in[7] + layer * DM; const float* modl = (const float*)(P.ws + WS_MODV) + (size_t)layer * 3 * NMOD;
  const float* rw = P.in[19] + (size_t)layer * DM * NE;
  const bf16_t* xsb = (const bf16_t*)(P.ws + WS_XSB); const float* xcx = (const float*)(P.ws + WS_XC);
  bf16_t* HB = (bf16_t*)(P.ws + WS_HB); float* aff = (float*)(P.ws + WS_AFF);
  const int lane = F.lane;
  __syncthreads();
  for (int f = F.tid; f < DM * 4; f += NTHREADS) { const int c = f >> 2, q = f & 3, j = c >> 8, ln = (c & 255) >> 2, i = c & 3;
    *(LAS f32x4*)(F.lds + ((4 * j + i) * 4 + q) * 1024 + 16 * ln) = *(const f32x4*)(rw + 4 * f); }
  __syncthreads();
  const unsigned wl = (unsigned)(uintptr_t)(F.lds + 16 * lane);
  const int stride = F.G * 8;
  int row = row_lo + F.bid * 8 + F.wave;
  f32x4 xv[4], xn[4], xm[4];
  if (row < nrows) xs_load(xsb, xcx, row, lane, xv);
  if (row + stride < nrows) xs_load(xsb, xcx, row + stride, lane, xn);
  int cv = -1; f32x4 ga[4], sb[4];
  while (row < nrows) {
    const int nrow = row + stride, mrow = nrow + stride;
    if (mrow < nrows) xs_load(xsb, xcx, mrow, lane, xm);
    const int v = row < NLAT ? row / SEQ : 2;
    if (v != cv) { cv = v; const float* shp = modl + v * NMOD + 3 * DM; const float* scp = shp + DM;
#pragma unroll
      for (int j = 0; j < 4; ++j) { const int c = 4 * lane + 256 * j; ga[j] = *(const f32x4*)(g + c) * (*(const f32x4*)(scp + c) + 1.f); sb[j] = *(const f32x4*)(shp + c); } }
    const float inv = rsqrtf(row_ssq(xv) * (1.f / DM) + EPS);
    { unsigned char* orow = (unsigned char*)HB + (size_t)row * DM;
#pragma unroll
      for (int j = 0; j < 4; ++j) { xv[j] = xv[j] * inv * ga[j] + sb[j]; *(unsigned*)(orow + 4 * lane + 256 * j) = pk4fp8(xv[j][0], xv[j][1], xv[j][2], xv[j][3]); } }
    typedef float f32x2 __attribute__((ext_vector_type(2)));
    f32x2 pp[8];
#pragma unroll
    for (int e = 0; e < 8; ++e) pp[e] = (f32x2){0.f, 0.f};
#pragma unroll
    for (int j = 0; j < 4; ++j) {
      unsigned wb = wl + j * 16384; asm volatile("" : "+v"(wb));
#pragma unroll
      for (int i = 0; i < 4; ++i)
#pragma unroll
        for (int q = 0; q < 4; ++q) {
          const f32x4 w = *(const LAS f32x4*)(wb + (i * 4 + q) * 1024); const f32x2 hv = (f32x2){xv[j][i], xv[j][i]};
          pp[2 * q] = __builtin_elementwise_fma(hv, (f32x2){w[0], w[1]}, pp[2 * q]); pp[2 * q + 1] = __builtin_elementwise_fma(hv, (f32x2){w[2], w[3]}, pp[2 * q + 1]);
        }
      __builtin_amdgcn_sched_barrier(0);
    }
    float p[16];
#pragma unroll
    for (int e = 0; e < 8; ++e) { p[2 * e] = pp[e][0]; p[2 * e + 1] = pp[e][1]; }
    float q8[8];
#pragma unroll
    for (int e = 0; e < 8; ++e) { auto rr = __builtin_amdgcn_permlane32_swap(__float_as_uint(p[e]), __float_as_uint(p[e + 8]), false, false); q8[e] = __uint_as_float(rr[0]) + __uint_as_float(rr[1]); }
    float q4[4];
#pragma unroll
    for (int e = 0; e < 4; ++e) { auto rr = __builtin_amdgcn_permlane16_swap(__float_as_uint(q8[e]), __float_as_uint(q8[e + 4]), false, false); q4[e] = __uint_as_float(rr[0]) + __uint_as_float(rr[1]); }
    float q2[2];
#pragma unroll
    for (int e = 0; e < 2; ++e) { const bool up = (lane & 8) != 0; const float snd = up ? q4[e] : q4[e + 2], keep = up ? q4[e + 2] : q4[e]; q2[e] = keep + dpp_mov<0x128>(snd); }
    float lg; { const bool up = (lane & 4) != 0; const float snd = up ? q2[0] : q2[1], keep = up ? q2[1] : q2[0]; const float t0 = dpp_mov<0x124>(snd), t1 = dpp_mov<0x12C>(snd); lg = keep + (up ? t0 : t1); }
    lg += dpp_mov<0x4E>(lg); lg += dpp_mov<0xB1>(lg);
    float mx = lg;
    mx = fmaxf(mx, dpp_mov<0x124>(mx)); mx = fmaxf(mx, dpp_mov<0x128>(mx));
    { auto rr = __builtin_amdgcn_permlane16_swap(__float_as_uint(mx), __float_as_uint(mx), false, false); mx = fmaxf(__uint_as_float(rr[0]), __uint_as_float(rr[1])); }
    { auto rr = __builtin_amdgcn_permlane32_swap(__float_as_uint(mx), __float_as_uint(mx), false, false); mx = fmaxf(__uint_as_float(rr[0]), __uint_as_float(rr[1])); }
    const float ex = expf(lg - mx);
    float sum = ex;
    sum += dpp_mov<0x124>(sum); sum += dpp_mov<0x128>(sum);
    { auto rr = __builtin_amdgcn_permlane16_swap(__float_as_uint(sum), __float_as_uint(sum), false, false); sum = __uint_as_float(rr[0]) + __uint_as_float(rr[1]); }
    { auto rr = __builtin_amdgcn_permlane32_swap(__float_as_uint(sum), __float_as_uint(sum), false, false); sum = __uint_as_float(rr[0]) + __uint_as_float(rr[1]); }
    if ((lane & 3) == 0) {
      const float a = ex / sum; const int e = 8 * (lane >> 5) + 4 * ((lane >> 4) & 1) + 2 * ((lane >> 3) & 1) + ((lane >> 2) & 1);
      if (row < NLAT) { const int b = row / SEQ, t = row % SEQ; aff[((size_t)(b * NE + e)) * SEQ + t] = a; }
      else { const int jj = row - NLAT, b = jj / CTX, t = jj % CTX; aff[(size_t)NB * NE * SEQ + ((size_t)(b * NE + e)) * CTX + t] = a; }
    }
#pragma unroll
    for (int j = 0; j < 4; ++j) { xv[j] = xn[j]; xn[j] = xm[j]; }
    row = nrow;
  }
  __syncthreads();
}

__device__ __forceinline__ void phase_norm2m(Frame& F, int layer) {
  const Params P = lds_params(F);
  const float* g = P.in[7] + layer * DM; const float* modl = (const float*)(P.ws + WS_MODV) + (size_t)layer * 3 * NMOD;
  const float* rw = P.in[19] + (size_t)layer * DM * NE;
  const bf16_t* xsb = (const bf16_t*)(P.ws + WS_XSB); unsigned char* HB8 = (unsigned char*)(P.ws + WS_HB); float* aff = (float*)(P.ws + WS_AFF);
  const int lane = F.lane, tid = F.tid;
  LAS unsigned char* WB = F.lds;
  LAS float* GA = (LAS float*)(F.lds + 65536);
  const int i = lane & 15, kq = lane >> 4;
  int blk = F.bid * 8 + F.wave;
  u32x4 xr[32];
  if (blk < NLAT / 16) { const bf16_t* xp0 = xsb + (size_t)(blk * 16 + i) * DM + 8 * kq;
#pragma unroll
    for (int s_ = 0; s_ < 32; ++s_) xr[s_] = *(const u32x4*)(xp0 + 32 * s_); }
  __syncthreads();
  for (int idx = tid; idx < 32 * 64; idx += NTHREADS) { const int s_ = idx >> 6, ln = idx & 63, n = ln & 15, kq_ = ln >> 4;
    u32x4 hi4, lo4;
#pragma unroll
    for (int e2 = 0; e2 < 4; ++e2) { const float w0 = rw[(size_t)(32 * s_ + 8 * kq_ + 2 * e2) * NE + n], w1 = rw[(size_t)(32 * s_ + 8 * kq_ + 2 * e2 + 1) * NE + n];
      const bf16_t h0 = f2bf(w0), h1 = f2bf(w1); hi4[e2] = (unsigned)h0 | ((unsigned)h1 << 16); lo4[e2] = pk2bf(w0 - bf2f(h0), w1 - bf2f(h1)); }
    *(LAS u32x4*)(WB + ((s_ * 2 + 0) * 64 + ln) * 16) = hi4; *(LAS u32x4*)(WB + ((s_ * 2 + 1) * 64 + ln) * 16) = lo4; }
  for (int idx = tid; idx < NB * DM; idx += NTHREADS) { const int v = idx / DM, c = idx % DM; const float* shp = modl + v * NMOD + 3 * DM;
    GA[(v * 2 + 0) * DM + c] = g[c] * (shp[DM + c] + 1.f); GA[(v * 2 + 1) * DM + c] = shp[c]; }
  __syncthreads();
  for (; blk < NLAT / 16; blk += F.G * 8) {
    const int row = blk * 16 + i, v = (blk * 16) / SEQ;
    float ss = 0.f;
#pragma unroll
    for (int s_ = 0; s_ < 32; ++s_) {
#pragma unroll
      for (int e2 = 0; e2 < 4; ++e2) { const float a = __uint_as_float(xr[s_][e2] << 16), b = __uint_as_float(xr[s_][e2] & 0xffff0000u); ss += a * a + b * b; } }
    { auto rr = __builtin_amdgcn_permlane16_swap(__float_as_uint(ss), __float_as_uint(ss), false, false); ss = __uint_as_float(rr[0]) + __uint_as_float(rr[1]); }
    { auto rr = __builtin_amdgcn_permlane32_swap(__float_as_uint(ss), __float_as_uint(ss), false, false); ss = __uint_as_float(rr[0]) + __uint_as_float(rr[1]); }
    const float inv = rsqrtf(ss * (1.f / DM) + EPS);
    f32x4 acc = {0.f, 0.f, 0.f, 0.f};
    unsigned char* orow = HB8 + (size_t)row * DM + 8 * kq;
    const LAS float* gap = GA + (v * 2) * DM + 8 * kq; const LAS float* sbp = gap + DM;
    const LAS unsigned char* wbp = WB + lane * 16;
#pragma unroll
    for (int s_ = 0; s_ < 32; ++s_) {
      const f32x4 ga0 = *(const LAS f32x4*)(gap + 32 * s_), ga1 = *(const LAS f32x4*)(gap + 32 * s_ + 4), sb0 = *(const LAS f32x4*)(sbp + 32 * s_), sb1 = *(const LAS f32x4*)(sbp + 32 * s_ + 4);
      u32x4 w = xr[s_]; asm volatile("" : "+v"(w));
      float h[8];
#pragma unroll
      for (int e2 = 0; e2 < 4; ++e2) { const float gA = e2 < 2 ? ga0[2 * e2] : ga1[2 * e2 - 4], gB = e2 < 2 ? ga0[2 * e2 + 1] : ga1[2 * e2 - 3], sA = e2 < 2 ? sb0[2 * e2] : sb1[2 * e2 - 4], sB = e2 < 2 ? sb0[2 * e2 + 1] : sb1[2 * e2 - 3];
        h[2 * e2] = __uint_as_float(w[e2] << 16) * inv * gA + sA; h[2 * e2 + 1] = __uint_as_float(w[e2] & 0xffff0000u) * inv * gB + sB; }
      { u32x2 o; o.x = pk4fp8(h[0], h[1], h[2], h[3]); o.y = pk4fp8(h[4], h[5], h[6], h[7]); *(u32x2*)(orow + 32 * s_) = o; }
      u32x4 ah, al;
#pragma unroll
      for (int e2 = 0; e2 < 4; ++e2) { const unsigned hw = att::cvtpk(h[2 * e2], h[2 * e2 + 1]); ah[e2] = hw;
        al[e2] = att::cvtpk(h[2 * e2] - __uint_as_float(hw << 16), h[2 * e2 + 1] - __uint_as_float(hw & 0xffff0000u)); }
      const bf16x8 bhi = *(const LAS bf16x8*)(wbp + (s_ * 2) * 1024), blo = *(const LAS bf16x8*)(wbp + (s_ * 2 + 1) * 1024);
      const bf16x8 ahi = __builtin_bit_cast(bf16x8, ah), alo = __builtin_bit_cast(bf16x8, al);
      acc = __builtin_amdgcn_mfma_f32_16x16x32_bf16(ahi, bhi, acc, 0, 0, 0);
      acc = __builtin_amdgcn_mfma_f32_16x16x32_bf16(alo, bhi, acc, 0, 0, 0);
      acc = __builtin_amdgcn_mfma_f32_16x16x32_bf16(ahi, blo, acc, 0, 0, 0);
      __builtin_amdgcn_sched_barrier(0);
    }
    const int jx = lane & 15, rg = lane >> 4;
#pragma unroll
    for (int r = 0; r < 4; ++r) {
      const float lg = acc[r];
      float mx = lg; mx = fmaxf(mx, dpp_mov<0xB1>(mx)); mx = fmaxf(mx, dpp_mov<0x4E>(mx)); mx = fmaxf(mx, dpp_mov<0x124>(mx)); mx = fmaxf(mx, dpp_mov<0x128>(mx));
      const float ex = expf(lg - mx);
      float sum = ex; sum += dpp_mov<0xB1>(sum); sum += dpp_mov<0x4E>(sum); sum += dpp_mov<0x124>(sum); sum += dpp_mov<0x128>(sum);
      const int rowg = blk * 16 + 4 * rg + r, b = rowg / SEQ, t = rowg % SEQ;
      aff[((size_t)(b * NE + jx)) * SEQ + t] = ex / sum;
    }
    if (blk + F.G * 8 < NLAT / 16) { const bf16_t* xpn = xsb + (size_t)((blk + F.G * 8) * 16 + i) * DM + 8 * kq;
#pragma unroll
      for (int s_ = 0; s_ < 32; ++s_) xr[s_] = *(const u32x4*)(xpn + 32 * s_); }
  }
  __syncthreads();
}

__device__ __forceinline__ void phase_preup(Frame& F) {
  const Params P = lds_params(F);
  const bf16_t* Pm = (const bf16_t*)(P.ws + WS_PB); bf16_t* QKN = (bf16_t*)(P.ws + WS_QN); bf16_t* CAT = (bf16_t*)(P.ws + WS_CAT);
  bf16_t* Kk = (bf16_t*)(P.ws + WS_QKV + OFF_K); const float* tab = (const float*)(P.ws + WS_ROPE);
  const float* cw = P.in[9]; const float* cb = P.in[10]; const float* qg = P.in[11]; const float* kg = P.in[13];
  const int lane = F.lane;
  const f32x4 gq = *(const f32x4*)(qg + 4 * lane); const float gk0 = kg[2 * lane], gk1 = kg[2 * lane + 1];
  float cw0[8], cw1[8], cw2[8], cbv[8];
#pragma unroll
  for (int i = 0; i < 8; ++i) { cw0[i] = cw[8 * lane + i]; cw1[i] = cw[512 + 8 * lane + i]; cw2[i] = cw[1024 + 8 * lane + i]; cbv[i] = cb[8 * lane + i]; }
  for (int row = F.bid * 8 + F.wave; row < NROW; row += F.G * 8) {
    const bf16_t* pr = Pm + (size_t)row * PPITCH;
    const bool lat = row < NLAT; int b, pos, t = 0, lo, hi;
    if (lat) { b = row / SEQ; t = row % SEQ; pos = CTX + t; lo = b * SEQ; hi = lo + SEQ; } else { const int j = row - NLAT; b = j / CTX; pos = j % CTX; lo = NLAT + b * CTX; hi = lo + CTX; }
    { const u32x2 qw = *(const u32x2*)(pr + 1536 + 4 * lane); const unsigned kw = *(const unsigned*)(pr + 1792 + 2 * lane);
      const float q0 = bf2f((bf16_t)(qw.x & 0xffff)), q1 = bf2f((bf16_t)(qw.x >> 16)), q2 = bf2f((bf16_t)(qw.y & 0xffff)), q3 = bf2f((bf16_t)(qw.y >> 16));
      const float k0 = bf2f((bf16_t)(kw & 0xffff)), k1 = bf2f((bf16_t)(kw >> 16));
      const float sq = wave_sum((q0 * q0 + q1 * q1) + (q2 * q2 + q3 * q3)), sk = wave_sum(k0 * k0 + k1 * k1);
      const float iq = rsqrtf(sq * (1.f / 256.f) + EPS), ik = rsqrtf(sk * (1.f / 128.f) + EPS);
      unsigned char* qrow = (unsigned char*)QKN + (size_t)row * 512;
      *(unsigned*)(qrow + 4 * lane) = pk4fp8(q0 * iq * gq[0], q1 * iq * gq[1], q2 * iq * gq[2], q3 * iq * gq[3]);
      *(unsigned short*)(qrow + 256 + 2 * lane) = (unsigned short)__builtin_amdgcn_cvt_pk_fp8_f32(k0 * ik * gk0, k1 * ik * gk1, 0, false);
      if (lane < 32) *(unsigned*)(qrow + 384 + 4 * lane) = 0u; }
    { const int p = lane & 15, a = p >> 3, ii = p & 7, hq = lane >> 4;
      const float x1 = bf2f(pr[1920 + a * 16 + ii]), x2 = bf2f(pr[1920 + a * 16 + 8 + ii]);
      float cs = 1.f, sn = 0.f;
      if (lat) { const int pp = a == 0 ? (t >> 6) : (t & 63); cs = tab[pp * 8 + ii]; sn = tab[2048 + pp * 8 + ii]; }
      const unsigned short w = (unsigned short)__builtin_amdgcn_cvt_pk_fp8_f32(x1 * cs - x2 * sn, x1 * sn + x2 * cs, 0, false);
#pragma unroll
      for (int hh = 0; hh < 2; ++hh) { const int h = 2 * hq + hh;
        *(unsigned short*)((char*)Kk + (size_t)(b * 8 + h) * NKEY * 96 + (size_t)(pos >> 6) * 6144 + (4 + (p >> 3)) * 1024 + (pos & 63) * 16 + (p & 7) * 2) = w; } }
    { const int c = 8 * lane;
      const u32x4 gbv = *(const u32x4*)(pr + c), gc1 = *(const u32x4*)(pr + 512 + c), u1 = *(const u32x4*)(pr + 1024 + c);
      u32x4 gc0 = {0u, 0u, 0u, 0u}, u0 = gc0, gc2 = gc0, u2 = gc0;
      if (row - 1 >= lo) { gc0 = *(const u32x4*)(pr - PPITCH + 512 + c); u0 = *(const u32x4*)(pr - PPITCH + 1024 + c); }
      if (row + 1 < hi) { gc2 = *(const u32x4*)(pr + PPITCH + 512 + c); u2 = *(const u32x4*)(pr + PPITCH + 1024 + c); }
      float y[8];
#pragma unroll
      for (int i = 0; i < 8; ++i) {
        const int sh = (i & 1) * 16; const int wi = i >> 1;
        const float z0 = bf2f((bf16_t)((gc0[wi] >> sh) & 0xffff)) * bf2f((bf16_t)((u0[wi] >> sh) & 0xffff));
        const float z1 = bf2f((bf16_t)((gc1[wi] >> sh) & 0xffff)) * bf2f((bf16_t)((u1[wi] >> sh) & 0xffff));
        const float z2 = bf2f((bf16_t)((gc2[wi] >> sh) & 0xffff)) * bf2f((bf16_t)((u2[wi] >> sh) & 0xffff));
        const float yy = z0 * cw0[i] + z1 * cw1[i] + z2 * cw2[i] + cbv[i];
        y[i] = bf2f((bf16_t)((gbv[wi] >> sh) & 0xffff)) * yy;
      }
      u32x4 w; w.x = pk2bf(y[0], y[1]); w.y = pk2bf(y[2], y[3]); w.z = pk2bf(y[4], y[5]); w.w = pk2bf(y[6], y[7]);
      *(u32x4*)(CAT + (size_t)row * DM + c) = w; }
  }
}

template <bool PROBE = false>
__device__ __forceinline__ void phase_combine(Frame& F, int layer) {
  const Params P = lds_params(F);
  const float* modv = (const float*)(P.ws + WS_MODV); const float* modl = modv + (size_t)layer * 3 * NMOD;
  const bf16_t* YE = (const bf16_t*)(P.ws + WS_QKV); const int* slot = (const int*)(P.ws + WS_SLOT);
  bf16_t* xsb = (bf16_t*)(P.ws + WS_XSB); float* xcx = (float*)(P.ws + WS_XC); bf16_t* HB = (bf16_t*)(P.ws + WS_HB);
  const int nrows = layer == 0 ? NROW : NLAT, lane = F.lane, stride = F.G * 8;
#define CB_SLOT(r) (((r) < NLAT) ? slot[((size_t)(((r) / SEQ) * NE + (lane & 15))) * SEQ + (r) % SEQ] \
                                 : slot[(size_t)NB * NE * SEQ + ((size_t)((((r) - NLAT) / CTX) * NE + (lane & 15))) * CTX + ((r) - NLAT) % CTX])
  int row = F.bid * 8 + F.wave;
  f32x4 xv[4], xn[4]; int sl = -1, sln = -1;
  int cv = -1; f32x4 g2v[4], ga[4], sb[4];
  if (row < nrows) { sl = CB_SLOT(row); xs_load(xsb, xcx, row, lane, xv); }
  while (row < nrows) {
    const int nrow = row + stride;
    if (nrow < nrows) { sln = CB_SLOT(nrow); xs_load(xsb, xcx, nrow, lane, xn); }
    int v; size_t ybase; int cap;
    if (row < NLAT) { const int b = row / SEQ; v = b; cap = CAP_L; ybase = (size_t)(b * NE) * CAP_L; }
    else { const int b = (row - NLAT) / CTX; v = 2; cap = CAP_C; ybase = (size_t)32 * CAP_L + (size_t)(b * NE) * CAP_C; }
    f32x4 acc[4];
#pragma unroll
    for (int j = 0; j < 4; ++j) acc[j] = (f32x4){0.f, 0.f, 0.f, 0.f};
    unsigned emask = (unsigned)(__ballot(sl >= 0) & 0xFFFFull);
    while (emask) {
      int ee[4]; u32x2 w[4][4];
#pragma unroll
      for (int k = 0; k < 4; ++k) { ee[k] = emask ? __builtin_ctz(emask) : -1; if (emask) emask &= emask - 1; }
#pragma unroll
      for (int k = 0; k < 4; ++k) if (ee[k] >= 0) { const int s_ = __builtin_amdgcn_readlane(sl, ee[k]); const bf16_t* yr = YE + (ybase + (size_t)ee[k] * cap + s_) * DM;
#pragma unroll
        for (int j = 0; j < 4; ++j) w[k][j] = *(const u32x2*)(yr + 4 * lane + 256 * j); }
#pragma unroll
      for (int k = 0; k < 4; ++k) if (ee[k] >= 0) {
#pragma unroll
        for (int j = 0; j < 4; ++j) { acc[j][0] += bf2f((bf16_t)(w[k][j].x & 0xffff)); acc[j][1] += bf2f((bf16_t)(w[k][j].x >> 16)); acc[j][2] += bf2f((bf16_t)(w[k][j].y & 0xffff)); acc[j][3] += bf2f((bf16_t)(w[k][j].y >> 16)); } }
    }
    if (v != cv) { cv = v;
      const float* m1 = modv + 3 * NMOD + v * NMOD;
#pragma unroll
      for (int j = 0; j < 4; ++j) { const int c = 4 * lane + 256 * j; g2v[j] = *(const f32x4*)(modl + v * NMOD + 5 * DM + c);
        if (layer == 0) { ga[j] = *(const f32x4*)(P.in[6] + DM + c) * (*(const f32x4*)(m1 + DM + c) + 1.f); sb[j] = *(const f32x4*)(m1 + c); }
        else ga[j] = *(const f32x4*)(P.in[23] + c); } }
#pragma unroll
    for (int j = 0; j < 4; ++j) xv[j] = xv[j] + g2v[j] * acc[j];
    const float inv = rsqrtf(row_ssq(xv) * (1.f / DM) + EPS);
    if (layer == 0) {
      if (PROBE) { }
      else if (row < NLAT) {
#pragma unroll
        for (int j = 0; j < 4; ++j) { u32x2 w; w.x = pk2bf(xv[j][0], xv[j][1]); w.y = pk2bf(xv[j][2], xv[j][3]); *(u32x2*)(xsb + (size_t)row * DM + 4 * lane + 256 * j) = w; } }
      else {
#pragma unroll
        for (int j = 0; j < 4; ++j) *(f32x4*)(xcx + (size_t)(row - NLAT) * DM + 4 * lane + 256 * j) = xv[j]; }
#pragma unroll
      for (int j = 0; j < 4; ++j) xv[j] = xv[j] * inv * ga[j] + sb[j];
      if (PROBE) { }
      else if (row < NLAT) { unsigned char* orow = (unsigned char*)HB + (size_t)row * DM;
#pragma unroll
        for (int j = 0; j < 4; ++j) *(unsigned*)(orow + 4 * lane + 256 * j) = pk4fp8(xv[j][0], xv[j][1], xv[j][2], xv[j][3]); }
      else { bf16_t* orow = HB + (size_t)row * DM;
#pragma unroll
        for (int j = 0; j < 4; ++j) { u32x2 w; w.x = pk2bf(xv[j][0], xv[j][1]); w.y = pk2bf(xv[j][2], xv[j][3]); *(u32x2*)(orow + 4 * lane + 256 * j) = w; } }
    } else {
      float* op = (PROBE ? (float*)(P.ws + WS_PB) : P.out) + (size_t)row * DM;
#pragma unroll
      for (int j = 0; j < 4; ++j) *(f32x4*)(op + 4 * lane + 256 * j) = xv[j] * inv * ga[j];
    }
#pragma unroll
    for (int j = 0; j < 4; ++j) xv[j] = xn[j];
    sl = sln; row = nrow;
  }
#undef CB_SLOT
}

__device__ __forceinline__ unsigned block_sum_u(unsigned v, LAS unsigned* red, int par, int wave, int lane) {
  v = (unsigned)wave_sum((float)v);
  if (lane == 0) red[par * 8 + wave] = v;
  __syncthreads();
  unsigned s = 0;
#pragma unroll
  for (int i = 0; i < 8; ++i) s += red[par * 8 + i];
  return s;
}
__device__ __forceinline__ void phase_topk(Frame& F, int layer) {
  const Params P = lds_params(F);
  const float* aff = (const float*)(P.ws + WS_AFF); int* sidx = (int*)(P.ws + WS_SIDX); float* sg = (float*)(P.ws + WS_SG); int* slot = (int*)(P.ws + WS_SLOT);
  LAS unsigned* red = (LAS unsigned*)F.lds;
  const int nprob = layer == 0 ? 64 : 32, tid = F.tid, lane = F.lane, wave = F.wave;
  for (int pb = F.bid; pb < nprob; pb += F.G) {
    const bool isctx = pb >= 32; const int ge = isctx ? pb - 32 : pb, n = isctx ? CTX : SEQ, cap = isctx ? CAP_C : CAP_L;
    const size_t aoff = isctx ? (size_t)NB * NE * SEQ + (size_t)ge * CTX : (size_t)ge * SEQ;
    const size_t soff = isctx ? (size_t)NB * NE * CAP_L + (size_t)ge * CAP_C : (size_t)ge * CAP_L;
    unsigned key[32];
#pragma unroll
    for (int j = 0; j < 8; ++j) {
      u32x4 w = {0u, 0u, 0u, 0u};
      if (32 * tid + 4 * j < n) w = *(const u32x4*)(aff + aoff + 32 * tid + 4 * j);
      key[4 * j] = w.x; key[4 * j + 1] = w.y; key[4 * j + 2] = w.z; key[4 * j + 3] = w.w;
    }
    __syncthreads();
    unsigned T = 0u; int par = 0;
    for (int bit = 30; bit >= 0; --bit) {
      const unsigned cand = T | (1u << bit);
      unsigned c = 0;
#pragma unroll
      for (int i = 0; i < 32; ++i) c += (key[i] >= cand) ? 1u : 0u;
      const unsigned tot = block_sum_u(c, red, par, wave, lane); par = (par + 1) & 3;
      if (tot >= (unsigned)cap) T = cand;
    }
    unsigned cg = 0, ce = 0;
#pragma unroll
    for (int i = 0; i < 32; ++i) { cg += (key[i] > T) ? 1u : 0u; ce += (key[i] == T) ? 1u : 0u; }
    const unsigned ngt = block_sum_u(cg, red, par, wave, lane); par = (par + 1) & 3;
    const unsigned need_eq = (unsigned)cap - ngt;
    unsigned pk = cg | (ce << 16), inc = pk;
#pragma unroll
    for (int o = 1; o < 64; o <<= 1) { const unsigned up = __shfl_up(inc, o); if (lane >= o) inc += up; }
    LAS unsigned* wtot = red + 32;
    __syncthreads();
    if (lane == 63) wtot[wave] = inc;
    __syncthreads();
    unsigned base = 0;
#pragma unroll
    for (int i = 0; i < 8; ++i) base += (i < wave) ? wtot[i] : 0u;
    unsigned excl = base + inc - pk;
    unsigned g_before = excl & 0xffffu, e_before = excl >> 16;
    int sl[32];
#pragma unroll
    for (int i = 0; i < 32; ++i) {
      const bool gt = key[i] > T, eq = key[i] == T;
      const bool take = gt || (eq && e_before < need_eq);
      const unsigned s = g_before + (e_before < need_eq ? e_before : need_eq);
      sl[i] = take ? (int)s : -1;
      if (take) { sidx[soff + s] = 32 * tid + i; sg[soff + s] = __uint_as_float(key[i]); }
      g_before += gt ? 1u : 0u; e_before += eq ? 1u : 0u;
    }
    if (32 * tid < n) {
#pragma unroll
      for (int j = 0; j < 8; ++j) { int4 w; w.x = sl[4 * j]; w.y = sl[4 * j + 1]; w.z = sl[4 * j + 2]; w.w = sl[4 * j + 3]; *(int4*)(slot + aoff + 32 * tid + 4 * j) = w; }
    }
    __syncthreads();
  }
  __syncthreads();
#ifndef CVT_SMALL
  if (F.G == 256 && F.bid >= 32) cvt_run_list(P, (LAS unsigned*)(F.lds + 1024), F.bid - 32, F.G - 32, 512, CvtMapRest{layer ? 8 : 2});
  return;
  if (F.G > 32) { if (F.bid >= 32) cvt_run_big(P, (LAS unsigned*)(F.lds + 1024), layer, F.bid - 32, F.G - 32); }
  else cvt_run_big(P, (LAS unsigned*)(F.lds + 1024), layer, F.bid, F.G);
  return;
#endif
  if (F.G > 32) { if (F.bid >= 32) { cvt_run<true>(P, (LAS float*)(F.lds + 1024), layer, F.bid - 32, F.G - 32, CVT_MOE);
#ifdef PROBE_CVT2
      __syncthreads(); cvt_run<true>(P, (LAS float*)(F.lds + 1024), layer, F.bid - 32, F.G - 32, CVT_MOE);
#endif
  } }
  else cvt_run<true>(P, (LAS float*)(F.lds + 1024), layer, F.bid, F.G, CVT_MOE);
}

__device__ __forceinline__ void rope4(f32x4& v0, f32x4& v1, const f32x4 cs, const f32x4 sn) {
  f32x4 w0, w1;
  w0[0] = v0[0] * cs[0] - v0[1] * sn[0]; w0[1] = v0[0] * sn[0] + v0[1] * cs[0]; w0[2] = v0[2] * cs[1] - v0[3] * sn[1]; w0[3] = v0[2] * sn[1] + v0[3] * cs[1];
  w1[0] = v1[0] * cs[2] - v1[1] * sn[2]; w1[1] = v1[0] * sn[2] + v1[1] * cs[2]; w1[2] = v1[2] * cs[3] - v1[3] * sn[3]; w1[3] = v1[2] * sn[3] + v1[3] * cs[3];
  v0 = w0; v1 = w1;
}
__device__ __forceinline__ int v_img(int k, int c) { const int kk = (k & ~0xC) | ((k & 4) << 1) | ((k & 8) >> 1); return ((kk >> 3) * 2 + (c >> 5)) * 512 + ((kk & 7) * 32 + (c & 31)) * 2; }
template <int KIND, bool ROT>
__device__ __forceinline__ void up_store(const f32x4 (&acc)[2][2][4][2], const int bj, char* base, const int pos0, const int dd, const float* tabp, const int tl, const int a) {
#pragma unroll
  for (int ai = 0; ai < 2; ++ai)
#pragma unroll
    for (int m = 0; m < 4; ++m) {
      const int ro = ai * 128 + m * 16;
      f32x4 v0 = acc[ai][bj][m][0], v1 = acc[ai][bj][m][1];
      if (ROT) { const int t = tl + ro; const int pp = a == 0 ? (t >> 6) : (t & 63); rope4(v0, v1, *(const f32x4*)(tabp + pp * 8), *(const f32x4*)(tabp + 2048 + pp * 8)); }
      const int pos = pos0 + ro;
      if (KIND == 2) {
        const unsigned w0 = pk4fp8(v0[0], v0[1], v0[2], v0[3]), w1 = pk4fp8(v1[0], v1[1], v1[2], v1[3]);
        const int qi = pos & 3; const unsigned sel = (unsigned)qi | ((unsigned)(4 + qi) << 8);
        unsigned o[2];
#pragma unroll
        for (int e = 0; e < 2; ++e) { const unsigned w = e ? w1 : w0;
          const unsigned t0 = (unsigned)__builtin_amdgcn_update_dpp(0, (int)w, 0x00, 0xF, 0xF, false), t1 = (unsigned)__builtin_amdgcn_update_dpp(0, (int)w, 0x55, 0xF, 0xF, false);
          const unsigned t2 = (unsigned)__builtin_amdgcn_update_dpp(0, (int)w, 0xAA, 0xF, 0xF, false), t3 = (unsigned)__builtin_amdgcn_update_dpp(0, (int)w, 0xFF, 0xF, 0xF, false);
          const unsigned x01 = __builtin_amdgcn_perm(t1, t0, sel), x23 = __builtin_amdgcn_perm(t3, t2, sel);
          o[e] = (x01 & 0xffffu) | (x23 << 16); }
        const int kk = pos & 63, a_ = kk >> 5, hi_ = (kk >> 2) & 1, j_ = (kk & 31) >> 3;
        char* tb = base + (size_t)(pos >> 6) * 4096 + (a_ * 2 + hi_) * 512 + j_ * 4;
#pragma unroll
        for (int e = 0; e < 2; ++e) { const int d = dd + 4 * e + qi; *(unsigned*)(tb + (d >> 5) * 2048 + (d & 31) * 16) = o[e]; } }
      else { u32x2 w; w.x = pk4fp8(v0[0], v0[1], v0[2], v0[3]); w.y = pk4fp8(v1[0], v1[1], v1[2], v1[3]);
        char* dst = KIND == 0 ? base + (size_t)pos * 96 + dd : base + (size_t)(pos >> 6) * 6144 + (dd >> 4) * 1024 + (pos & 63) * 16 + (dd & 15);
        *(u32x2*)dst = w; }
    }
}
struct EpiUp {
  static constexpr bool PERM = true;
  bf16_t* Q; bf16_t* QC; bf16_t* K; bf16_t* V; const float* tab;
  __device__ __forceinline__ void operator()(const f32x4 (&acc)[2][2][4][2], const pg8::Unit& u, int wr, int wc, int fr, int fq) const {
    const int trow0 = u.pm * 256; const bool isctx = trow0 >= NLAT;
    const int b = isctx ? (trow0 - NLAT) / CTX : trow0 / SEQ;
    const int tl = (isctx ? 0 : trow0 % SEQ) + wr * 64 + fr;
#pragma unroll
    for (int bj = 0; bj < 2; ++bj) {
      const int cg = u.pn * 256 + bj * 128 + wc * 32;
      if (cg < 768) { const int h = cg / 96, ddg = cg % 96;
        char* base = isctx ? (char*)QC + (size_t)(b * 8 + h) * CTX * 96 : (char*)Q + (size_t)(b * 8 + h) * SEQ * 96;
        if (ddg >= 64 && !isctx) up_store<0, true>(acc, bj, base, tl, ddg + 8 * fq, tab + ((4 * fq) & 7), tl, (4 * fq) >> 3);
        else up_store<0, false>(acc, bj, base, tl, ddg + 8 * fq, tab, tl, 0); }
      else { const int j = cg - 768, h = j >> 7, ddg = j & 127; const int pos0 = (isctx ? 0 : CTX) + tl;
        if (ddg < 64) up_store<1, false>(acc, bj, (char*)K + (size_t)(b * 8 + h) * NKEY * 96, pos0, ddg + 8 * fq, tab, tl, 0);
        else up_store<2, false>(acc, bj, (char*)V + (size_t)(b * 8 + h) * NKEY * 64, pos0, (ddg - 64) + 8 * fq, tab, tl, 0); }
    }
  }
};
struct EpiQkv2 {
  static constexpr bool PERM = true;
  bf16_t* Q2; bf16_t* K2; bf16_t* V2; const float* tab;
  __device__ __forceinline__ void operator()(const f32x4 (&acc)[2][2][4][2], const pg8::Unit& u, int wr, int wc, int fr, int fq) const {
    const int trow0 = u.pm * 256; const bool isctx = trow0 >= NLAT;
    const int b = isctx ? (trow0 - NLAT) / CTX : trow0 / SEQ;
    const int tl = (isctx ? 0 : trow0 % SEQ) + wr * 64 + fr;
#pragma unroll
    for (int bj = 0; bj < 2; ++bj) {
      const int cg = u.pn * 256 + bj * 128 + wc * 32;
      if (isctx && cg < 1024) continue;
      const int hh = cg >> 6, dd = (cg & 63) + 8 * fq; const int pos = (isctx ? 0 : CTX) + tl;
      const bool rot = (cg < 1280) && !isctx;
      const int kind = cg < 1024 ? 0 : (cg < 1280 ? 1 : 2);
      char* dst0;
      if (kind == 0) dst0 = (char*)Q2 + ((size_t)(b * 16 + hh) * SEQ + tl) * 64 + dd;
      else if (kind == 1) dst0 = (char*)K2 + (size_t)(b * 4 + hh - 16) * NKEY * 64;
      else dst0 = (char*)V2 + (size_t)(b * 4 + hh - 20) * NKEY * 64;
      const int p0 = dd >> 1, a = p0 >> 4, i0 = p0 & 15;
#pragma unroll
      for (int ai = 0; ai < 2; ++ai)
#pragma unroll
        for (int m = 0; m < 4; ++m) {
          const int ro = ai * 128 + m * 16;
          f32x4 v0 = acc[ai][bj][m][0], v1 = acc[ai][bj][m][1];
          if (rot) { const int t = tl + ro; const int pp = a == 0 ? (t >> 6) : (t & 63);
            rope4(v0, v1, *(const f32x4*)(tab + 4096 + pp * 16 + i0), *(const f32x4*)(tab + 8192 + pp * 16 + i0)); }
          const int ps = pos + ro;
          const unsigned w0 = pk4fp8(v0[0], v0[1], v0[2], v0[3]), w1 = pk4fp8(v1[0], v1[1], v1[2], v1[3]);
          if (kind < 2) { u32x2 w; w.x = w0; w.y = w1;
            char* dst = kind == 0 ? dst0 + (size_t)ro * 64 : dst0 + (size_t)(ps >> 6) * 4096 + (dd >> 4) * 1024 + (ps & 63) * 16 + (dd & 15);
            *(u32x2*)dst = w; }
          else {
            const int qi = ps & 3; const unsigned sel = (unsigned)qi | ((unsigned)(4 + qi) << 8);
            const int kk = ps & 63, a_ = kk >> 5, hi_ = (kk >> 2) & 1, j_ = (kk & 31) >> 3;
            char* tb = dst0 + (size_t)(ps >> 6) * 4096 + (a_ * 2 + hi_) * 512 + j_ * 4;
#pragma unroll
            for (int e = 0; e < 2; ++e) { const unsigned w = e ? w1 : w0;
              const unsigned t0 = (unsigned)__builtin_amdgcn_update_dpp(0, (int)w, 0x00, 0xF, 0xF, false), t1 = (unsigned)__builtin_amdgcn_update_dpp(0, (int)w, 0x55, 0xF, 0xF, false);
              const unsigned t2 = (unsigned)__builtin_amdgcn_update_dpp(0, (int)w, 0xAA, 0xF, 0xF, false), t3 = (unsigned)__builtin_amdgcn_update_dpp(0, (int)w, 0xFF, 0xF, 0xF, false);
              const unsigned x01 = __builtin_amdgcn_perm(t1, t0, sel), x23 = __builtin_amdgcn_perm(t3, t2, sel);
              const int d = dd + 4 * e + qi; *(unsigned*)(tb + (d >> 5) * 2048 + (d & 31) * 16) = (x01 & 0xffffu) | (x23 << 16); } }
        }
    }
  }
};

enum { PH_PRO = 0, PH_L0_NORM1, PH_L0_WIN, PH_L0_PREUP, PH_L0_UP, PH_L0_ATTN, PH_L0_WOUT, PH_L0_NORM2, PH_L0_TOPK, PH_L0_GU, PH_L0_DOWN, PH_L0_COMB,
       PH_L1_QKV, PH_L1_ATTN, PH_L1_WOUT, PH_L1_NORM2, PH_L1_TOPK, PH_L1_GU, PH_L1_DOWN, PH_L1_COMB, PH_COUNT };

template <class Epi>
__device__ __forceinline__ void sg_tile(const bf16_t* __restrict__ X, const bf16_t* __restrict__ Wt, const int K, const int row0, const int col0, const int lane, const Epi& E) {
    using att::f32x16;
    const int r32 = lane & 31, hi = lane >> 5;
    const bf16_t* xp = X + (size_t)(row0 + r32) * K + hi * 8;
    const bf16_t* w0 = Wt + (size_t)(col0 + r32) * K + hi * 8;
    f32x16 a0 = {}, a1 = {};
#pragma unroll 16
    for (int s = 0; s < K; s += 32) {
        const bf16x8 x0 = *reinterpret_cast<const bf16x8*>(xp + s), wa = *reinterpret_cast<const bf16x8*>(w0 + s);
        const bf16x8 x1 = *reinterpret_cast<const bf16x8*>(xp + s + 16), wb = *reinterpret_cast<const bf16x8*>(w0 + s + 16);
        a0 = __builtin_amdgcn_mfma_f32_32x32x16_bf16(wa, x0, a0, 0, 0, 0); a1 = __builtin_amdgcn_mfma_f32_32x32x16_bf16(wb, x1, a1, 0, 0, 0);
    }
#pragma unroll
    for (int g = 0; g < 4; ++g)
        E(row0 + r32, col0 + 8 * g + 4 * hi, (f32x4){a0[4 * g] + a1[4 * g], a0[4 * g + 1] + a1[4 * g + 1], a0[4 * g + 2] + a1[4 * g + 2], a0[4 * g + 3] + a1[4 * g + 3]});
}
template <class Epi>
__device__ __forceinline__ void sg_ctx(Frame& F, const bf16_t* X, const bf16_t* Wt, int K, int col_lo, int col_hi, const Epi& E) {
    const int ncb = (col_hi - col_lo) / 32, nu = (NCTX / 32) * ncb;
    for (int u = F.bid + F.wave * F.G; u < nu; u += 8 * F.G) sg_tile(X, Wt, K, NLAT + 32 * (u / ncb), col_lo + 32 * (u % ncb), F.lane, E);
}
struct SgStore { bf16_t* out; int ld; __device__ __forceinline__ void operator()(int row, int col, f32x4 v) const { u32x2 w; w.x = pk2bf(v[0], v[1]); w.y = pk2bf(v[2], v[3]); *(u32x2*)(out + (size_t)row * ld + col) = w; } };
struct SgResidCtx { const float* xin; float* xo; const float* gate;
    __device__ __forceinline__ void operator()(int row, int col, f32x4 v) const { const size_t o = (size_t)(row - NLAT) * DM + col; *(f32x4*)(xo + o) = *(const f32x4*)(xin + o) + *(const f32x4*)(gate + col) * v; } };
struct SgKv2Ctx { char* K2; char* V2;
    __device__ __forceinline__ void operator()(int row, int col, f32x4 v) const {
        const int j = row - NLAT, b = j / CTX, pos = j % CTX, hh = (col - 1024) >> 6, dd = col & 63;
        if (hh < 4) *(unsigned*)(K2 + (size_t)(b * 4 + hh) * NKEY * 64 + (size_t)(pos >> 6) * 4096 + (dd >> 4) * 1024 + (pos & 63) * 16 + (dd & 15)) = pk4fp8(v[0], v[1], v[2], v[3]);
        else { const int kk = pos & 63, a_ = kk >> 5, hi_ = (kk >> 2) & 1, tt = (kk & 3) + 4 * ((kk & 31) >> 3);
          char* tb = V2 + (size_t)(b * 4 + hh - 4) * NKEY * 64 + (size_t)(pos >> 6) * 4096 + (a_ * 2 + hi_) * 512 + tt;
#pragma unroll
          for (int e = 0; e < 4; ++e) { const int d = dd + e; *(unsigned char*)(tb + (d >> 5) * 2048 + (d & 31) * 16) = f2fp8(v[e]); } } } };

__device__ __forceinline__ void sg_tile64(const bf16_t* __restrict__ xr0, const bf16_t* __restrict__ xr1, const bf16_t* __restrict__ Wt, const int K, const int col0, const int lane,
                                          att::f32x16 (&acc)[2][2]) {
    const int r32 = lane & 31, hi = lane >> 5;
    const bf16_t* x0 = xr0 + hi * 8; const bf16_t* x1 = xr1 + hi * 8;
    const bf16_t* w0 = Wt + (size_t)(col0 + r32) * K + hi * 8; const bf16_t* w1 = w0 + (size_t)32 * K;
#pragma unroll
    for (int a = 0; a < 2; ++a)
#pragma unroll
        for (int b = 0; b < 2; ++b) acc[a][b] = att::f32x16{};
#pragma unroll 8
    for (int s = 0; s < K; s += 16) {
        const bf16x8 xa = *reinterpret_cast<const bf16x8*>(x0 + s), xb = *reinterpret_cast<const bf16x8*>(x1 + s);
        const bf16x8 wa = *reinterpret_cast<const bf16x8*>(w0 + s), wb = *reinterpret_cast<const bf16x8*>(w1 + s);
        acc[0][0] = __builtin_amdgcn_mfma_f32_32x32x16_bf16(wa, xa, acc[0][0], 0, 0, 0); acc[0][1] = __builtin_amdgcn_mfma_f32_32x32x16_bf16(wa, xb, acc[0][1], 0, 0, 0);
        acc[1][0] = __builtin_amdgcn_mfma_f32_32x32x16_bf16(wb, xa, acc[1][0], 0, 0, 0); acc[1][1] = __builtin_amdgcn_mfma_f32_32x32x16_bf16(wb, xb, acc[1][1], 0, 0, 0);
    }
}
__device__ __forceinline__ void sg_moe_gu_ctx(Frame& F, const Params& P) {
    const bf16_t* HB = (const bf16_t*)(P.ws + WS_HB); const int* sidx = (const int*)(P.ws + WS_SIDX) + 32 * CAP_L;
    bf16_t* HID = (bf16_t*)(P.ws + WS_PB) + (size_t)32 * CAP_L * DFF;
    const int lane = F.lane, r32 = lane & 31, hi = lane >> 5;
    for (int u = F.bid + F.wave * F.G; u < 16 * 32; u += 8 * F.G) {
        const int e = u >> 5, cb = u & 31;
        const int t0 = sidx[(0 * 16 + e) * CAP_C + r32], t1 = sidx[(1 * 16 + e) * CAP_C + r32];
        att::f32x16 acc[2][2];
        sg_tile64(HB + ((size_t)NLAT + 0 * CTX + t0) * DM, HB + ((size_t)NLAT + 1 * CTX + t1) * DM, (const bf16_t*)(P.ws + WS_W + OFF_WGU) + (size_t)e * 2048 * DM, DM, cb * 64, lane, acc);
#pragma unroll
        for (int rb = 0; rb < 2; ++rb) { bf16_t* hrow = HID + ((size_t)(rb * 16 + e) * CAP_C + r32) * DFF;
#pragma unroll
            for (int c2 = 0; c2 < 2; ++c2)
#pragma unroll
                for (int g = 0; g < 4; ++g) { const int col = cb * 64 + c2 * 32 + 8 * g + 4 * hi;
                    const att::f32x16& a = acc[c2][rb];
                    *(unsigned*)(hrow + (col >> 1)) = pk2bf(silu_f(a[4 * g]) * a[4 * g + 1], silu_f(a[4 * g + 2]) * a[4 * g + 3]); } }
    }
}
__device__ __forceinline__ void sg_moe_down_ctx(Frame& F, const Params& P) {
    const bf16_t* HID = (const bf16_t*)(P.ws + WS_PB) + (size_t)32 * CAP_L * DFF; bf16_t* YE = (bf16_t*)(P.ws + WS_QKV) + (size_t)32 * CAP_L * DM;
    const float* sg = (const float*)(P.ws + WS_SG) + 32 * CAP_L;
    const int lane = F.lane, r32 = lane & 31, hi = lane >> 5;
    for (int u = F.bid + F.wave * F.G; u < 16 * 16; u += 8 * F.G) {
        const int e = u >> 4, cb = u & 15;
        att::f32x16 acc[2][2];
        sg_tile64(HID + ((size_t)(0 * 16 + e) * CAP_C + r32) * DFF, HID + ((size_t)(1 * 16 + e) * CAP_C + r32) * DFF, (const bf16_t*)(P.ws + WS_W + OFF_WD) + (size_t)e * 1024 * DFF, DFF, cb * 64, lane, acc);
#pragma unroll
        for (int rb = 0; rb < 2; ++rb) { const size_t r = (size_t)(rb * 16 + e) * CAP_C + r32; const float gv = sg[r]; bf16_t* yrow = YE + r * DM;
#pragma unroll
            for (int c2 = 0; c2 < 2; ++c2)
#pragma unroll
                for (int g = 0; g < 4; ++g) { const int col = cb * 64 + c2 * 32 + 8 * g + 4 * hi; const att::f32x16& a = acc[c2][rb];
                    u32x2 w; w.x = pk2bf(a[4 * g] * gv, a[4 * g + 1] * gv); w.y = pk2bf(a[4 * g + 2] * gv, a[4 * g + 3] * gv); *(u32x2*)(yrow + col) = w; } }
    }
}

__device__ __forceinline__ void phase_gemm_win(Frame& F) {
    const Params P = lds_params(F);
    pg8::SchedPlain S; S.init(NLAT, 2048, DM, (const bf16_t*)(P.ws + WS_W + OFF_WIN), F.G, F.bid);
    EpiStore E{(bf16_t*)(P.ws + WS_PB), PPITCH};
    pg8::gemm_phase<EpiStore, pg8::SchedPlain, true>(F.lds, (const char*)(P.ws + WS_HB), DM, S, E);
    sg_ctx(F, (const bf16_t*)(P.ws + WS_HB), (const bf16_t*)(P.ws + WS_W + OFF_WIN), DM, 0, 1984, SgStore{(bf16_t*)(P.ws + WS_PB), PPITCH});
}
__device__ __forceinline__ void phase_gemm_up(Frame& F) {
    const Params P = lds_params(F);
    pg8::SchedUp S; S.init(NROW, 1792, 512, (const bf16_t*)(P.ws + WS_W + OFF_WUP), F.G, F.bid);
    EpiUp E{(bf16_t*)(P.ws + WS_QKV + OFF_Q), (bf16_t*)(P.ws + WS_QKV + OFF_QC), (bf16_t*)(P.ws + WS_QKV + OFF_K), (bf16_t*)(P.ws + WS_QKV + OFF_V), (const float*)(P.ws + WS_ROPE)};
    pg8::gemm_phase<EpiUp, pg8::SchedUp, true>(F.lds, (const char*)(P.ws + WS_QN), 512, S, E);
}
__device__ __forceinline__ void phase_gemm_wout(Frame& F, int layer) {
    const Params P = lds_params(F);
    float* modv = (float*)(P.ws + WS_MODV); float* xc = (float*)(P.ws + WS_XC);
    if (layer == 0) {
        pg8::SchedPlain S; S.init(NLAT, DM, DM, (const bf16_t*)(P.ws + WS_W + OFF_WOUT), F.G, F.bid);
        EpiResidB<true> E{P.in[0], (bf16_t*)(P.ws + WS_XSB), modv, 2 * DM};
        pg8::gemm_phase<EpiResidB<true>, pg8::SchedPlain, true>(F.lds, (const char*)(P.ws + WS_CAT), DM, S, E);
        sg_ctx(F, (const bf16_t*)(P.ws + WS_CAT), (const bf16_t*)(P.ws + WS_W + OFF_WOUT), DM, 0, DM, SgResidCtx{P.in[2], xc, modv + 2 * NMOD + 2 * DM});
    } else {
        pg8::SchedPlainT<1, 0x7B7B7B7B> S; S.init(NLAT, DM, DM, (const bf16_t*)(P.ws + WS_W + OFF_WSO), F.G, F.bid);
        EpiResidB<false> E{nullptr, (bf16_t*)(P.ws + WS_XSB), modv + 3 * NMOD, 2 * DM};
        pg8::gemm_phase<EpiResidB<false>, pg8::SchedPlainT<1, 0x7B7B7B7B>, true>(F.lds, (const char*)(P.ws + WS_CAT), DM, S, E);
    }
}
__device__ __forceinline__ void phase_gemm_gu(Frame& F, int layer) {
    const Params P = lds_params(F);
    SchedMoeGU S; S.init((const int*)(P.ws + WS_SIDX), (const bf16_t*)(layer ? P.ws + WS_W2 : P.ws + WS_W + OFF_WGU), F.G, F.bid, layer == 0);
    EpiHidMk E{(bf16_t*)(P.ws + WS_PB)};
    pg8::gemm_phase<EpiHidMk, SchedMoeGU, true>(F.lds, (const char*)(P.ws + WS_HB), DM, S, E);
}
__device__ __forceinline__ void phase_gemm_down(Frame& F, int layer) {
    const Params P = lds_params(F);
    SchedMoeDown S; S.init((const bf16_t*)(layer ? P.ws + WS_W2 + W2_WD : P.ws + WS_W + OFF_WD), F.G, F.bid, layer == 0);
    EpiYeMk E{(bf16_t*)(P.ws + WS_QKV), (const float*)(P.ws + WS_SG)};
    pg8::gemm_phase<EpiYeMk, SchedMoeDown, true>(F.lds, (const char*)(P.ws + WS_PB), DFF, S, E);
}
__device__ __forceinline__ void phase_gemm_qkv2(Frame& F) {
    const Params P = lds_params(F);
    pg8::SchedPlainT<1> S; S.init(NLAT, 1536, DM, (const bf16_t*)(P.ws + WS_W + OFF_WQKV8), F.G, F.bid);
    EpiQkv2 E{(bf16_t*)(P.ws + WS_QKV + OFF_Q2), (bf16_t*)(P.ws + WS_QKV + OFF_K2), (bf16_t*)(P.ws + WS_QKV + OFF_V2), (const float*)(P.ws + WS_ROPE)};
    pg8::gemm_phase<EpiQkv2, pg8::SchedPlainT<1>, true>(F.lds, (const char*)(P.ws + WS_HB), DM, S, E);
    sg_ctx(F, (const bf16_t*)(P.ws + WS_HB), (const bf16_t*)(P.ws + WS_W + OFF_WQKV), DM, 1024, 1536, SgKv2Ctx{(char*)(P.ws + WS_QKV + OFF_K2), (char*)(P.ws + WS_QKV + OFF_V2)});
}

__global__ void __launch_bounds__(NTHREADS, 2) mk_fwd(Params KP) {
    extern __shared__ __attribute__((aligned(16))) unsigned char lds_raw[];
    Frame F;
    F.lds = (LAS unsigned char*)lds_raw; F.tid = threadIdx.x; F.lane = F.tid & 63; F.wave = __builtin_amdgcn_readfirstlane(F.tid >> 6); F.G = gridDim.x; F.bid = blockIdx.x;
    volatile LAS unsigned* MISC = (volatile LAS unsigned*)(F.lds + LDS_MISC);
    if (F.tid < 16) MISC[F.tid] = 0u;
    if (F.tid < 26) { const unsigned long long v = F.tid < 24 ? (unsigned long long)KP.in[F.tid] : (F.tid == 24 ? (unsigned long long)KP.out : (unsigned long long)KP.ws);
        ((LAS unsigned long long*)(F.lds + LDS_MISC + 64))[F.tid] = v; }
    if ((threadIdx.x & 63) == 0) ((LAS unsigned*)(F.lds + LDS_MISC + 512))[(unsigned)__builtin_amdgcn_s_getreg(0x2804) & 63u] = threadIdx.x >> 6;
    __syncthreads();
    const int lo = KP.ph_lo, hi = KP.ph_hi;
    const bool multi = (hi - lo) > 1;
    XcdBarrier bar; bar.bar = (unsigned*)(KP.ws + WS_CTL); bar.x = 0; bar.st = nullptr;
    if (multi) bar = xcd_barrier_post((unsigned*)(KP.ws + WS_CTL), MISC);
#ifndef PHMASK
#define PHMASK 0xFFFFFu
#endif
#define IN(k) ((((PHMASK) >> (k)) & 1u) && lo <= (k) && (k) < hi)
#define SEAM(k) do { if (IN(k) && IN((k) + 1)) xcd_barrier(bar); } while (0)
#ifndef PROBE_DUP
#define PROBE_DUP 0u
#endif
#define RUN(k, call) do { if (IN(k)) { Frame F; { int t_ = my_tid(); asm volatile("" : "+v"(t_)); F.lds = (LAS unsigned char*)lds_raw; F.tid = t_; F.lane = t_ & 63; \
        F.wave = __builtin_amdgcn_readfirstlane(t_ >> 6); F.G = gridDim.x; F.bid = blockIdx.x; } \
        call; if (((PROBE_DUP) >> (k)) & 1u) { xcd_barrier(bar); call; } } SEAM(k); } while (0)
#ifdef PROBE_UB
    RUN(PH_PRO, phase_ubench(F));
#endif
    RUN(PH_PRO, phase_prologue(F));
    RUN(PH_L0_NORM1, phase_norm1_l0(F));
#ifdef PROBE_RND
    if (PROBE_RND & 1) { RUN(PH_L0_WIN, phase_rnd(F, WS_HB, (size_t)NROW * DM * 2)); if (IN(PH_L0_WIN)) xcd_barrier(bar); }
#endif
    RUN(PH_L0_WIN, phase_gemm_win(F));
    RUN(PH_L0_PREUP, phase_preup(F));
#ifdef PROBE_RND
    if (PROBE_RND & 16) { RUN(PH_L0_UP, phase_rnd(F, WS_QN, (size_t)NROW * 384 * 2)); if (IN(PH_L0_UP)) xcd_barrier(bar); }
#endif
    RUN(PH_L0_UP, phase_gemm_up(F));
    RUN(PH_L0_ATTN, phase_attn_mla(F));
#ifdef PROBE_ATT_ABL
    RUN(PH_L0_ATTN, phase_attn_probe(F)); if (IN(PH_L0_ATTN)) xcd_barrier(bar);
#endif
#ifdef PROBE_RND
    if (PROBE_RND & 2) { RUN(PH_L0_WOUT, phase_rnd(F, WS_CAT, (size_t)NROW * DM * 2)); if (IN(PH_L0_WOUT)) xcd_barrier(bar); }
#endif
    RUN(PH_L0_WOUT, phase_gemm_wout(F, 0));
    RUN(PH_L0_NORM2, (phase_norm2m(F, 0), phase_norm2(F, 0, NLAT, NROW)));
    RUN(PH_L0_TOPK, phase_topk(F, 0));
    RUN(PH_L0_GU, phase_gemm_gu(F, 0));
    RUN(PH_L0_DOWN, phase_gemm_down(F, 0));
    RUN(PH_L0_COMB, phase_combine(F, 0));
#ifdef PROBE_COMB
    if (IN(PH_L0_COMB)) { Frame F; F.lds = (LAS unsigned char*)lds_raw; F.tid = my_tid(); F.lane = F.tid & 63; F.wave = __builtin_amdgcn_readfirstlane(F.tid >> 6); F.G = gridDim.x; F.bid = blockIdx.x; phase_combine<true>(F, PROBE_COMB); xcd_barrier(bar); }
#endif
#ifdef PROBE_RND
    if (PROBE_RND & 4) { RUN(PH_L1_QKV, phase_rnd(F, WS_HB, (size_t)NROW * DM * 2)); if (IN(PH_L1_QKV)) xcd_barrier(bar); }
#endif
    RUN(PH_L1_QKV, phase_gemm_qkv2(F));
#ifdef PROBE_RND
    if (PROBE_RND & 32) { RUN(PH_L1_ATTN, phase_rnd(F, WS_QKV + OFF_Q2, OFF_V2 + (size_t)NB * 4 * NKEY * 64 * 2 - OFF_Q2)); if (IN(PH_L1_ATTN)) xcd_barrier(bar); }
#endif
    RUN(PH_L1_ATTN, phase_attn_swa(F));
#ifdef PROBE_RND
    if (PROBE_RND & 8) { RUN(PH_L1_WOUT, phase_rnd(F, WS_CAT, (size_t)NLAT * DM * 2)); if (IN(PH_L1_WOUT)) xcd_barrier(bar); }
#endif
    RUN(PH_L1_WOUT, phase_gemm_wout(F, 1));
    RUN(PH_L1_NORM2, phase_norm2m(F, 1));
    RUN(PH_L1_TOPK, phase_topk(F, 1));
    RUN(PH_L1_GU, phase_gemm_gu(F, 1));
    RUN(PH_L1_DOWN, phase_gemm_down(F, 1));
    RUN(PH_L1_COMB, phase_combine(F, 1));
#undef IN
#undef SEAM
#undef RUN
}

static void launch_phase(hipStream_t s, int grid, const Params& base, int lo, int hi) {
  Params p = base; p.ph_lo = lo; p.ph_hi = hi;
  hipLaunchKernelGGL(mk_fwd, dim3(grid), dim3(NTHREADS), LDS_BYTES, s, p);
}

extern "C" void kernel_launch(void* const* d_in, const int* in_sizes, int n_in, void* d_out, int out_size, void* d_ws, size_t ws_size, hipStream_t stream) {
  static int grid = 0;
  if (grid == 0) {
    if (n_in != 24 || ws_size < WS_END || out_size != NLAT * DM) { fprintf(stderr, "kernel_launch: bad sizes n_in %d ws %zu (need %zu) out %d\n", n_in, ws_size, (size_t)WS_END, out_size); grid = -1; return; }
    int dev = 0, cus = 0;
    if (hipGetDevice(&dev) != hipSuccess || hipDeviceGetAttribute(&cus, hipDeviceAttributeMultiprocessorCount, dev) != hipSuccess) { grid = -1; return; }
    if (hipFuncSetAttribute((const void*)mk_fwd, hipFuncAttributeMaxDynamicSharedMemorySize, LDS_BYTES) != hipSuccess) { fprintf(stderr, "kernel_launch: hipFuncSetAttribute failed\n"); grid = -1; return; }
    int per_cu = 0;
    if (hipOccupancyMaxActiveBlocksPerMultiprocessor(&per_cu, (const void*)mk_fwd, NTHREADS, LDS_BYTES) != hipSuccess || per_cu < 1) { fprintf(stderr, "kernel_launch: occupancy query says %d\n", per_cu); grid = -1; return; }
    grid = cus;
  }
  if (grid < 0) return;
  Params P{};
  for (int i = 0; i < 24; ++i) P.in[i] = (const float*)d_in[i];
  P.out = (float*)d_out; P.ws = (unsigned char*)d_ws; P.ph_lo = 0; P.ph_hi = 0;
  if (hipMemsetAsync((char*)d_ws + WS_CTL, 0, CTL_BYTES, stream) != hipSuccess) return;
#ifdef MK_PER_PHASE
  for (int ph = 0; ph < PH_COUNT; ++ph) launch_phase(stream, grid, P, ph, ph + 1);
#else
  launch_phase(stream, grid, P, 0, PH_COUNT);
#endif
}
```
